# Optimizing an MI355X kernel written in HIP

```python
import math
import jax, jax.numpy as jnp
from jax import lax
import numpy as np

D_MODEL = 1024
BATCH = 8
SEQ = 8192
DEPTH = 2

CTX_LEN = 256
GRID_W = 64
QBLOCK = 128
WINDOW = 128
ROPE_THETA = 10000.0
EPS = 1e-6
NEG_INF = -1e30
D_FF = 2816
N_SUBLAYERS = 3
N_BRANCH = 4

HEAD_DIM = 64
GQA_HEADS = 4
GQA_KV_HEADS = 2
MLA_HEADS = 4
MLA_Q_RANK = 256
MLA_KV_RANK = 128
MLA_NOPE = 64
MLA_ROPE = 32
MLA_V = 64
DIFF_HEADS = 4
DIFF_QK = 32
DIFF_V = 2 * DIFF_QK
SWA_HEADS = 4
SWA_KV_HEADS = 2
BRANCH_W = 256

GQA_COLS = (GQA_HEADS + 2 * GQA_KV_HEADS) * HEAD_DIM
MLA_COLS = MLA_Q_RANK + MLA_KV_RANK + MLA_ROPE
DIFF_COLS = DIFF_HEADS * (4 * DIFF_QK + DIFF_V)
SWA_COLS = (SWA_HEADS + 2 * SWA_KV_HEADS) * HEAD_DIM
GATE_COLS = N_BRANCH * D_MODEL
IN_SPLITS = [GQA_COLS, GQA_COLS + MLA_COLS, GQA_COLS + MLA_COLS + DIFF_COLS,
             GQA_COLS + MLA_COLS + DIFF_COLS + SWA_COLS]
IN_COLS = IN_SPLITS[-1] + GATE_COLS

GQA_SCALE = HEAD_DIM ** -0.5
MLA_SCALE = (MLA_NOPE + MLA_ROPE) ** -0.5
DIFF_SCALE = DIFF_QK ** -0.5

kernel_name = 'hybrid_parallel_mixer_dit_block'


def rms_norm(x, g):
    xf = x.astype(jnp.float32)
    y = xf * lax.rsqrt(jnp.mean(xf * xf, axis=-1, keepdims=True) + EPS)
    return (y * g.astype(jnp.float32)).astype(x.dtype)


def adaln(x, g, shift, scale):
    return rms_norm(x, g) * (1 + scale[:, None, :]) + shift[:, None, :]


def swiglu(x, w_gate, w_up, w_down):
    return (jax.nn.silu(x @ w_gate) * (x @ w_up)) @ w_down


def ffn_half(x, mod_s, g_pre, g_post, w_gate, w_up, w_down):
    u = adaln(x, g_pre, mod_s[:, 0], mod_s[:, 1])
    return x + 0.5 * mod_s[:, 2][:, None, :] * rms_norm(swiglu(u, w_gate, w_up, w_down), g_post)


def axial_rope_tables(n_tokens, rot_dim):
    rows = n_tokens // GRID_W
    row = jnp.repeat(jnp.arange(rows, dtype=jnp.float32), GRID_W)
    col = jnp.tile(jnp.arange(GRID_W, dtype=jnp.float32), rows)
    half = rot_dim // 2
    inv_freq = ROPE_THETA ** (-jnp.arange(0, half, 2, dtype=jnp.float32) / half)
    ang_r = row[:, None] * inv_freq[None, :]
    ang_c = col[:, None] * inv_freq[None, :]
    return (jnp.cos(ang_r), jnp.sin(ang_r), jnp.cos(ang_c), jnp.sin(ang_c))


def _rotate(x, cos, sin):
    n = x.shape[-1] // 2
    x1, x2 = x[..., :n], x[..., n:]
    cos, sin = cos[:, None, :], sin[:, None, :]
    return jnp.concatenate([x1 * cos - x2 * sin, x2 * cos + x1 * sin], axis=-1)


def apply_axial_rope(x, rope):
    if rope is None:
        return x
    cos_r, sin_r, cos_c, sin_c = rope
    h = x.shape[-1] // 2
    out = jnp.concatenate([_rotate(x[..., :h], cos_r, sin_r), _rotate(x[..., h:], cos_c, sin_c)], axis=-1)
    return out.astype(x.dtype)


def q_heads(q, n_kv):
    B, T, H, d = q.shape
    return q.reshape(B, T, n_kv, H // n_kv, d).transpose(0, 2, 3, 1, 4)


def kv_heads(k):
    return k.transpose(0, 2, 1, 3)


def merge_heads(o):
    B, K, G, T, d = o.shape
    return o.transpose(0, 3, 1, 2, 4).reshape(B, T, K * G * d)


def gqa_proj(h, n_heads, n_kv, rope, q_gain=None, k_gain=None):
    B, T, _ = h.shape
    q, k, v = jnp.split(h, [n_heads * HEAD_DIM, (n_heads + n_kv) * HEAD_DIM], axis=-1)
    q = q.reshape(B, T, n_heads, HEAD_DIM)
    k = k.reshape(B, T, n_kv, HEAD_DIM)
    v = v.reshape(B, T, n_kv, HEAD_DIM)
    if q_gain is not None:
        q = rms_norm(q, q_gain)
        k = rms_norm(k, k_gain)
    q = apply_axial_rope(q, rope)
    k = apply_axial_rope(k, rope)
    return q_heads(q, n_kv), kv_heads(k), kv_heads(v)


def mla_proj(h, q_gain, kv_gain, w_uq, w_ukv, rope):
    B, T, _ = h.shape
    c_q, c_kv, k_pe = jnp.split(h, [MLA_Q_RANK, MLA_Q_RANK + MLA_KV_RANK], axis=-1)
    q = (rms_norm(c_q, q_gain) @ w_uq).reshape(B, T, MLA_HEADS, MLA_NOPE + MLA_ROPE)
    kv = (rms_norm(c_kv, kv_gain) @ w_ukv).reshape(B, T, MLA_HEADS, MLA_NOPE + MLA_V)
    q_nope, q_pe = q[..., :MLA_NOPE], q[..., MLA_NOPE:]
    k_nope, v = kv[..., :MLA_NOPE], kv[..., MLA_NOPE:]
    q_pe = apply_axial_rope(q_pe, rope)
    k_pe = apply_axial_rope(k_pe[:, :, None, :], rope)
    q = jnp.concatenate([q_nope, q_pe], axis=-1)
    k = jnp.concatenate([k_nope, jnp.broadcast_to(k_pe, (B, T, MLA_HEADS, MLA_ROPE))], axis=-1)
    return q_heads(q, MLA_HEADS), kv_heads(k), kv_heads(v)


def diff_proj(h, rope):
    B, T, _ = h.shape
    q, k, v = jnp.split(h, [2 * DIFF_HEADS * DIFF_QK, 4 * DIFF_HEADS * DIFF_QK], axis=-1)
    q = apply_axial_rope(q.reshape(B, T, 2 * DIFF_HEADS, DIFF_QK), rope).reshape(B, T, DIFF_HEADS, 2, DIFF_QK)
    k = apply_axial_rope(k.reshape(B, T, 2 * DIFF_HEADS, DIFF_QK), rope).reshape(B, T, DIFF_HEADS, 2, DIFF_QK)
    v = v.reshape(B, T, DIFF_HEADS, DIFF_V)
    return (q_heads(q[..., 0, :], DIFF_HEADS), q_heads(q[..., 1, :], DIFF_HEADS),
            kv_heads(k[..., 0, :]), kv_heads(k[..., 1, :]), kv_heads(v))


def sweep_query_blocks(block_fn, *qs):
    S = qs[0].shape[-2]
    nb = S // QBLOCK

    def split(a):
        return jnp.moveaxis(a.reshape(a.shape[:-2] + (nb, QBLOCK, a.shape[-1])), -3, 0)

    out = lax.map(lambda xs: block_fn(xs[0], *xs[1]), (jnp.arange(nb), tuple(split(a) for a in qs)))
    out = jnp.moveaxis(out, 0, -3)
    return out.reshape(out.shape[:-3] + (S, out.shape[-1]))


def _scores(q, k, scale):
    return jnp.einsum('bkgqd,bktd->bkgqt', q, k, preferred_element_type=jnp.float32) * scale


def _weigh(p, v):
    return jnp.einsum('bkgqt,bktd->bkgqd', p.astype(v.dtype), v)


def _sink_column(sink, s):
    return jnp.broadcast_to(sink.astype(jnp.float32)[None, :, :, None, None], s.shape[:-1] + (1,))


def dense_attention(q, k, v, scale, sink=None):
    def block(b, qb):
        s = _scores(qb, k, scale)
        if sink is None:
            return _weigh(jax.nn.softmax(s, axis=-1), v)
        p = jax.nn.softmax(jnp.concatenate([s, _sink_column(sink, s)], axis=-1), axis=-1)[..., :-1]
        return _weigh(p, v)
    return sweep_query_blocks(block, q)


def diff_attention(q1, q2, k1, k2, v, lam, scale):
    def block(b, q1b, q2b):
        p = (jax.nn.softmax(_scores(q1b, k1, scale), axis=-1)
             - lam * jax.nn.softmax(_scores(q2b, k2, scale), axis=-1))
        return _weigh(p, v)
    return sweep_query_blocks(block, q1, q2)


def window_attention(q, k, v, k_ctx, v_ctx, sink, scale):
    S = q.shape[-2]
    pad = ((0, 0), (0, 0), (QBLOCK, QBLOCK), (0, 0))
    k_pad, v_pad = jnp.pad(k, pad), jnp.pad(v, pad)
    qi = jnp.arange(QBLOCK)[:, None]
    kj = jnp.arange(3 * QBLOCK)[None, :]
    band = jnp.abs(kj - qi - QBLOCK) <= WINDOW

    def block(b, qb):
        kb = lax.dynamic_slice_in_dim(k_pad, b * QBLOCK, 3 * QBLOCK, axis=2)
        vb = lax.dynamic_slice_in_dim(v_pad, b * QBLOCK, 3 * QBLOCK, axis=2)
        j = (b - 1) * QBLOCK + kj
        allowed = band & (j >= 0) & (j < S)
        s_lat = jnp.where(allowed, _scores(qb, kb, scale), NEG_INF)
        s_ctx = _scores(qb, k_ctx, scale)
        s = jnp.concatenate([s_ctx, s_lat, _sink_column(sink, s_lat)], axis=-1)
        p = jax.nn.softmax(s, axis=-1)[..., :-1]
        return _weigh(p, jnp.concatenate([v_ctx, vb], axis=2))
    return sweep_query_blocks(block, q)


def diff_finish(o, gain, lam_init):
    return merge_heads(rms_norm(o, gain) * (1 - lam_init))


def diff_lambda_init(layer):
    return 0.8 - 0.6 * math.exp(-0.3 * layer)


def merge_branches(h_gate, outs, w_branch, w_out):
    g = jax.nn.sigmoid(h_gate.reshape(h_gate.shape[:-1] + (N_BRANCH, D_MODEL)))
    y = g[..., 0, :] * (outs[0] @ w_branch[0])
    for i in range(1, N_BRANCH):
        y = y + g[..., i, :] * (outs[i] @ w_branch[i])
    return y @ w_out


def token_mixers(u, u_c, w_in, gqa_q_norm, gqa_k_norm, mla_q_norm, mla_kv_norm, mla_w_uq, mla_w_ukv,
                 diff_lambda, diff_subln, swa_sink, w_branch, w_out, lam_init, ropes, need_ctx):
    h = jnp.split(u @ w_in, IN_SPLITS, axis=-1)
    hc = jnp.split(u_c @ w_in, IN_SPLITS, axis=-1)
    sink = swa_sink.reshape(SWA_KV_HEADS, SWA_HEADS // SWA_KV_HEADS)
    lf = diff_lambda.astype(jnp.float32)
    lam = jnp.exp(jnp.sum(lf[0] * lf[1])) - jnp.exp(jnp.sum(lf[2] * lf[3])) + lam_init

    def cat(a_ctx, a_lat):
        return jnp.concatenate([a_ctx, a_lat], axis=2)

    qa, ka, va = gqa_proj(h[0], GQA_HEADS, GQA_KV_HEADS, ropes[HEAD_DIM], gqa_q_norm, gqa_k_norm)
    qa_c, ka_c, va_c = gqa_proj(hc[0], GQA_HEADS, GQA_KV_HEADS, None, gqa_q_norm, gqa_k_norm)
    qm, km, vm = mla_proj(h[1], mla_q_norm, mla_kv_norm, mla_w_uq, mla_w_ukv, ropes[MLA_ROPE])
    qm_c, km_c, vm_c = mla_proj(hc[1], mla_q_norm, mla_kv_norm, mla_w_uq, mla_w_ukv, None)
    q1, q2, k1, k2, vd = diff_proj(h[2], ropes[DIFF_QK])
    q1_c, q2_c, k1_c, k2_c, vd_c = diff_proj(hc[2], None)
    qs, ks, vs = gqa_proj(h[3], SWA_HEADS, SWA_KV_HEADS, ropes[HEAD_DIM])
    qs_c, ks_c, vs_c = gqa_proj(hc[3], SWA_HEADS, SWA_KV_HEADS, None)

    outs = [merge_heads(dense_attention(qa, cat(ka_c, ka), cat(va_c, va), GQA_SCALE)),
            merge_heads(dense_attention(qm, cat(km_c, km), cat(vm_c, vm), MLA_SCALE)),
            diff_finish(diff_attention(q1, q2, cat(k1_c, k1), cat(k2_c, k2), cat(vd_c, vd), lam, DIFF_SCALE),
                        diff_subln, lam_init),
            merge_heads(window_attention(qs, ks, vs, ks_c, vs_c, sink, GQA_SCALE))]
    y = merge_branches(h[4], outs, w_branch, w_out)
    if not need_ctx:
        return y, None
    outs_c = [merge_heads(dense_attention(qa_c, ka_c, va_c, GQA_SCALE)),
              merge_heads(dense_attention(qm_c, km_c, vm_c, MLA_SCALE)),
              diff_finish(diff_attention(q1_c, q2_c, k1_c, k2_c, vd_c, lam, DIFF_SCALE), diff_subln, lam_init),
              merge_heads(dense_attention(qs_c, ks_c, vs_c, GQA_SCALE, sink))]
    return y, merge_branches(hc[4], outs_c, w_branch, w_out)


def setup_inputs(seed: int = 0) -> dict:
    key = jax.random.key(seed)
    ks = jax.random.split(key, 23)

    def nrm(k, shape, s):
        return s * jax.random.normal(k, shape, jnp.float32)

    def gain(k, shape):
        return 1.0 + 0.05 * jax.random.normal(k, shape, jnp.float32)

    D = D_MODEL
    return {
        'x': nrm(ks[0], (BATCH, SEQ, D), 1.0),
        'c': nrm(ks[1], (BATCH, D), 1.0),
        'ctx': nrm(ks[2], (BATCH, CTX_LEN, D), 1.0),
        'c_ctx': nrm(ks[3], (D,), 1.0),
        'w_mod': nrm(ks[4], (DEPTH, D, N_SUBLAYERS * 3 * D), 0.5 * D ** -0.5),
        'b_mod': nrm(ks[5], (DEPTH, N_SUBLAYERS * 3 * D), 0.02),
        'g_pre': gain(ks[6], (DEPTH, N_SUBLAYERS, D)),
        'g_post': gain(ks[7], (DEPTH, N_SUBLAYERS, D)),
        'w_ffn_gate': nrm(ks[8], (DEPTH, 2, D, D_FF), D ** -0.5),
        'w_ffn_up': nrm(ks[9], (DEPTH, 2, D, D_FF), D ** -0.5),
        'w_ffn_down': nrm(ks[10], (DEPTH, 2, D_FF, D), D_FF ** -0.5),
        'w_in': nrm(ks[11], (DEPTH, D, IN_COLS), D ** -0.5),
        'gqa_q_norm': gain(ks[12], (DEPTH, HEAD_DIM)),
        'gqa_k_norm': gain(ks[13], (DEPTH, HEAD_DIM)),
        'mla_q_norm': gain(ks[14], (DEPTH, MLA_Q_RANK)),
        'mla_kv_norm': gain(ks[15], (DEPTH, MLA_KV_RANK)),
        'mla_w_uq': nrm(ks[16], (DEPTH, MLA_Q_RANK, MLA_HEADS * (MLA_NOPE + MLA_ROPE)), MLA_Q_RANK ** -0.5),
        'mla_w_ukv': nrm(ks[17], (DEPTH, MLA_KV_RANK, MLA_HEADS * (MLA_NOPE + MLA_V)), MLA_KV_RANK ** -0.5),
        'diff_lambda': nrm(ks[18], (DEPTH, 4, DIFF_QK), 0.1),
        'diff_subln': gain(ks[19], (DEPTH, DIFF_V)),
        'swa_sink': nrm(ks[20], (DEPTH, SWA_HEADS), 0.5),
        'w_branch': nrm(ks[21], (DEPTH, N_BRANCH, BRANCH_W, D), BRANCH_W ** -0.5),
        'w_out': nrm(ks[22], (DEPTH, D, D), D ** -0.5),
    }


def reference(x, c, ctx, c_ctx, w_mod, b_mod, g_pre, g_post, w_ffn_gate, w_ffn_up, w_ffn_down, w_in,
              gqa_q_norm, gqa_k_norm, mla_q_norm, mla_kv_norm, mla_w_uq, mla_w_ukv,
              diff_lambda, diff_subln, swa_sink, w_branch, w_out):
    S = x.shape[1]
    ropes = {d: axial_rope_tables(S, d) for d in (HEAD_DIM, MLA_ROPE, DIFF_QK)}
    silu_c = jax.nn.silu(c)
    silu_cc = jax.nn.silu(c_ctx)[None, :]
    for l in range(DEPTH):
        need_ctx = l < DEPTH - 1
        mod = (silu_c @ w_mod[l] + b_mod[l]).reshape(-1, N_SUBLAYERS, 3, D_MODEL)
        mod_c = (silu_cc @ w_mod[l] + b_mod[l]).reshape(1, N_SUBLAYERS, 3, D_MODEL)
        ffn1 = (w_ffn_gate[l, 0], w_ffn_up[l, 0], w_ffn_down[l, 0])
        ffn2 = (w_ffn_gate[l, 1], w_ffn_up[l, 1], w_ffn_down[l, 1])
        x = ffn_half(x, mod[:, 0], g_pre[l, 0], g_post[l, 0], *ffn1)
        ctx = ffn_half(ctx, mod_c[:, 0], g_pre[l, 0], g_post[l, 0], *ffn1)
        u = adaln(x, g_pre[l, 1], mod[:, 1, 0], mod[:, 1, 1])
        u_c = adaln(ctx, g_pre[l, 1], mod_c[:, 1, 0], mod_c[:, 1, 1])
        y, y_c = token_mixers(u, u_c, w_in[l], gqa_q_norm[l], gqa_k_norm[l], mla_q_norm[l], mla_kv_norm[l],
                              mla_w_uq[l], mla_w_ukv[l], diff_lambda[l], diff_subln[l], swa_sink[l],
                              w_branch[l], w_out[l], diff_lambda_init(l), ropes, need_ctx)
        x = x + mod[:, 1, 2][:, None, :] * rms_norm(y, g_post[l, 1])
        x = ffn_half(x, mod[:, 2], g_pre[l, 2], g_post[l, 2], *ffn2)
        if need_ctx:
            ctx = ctx + mod_c[:, 1, 2][:, None, :] * rms_norm(y_c, g_post[l, 1])
            ctx = ffn_half(ctx, mod_c[:, 2], g_pre[l, 2], g_post[l, 2], *ffn2)
    return x
```

```cpp
#include <hip/hip_runtime.h>
#include <hip/hip_cooperative_groups.h>
#include <cstdio>
#include <cstdint>
namespace cg = cooperative_groups;

#define LAS __attribute__((address_space(3)))
typedef unsigned short bf16_t;
typedef short bf16x8 __attribute__((ext_vector_type(8)));
typedef short s16x4 __attribute__((ext_vector_type(4)));
typedef float f32x4 __attribute__((ext_vector_type(4)));
typedef float f32x16 __attribute__((ext_vector_type(16)));
typedef unsigned u32x4 __attribute__((ext_vector_type(4)));
typedef unsigned u32x2 __attribute__((ext_vector_type(2)));

constexpr int DM = 1024, NB = 8, SEQ = 8192, CTX = 256, RPB = SEQ + CTX, R = NB * RPB, DFF = 2816;
constexpr int NHIN = 2304, INCOLS = 6304, GATE0 = 2208;
constexpr int MODW = 9216;
constexpr float EPS = 1e-6f;
constexpr float LOG2E = 1.4426950408889634f;
constexpr float QS_GQA = 0.125f * LOG2E, QS_MLA = 0.10206207261596577f * LOG2E, QS_DIFF = 0.17677669529663687f * LOG2E;

constexpr size_t MiB = 1u << 20;
constexpr size_t WS_MOD = 0;
constexpr size_t WS_XC = 2 * MiB;
constexpr size_t WS_W = 10 * MiB;
constexpr size_t W_GU = 0, W_GU_SZ = (size_t)5632 * 1024 * 2;
constexpr size_t W_D = W_GU + 2 * W_GU_SZ, W_D_SZ = (size_t)1024 * 2816 * 2;
constexpr size_t W_IN = W_D + 2 * W_D_SZ, W_IN_SZ = (size_t)NHIN * 1024 * 2;
constexpr size_t W_G = W_IN + W_IN_SZ, W_G_SZ = (size_t)4096 * 1024 * 2;
constexpr size_t W_BR = W_G + W_G_SZ;
constexpr size_t W_OUT = W_BR + W_G_SZ, W_OUT_SZ = (size_t)1024 * 1024 * 2;
constexpr size_t W_MLA = W_OUT + W_OUT_SZ, W_MLA_SZ = (size_t)1024 * 384 * 2;
constexpr size_t W_LAYER = W_MLA + W_MLA_SZ;
static_assert(WS_W + 2 * W_LAYER <= 124 * MiB, "weights");
constexpr size_t ROWBUF = (size_t)R * 1024 * 2;
constexpr size_t WS_U = 124 * MiB;
constexpr size_t WS_Y = WS_U + ROWBUF;
constexpr size_t WS_BIG = WS_Y + ROWBUF;
constexpr size_t WS_OUTS = WS_BIG + (size_t)R * NHIN * 2;
constexpr size_t WS_VT = WS_OUTS + ROWBUF;
constexpr size_t WS_GSCR = WS_VT + (size_t)NB * 768 * RPB * 2;
constexpr size_t WS_END = WS_GSCR + 256 * 131072;
static_assert(WS_END <= 1024 * MiB, "ws");
static_assert(WS_BIG + (size_t)R * DFF * 2 <= WS_END, "H");

constexpr int LDS_BYTES = 147456;

__device__ __forceinline__ unsigned f2bf(float f) { unsigned u = __builtin_bit_cast(unsigned, f); return (u + 0x7fffu + ((u >> 16) & 1u)) >> 16; }
__device__ __forceinline__ unsigned pk2(float lo, float hi) { return f2bf(lo) | (f2bf(hi) << 16); }
__device__ __forceinline__ float bf2f(unsigned short h) { return __builtin_bit_cast(float, (unsigned)h << 16); }
__device__ __forceinline__ float bflo(unsigned w) { return __builtin_bit_cast(float, w << 16); }
__device__ __forceinline__ float bfhi(unsigned w) { return __builtin_bit_cast(float, w & 0xffff0000u); }
__device__ __forceinline__ float wave_sum(float v) {
#pragma unroll
    for (int o = 1; o < 64; o <<= 1) v += __shfl_xor(v, o);
    return v;
}
__device__ __forceinline__ int ptid() { int t = threadIdx.x; asm volatile("" : "+v"(t)); return t; }
__device__ __forceinline__ float fexp2(float x) { return __builtin_amdgcn_exp2f(x); }
__device__ __forceinline__ float frcp(float x) { return __builtin_amdgcn_rcpf(x); }
__device__ __forceinline__ float sigmoidf_(float x) { return frcp(1.f + fexp2(-x * LOG2E)); }

namespace pg8 {
constexpr int BM = 256, BK = 64, HALF = 128, HTB = HALF * BK * 2, STAGE_BYTES = 8 * HTB, NXCD = 8, WGM = 8;
__device__ __forceinline__ int lds_byte(int r, int c) { const int st = (r >> 4) * 2 + (c >> 5), rr = r & 15, cc = c & 31, ob = rr * 64 + cc * 2; return st * 1024 + (ob ^ (((ob >> 9) & 1) << 5)); }
__device__ __forceinline__ void stage_rc(int b, int& Rr, int& C) { const int st = b / 1024, sb = b % 1024, swz = sb ^ (((sb >> 9) & 1) << 5); Rr = (st >> 1) * 16 + swz / 64; C = (st & 1) * 32 + (swz % 64) / 2; }
__device__ __forceinline__ int perm32(int rho) { const int n = rho >> 4, i = rho & 15; return 8 * (i >> 2) + 4 * n + (i & 3); }

struct Unit { int pm, pn, kind; };
struct Gemm { const bf16_t* A; const bf16_t* Bt; const bf16_t* A2; const bf16_t* Bt2; int lda, ldb, K; };

struct StaticOrder {
    int nM, nN, nwg, G, c, dual;
    __device__ void init(int M, int N, int G_, int c_, int dual_) { nM = M / BM; nN = N / BM; nwg = nM * nN; G = G_; c = c_; dual = dual_; }
    __device__ bool next(int i, Unit& u) const {
        const int ii = dual ? (i >> 1) : i;
        u.kind = dual ? (i & 1) : 0;
        const long L = (long)ii * G + c; if (L >= nwg) return false;
        int wgid = (int)L; { const int q = nwg / NXCD, r = nwg % NXCD, xcd = wgid % NXCD, off = wgid / NXCD; wgid = (xcd < r ? xcd * (q + 1) : r * (q + 1) + (xcd - r) * q) + off; }
        const int nig = WGM * nN, gid = wgid / nig, fm = gid * WGM, gsz = (nM - fm) < WGM ? (nM - fm) : WGM;
        u.pm = fm + ((wgid % nig) % gsz); u.pn = (wgid % nig) / gsz; return true;
    }
};

typedef float f32x2_t __attribute__((ext_vector_type(2))); typedef __bf16 bf16x2_t __attribute__((ext_vector_type(2)));
__device__ __forceinline__ unsigned cvt_pk_bf16(float lo, float hi) { f32x2_t v = {lo, hi}; bf16x2_t b = __builtin_convertvector(v, bf16x2_t); return __builtin_bit_cast(unsigned, b); }

struct Epi {
    int mode; bf16_t* O; int ldc; u32x4* scr;
    __device__ __forceinline__ void operator()(const f32x4 (&acc)[2][2][4][2], const Unit& u, int wr, int wc, int fr, int fq) const {
        const int row0 = u.pm * BM + wr * 64 + fr;
        if (mode == 0) {
            const int col0 = u.pn * BM + wc * 32 + 8 * fq;
#pragma unroll
            for (int ai = 0; ai < 2; ++ai)
#pragma unroll
                for (int m = 0; m < 4; ++m) { bf16_t* rowp = O + (size_t)(row0 + ai * HALF + m * 16) * ldc + col0;
#pragma unroll
                    for (int bj = 0; bj < 2; ++bj) { const f32x4 v0 = acc[ai][bj][m][0], v1 = acc[ai][bj][m][1];
                        u32x4 w; w.x = cvt_pk_bf16(v0[0], v0[1]); w.y = cvt_pk_bf16(v0[2], v0[3]); w.z = cvt_pk_bf16(v1[0], v1[1]); w.w = cvt_pk_bf16(v1[2], v1[3]);
                        *(u32x4*)(rowp + bj * HALF) = w; } }
        } else if (mode == 1) {
            const int col0 = u.pn * HALF + wc * 32 + 8 * fq;
#pragma unroll
            for (int ai = 0; ai < 2; ++ai)
#pragma unroll
                for (int m = 0; m < 4; ++m) { bf16_t* rowp = O + (size_t)(row0 + ai * HALF + m * 16) * ldc + col0;
                    float h[8];
#pragma unroll
                    for (int n = 0; n < 2; ++n)
#pragma unroll
                        for (int e = 0; e < 4; ++e) { const float g = acc[ai][0][m][n][e], up = acc[ai][1][m][n][e]; h[n * 4 + e] = g * sigmoidf_(g) * up; }
                    u32x4 w; w.x = cvt_pk_bf16(h[0], h[1]); w.y = cvt_pk_bf16(h[2], h[3]); w.z = cvt_pk_bf16(h[4], h[5]); w.w = cvt_pk_bf16(h[6], h[7]);
                    *(u32x4*)rowp = w; }
        } else if (mode == 3) {
            const int col0 = u.pn * BM + wc * 32 + 8 * fq;
#pragma unroll
            for (int ai = 0; ai < 2; ++ai)
#pragma unroll
                for (int m = 0; m < 4; ++m) { bf16_t* rowp = O + (size_t)(row0 + ai * HALF + m * 16) * ldc + col0;
#pragma unroll
                    for (int bj = 0; bj < 2; ++bj) { const f32x4 v0 = acc[ai][bj][m][0], v1 = acc[ai][bj][m][1];
                        u32x4 w; w.x = cvt_pk_bf16(sigmoidf_(v0[0]), sigmoidf_(v0[1])); w.y = cvt_pk_bf16(sigmoidf_(v0[2]), sigmoidf_(v0[3]));
                        w.z = cvt_pk_bf16(sigmoidf_(v1[0]), sigmoidf_(v1[1])); w.w = cvt_pk_bf16(sigmoidf_(v1[2]), sigmoidf_(v1[3]));
                        *(u32x4*)(rowp + bj * HALF) = w; } }
        } else {
            const int gcol0 = u.pn * BM + wc * 32 + 8 * fq, col0 = u.pn * 64 + wc * 16 + 4 * fq;
#pragma unroll
            for (int ai = 0; ai < 2; ++ai)
#pragma unroll
                for (int m = 0; m < 4; ++m) { float y0 = 0.f, y1 = 0.f, y2 = 0.f, y3 = 0.f;
                    const bf16_t* gp = (const bf16_t*)scr + (size_t)(row0 + ai * HALF + m * 16) * 4096 + gcol0;
#pragma unroll
                    for (int bj = 0; bj < 2; ++bj) { const u32x4 w = *(const u32x4*)(gp + bj * HALF); const f32x4 v0 = acc[ai][bj][m][0], v1 = acc[ai][bj][m][1];
                        y0 += bflo(w.x) * v0[0] + bflo(w.z) * v1[0]; y1 += bfhi(w.x) * v0[1] + bfhi(w.z) * v1[1];
                        y2 += bflo(w.y) * v0[2] + bflo(w.w) * v1[2]; y3 += bfhi(w.y) * v0[3] + bfhi(w.w) * v1[3]; }
                    u32x2 o; o.x = cvt_pk_bf16(y0, y1); o.y = cvt_pk_bf16(y2, y3);
                    *(u32x2*)(O + (size_t)(row0 + ai * HALF + m * 16) * ldc + col0) = o; }
        }
    }
};

template <class Sched>
__device__ __forceinline__ void gemm_phase(LAS unsigned char* lds, const Gemm g, const Sched& S, const Epi& E) {
    const int tid = ptid(), wid = __builtin_amdgcn_readfirstlane(tid >> 6), lane = tid & 63, wr = wid >> 2, wc = wid & 3, fr = lane & 15, fq = lane >> 4;
    const int K = g.K, nt = K / BK;
    unsigned voffA[2], voffB[2];
#pragma unroll
    for (int i = 0; i < 2; ++i) { int Rr, C; stage_rc(tid * 16 + i * 8192, Rr, C); const int Rb = (Rr & ~31) + perm32(Rr & 31);
        voffA[i] = (unsigned)(Rr * g.lda + C) * 2u; voffB[i] = (unsigned)(Rb * g.ldb + C) * 2u; }
    const size_t kstep = (size_t)(BK * 2);
    const size_t hsA = (size_t)HALF * g.lda * 2, hsB = (size_t)HALF * g.ldb * 2;
    const size_t tsA = 2 * hsA, tsB = 2 * hsB;
    const unsigned ldsw = (unsigned)wid * 1024u;
    const int aoff = lds_byte(wr * 64 + fr, fq * 8), boff = lds_byte(wc * 32 + fr, fq * 8);
#define PG8_SA(b, h) (((b) * 2 + (h)) * HTB)
#define PG8_SB(b, h) ((4 + (b) * 2 + (h)) * HTB)
#define PG8_STAGE(bufoff, gbase, voff) do { _Pragma("unroll") for (int _i = 0; _i < 2; ++_i) \
        __builtin_amdgcn_global_load_lds((const unsigned*)((const char*)(gbase) + (voff)[_i]), (LAS unsigned*)(lds + (bufoff) + ldsw + _i * 8192), 16, 0, 0); } while (0)
#define PG8_LDA(dst, b, h) do { _Pragma("unroll") for (int m = 0; m < 4; ++m) _Pragma("unroll") for (int k = 0; k < 2; ++k) dst[m][k] = *(const LAS bf16x8*)(lds + PG8_SA(b, h) + aoff + m * 2048 + k * 1024); } while (0)
#define PG8_LDB(dst, b, h) do { _Pragma("unroll") for (int n = 0; n < 2; ++n) _Pragma("unroll") for (int k = 0; k < 2; ++k) dst[n][k] = *(const LAS bf16x8*)(lds + PG8_SB(b, h) + boff + n * 2048 + k * 1024); } while (0)
#define PG8_MMA(ai, bj, At, Bt) do { __builtin_amdgcn_s_setprio(1); _Pragma("unroll") for (int m = 0; m < 4; ++m) _Pragma("unroll") for (int n = 0; n < 2; ++n) _Pragma("unroll") for (int k = 0; k < 2; ++k) \
        acc[ai][bj][m][n] = __builtin_amdgcn_mfma_f32_16x16x32_bf16(Bt[n][k], At[m][k], acc[ai][bj][m][n], 0, 0, 0); __builtin_amdgcn_s_setprio(0); } while (0)
#define PG8_WAIT_V(n) asm volatile("s_waitcnt vmcnt(" #n ")" ::: "memory")
#define PG8_WAIT_L(n) asm volatile("s_waitcnt lgkmcnt(" #n ")" ::: "memory")
#define PG8_BAR __builtin_amdgcn_s_barrier()
#define PG8_SCHED __builtin_amdgcn_sched_barrier(0)
#define PG8_UA(u) ((const char*)((u).kind ? g.A2 : g.A) + (size_t)(u).pm * tsA)
#define PG8_UB(u) ((const char*)((u).kind ? g.Bt2 : g.Bt) + (size_t)(u).pn * tsB)
    Unit cur, nxt; int ui = 0;
    if (!S.next(0, cur)) return;
    f32x4 acc[2][2][4][2];
#pragma unroll
    for (int a = 0; a < 2; ++a)
#pragma unroll
        for (int b = 0; b < 2; ++b)
#pragma unroll
            for (int m = 0; m < 4; ++m)
#pragma unroll
                for (int n = 0; n < 2; ++n) acc[a][b][m][n] = (f32x4){0.f, 0.f, 0.f, 0.f};
    bf16x8 At[4][2], B0[2][2], B1[2][2];
    const char* cA = PG8_UA(cur); const char* cB = PG8_UB(cur);
    {
        PG8_STAGE(PG8_SB(0, 0), cB, voffB); PG8_STAGE(PG8_SB(0, 1), cB + hsB, voffB); PG8_STAGE(PG8_SA(0, 0), cA, voffA); PG8_STAGE(PG8_SA(0, 1), cA + hsA, voffA);
        if (wr == 1) PG8_BAR;
        PG8_WAIT_V(2); PG8_BAR;
        PG8_STAGE(PG8_SB(1, 0), cB + kstep, voffB); PG8_STAGE(PG8_SA(1, 0), cA + kstep, voffA); PG8_STAGE(PG8_SB(1, 1), cB + hsB + kstep, voffB);
        PG8_WAIT_V(6); PG8_BAR;
    }
    for (;;) {
        const bool has_next = S.next(ui + 1, nxt);
        const char* nA = has_next ? PG8_UA(nxt) : cA; const char* nB = has_next ? PG8_UB(nxt) : cB;
        for (int t = 0; t < nt; t += 2) {
            const bool last = (t == nt - 2);
            const char* a1 = cA + (size_t)(t + 1) * kstep;
            const char* a2 = last ? nA : cA + (size_t)(t + 2) * kstep; const char* b2 = last ? nB : cB + (size_t)(t + 2) * kstep;
            const char* a3 = a2 + kstep; const char* b3 = b2 + kstep;
            PG8_LDB(B0, 0, 0); PG8_LDB(B1, 0, 1); PG8_SCHED; PG8_LDA(At, 0, 0); PG8_STAGE(PG8_SA(1, 1), a1 + hsA, voffA);
            PG8_WAIT_V(8); PG8_WAIT_L(0); PG8_BAR; PG8_MMA(0, 0, At, B0); PG8_MMA(0, 1, At, B1); PG8_BAR; PG8_SCHED;
            PG8_LDA(At, 0, 1); PG8_STAGE(PG8_SB(0, 0), b2, voffB); PG8_STAGE(PG8_SB(0, 1), b2 + hsB, voffB); PG8_STAGE(PG8_SA(0, 0), a2, voffA);
            PG8_WAIT_V(8); PG8_WAIT_L(0); PG8_BAR; PG8_MMA(1, 0, At, B0); PG8_MMA(1, 1, At, B1); PG8_BAR; PG8_SCHED;
            PG8_LDB(B0, 1, 0); PG8_LDB(B1, 1, 1); PG8_SCHED; PG8_LDA(At, 1, 0); PG8_STAGE(PG8_SA(0, 1), a2 + hsA, voffA);
            PG8_WAIT_V(8); PG8_WAIT_L(0); PG8_BAR; PG8_MMA(0, 0, At, B0); PG8_MMA(0, 1, At, B1); PG8_BAR; PG8_SCHED;
            PG8_LDA(At, 1, 1); PG8_STAGE(PG8_SB(1, 0), b3, voffB); PG8_STAGE(PG8_SB(1, 1), b3 + hsB, voffB); PG8_STAGE(PG8_SA(1, 0), a3, voffA);
            PG8_WAIT_V(8); PG8_WAIT_L(0); PG8_BAR; PG8_MMA(1, 0, At, B0); PG8_MMA(1, 1, At, B1); PG8_BAR; PG8_SCHED;
        }
        if (wr == 0) PG8_BAR;
        E(acc, cur, wr, wc, fr, fq);
        if (!has_next) break;
#pragma unroll
        for (int a = 0; a < 2; ++a)
#pragma unroll
            for (int b = 0; b < 2; ++b)
#pragma unroll
                for (int m = 0; m < 4; ++m)
#pragma unroll
                    for (int n = 0; n < 2; ++n) acc[a][b][m][n] = (f32x4){0.f, 0.f, 0.f, 0.f};
        cur = nxt; cA = nA; cB = nB; ++ui;
        if (wr == 1) PG8_BAR;
    }
    PG8_WAIT_V(0);
    PG8_BAR;
#undef PG8_SA
#undef PG8_SB
#undef PG8_STAGE
#undef PG8_LDA
#undef PG8_LDB
#undef PG8_MMA
#undef PG8_WAIT_V
#undef PG8_WAIT_L
#undef PG8_BAR
#undef PG8_SCHED
#undef PG8_UA
#undef PG8_UB
}
}

struct Args {
    const float* x; const float* c; const float* ctx; const float* c_ctx; const float* w_mod; const float* b_mod; const float* g_pre; const float* g_post;
    const float* w_gate; const float* w_up; const float* w_down; const float* w_in; const float* gqa_qn; const float* gqa_kn; const float* mla_qn; const float* mla_kvn;
    const float* w_uq; const float* w_ukv; const float* dlam; const float* dsub; const float* sink; const float* w_branch; const float* w_out;
    float* out; unsigned char* ws; int ph_lo, ph_hi;
};
typedef const __attribute__((address_space(4))) Args CArgs;

template <class F>
__device__ __forceinline__ void conv_item(bf16_t* WT, int K, int nblk, int item, LAS float* scr, int lane, const F& f) {
    const int kb = item / nblk, nb = item % nblk, k0 = 64 * kb, n0 = 32 * nb;
#pragma unroll 8
    for (int i = 0; i < 32; ++i) { const int kk = 2 * i + (lane >> 5); scr[kk * 33 + (lane & 31)] = f(n0 + (lane & 31), k0 + kk); }
    asm volatile("s_waitcnt lgkmcnt(0)" ::: "memory");
    const int c = lane & 7;
#pragma unroll
    for (int j = 0; j < 4; ++j) { const int n = (lane >> 3) + 8 * j; const LAS float* s = scr + (8 * c) * 33 + n;
        u32x4 o; o.x = pk2(s[0 * 33], s[1 * 33]); o.y = pk2(s[2 * 33], s[3 * 33]); o.z = pk2(s[4 * 33], s[5 * 33]); o.w = pk2(s[6 * 33], s[7 * 33]);
        *(u32x4*)(WT + (size_t)(n0 + n) * K + k0 + 8 * c) = o; }
    asm volatile("s_waitcnt lgkmcnt(0)" ::: "memory");
}

__device__ __forceinline__ void p0_phase(CArgs& a, LAS unsigned char* lds) {
    const int tid = ptid(), lane = tid & 63, wave = tid >> 6;
    float* MOD = (float*)(a.ws + WS_MOD);
    {
        LAS float* sl = (LAS float*)lds;
        LAS float* red = (LAS float*)(lds + 40960);
        for (int i = tid; i < 9 * 1024; i += 512) { const int r = i >> 10, k = i & 1023; const float v = r < 8 ? a.c[r * 1024 + k] : a.c_ctx[k]; sl[i] = v * sigmoidf_(v); }
        __syncthreads();
        for (int it = blockIdx.x; it < 2 * 144; it += gridDim.x) {
            const int l = it / 144, n0 = (it % 144) * 64;
            const float* W = a.w_mod + (size_t)l * 1024 * MODW + n0 + lane;
            float acc[9];
#pragma unroll
            for (int r = 0; r < 9; ++r) acc[r] = 0.f;
#pragma unroll 8
            for (int kk = 0; kk < 128; ++kk) { const int k = wave * 128 + kk; const float wv = W[(size_t)k * MODW];
#pragma unroll
                for (int r = 0; r < 9; ++r) acc[r] += sl[r * 1024 + k] * wv; }
#pragma unroll
            for (int r = 0; r < 9; ++r) red[(wave * 9 + r) * 64 + lane] = acc[r];
            __syncthreads();
            for (int i = tid; i < 9 * 64; i += 512) { const int r = i >> 6, cidx = i & 63; float s = a.b_mod[l * MODW + n0 + cidx];
#pragma unroll
                for (int w = 0; w < 8; ++w) s += red[(w * 9 + r) * 64 + cidx];
                MOD[((size_t)l * 9 + r) * MODW + n0 + cidx] = s; }
            __syncthreads();
        }
        __syncthreads();
    }
    LAS float* scr = (LAS float*)(lds + wave * 8448);
    const int gw = blockIdx.x * 8 + wave, NGW = gridDim.x * 8;
    constexpr int I_GU = 176 * 16, I_D = 32 * 44, I_IN = 72 * 16, I_G = 128 * 16, I_OUT = 32 * 16, I_MLA = 32 * 6;
    constexpr int I_LAYER = 2 * I_GU + 2 * I_D + I_IN + 2 * I_G + I_OUT + I_MLA;
    for (int it = gw; it < 2 * I_LAYER; it += NGW) {
        const int l = it / I_LAYER; int r = it % I_LAYER;
        unsigned char* wb = a.ws + WS_W + (size_t)l * W_LAYER;
        if (r < 2 * I_GU) { const int s = r / I_GU; r %= I_GU;
            const float* wg = a.w_gate + (size_t)(l * 2 + s) * 1024 * DFF; const float* wu = a.w_up + (size_t)(l * 2 + s) * 1024 * DFF;
            conv_item((bf16_t*)(wb + W_GU + s * W_GU_SZ), 1024, 176, r, scr, lane, [=](int n, int k) { const int j = (n >> 8) * 128 + (n & 127); return ((n >> 7) & 1) ? wu[(size_t)k * DFF + j] : wg[(size_t)k * DFF + j]; });
            continue; }
        r -= 2 * I_GU;
        if (r < 2 * I_D) { const int s = r / I_D; r %= I_D;
            const float* wd = a.w_down + (size_t)(l * 2 + s) * DFF * 1024;
            conv_item((bf16_t*)(wb + W_D + s * W_D_SZ), DFF, 32, r, scr, lane, [=](int n, int k) { return wd[(size_t)k * 1024 + n]; });
            continue; }
        r -= 2 * I_D;
        const float* win = a.w_in + (size_t)l * 1024 * INCOLS;
        if (r < I_IN) { conv_item((bf16_t*)(wb + W_IN), 1024, 72, r, scr, lane, [=](int n, int k) { return n < GATE0 ? win[(size_t)k * INCOLS + n] : 0.f; }); continue; }
        r -= I_IN;
        if (r < I_G) { conv_item((bf16_t*)(wb + W_G), 1024, 128, r, scr, lane, [=](int n, int k) {
                const int br = 2 * ((n >> 7) & 1) + ((n >> 2) & 1), ch = 64 * (n >> 8) + 16 * ((n >> 5) & 3) + 4 * ((n >> 3) & 3) + (n & 3);
                return win[(size_t)k * INCOLS + GATE0 + br * 1024 + ch]; }); continue; }
        r -= I_G;
        if (r < I_G) { const float* wbr = a.w_branch + (size_t)l * 4 * 256 * 1024;
            conv_item((bf16_t*)(wb + W_BR), 1024, 128, r, scr, lane, [=](int n, int k) {
                const int br = 2 * ((n >> 7) & 1) + ((n >> 2) & 1), ch = 64 * (n >> 8) + 16 * ((n >> 5) & 3) + 4 * ((n >> 3) & 3) + (n & 3);
                return (k >> 8) == br ? wbr[((size_t)br * 256 + (k & 255)) * 1024 + ch] : 0.f; }); continue; }
        r -= I_G;
        if (r < I_OUT) { const float* wo = a.w_out + (size_t)l * 1024 * 1024;
            conv_item((bf16_t*)(wb + W_OUT), 1024, 32, r, scr, lane, [=](int n, int k) { return wo[(size_t)k * 1024 + n]; }); continue; }
        r -= I_OUT;
        { const float* uq = a.w_uq + (size_t)l * 256 * 384; const float* ukv = a.w_ukv + (size_t)l * 128 * 512; const float* gq = a.mla_qn + l * 256; const float* gkv = a.mla_kvn + l * 128;
            conv_item((bf16_t*)(wb + W_MLA), 384, 32, r, scr, lane, [=](int n, int k) {
                float v = 0.f;
                if (n < 384) { if (k < 256) v = gq[k] * uq[(size_t)k * 384 + n]; }
                else if (n < 896) { if (k >= 256) v = gkv[k - 256] * ukv[(size_t)(k - 256) * 512 + (n - 384)]; }
                return v; }); }
    }
}

__device__ __forceinline__ void row_phase(CArgs& a, int l, bool first, const bf16_t* Y, int sub_y, float gscale, bf16_t* U, int sub_u, int l_u) {
    const int tid_ = ptid(); const int lane = tid_ & 63, wave = tid_ >> 6;
    const int gw = blockIdx.x * 8 + wave, NGW = gridDim.x * 8;
    const float* MOD = (const float*)(a.ws + WS_MOD);
    float* XC = (float*)(a.ws + WS_XC);
    for (int row = gw; row < R; row += NGW) {
        const int b = row / RPB, t = row % RPB; const bool isctx = t < CTX;
        const float* xs; float* xd;
        if (isctx) { const size_t o = (size_t)(b * CTX + t) * DM; xs = (first ? a.ctx : XC) + o; xd = XC + o; }
        else { const size_t o = (size_t)(b * SEQ + (t - CTX)) * DM; xs = (first ? a.x : a.out) + o; xd = a.out + o; }
        const int mrow = isctx ? 8 : b;
        f32x4 v[4];
#pragma unroll
        for (int j = 0; j < 4; ++j) v[j] = *(const f32x4*)(xs + 4 * lane + 256 * j);
        if (Y) {
            const float* md = MOD + ((size_t)l * 9 + mrow) * MODW + (sub_y * 3 + 2) * 1024;
            const float* gp = a.g_post + (l * 3 + sub_y) * 1024;
            f32x4 y[4]; float ss = 0.f;
#pragma unroll
            for (int j = 0; j < 4; ++j) { const u32x2 w = *(const u32x2*)(Y + (size_t)row * DM + 4 * lane + 256 * j);
                y[j] = (f32x4){bflo(w.x), bfhi(w.x), bflo(w.y), bfhi(w.y)}; ss += (y[j].x * y[j].x + y[j].y * y[j].y) + (y[j].z * y[j].z + y[j].w * y[j].w); }
            const float rs = __builtin_amdgcn_rsqf(wave_sum(ss) * (1.f / DM) + EPS) * gscale;
#pragma unroll
            for (int j = 0; j < 4; ++j) { const f32x4 g = *(const f32x4*)(md + 4 * lane + 256 * j), p = *(const f32x4*)(gp + 4 * lane + 256 * j);
                v[j] = v[j] + (y[j] * rs) * p * g; *(f32x4*)(xd + 4 * lane + 256 * j) = v[j]; }
        }
        if (U) {
            const float* md = MOD + ((size_t)l_u * 9 + mrow) * MODW + (sub_u * 3) * 1024;
            const float* gp = a.g_pre + (l_u * 3 + sub_u) * 1024;
            float ss = 0.f;
#pragma unroll
            for (int j = 0; j < 4; ++j) ss += (v[j].x * v[j].x + v[j].y * v[j].y) + (v[j].z * v[j].z + v[j].w * v[j].w);
            const float rs = __builtin_amdgcn_rsqf(wave_sum(ss) * (1.f / DM) + EPS);
#pragma unroll
            for (int j = 0; j < 4; ++j) { const f32x4 sh = *(const f32x4*)(md + 4 * lane + 256 * j), sc = *(const f32x4*)(md + 1024 + 4 * lane + 256 * j), p = *(const f32x4*)(gp + 4 * lane + 256 * j);
                const f32x4 u = (v[j] * rs) * p * (sc + 1.f) + sh;
                u32x2 w; w.x = pk2(u.x, u.y); w.y = pk2(u.z, u.w);
                *(u32x2*)(U + (size_t)row * DM + 4 * lane + 256 * j) = w; }
        }
    }
}

constexpr int VSTR = 136;
constexpr int TAB_OFF = 768 * VSTR;
__device__ __forceinline__ float rope64(float v, int lane, bool lat, const LAS float* tab, int prow, int pcol) {
    if (!lat) return v;
    const float p = __shfl_xor(v, 16);
    const int pos = (lane & 32) ? pcol : prow; const int f = lane & 15;
    const float c = tab[(pos * 16 + f) * 2], s = tab[(pos * 16 + f) * 2 + 1];
    return (lane & 16) ? (v * c + p * s) : (v * c - p * s);
}
__device__ __forceinline__ float rope32(float v, int lane, bool lat, const LAS float* tab, int prow, int pcol) {
    if (!lat) return v;
    const float p = __shfl_xor(v, 8);
    const int pos = (lane & 16) ? pcol : prow; const int f = 2 * (lane & 7);
    const float c = tab[(pos * 16 + f) * 2], s = tab[(pos * 16 + f) * 2 + 1];
    return (lane & 8) ? (v * c + p * s) : (v * c - p * s);
}
__device__ __forceinline__ void prep_phase(CArgs& a, int l, LAS unsigned char* lds) {
    const int tid = ptid(), lane = tid & 63, wave = tid >> 6;
    bf16_t* HIN = (bf16_t*)(a.ws + WS_BIG); bf16_t* MUP = (bf16_t*)(a.ws + WS_Y); bf16_t* VT = (bf16_t*)(a.ws + WS_VT);
    LAS float* tab = (LAS float*)(lds + TAB_OFF);
    for (int i = tid; i < 128 * 16; i += 512) { const int pos = i >> 4, f = i & 15;
        const float invf = fexp2(-(float)(2 * f) * (1.f / 32.f) * 13.287712379549449f);
        float rev = (float)pos * invf * 0.15915494309189535f; rev -= __builtin_floorf(rev);
        tab[i * 2] = __builtin_amdgcn_cosf(rev); tab[i * 2 + 1] = __builtin_amdgcn_sinf(rev); }
    __syncthreads();
    const float gq = a.gqa_qn[l * 64 + lane], gk = a.gqa_kn[l * 64 + lane];
    for (int tile = blockIdx.x; tile < R / 64; tile += gridDim.x) {
        const int row0 = tile * 64, b = row0 / RPB, t0 = row0 % RPB;
        for (int rr = 0; rr < 8; ++rr) {
            const int tk = wave * 8 + rr, row = row0 + tk, t = t0 + tk; const bool lat = t >= CTX;
            const int tl = lat ? t - CTX : 0, prow = tl >> 6, pcol = tl & 63;
            bf16_t* h = HIN + (size_t)row * NHIN; bf16_t* mu = MUP + (size_t)row * 1024;
            LAS bf16_t* vst = (LAS bf16_t*)lds + tk;
#pragma unroll
            for (int c = 0; c < 6; ++c) { float v = bf2f(h[c * 64 + lane]);
                const float ss = wave_sum(v * v); v = v * __builtin_amdgcn_rsqf(ss * (1.f / 64.f) + EPS) * (c < 4 ? gq : gk);
                v = rope64(v, lane, lat, tab, prow, pcol); if (c < 4) v *= QS_GQA;
                h[c * 64 + lane] = (bf16_t)f2bf(v); }
#pragma unroll
            for (int c = 0; c < 2; ++c) vst[(0 + c * 64 + lane) * (VSTR / 2)] = h[384 + c * 64 + lane];
            float sq = 0.f, skv = 0.f;
#pragma unroll
            for (int c = 0; c < 4; ++c) { const float v = bf2f(h[512 + c * 64 + lane]); sq += v * v; }
#pragma unroll
            for (int c = 0; c < 2; ++c) { const float v = bf2f(h[768 + c * 64 + lane]); skv += v * v; }
            const float rq = __builtin_amdgcn_rsqf(wave_sum(sq) * (1.f / 256.f) + EPS) * QS_MLA, rkv = __builtin_amdgcn_rsqf(wave_sum(skv) * (1.f / 128.f) + EPS);
#pragma unroll
            for (int hh = 0; hh < 4; ++hh) {
                { const float v = bf2f(mu[hh * 96 + lane]) * rq; mu[hh * 96 + lane] = (bf16_t)f2bf(v); }
                { float v = bf2f(mu[hh * 96 + 64 + (lane & 31)]) * rq; v = rope32(v, lane, lat, tab, prow, pcol); if (lane < 32) mu[hh * 96 + 64 + lane] = (bf16_t)f2bf(v); }
                { const float v = bf2f(mu[384 + hh * 128 + lane]) * rkv; mu[384 + hh * 128 + lane] = (bf16_t)f2bf(v); }
                { const float v = bf2f(mu[384 + hh * 128 + 64 + lane]) * rkv; vst[(128 + hh * 64 + lane) * (VSTR / 2)] = (bf16_t)f2bf(v); }
            }
            { float v = bf2f(h[896 + (lane & 31)]); v = rope32(v, lane, lat, tab, prow, pcol); if (lane < 32) mu[896 + lane] = (bf16_t)f2bf(v); }
#pragma unroll
            for (int c = 0; c < 8; ++c) { float v = bf2f(h[928 + c * 64 + lane]); v = rope32(v, lane, lat, tab, prow, pcol); if (c < 4) v *= QS_DIFF; h[928 + c * 64 + lane] = (bf16_t)f2bf(v); }
#pragma unroll
            for (int c = 0; c < 4; ++c) vst[(384 + c * 64 + lane) * (VSTR / 2)] = h[1440 + c * 64 + lane];
#pragma unroll
            for (int c = 0; c < 6; ++c) { float v = bf2f(h[1696 + c * 64 + lane]); v = rope64(v, lane, lat, tab, prow, pcol); if (c < 4) v *= QS_GQA; h[1696 + c * 64 + lane] = (bf16_t)f2bf(v); }
#pragma unroll
            for (int c = 0; c < 2; ++c) vst[(640 + c * 64 + lane) * (VSTR / 2)] = h[2080 + c * 64 + lane];
        }
        __syncthreads();
        bf16_t* vt = VT + (size_t)b * 768 * RPB + t0;
        for (int p = tid; p < 768 * 8; p += 512) { const int vr = p >> 3, seg = p & 7;
            const LAS u32x2* s = (const LAS u32x2*)(lds + vr * VSTR + seg * 16); const u32x2 lo = s[0], hi = s[1];
            *(u32x4*)(vt + (size_t)vr * RPB + seg * 8) = (u32x4){lo.x, lo.y, hi.x, hi.y}; }
        __syncthreads();
    }
}

__device__ __forceinline__ int crow(int r, int hi) { return (r & 3) + 8 * (r >> 2) + 4 * hi; }
constexpr int AT_KBUF = 64 * (96 * 2 + 16);
constexpr int AT_VSTR = 144, AT_VBUF = 64 * AT_VSTR;
constexpr int AT_K0 = 0, AT_V0 = 2 * AT_KBUF, AT_WS = AT_V0 + 2 * AT_VBUF;

struct AttnSrc { const bf16_t* Q; int ldq; const bf16_t* K1; int ldk1; const bf16_t* K2; int ldk2; const bf16_t* VT; };

template <int DQK, bool WIN>
__device__ __forceinline__ void attn_pass(const AttnSrc& s, int NT, int lo, int q0lat, float sink_l2, bool has_sink, LAS unsigned char* lds, f32x16 (&o)[2]) {
    constexpr int KSTR = DQK * 2 + 16, NCH = DQK / 8, NKS = DQK / 16;
    const int tid = ptid(), lane = tid & 63, r32 = lane & 31, hi = lane >> 5; const int wid = __builtin_amdgcn_readfirstlane(tid >> 6);
    LAS float* wsf = (LAS float*)(lds + AT_WS) + wid * 32;
    bf16x8 qf[NKS];
    { const bf16_t* qp = s.Q + (size_t)(wid * 32 + r32) * s.ldq + 8 * hi;
#pragma unroll
        for (int ks = 0; ks < NKS; ++ks) qf[ks] = *(const bf16x8*)(qp + 16 * ks); }
    o[0] = (f32x16){}; o[1] = (f32x16){};
    float mhat = -1e30f, lsum = 0.f;
    const int kkey0 = tid / NCH, kc0 = tid % NCH;
    const int kkey1 = (tid + 512) / NCH, kc1 = (tid + 512) % NCH;
    const bool kv0 = tid < 64 * NCH, kv1 = (DQK == 96) && (tid < 256);
    const int vdv = tid >> 3, vseg = tid & 7;
    u32x4 kr0, kr1, vr;
    auto kaddr = [&](int key, int c) -> const bf16_t* { return (DQK == 96 && c >= 8) ? s.K2 + (size_t)key * s.ldk2 + (c - 8) * 8 : s.K1 + (size_t)key * s.ldk1 + c * 8; };
#define AT_TILE(i) ((i) < 4 ? (i) : lo - 4 + (i))
#define AT_GLOAD(i) do { const int key0_ = AT_TILE(i) * 64; \
        if (kv0) kr0 = *(const u32x4*)kaddr(key0_ + kkey0, kc0); if (kv1) kr1 = *(const u32x4*)kaddr(key0_ + kkey1, kc1); \
        vr = *(const u32x4*)(s.VT + (size_t)vdv * RPB + key0_ + vseg * 8); } while (0)
#define AT_LSTORE(buf) do { if (kv0) *(LAS u32x4*)(lds + AT_K0 + (buf) * AT_KBUF + kkey0 * KSTR + kc0 * 16) = kr0; \
        if (kv1) *(LAS u32x4*)(lds + AT_K0 + (buf) * AT_KBUF + kkey1 * KSTR + kc1 * 16) = kr1; \
        *(LAS u32x4*)(lds + AT_V0 + (buf) * AT_VBUF + vdv * AT_VSTR + vseg * 16) = vr; } while (0)
    AT_GLOAD(0); AT_LSTORE(0);
    __syncthreads();
    for (int i = 0; i < NT; ++i) {
        const int buf = i & 1;
        if (i + 1 < NT) AT_GLOAD(i + 1);
        const LAS unsigned char* kb = lds + AT_K0 + buf * AT_KBUF + r32 * KSTR + hi * 16;
        f32x16 s0 = (f32x16){}, s1 = (f32x16){};
#pragma unroll
        for (int ks = 0; ks < NKS; ++ks) {
            const bf16x8 a0 = *(const LAS bf16x8*)(kb + ks * 32), a1 = *(const LAS bf16x8*)(kb + 32 * KSTR + ks * 32);
            s0 = __builtin_amdgcn_mfma_f32_32x32x16_bf16(a0, qf[ks], s0, 0, 0, 0);
            s1 = __builtin_amdgcn_mfma_f32_32x32x16_bf16(a1, qf[ks], s1, 0, 0, 0);
        }
        if (WIN && i >= 4) {
            const int jb = AT_TILE(i) * 64 - CTX + 4 * hi, qi = q0lat + wid * 32 + r32;
#pragma unroll
            for (int r = 0; r < 16; ++r) { const int j = jb + (r & 3) + 8 * (r >> 2); const int d0 = qi - j, d1 = qi - (j + 32);
                if (d0 > 128 || d0 < -128) s0[r] = -1e30f; if (d1 > 128 || d1 < -128) s1[r] = -1e30f; }
        }
        float rm = s0[0];
#pragma unroll
        for (int r = 1; r < 16; ++r) rm = fmaxf(rm, s0[r]);
#pragma unroll
        for (int r = 0; r < 16; ++r) rm = fmaxf(rm, s1[r]);
        rm = fmaxf(rm, __shfl_xor(rm, 32));
        if (__any(rm > mhat + 8.f)) {
            const float nm = fmaxf(mhat, rm), f = fexp2(mhat - nm);
            lsum *= f; mhat = nm;
            if (hi == 0) wsf[r32] = f;
#pragma unroll
            for (int r = 0; r < 16; ++r) { const float fr_ = wsf[crow(r, hi)]; o[0][r] *= fr_; o[1][r] *= fr_; }
        }
        float ps = 0.f;
#pragma unroll
        for (int r = 0; r < 16; ++r) { s0[r] = fexp2(s0[r] - mhat); s1[r] = fexp2(s1[r] - mhat); ps += s0[r] + s1[r]; }
        lsum += ps;
        bf16x8 pa[4];
#pragma unroll
        for (int kk = 0; kk < 4; ++kk) {
            u32x4 w;
            if (kk < 2) { w.x = pk2(s0[8 * kk + 0], s0[8 * kk + 1]); w.y = pk2(s0[8 * kk + 2], s0[8 * kk + 3]); w.z = pk2(s0[8 * kk + 4], s0[8 * kk + 5]); w.w = pk2(s0[8 * kk + 6], s0[8 * kk + 7]); }
            else { const int k2 = kk - 2; w.x = pk2(s1[8 * k2 + 0], s1[8 * k2 + 1]); w.y = pk2(s1[8 * k2 + 2], s1[8 * k2 + 3]); w.z = pk2(s1[8 * k2 + 4], s1[8 * k2 + 5]); w.w = pk2(s1[8 * k2 + 6], s1[8 * k2 + 7]); }
            pa[kk] = __builtin_bit_cast(bf16x8, w);
        }
        const LAS unsigned char* vb = lds + AT_V0 + buf * AT_VBUF + r32 * AT_VSTR + hi * 8;
#pragma unroll
        for (int dvb = 0; dvb < 2; ++dvb)
#pragma unroll
            for (int kk = 0; kk < 4; ++kk) {
                const u32x2 lo_ = *(const LAS u32x2*)(vb + dvb * 32 * AT_VSTR + kk * 32), hi_ = *(const LAS u32x2*)(vb + dvb * 32 * AT_VSTR + kk * 32 + 16);
                const bf16x8 bv = __builtin_bit_cast(bf16x8, (u32x4){lo_.x, lo_.y, hi_.x, hi_.y});
                o[dvb] = __builtin_amdgcn_mfma_f32_32x32x16_bf16(pa[kk], bv, o[dvb], 0, 0, 0);
            }
        if (i + 1 < NT) AT_LSTORE(buf ^ 1);
        __syncthreads();
    }
    float lt = lsum + __shfl_xor(lsum, 32);
    if (has_sink) lt += fexp2(sink_l2 - mhat);
    if (hi == 0) wsf[r32] = frcp(lt);
#pragma unroll
    for (int r = 0; r < 16; ++r) { const float fr_ = wsf[crow(r, hi)]; o[0][r] *= fr_; o[1][r] *= fr_; }
#undef AT_TILE
#undef AT_GLOAD
#undef AT_LSTORE
}

__device__ __forceinline__ void attn_store(bf16_t* O, int row0, int col0, const f32x16 (&o)[2]) {
    const int tid_ = ptid(); const int lane = tid_ & 63, r32 = lane & 31, hi = lane >> 5, wid = tid_ >> 6;
#pragma unroll
    for (int dvb = 0; dvb < 2; ++dvb)
#pragma unroll
        for (int r = 0; r < 16; ++r) O[(size_t)(row0 + wid * 32 + crow(r, hi)) * 1024 + col0 + dvb * 32 + r32] = (bf16_t)f2bf(o[dvb][r]);
}

__device__ __forceinline__ void attn_unit(CArgs& a, int l, int branch, int b, int h, int qb, float lam, float lam_init, LAS unsigned char* lds) {
    const bf16_t* HIN = (const bf16_t*)(a.ws + WS_BIG) + (size_t)b * RPB * NHIN; const bf16_t* MUP = (const bf16_t*)(a.ws + WS_Y) + (size_t)b * RPB * 1024;
    const bf16_t* VT = (const bf16_t*)(a.ws + WS_VT) + (size_t)b * 768 * RPB; bf16_t* OUTS = (bf16_t*)(a.ws + WS_OUTS);
    const bool cq = qb < 0; const int qrow = cq ? 0 : CTX + 256 * qb;
    const int NTd = cq ? 4 : 132;
    const int orow0 = b * RPB + qrow;
    f32x16 o[2];
    AttnSrc s;
    if (branch == 0) {
        s.Q = HIN + (size_t)qrow * NHIN + 64 * h; s.ldq = NHIN; s.K1 = HIN + 256 + 64 * (h >> 1); s.ldk1 = NHIN; s.K2 = nullptr; s.ldk2 = 0; s.VT = VT + (size_t)(0 + 64 * (h >> 1)) * RPB;
        attn_pass<64, false>(s, NTd, 4, 0, 0.f, false, lds, o);
        attn_store(OUTS, orow0, 0 + 64 * h, o);
    } else if (branch == 1) {
        s.Q = MUP + (size_t)qrow * 1024 + 96 * h; s.ldq = 1024; s.K1 = MUP + 384 + 128 * h; s.ldk1 = 1024; s.K2 = MUP + 896; s.ldk2 = 1024; s.VT = VT + (size_t)(128 + 64 * h) * RPB;
        attn_pass<96, false>(s, NTd, 4, 0, 0.f, false, lds, o);
        attn_store(OUTS, orow0, 256 + 64 * h, o);
    } else if (branch == 2) {
        f32x16 o2[2];
        s.Q = HIN + (size_t)qrow * NHIN + 928 + 64 * h; s.ldq = NHIN; s.K1 = HIN + 1184 + 64 * h; s.ldk1 = NHIN; s.K2 = nullptr; s.ldk2 = 0; s.VT = VT + (size_t)(384 + 64 * h) * RPB;
        attn_pass<32, false>(s, NTd, 4, 0, 0.f, false, lds, o);
        s.Q += 32; s.K1 += 32;
        attn_pass<32, false>(s, NTd, 4, 0, 0.f, false, lds, o2);
        const int lane = ptid() & 63, r32 = lane & 31;
        const float g0 = a.dsub[l * 64 + r32] * (1.f - lam_init), g1 = a.dsub[l * 64 + 32 + r32] * (1.f - lam_init);
#pragma unroll
        for (int r = 0; r < 16; ++r) { const float x0 = o[0][r] - lam * o2[0][r], x1 = o[1][r] - lam * o2[1][r];
            float ss = x0 * x0 + x1 * x1;
#pragma unroll
            for (int m = 1; m < 32; m <<= 1) ss += __shfl_xor(ss, m);
            const float rs = __builtin_amdgcn_rsqf(ss * (1.f / 64.f) + EPS);
            o[0][r] = x0 * rs * g0; o[1][r] = x1 * rs * g1; }
        attn_store(OUTS, orow0, 512 + 64 * h, o);
    } else {
        s.Q = HIN + (size_t)qrow * NHIN + 1696 + 64 * h; s.ldq = NHIN; s.K1 = HIN + 1952 + 64 * (h >> 1); s.ldk1 = NHIN; s.K2 = nullptr; s.ldk2 = 0; s.VT = VT + (size_t)(640 + 64 * (h >> 1)) * RPB;
        const float sk = a.sink[l * 4 + h] * LOG2E;
        if (cq) attn_pass<64, false>(s, 4, 4, 0, sk, true, lds, o);
        else { const int q0 = 256 * qb; const int lo = 4 + (q0 >= 128 ? q0 - 128 : 0) / 64, hiT = 4 + ((q0 + 384) < SEQ ? (q0 + 384) : SEQ) / 64;
            attn_pass<64, true>(s, 4 + hiT - lo, lo, q0, sk, true, lds, o); }
        attn_store(OUTS, orow0, 768 + 64 * h, o);
    }
}

__device__ __forceinline__ void attn_phase(CArgs& a, int l, LAS unsigned char* lds) {
    const float lam_init = 0.8f - 0.6f * __expf(-0.3f * (float)l);
    float lam;
    { const float* dl = a.dlam + l * 128; float s1 = 0.f, s2 = 0.f;
        for (int i = 0; i < 32; ++i) { s1 += dl[i] * dl[32 + i]; s2 += dl[64 + i] * dl[96 + i]; }
        lam = __expf(s1) - __expf(s2) + lam_init; }
    const int G = gridDim.x, bx = blockIdx.x;
    const int vcu = (G % 8 == 0) ? (bx % 8) * (G / 8) + bx / 8 : bx;
    for (int ty = 0; ty < 4; ++ty) {
        const int branch = ty == 0 ? 2 : ty == 1 ? 1 : ty == 2 ? 0 : 3;
        for (int idx = vcu; idx < NB * 4 * 32; idx += G) { const int bh = idx >> 5, qb = idx & 31; attn_unit(a, l, branch, bh >> 2, bh & 3, qb, lam, lam_init, lds); }
    }
    for (int idx = vcu; idx < NB * 16; idx += G) attn_unit(a, l, (idx >> 2) & 3, idx >> 4, idx & 3, -1, lam, lam_init, lds);
}

constexpr int NPHASE = 2 + 32;
__global__ void __launch_bounds__(512, 2) fwd_kernel(Args a_) {
    extern __shared__ __attribute__((aligned(16))) unsigned char lds_raw[];
    LAS unsigned char* lds = (LAS unsigned char*)lds_raw;
    cg::grid_group grid = cg::this_grid();
    const int lo = a_.ph_lo, hi = a_.ph_hi < NPHASE ? a_.ph_hi : NPHASE;
    for (int ph = lo; ph < hi; ++ph) {
        CArgs* ap_ = (CArgs*)__builtin_amdgcn_kernarg_segment_ptr(); asm volatile("" : "+s"(ap_) :: "memory"); CArgs& a = *ap_;
        int G = gridDim.x, bx = blockIdx.x; asm volatile("" : "+s"(G), "+s"(bx));
        if (ph == 0) p0_phase(a, lds);
        else if (ph == 1) row_phase(a, 0, true, nullptr, 0, 0.f, (bf16_t*)(a.ws + WS_U), 0, 0);
        else {
            const int l = (ph - 2) / 16, k = (ph - 2) % 16;
            unsigned char* ws = a.ws;
            const unsigned char* wb = ws + WS_W + (size_t)l * W_LAYER;
            bf16_t* U = (bf16_t*)(ws + WS_U); bf16_t* Yb = (bf16_t*)(ws + WS_Y); bf16_t* BIG = (bf16_t*)(ws + WS_BIG);
            if (k == 5) prep_phase(a, l, lds);
#ifndef X_ATTN
            else if (k == 6) attn_phase(a, l, lds);
#endif
            else if (k == 2) row_phase(a, l, l == 0, Yb, 0, 0.5f, U, 1, l);
            else if (k == 12) row_phase(a, l, false, BIG, 1, 1.0f, U, 2, l);
            else if (k == 15) row_phase(a, l, false, Yb, 2, 0.5f, l == 0 ? U : nullptr, 0, l + 1);
            else {
                pg8::Gemm g; pg8::Epi E; int N; int dual = 0; int Mrows = R;
                g.A2 = nullptr; g.Bt2 = nullptr; E.scr = nullptr;
                if (k == 0 || k == 13) { const int s = k == 13; g.A = U; g.Bt = (const bf16_t*)(wb + W_GU + s * W_GU_SZ); g.lda = 1024; g.ldb = 1024; g.K = 1024; N = 5632; E.mode = 1; E.O = BIG; E.ldc = DFF; }
                else if (k == 1 || k == 14) { const int s = k == 14; g.A = BIG; g.Bt = (const bf16_t*)(wb + W_D + s * W_D_SZ); g.lda = DFF; g.ldb = DFF; g.K = DFF; N = 1024; E.mode = 0; E.O = Yb; E.ldc = 1024; }
                else if (k == 3) { g.A = U; g.Bt = (const bf16_t*)(wb + W_IN); g.lda = 1024; g.ldb = 1024; g.K = 1024; N = NHIN; E.mode = 0; E.O = BIG; E.ldc = NHIN; }
                else if (k == 4) { g.A = BIG + 512; g.Bt = (const bf16_t*)(wb + W_MLA); g.lda = NHIN; g.ldb = 384; g.K = 384; N = 1024; E.mode = 0; E.O = Yb; E.ldc = 1024; }
                else if (k == 7 || k == 9) { const size_t ro = (size_t)(k == 9) * (R / 2) * 1024; Mrows = R / 2;
                    g.A = U + ro; g.Bt = (const bf16_t*)(wb + W_G); g.lda = 1024; g.ldb = 1024; g.K = 1024; N = 4096; E.mode = 3; E.O = BIG; E.ldc = 4096; }
                else if (k == 8 || k == 10) { const size_t ro = (size_t)(k == 10) * (R / 2) * 1024; Mrows = R / 2;
                    g.A = (const bf16_t*)(ws + WS_OUTS) + ro; g.Bt = (const bf16_t*)(wb + W_BR); g.lda = 1024; g.ldb = 1024; g.K = 1024; N = 4096; E.mode = 4; E.O = Yb + ro; E.ldc = 1024; E.scr = (u32x4*)BIG; }
                else { g.A = Yb; g.Bt = (const bf16_t*)(wb + W_OUT); g.lda = 1024; g.ldb = 1024; g.K = 1024; N = 1024; E.mode = 0; E.O = BIG; E.ldc = 1024; }
                pg8::StaticOrder S; S.init(Mrows, N, G, bx, dual);
                pg8::gemm_phase(lds, g, S, E);
            }
        }
        if (ph + 1 < hi) {
            asm volatile("s_waitcnt vmcnt(0) lgkmcnt(0)" ::: "memory");
            __syncthreads();
            if (ptid() < 64) { __builtin_amdgcn_fence(__ATOMIC_RELEASE, "agent"); asm volatile("s_waitcnt vmcnt(0)" ::: "memory"); }
            grid.sync();
            __builtin_amdgcn_fence(__ATOMIC_ACQUIRE, "agent");
            asm volatile("s_waitcnt vmcnt(0)" ::: "memory");
        }
    }
}

extern "C" void kernel_launch(void* const* d_in, const int* in_sizes, int n_in, void* d_out, int out_size, void* d_ws, size_t ws_size, hipStream_t stream) {
    static int grid = 0;
    if (grid == 0) {
        int dev = 0, cus = 0;
        if (hipGetDevice(&dev) != hipSuccess || hipDeviceGetAttribute(&cus, hipDeviceAttributeMultiprocessorCount, dev) != hipSuccess) { grid = -1; return; }
        if (hipFuncSetAttribute((const void*)fwd_kernel, hipFuncAttributeMaxDynamicSharedMemorySize, LDS_BYTES) != hipSuccess) { fprintf(stderr, "hipFuncSetAttribute failed\n"); grid = -1; return; }
        int per_cu = 0;
        if (hipOccupancyMaxActiveBlocksPerMultiprocessor(&per_cu, (const void*)fwd_kernel, 512, LDS_BYTES) != hipSuccess || per_cu < 1) fprintf(stderr, "occupancy query: %d\n", per_cu);
        (void)hipGetLastError();
        grid = cus;
        if (ws_size < WS_END) { fprintf(stderr, "workspace too small\n"); grid = -1; return; }
    }
    if (grid < 0) return;
    Args a{};
    const float** p = (const float**)&a;
    for (int i = 0; i < 23; ++i) p[i] = (const float*)d_in[i];
    a.out = (float*)d_out; a.ws = (unsigned char*)d_ws; a.ph_lo = 0; a.ph_hi = 1000;
    void* args[] = {&a};
    hipError_t e = hipLaunchCooperativeKernel((const void*)fwd_kernel, dim3(grid), dim3(512), args, LDS_BYTES, stream);
    if (e != hipSuccess) fprintf(stderr, "cooperative launch failed: %s\n", hipGetErrorString(e));
}
```

```cpp
#include <hip/hip_runtime.h>
#include <hip/hip_cooperative_groups.h>
#include <cstdio>
#include <cstdint>
namespace cg = cooperative_groups;

#define LAS __attribute__((address_space(3)))
typedef unsigned short bf16_t;
typedef short bf16x8 __attribute__((ext_vector_type(8)));
typedef short s16x4 __attribute__((ext_vector_type(4)));
typedef float f32x4 __attribute__((ext_vector_type(4)));
typedef float f32x16 __attribute__((ext_vector_type(16)));
typedef unsigned u32x4 __attribute__((ext_vector_type(4)));
typedef unsigned u32x2 __attribute__((ext_vector_type(2)));

constexpr int DM = 1024, NB = 8, SEQ = 8192, CTX = 256, RPB = SEQ + CTX, R = NB * RPB, DFF = 2816;
constexpr int NHIN = 2304, INCOLS = 6304, GATE0 = 2208;
constexpr int MODW = 9216;
constexpr float EPS = 1e-6f;
constexpr float LOG2E = 1.4426950408889634f;
constexpr float QS_GQA = 0.125f * LOG2E, QS_MLA = 0.10206207261596577f * LOG2E, QS_DIFF = 0.17677669529663687f * LOG2E;

constexpr size_t MiB = 1u << 20;
constexpr size_t WS_MOD = 0;
constexpr size_t WS_XC = 2 * MiB;
constexpr size_t WS_W = 10 * MiB;
constexpr size_t W_GU = 0, W_GU_SZ = (size_t)5632 * 1024 * 2;
constexpr size_t W_D = W_GU + 2 * W_GU_SZ, W_D_SZ = (size_t)1024 * 2816 * 2;
constexpr size_t W_IN = W_D + 2 * W_D_SZ, W_IN_SZ = (size_t)NHIN * 1024 * 2;
constexpr size_t W_G = W_IN + W_IN_SZ, W_G_SZ = (size_t)4096 * 1024 * 2;
constexpr size_t W_BR = W_G + W_G_SZ;
constexpr size_t W_OUT = W_BR + W_G_SZ, W_OUT_SZ = (size_t)1024 * 1024 * 2;
constexpr size_t W_MLA = W_OUT + W_OUT_SZ, W_MLA_SZ = (size_t)1024 * 384 * 2;
constexpr size_t W_LAYER = W_MLA + W_MLA_SZ;
static_assert(WS_W + 2 * W_LAYER <= 124 * MiB, "weights");
constexpr size_t ROWBUF = (size_t)R * 1024 * 2;
constexpr size_t WS_U = 124 * MiB;
constexpr size_t WS_Y = WS_U + ROWBUF;
constexpr size_t WS_BIG = WS_Y + ROWBUF;
constexpr size_t WS_OUTS = WS_BIG + (size_t)R * NHIN * 2;
constexpr size_t WS_VT = WS_OUTS + ROWBUF;
constexpr size_t WS_GSCR = WS_VT + (size_t)NB * 768 * RPB * 2;
constexpr size_t WS_END = WS_GSCR + 256 * 131072;
static_assert(WS_END <= 1024 * MiB, "ws");
static_assert(WS_BIG + (size_t)R * DFF * 2 <= WS_END, "H");

constexpr int LDS_BYTES = 147456;

__device__ __forceinline__ unsigned f2bf(float f) { unsigned u = __builtin_bit_cast(unsigned, f); return (u + 0x7fffu + ((u >> 16) & 1u)) >> 16; }
__device__ __forceinline__ unsigned pk2(float lo, float hi) { return f2bf(lo) | (f2bf(hi) << 16); }
__device__ __forceinline__ float bf2f(unsigned short h) { return __builtin_bit_cast(float, (unsigned)h << 16); }
__device__ __forceinline__ float bflo(unsigned w) { return __builtin_bit_cast(float, w << 16); }
__device__ __forceinline__ float bfhi(unsigned w) { return __builtin_bit_cast(float, w & 0xffff0000u); }
__device__ __forceinline__ float wave_sum(float v) {
#pragma unroll
    for (int o = 1; o < 64; o <<= 1) v += __shfl_xor(v, o);
    return v;
}
__device__ __forceinline__ int ptid() { int t = threadIdx.x; asm volatile("" : "+v"(t)); return t; }
__device__ __forceinline__ float fexp2(float x) { return __builtin_amdgcn_exp2f(x); }
__device__ __forceinline__ float frcp(float x) { return __builtin_amdgcn_rcpf(x); }
__device__ __forceinline__ float sigmoidf_(float x) { return frcp(1.f + fexp2(-x * LOG2E)); }

namespace pg8 {
constexpr int BM = 256, BK = 64, HALF = 128, HTB = HALF * BK * 2, STAGE_BYTES = 8 * HTB, NXCD = 8, WGM = 8;
__device__ __forceinline__ int lds_byte(int r, int c) { const int st = (r >> 4) * 2 + (c >> 5), rr = r & 15, cc = c & 31, ob = rr * 64 + cc * 2; return st * 1024 + (ob ^ (((ob >> 9) & 1) << 5)); }
__device__ __forceinline__ void stage_rc(int b, int& Rr, int& C) { const int st = b / 1024, sb = b % 1024, swz = sb ^ (((sb >> 9) & 1) << 5); Rr = (st >> 1) * 16 + swz / 64; C = (st & 1) * 32 + (swz % 64) / 2; }
__device__ __forceinline__ int perm32(int rho) { const int n = rho >> 4, i = rho & 15; return 8 * (i >> 2) + 4 * n + (i & 3); }

struct Unit { int pm, pn, kind; };
struct Gemm { const bf16_t* A; const bf16_t* Bt; const bf16_t* A2; const bf16_t* Bt2; int lda, ldb, K; };

struct StaticOrder {
    int nM, nN, nwg, G, c, dual;
    __device__ void init(int M, int N, int G_, int c_, int dual_) { nM = M / BM; nN = N / BM; nwg = nM * nN; G = G_; c = c_; dual = dual_; }
    __device__ bool next(int i, Unit& u) const {
        const int ii = dual ? (i >> 1) : i;
        u.kind = dual ? (i & 1) : 0;
        const long L = (long)ii * G + c; if (L >= nwg) return false;
        int wgid = (int)L; { const int q = nwg / NXCD, r = nwg % NXCD, xcd = wgid % NXCD, off = wgid / NXCD; wgid = (xcd < r ? xcd * (q + 1) : r * (q + 1) + (xcd - r) * q) + off; }
        const int nig = WGM * nN, gid = wgid / nig, fm = gid * WGM, gsz = (nM - fm) < WGM ? (nM - fm) : WGM;
        u.pm = fm + ((wgid % nig) % gsz); u.pn = (wgid % nig) / gsz; return true;
    }
};

typedef float f32x2_t __attribute__((ext_vector_type(2))); typedef __bf16 bf16x2_t __attribute__((ext_vector_type(2)));
__device__ __forceinline__ unsigned cvt_pk_bf16(float lo, float hi) { f32x2_t v = {lo, hi}; bf16x2_t b = __builtin_convertvector(v, bf16x2_t); return __builtin_bit_cast(unsigned, b); }

struct Epi {
    int mode; bf16_t* O; int ldc; u32x4* scr;
    __device__ __forceinline__ void operator()(const f32x4 (&acc)[2][2][4][2], const Unit& u, int wr, int wc, int fr, int fq) const {
        const int row0 = u.pm * BM + wr * 64 + fr;
        if (mode == 0) {
            const int col0 = u.pn * BM + wc * 32 + 8 * fq;
#pragma unroll
            for (int ai = 0; ai < 2; ++ai)
#pragma unroll
                for (int m = 0; m < 4; ++m) { bf16_t* rowp = O + (size_t)(row0 + ai * HALF + m * 16) * ldc + col0;
#pragma unroll
                    for (int bj = 0; bj < 2; ++bj) { const f32x4 v0 = acc[ai][bj][m][0], v1 = acc[ai][bj][m][1];
                        u32x4 w; w.x = cvt_pk_bf16(v0[0], v0[1]); w.y = cvt_pk_bf16(v0[2], v0[3]); w.z = cvt_pk_bf16(v1[0], v1[1]); w.w = cvt_pk_bf16(v1[2], v1[3]);
                        *(u32x4*)(rowp + bj * HALF) = w; } }
        } else if (mode == 1) {
            const int col0 = u.pn * HALF + wc * 32 + 8 * fq;
#pragma unroll
            for (int ai = 0; ai < 2; ++ai)
#pragma unroll
                for (int m = 0; m < 4; ++m) { bf16_t* rowp = O + (size_t)(row0 + ai * HALF + m * 16) * ldc + col0;
                    float h[8];
#pragma unroll
                    for (int n = 0; n < 2; ++n)
#pragma unroll
                        for (int e = 0; e < 4; ++e) { const float g = acc[ai][0][m][n][e], up = acc[ai][1][m][n][e]; h[n * 4 + e] = g * sigmoidf_(g) * up; }
                    u32x4 w; w.x = cvt_pk_bf16(h[0], h[1]); w.y = cvt_pk_bf16(h[2], h[3]); w.z = cvt_pk_bf16(h[4], h[5]); w.w = cvt_pk_bf16(h[6], h[7]);
                    *(u32x4*)rowp = w; }
        } else if (mode == 3) {
            const int col0 = u.pn * BM + wc * 32 + 8 * fq;
#pragma unroll
            for (int ai = 0; ai < 2; ++ai)
#pragma unroll
                for (int m = 0; m < 4; ++m) { bf16_t* rowp = O + (size_t)(row0 + ai * HALF + m * 16) * ldc + col0;
#pragma unroll
                    for (int bj = 0; bj < 2; ++bj) { const f32x4 v0 = acc[ai][bj][m][0], v1 = acc[ai][bj][m][1];
                        u32x4 w; w.x = cvt_pk_bf16(sigmoidf_(v0[0]), sigmoidf_(v0[1])); w.y = cvt_pk_bf16(sigmoidf_(v0[2]), sigmoidf_(v0[3]));
                        w.z = cvt_pk_bf16(sigmoidf_(v1[0]), sigmoidf_(v1[1])); w.w = cvt_pk_bf16(sigmoidf_(v1[2]), sigmoidf_(v1[3]));
                        *(u32x4*)(rowp + bj * HALF) = w; } }
        } else {
            const int gcol0 = u.pn * BM + wc * 32 + 8 * fq, col0 = u.pn * 64 + wc * 16 + 4 * fq;
#pragma unroll
            for (int ai = 0; ai < 2; ++ai)
#pragma unroll
                for (int m = 0; m < 4; ++m) { float y0 = 0.f, y1 = 0.f, y2 = 0.f, y3 = 0.f;
                    const bf16_t* gp = (const bf16_t*)scr + (size_t)(row0 + ai * HALF + m * 16) * 4096 + gcol0;
#pragma unroll
                    for (int bj = 0; bj < 2; ++bj) { const u32x4 w = *(const u32x4*)(gp + bj * HALF); const f32x4 v0 = acc[ai][bj][m][0], v1 = acc[ai][bj][m][1];
                        y0 += bflo(w.x) * v0[0] + bflo(w.z) * v1[0]; y1 += bfhi(w.x) * v0[1] + bfhi(w.z) * v1[1];
                        y2 += bflo(w.y) * v0[2] + bflo(w.w) * v1[2]; y3 += bfhi(w.y) * v0[3] + bfhi(w.w) * v1[3]; }
                    u32x2 o; o.x = cvt_pk_bf16(y0, y1); o.y = cvt_pk_bf16(y2, y3);
                    *(u32x2*)(O + (size_t)(row0 + ai * HALF + m * 16) * ldc + col0) = o; }
        }
    }
};

template <bool ZSKIP, class Sched>
__device__ __forceinline__ void gemm_phase(LAS unsigned char* lds, const Gemm g, const Sched& S, const Epi& E) {
    const int tid = ptid(), wid = __builtin_amdgcn_readfirstlane(tid >> 6), lane = tid & 63, wr = wid >> 2, wc = wid & 3, fr = lane & 15, fq = lane >> 4;
    const int K = g.K, nt = K / BK;
    unsigned voffA[2], voffB[2];
#pragma unroll
    for (int i = 0; i < 2; ++i) { int Rr, C; stage_rc(tid * 16 + i * 8192, Rr, C); const int Rb = (Rr & ~31) + perm32(Rr & 31);
        voffA[i] = (unsigned)(Rr * g.lda + C) * 2u; voffB[i] = (unsigned)(Rb * g.ldb + C) * 2u; }
    const size_t kstep = (size_t)(BK * 2);
    const size_t hsA = (size_t)HALF * g.lda * 2, hsB = (size_t)HALF * g.ldb * 2;
    const size_t tsA = 2 * hsA, tsB = 2 * hsB;
    const unsigned ldsw = (unsigned)wid * 1024u;
    const int aoff = lds_byte(wr * 64 + fr, fq * 8), boff = lds_byte(wc * 32 + fr, fq * 8);
#define PG8_SA(b, h) (((b) * 2 + (h)) * HTB)
#define PG8_SB(b, h) ((4 + (b) * 2 + (h)) * HTB)
#define PG8_STAGE(bufoff, gbase, voff) do { _Pragma("unroll") for (int _i = 0; _i < 2; ++_i) \
        __builtin_amdgcn_global_load_lds((const unsigned*)((const char*)(gbase) + (voff)[_i]), (LAS unsigned*)(lds + (bufoff) + ldsw + _i * 8192), 16, 0, 0); } while (0)
#define PG8_LDA(dst, b, h) do { _Pragma("unroll") for (int m = 0; m < 4; ++m) _Pragma("unroll") for (int k = 0; k < 2; ++k) dst[m][k] = *(const LAS bf16x8*)(lds + PG8_SA(b, h) + aoff + m * 2048 + k * 1024); } while (0)
#define PG8_LDB(dst, b, h) do { _Pragma("unroll") for (int n = 0; n < 2; ++n) _Pragma("unroll") for (int k = 0; k < 2; ++k) dst[n][k] = *(const LAS bf16x8*)(lds + PG8_SB(b, h) + boff + n * 2048 + k * 1024); } while (0)
#define PG8_MMA(ai, bj, At, Bt) do { __builtin_amdgcn_s_setprio(1); _Pragma("unroll") for (int m = 0; m < 4; ++m) _Pragma("unroll") for (int n = 0; n < 2; ++n) _Pragma("unroll") for (int k = 0; k < 2; ++k) \
        acc[ai][bj][m][n] = __builtin_amdgcn_mfma_f32_16x16x32_bf16(Bt[n][k], At[m][k], acc[ai][bj][m][n], 0, 0, 0); __builtin_amdgcn_s_setprio(0); } while (0)
#define PG8_MMA1(ai, bj, nn, At, Bt) do { __builtin_amdgcn_s_setprio(1); _Pragma("unroll") for (int m = 0; m < 4; ++m) _Pragma("unroll") for (int k = 0; k < 2; ++k) \
        acc[ai][bj][m][nn] = __builtin_amdgcn_mfma_f32_16x16x32_bf16(Bt[nn][k], At[m][k], acc[ai][bj][m][nn], 0, 0, 0); __builtin_amdgcn_s_setprio(0); } while (0)
#define PG8_MMAZ(ai, At) do { if (zbr == 0) PG8_MMA1(ai, 0, 0, At, B0); else if (zbr == 1) PG8_MMA1(ai, 0, 1, At, B0); else if (zbr == 2) PG8_MMA1(ai, 1, 0, At, B1); else PG8_MMA1(ai, 1, 1, At, B1); } while (0)
#define PG8_MM2(ai, At) do { if constexpr (ZSKIP) PG8_MMAZ(ai, At); else { PG8_MMA(ai, 0, At, B0); PG8_MMA(ai, 1, At, B1); } } while (0)
#define PG8_WAIT_V(n) asm volatile("s_waitcnt vmcnt(" #n ")" ::: "memory")
#define PG8_WAIT_L(n) asm volatile("s_waitcnt lgkmcnt(" #n ")" ::: "memory")
#define PG8_BAR __builtin_amdgcn_s_barrier()
#define PG8_SCHED __builtin_amdgcn_sched_barrier(0)
#define PG8_UA(u) ((const char*)((u).kind ? g.A2 : g.A) + (size_t)(u).pm * tsA)
#define PG8_UB(u) ((const char*)((u).kind ? g.Bt2 : g.Bt) + (size_t)(u).pn * tsB)
    Unit cur, nxt; int ui = 0;
    if (!S.next(0, cur)) return;
    f32x4 acc[2][2][4][2];
#pragma unroll
    for (int a = 0; a < 2; ++a)
#pragma unroll
        for (int b = 0; b < 2; ++b)
#pragma unroll
            for (int m = 0; m < 4; ++m)
#pragma unroll
                for (int n = 0; n < 2; ++n) acc[a][b][m][n] = (f32x4){0.f, 0.f, 0.f, 0.f};
    bf16x8 At[4][2], B0[2][2], B1[2][2];
    const char* cA = PG8_UA(cur); const char* cB = PG8_UB(cur);
    {
        PG8_STAGE(PG8_SB(0, 0), cB, voffB); PG8_STAGE(PG8_SB(0, 1), cB + hsB, voffB); PG8_STAGE(PG8_SA(0, 0), cA, voffA); PG8_STAGE(PG8_SA(0, 1), cA + hsA, voffA);
        if (wr == 1) PG8_BAR;
        PG8_WAIT_V(2); PG8_BAR;
        PG8_STAGE(PG8_SB(1, 0), cB + kstep, voffB); PG8_STAGE(PG8_SA(1, 0), cA + kstep, voffA); PG8_STAGE(PG8_SB(1, 1), cB + hsB + kstep, voffB);
        PG8_WAIT_V(6); PG8_BAR;
    }
    for (;;) {
        const bool has_next = S.next(ui + 1, nxt);
        const char* nA = has_next ? PG8_UA(nxt) : cA; const char* nB = has_next ? PG8_UB(nxt) : cB;
        for (int t = 0; t < nt; t += 2) {
            const bool last = (t == nt - 2); const int zbr = t >> 2;
            const char* a1 = cA + (size_t)(t + 1) * kstep;
            const char* a2 = last ? nA : cA + (size_t)(t + 2) * kstep; const char* b2 = last ? nB : cB + (size_t)(t + 2) * kstep;
            const char* a3 = a2 + kstep; const char* b3 = b2 + kstep;
            PG8_LDB(B0, 0, 0); PG8_LDB(B1, 0, 1); PG8_SCHED; PG8_LDA(At, 0, 0); PG8_STAGE(PG8_SA(1, 1), a1 + hsA, voffA);
            PG8_WAIT_V(8); PG8_WAIT_L(0); PG8_BAR; PG8_MM2(0, At); PG8_BAR; PG8_SCHED;
            PG8_LDA(At, 0, 1); PG8_STAGE(PG8_SB(0, 0), b2, voffB); PG8_STAGE(PG8_SB(0, 1), b2 + hsB, voffB); PG8_STAGE(PG8_SA(0, 0), a2, voffA);
            PG8_WAIT_V(8); PG8_WAIT_L(0); PG8_BAR; PG8_MM2(1, At); PG8_BAR; PG8_SCHED;
            PG8_LDB(B0, 1, 0); PG8_LDB(B1, 1, 1); PG8_SCHED; PG8_LDA(At, 1, 0); PG8_STAGE(PG8_SA(0, 1), a2 + hsA, voffA);
            PG8_WAIT_V(8); PG8_WAIT_L(0); PG8_BAR; PG8_MM2(0, At); PG8_BAR; PG8_SCHED;
            PG8_LDA(At, 1, 1); PG8_STAGE(PG8_SB(1, 0), b3, voffB); PG8_STAGE(PG8_SB(1, 1), b3 + hsB, voffB); PG8_STAGE(PG8_SA(1, 0), a3, voffA);
            PG8_WAIT_V(8); PG8_WAIT_L(0); PG8_BAR; PG8_MM2(1, At); PG8_BAR; PG8_SCHED;
        }
        if (wr == 0) PG8_BAR;
        E(acc, cur, wr, wc, fr, fq);
        if (!has_next) break;
#pragma unroll
        for (int a = 0; a < 2; ++a)
#pragma unroll
            for (int b = 0; b < 2; ++b)
#pragma unroll
                for (int m = 0; m < 4; ++m)
#pragma unroll
                    for (int n = 0; n < 2; ++n) acc[a][b][m][n] = (f32x4){0.f, 0.f, 0.f, 0.f};
        cur = nxt; cA = nA; cB = nB; ++ui;
        if (wr == 1) PG8_BAR;
    }
    PG8_WAIT_V(0);
    PG8_BAR;
#undef PG8_SA
#undef PG8_SB
#undef PG8_STAGE
#undef PG8_LDA
#undef PG8_LDB
#undef PG8_MMA
#undef PG8_MMA1
#undef PG8_MMAZ
#undef PG8_MM2
#undef PG8_WAIT_V
#undef PG8_WAIT_L
#undef PG8_BAR
#undef PG8_SCHED
#undef PG8_UA
#undef PG8_UB
}
}

struct Args {
    const float* x; const float* c; const float* ctx; const float* c_ctx; const float* w_mod; const float* b_mod; const float* g_pre; const float* g_post;
    const float* w_gate; const float* w_up; const float* w_down; const float* w_in; const float* gqa_qn; const float* gqa_kn; const float* mla_qn; const float* mla_kvn;
    const float* w_uq; const float* w_ukv; const float* dlam; const float* dsub; const float* sink; const float* w_branch; const float* w_out;
    float* out; unsigned char* ws; int ph_lo, ph_hi;
};
typedef const __attribute__((address_space(4))) Args CArgs;

template <class F>
__device__ __forceinline__ void conv_item(bf16_t* WT, int K, int nblk, int item, LAS float* scr, int lane, const F& f) {
    const int kb = item / nblk, nb = item % nblk, k0 = 64 * kb, n0 = 32 * nb;
#pragma unroll 8
    for (int i = 0; i < 32; ++i) { const int kk = 2 * i + (lane >> 5); scr[kk * 33 + (lane & 31)] = f(n0 + (lane & 31), k0 + kk); }
    asm volatile("s_waitcnt lgkmcnt(0)" ::: "memory");
    const int c = lane & 7;
#pragma unroll
    for (int j = 0; j < 4; ++j) { const int n = (lane >> 3) + 8 * j; const LAS float* s = scr + (8 * c) * 33 + n;
        u32x4 o; o.x = pk2(s[0 * 33], s[1 * 33]); o.y = pk2(s[2 * 33], s[3 * 33]); o.z = pk2(s[4 * 33], s[5 * 33]); o.w = pk2(s[6 * 33], s[7 * 33]);
        *(u32x4*)(WT + (size_t)(n0 + n) * K + k0 + 8 * c) = o; }
    asm volatile("s_waitcnt lgkmcnt(0)" ::: "memory");
}

__device__ __forceinline__ void p0_phase(CArgs& a, LAS unsigned char* lds) {
    const int tid = ptid(), lane = tid & 63, wave = tid >> 6;
    float* MOD = (float*)(a.ws + WS_MOD);
    {
        LAS float* sl = (LAS float*)lds;
        LAS float* red = (LAS float*)(lds + 40960);
        for (int i = tid; i < 9 * 1024; i += 512) { const int r = i >> 10, k = i & 1023; const float v = r < 8 ? a.c[r * 1024 + k] : a.c_ctx[k]; sl[i] = v * sigmoidf_(v); }
        __syncthreads();
        for (int it = blockIdx.x; it < 2 * 144; it += gridDim.x) {
            const int l = it / 144, n0 = (it % 144) * 64;
            const float* W = a.w_mod + (size_t)l * 1024 * MODW + n0 + lane;
            float acc[9];
#pragma unroll
            for (int r = 0; r < 9; ++r) acc[r] = 0.f;
#pragma unroll 8
            for (int kk = 0; kk < 128; ++kk) { const int k = wave * 128 + kk; const float wv = W[(size_t)k * MODW];
#pragma unroll
                for (int r = 0; r < 9; ++r) acc[r] += sl[r * 1024 + k] * wv; }
#pragma unroll
            for (int r = 0; r < 9; ++r) red[(wave * 9 + r) * 64 + lane] = acc[r];
            __syncthreads();
            for (int i = tid; i < 9 * 64; i += 512) { const int r = i >> 6, cidx = i & 63; float s = a.b_mod[l * MODW + n0 + cidx];
#pragma unroll
                for (int w = 0; w < 8; ++w) s += red[(w * 9 + r) * 64 + cidx];
                MOD[((size_t)l * 9 + r) * MODW + n0 + cidx] = s; }
            __syncthreads();
        }
        __syncthreads();
    }
    LAS float* scr = (LAS float*)(lds + wave * 8448);
    const int gw = blockIdx.x * 8 + wave, NGW = gridDim.x * 8;
    constexpr int I_GU = 176 * 16, I_D = 32 * 44, I_IN = 72 * 16, I_G = 128 * 16, I_OUT = 32 * 16, I_MLA = 32 * 6;
    constexpr int I_LAYER = 2 * I_GU + 2 * I_D + I_IN + 2 * I_G + I_OUT + I_MLA;
    for (int it = gw; it < 2 * I_LAYER; it += NGW) {
        const int l = it / I_LAYER; int r = it % I_LAYER;
        unsigned char* wb = a.ws + WS_W + (size_t)l * W_LAYER;
        if (r < 2 * I_GU) { const int s = r / I_GU; r %= I_GU;
            const float* wg = a.w_gate + (size_t)(l * 2 + s) * 1024 * DFF; const float* wu = a.w_up + (size_t)(l * 2 + s) * 1024 * DFF;
            conv_item((bf16_t*)(wb + W_GU + s * W_GU_SZ), 1024, 176, r, scr, lane, [=](int n, int k) { const int j = (n >> 8) * 128 + (n & 127); return ((n >> 7) & 1) ? wu[(size_t)k * DFF + j] : wg[(size_t)k * DFF + j]; });
            continue; }
        r -= 2 * I_GU;
        if (r < 2 * I_D) { const int s = r / I_D; r %= I_D;
            const float* wd = a.w_down + (size_t)(l * 2 + s) * DFF * 1024;
            conv_item((bf16_t*)(wb + W_D + s * W_D_SZ), DFF, 32, r, scr, lane, [=](int n, int k) { return wd[(size_t)k * 1024 + n]; });
            continue; }
        r -= 2 * I_D;
        const float* win = a.w_in + (size_t)l * 1024 * INCOLS;
        if (r < I_IN) { conv_item((bf16_t*)(wb + W_IN), 1024, 72, r, scr, lane, [=](int n, int k) { return n < GATE0 ? win[(size_t)k * INCOLS + n] : 0.f; }); continue; }
        r -= I_IN;
        if (r < I_G) { conv_item((bf16_t*)(wb + W_G), 1024, 128, r, scr, lane, [=](int n, int k) {
                const int br = 2 * ((n >> 7) & 1) + ((n >> 2) & 1), ch = 64 * (n >> 8) + 16 * ((n >> 5) & 3) + 4 * ((n >> 3) & 3) + (n & 3);
                return win[(size_t)k * INCOLS + GATE0 + br * 1024 + ch]; }); continue; }
        r -= I_G;
        if (r < I_G) { const float* wbr = a.w_branch + (size_t)l * 4 * 256 * 1024;
            conv_item((bf16_t*)(wb + W_BR), 1024, 128, r, scr, lane, [=](int n, int k) {
                const int br = 2 * ((n >> 7) & 1) + ((n >> 2) & 1), ch = 64 * (n >> 8) + 16 * ((n >> 5) & 3) + 4 * ((n >> 3) & 3) + (n & 3);
                return (k >> 8) == br ? wbr[((size_t)br * 256 + (k & 255)) * 1024 + ch] : 0.f; }); continue; }
        r -= I_G;
        if (r < I_OUT) { const float* wo = a.w_out + (size_t)l * 1024 * 1024;
            conv_item((bf16_t*)(wb + W_OUT), 1024, 32, r, scr, lane, [=](int n, int k) { return wo[(size_t)k * 1024 + n]; }); continue; }
        r -= I_OUT;
        { const float* uq = a.w_uq + (size_t)l * 256 * 384; const float* ukv = a.w_ukv + (size_t)l * 128 * 512; const float* gq = a.mla_qn + l * 256; const float* gkv = a.mla_kvn + l * 128;
            conv_item((bf16_t*)(wb + W_MLA), 384, 32, r, scr, lane, [=](int n, int k) {
                float v = 0.f;
                if (n < 384) { if (k < 256) v = gq[k] * uq[(size_t)k * 384 + n]; }
                else if (n < 896) { if (k >= 256) v = gkv[k - 256] * ukv[(size_t)(k - 256) * 512 + (n - 384)]; }
                return v; }); }
    }
}

__device__ __forceinline__ void row_phase(CArgs& a, int l, bool first, const bf16_t* Y, int sub_y, float gscale, bf16_t* U, int sub_u, int l_u) {
    const int tid_ = ptid(); const int lane = tid_ & 63, wave = tid_ >> 6;
    const int gw = blockIdx.x * 8 + wave, NGW = gridDim.x * 8;
    const float* MOD = (const float*)(a.ws + WS_MOD);
    float* XC = (float*)(a.ws + WS_XC);
    for (int row = gw; row < R; row += NGW) {
        const int b = row / RPB, t = row % RPB; const bool isctx = t < CTX;
        const float* xs; float* xd;
        if (isctx) { const size_t o = (size_t)(b * CTX + t) * DM; xs = (first ? a.ctx : XC) + o; xd = XC + o; }
        else { const size_t o = (size_t)(b * SEQ + (t - CTX)) * DM; xs = (first ? a.x : a.out) + o; xd = a.out + o; }
        const int mrow = isctx ? 8 : b;
        f32x4 v[4];
#pragma unroll
        for (int j = 0; j < 4; ++j) v[j] = *(const f32x4*)(xs + 4 * lane + 256 * j);
        if (Y) {
            const float* md = MOD + ((size_t)l * 9 + mrow) * MODW + (sub_y * 3 + 2) * 1024;
            const float* gp = a.g_post + (l * 3 + sub_y) * 1024;
            f32x4 y[4]; float ss = 0.f;
#pragma unroll
            for (int j = 0; j < 4; ++j) { const u32x2 w = *(const u32x2*)(Y + (size_t)row * DM + 4 * lane + 256 * j);
                y[j] = (f32x4){bflo(w.x), bfhi(w.x), bflo(w.y), bfhi(w.y)}; ss += (y[j].x * y[j].x + y[j].y * y[j].y) + (y[j].z * y[j].z + y[j].w * y[j].w); }
            const float rs = __builtin_amdgcn_rsqf(wave_sum(ss) * (1.f / DM) + EPS) * gscale;
#pragma unroll
            for (int j = 0; j < 4; ++j) { const f32x4 g = *(const f32x4*)(md + 4 * lane + 256 * j), p = *(const f32x4*)(gp + 4 * lane + 256 * j);
                v[j] = v[j] + (y[j] * rs) * p * g; *(f32x4*)(xd + 4 * lane + 256 * j) = v[j]; }
        }
        if (U) {
            const float* md = MOD + ((size_t)l_u * 9 + mrow) * MODW + (sub_u * 3) * 1024;
            const float* gp = a.g_pre + (l_u * 3 + sub_u) * 1024;
            float ss = 0.f;
#pragma unroll
            for (int j = 0; j < 4; ++j) ss += (v[j].x * v[j].x + v[j].y * v[j].y) + (v[j].z * v[j].z + v[j].w * v[j].w);
            const float rs = __builtin_amdgcn_rsqf(wave_sum(ss) * (1.f / DM) + EPS);
#pragma unroll
            for (int j = 0; j < 4; ++j) { const f32x4 sh = *(const f32x4*)(md + 4 * lane + 256 * j), sc = *(const f32x4*)(md + 1024 + 4 * lane + 256 * j), p = *(const f32x4*)(gp + 4 * lane + 256 * j);
                const f32x4 u = (v[j] * rs) * p * (sc + 1.f) + sh;
                u32x2 w; w.x = pk2(u.x, u.y); w.y = pk2(u.z, u.w);
                *(u32x2*)(U + (size_t)row * DM + 4 * lane + 256 * j) = w; }
        }
    }
}

constexpr int VSTR = 136;
constexpr int TAB_OFF = 768 * VSTR;
__device__ __forceinline__ float rope64(float v, int lane, bool lat, const LAS float* tab, int prow, int pcol) {
    if (!lat) return v;
    const float p = __shfl_xor(v, 16);
    const int pos = (lane & 32) ? pcol : prow; const int f = lane & 15;
    const float c = tab[(pos * 16 + f) * 2], s = tab[(pos * 16 + f) * 2 + 1];
    return (lane & 16) ? (v * c + p * s) : (v * c - p * s);
}
__device__ __forceinline__ float rope32(float v, int lane, bool lat, const LAS float* tab, int prow, int pcol) {
    if (!lat) return v;
    const float p = __shfl_xor(v, 8);
    const int pos = (lane & 16) ? pcol : prow; const int f = 2 * (lane & 7);
    const float c = tab[(pos * 16 + f) * 2], s = tab[(pos * 16 + f) * 2 + 1];
    return (lane & 8) ? (v * c + p * s) : (v * c - p * s);
}
__device__ __forceinline__ void prep_phase(CArgs& a, int l, LAS unsigned char* lds) {
    const int tid = ptid(), lane = tid & 63, wave = tid >> 6;
    bf16_t* HIN = (bf16_t*)(a.ws + WS_BIG); bf16_t* MUP = (bf16_t*)(a.ws + WS_Y); bf16_t* VT = (bf16_t*)(a.ws + WS_VT);
    LAS float* tab = (LAS float*)(lds + TAB_OFF);
    for (int i = tid; i < 128 * 16; i += 512) { const int pos = i >> 4, f = i & 15;
        const float invf = fexp2(-(float)(2 * f) * (1.f / 32.f) * 13.287712379549449f);
        float rev = (float)pos * invf * 0.15915494309189535f; rev -= __builtin_floorf(rev);
        tab[i * 2] = __builtin_amdgcn_cosf(rev); tab[i * 2 + 1] = __builtin_amdgcn_sinf(rev); }
    __syncthreads();
    const float gq = a.gqa_qn[l * 64 + lane], gk = a.gqa_kn[l * 64 + lane];
    for (int tile = blockIdx.x; tile < R / 64; tile += gridDim.x) {
        const int row0 = tile * 64, b = row0 / RPB, t0 = row0 % RPB;
        for (int rr = 0; rr < 8; ++rr) {
            const int tk = wave * 8 + rr, row = row0 + tk, t = t0 + tk; const bool lat = t >= CTX;
            const int tl = lat ? t - CTX : 0, prow = tl >> 6, pcol = tl & 63;
            bf16_t* h = HIN + (size_t)row * NHIN; bf16_t* mu = MUP + (size_t)row * 1024;
            LAS bf16_t* vst = (LAS bf16_t*)lds + tk;
#pragma unroll
            for (int c = 0; c < 6; ++c) { float v = bf2f(h[c * 64 + lane]);
                const float ss = wave_sum(v * v); v = v * __builtin_amdgcn_rsqf(ss * (1.f / 64.f) + EPS) * (c < 4 ? gq : gk);
                v = rope64(v, lane, lat, tab, prow, pcol); if (c < 4) v *= QS_GQA;
                h[c * 64 + lane] = (bf16_t)f2bf(v); }
#pragma unroll
            for (int c = 0; c < 2; ++c) vst[(0 + c * 64 + lane) * (VSTR / 2)] = h[384 + c * 64 + lane];
            float sq = 0.f, skv = 0.f;
#pragma unroll
            for (int c = 0; c < 4; ++c) { const float v = bf2f(h[512 + c * 64 + lane]); sq += v * v; }
#pragma unroll
            for (int c = 0; c < 2; ++c) { const float v = bf2f(h[768 + c * 64 + lane]); skv += v * v; }
            const float rq = __builtin_amdgcn_rsqf(wave_sum(sq) * (1.f / 256.f) + EPS) * QS_MLA, rkv = __builtin_amdgcn_rsqf(wave_sum(skv) * (1.f / 128.f) + EPS);
#pragma unroll
            for (int hh = 0; hh < 4; ++hh) {
                { const float v = bf2f(mu[hh * 96 + lane]) * rq; mu[hh * 96 + lane] = (bf16_t)f2bf(v); }
                { float v = bf2f(mu[hh * 96 + 64 + (lane & 31)]) * rq; v = rope32(v, lane, lat, tab, prow, pcol); if (lane < 32) mu[hh * 96 + 64 + lane] = (bf16_t)f2bf(v); }
                { const float v = bf2f(mu[384 + hh * 128 + lane]) * rkv; mu[384 + hh * 128 + lane] = (bf16_t)f2bf(v); }
                { const float v = bf2f(mu[384 + hh * 128 + 64 + lane]) * rkv; vst[(128 + hh * 64 + lane) * (VSTR / 2)] = (bf16_t)f2bf(v); }
            }
            { float v = bf2f(h[896 + (lane & 31)]); v = rope32(v, lane, lat, tab, prow, pcol); if (lane < 32) mu[896 + lane] = (bf16_t)f2bf(v); }
#pragma unroll
            for (int c = 0; c < 8; ++c) { float v = bf2f(h[928 + c * 64 + lane]); v = rope32(v, lane, lat, tab, prow, pcol); if (c < 4) v *= QS_DIFF; h[928 + c * 64 + lane] = (bf16_t)f2bf(v); }
#pragma unroll
            for (int c = 0; c < 4; ++c) vst[(384 + c * 64 + lane) * (VSTR / 2)] = h[1440 + c * 64 + lane];
#pragma unroll
            for (int c = 0; c < 6; ++c) { float v = bf2f(h[1696 + c * 64 + lane]); v = rope64(v, lane, lat, tab, prow, pcol); if (c < 4) v *= QS_GQA; h[1696 + c * 64 + lane] = (bf16_t)f2bf(v); }
#pragma unroll
            for (int c = 0; c < 2; ++c) vst[(640 + c * 64 + lane) * (VSTR / 2)] = h[2080 + c * 64 + lane];
        }
        __syncthreads();
        bf16_t* vt = VT + (size_t)b * 768 * RPB + t0;
        for (int p = tid; p < 768 * 8; p += 512) { const int vr = p >> 3, seg = p & 7;
            const LAS u32x2* s = (const LAS u32x2*)(lds + vr * VSTR + seg * 16); const u32x2 lo = s[0], hi = s[1];
            *(u32x4*)(vt + (size_t)vr * RPB + seg * 8) = (u32x4){lo.x, lo.y, hi.x, hi.y}; }
        __syncthreads();
    }
}

__device__ __forceinline__ int crow(int r, int hi) { return (r & 3) + 8 * (r >> 2) + 4 * hi; }
constexpr int AT_KBUF = 64 * (96 * 2 + 16);
constexpr int AT_VSTR = 144, AT_VBUF = 64 * AT_VSTR;
constexpr int AT_K0 = 0, AT_V0 = 2 * AT_KBUF, AT_WS = AT_V0 + 2 * AT_VBUF;

struct AttnSrc { const bf16_t* Q; int ldq; const bf16_t* K1; int ldk1; const bf16_t* K2; int ldk2; const bf16_t* VT; };

template <int DQK, bool WIN>
__device__ __forceinline__ void attn_pass(const AttnSrc& s, int NT, int lo, int q0lat, float sink_l2, bool has_sink, LAS unsigned char* lds, f32x16 (&o)[2]) {
    constexpr int KSTR = DQK * 2 + 16, NCH = DQK / 8, NKS = DQK / 16;
    const int tid = ptid(), lane = tid & 63, r32 = lane & 31, hi = lane >> 5; const int wid = __builtin_amdgcn_readfirstlane(tid >> 6);
    LAS float* wsf = (LAS float*)(lds + AT_WS) + wid * 32;
    bf16x8 qf[NKS];
    { const bf16_t* qp = s.Q + (size_t)(wid * 32 + r32) * s.ldq + 8 * hi;
#pragma unroll
        for (int ks = 0; ks < NKS; ++ks) qf[ks] = *(const bf16x8*)(qp + 16 * ks); }
    o[0] = (f32x16){}; o[1] = (f32x16){};
    f32x16 negm = (f32x16){}; asm volatile("" : "+v"(negm));
    float mhat = 0.f, lsum = 0.f;
    const int kkey0 = tid / NCH, kc0 = tid % NCH;
    const int kkey1 = (tid + 512) / NCH, kc1 = (tid + 512) % NCH;
    const bool kv0 = tid < 64 * NCH, kv1 = (DQK == 96) && (tid < 256);
    const int vdv = tid >> 3, vseg = tid & 7;
    u32x4 kr0 = (u32x4){}, kr1 = (u32x4){}, vr = (u32x4){}, kn0 = (u32x4){}, kn1 = (u32x4){}, vn = (u32x4){};
    auto kaddr = [&](int key, int c) -> const bf16_t* { return (DQK == 96 && c >= 8) ? s.K2 + (size_t)key * s.ldk2 + (c - 8) * 8 : s.K1 + (size_t)key * s.ldk1 + c * 8; };
#define AT_TILE(i) ((i) < 4 ? (i) : lo - 4 + (i))
#define AT_GLOAD(K0, K1, V, i) do { const int key0_ = AT_TILE(i) * 64; \
        if (kv0) K0 = *(const u32x4*)kaddr(key0_ + kkey0, kc0); if (kv1) K1 = *(const u32x4*)kaddr(key0_ + kkey1, kc1); \
        V = *(const u32x4*)(s.VT + (size_t)vdv * RPB + key0_ + vseg * 8); } while (0)
#define AT_LSTORE(K0, K1, V, buf) do { if (kv0) *(LAS u32x4*)(lds + AT_K0 + (buf) * AT_KBUF + kkey0 * KSTR + kc0 * 16) = K0; \
        if (kv1) *(LAS u32x4*)(lds + AT_K0 + (buf) * AT_KBUF + kkey1 * KSTR + kc1 * 16) = K1; \
        *(LAS u32x4*)(lds + AT_V0 + (buf) * AT_VBUF + vdv * AT_VSTR + vseg * 16) = V; } while (0)
#define MX3(a, b, c) __builtin_fmaxf(__builtin_fmaxf((a), (b)), (c))
    AT_GLOAD(kr0, kr1, vr, 0); AT_LSTORE(kr0, kr1, vr, 0);
    if (NT > 1) AT_GLOAD(kr0, kr1, vr, 1);
    __syncthreads();
    for (int i = 0; i < NT; ++i) {
        const int buf = i & 1;
        if (i + 2 < NT) AT_GLOAD(kn0, kn1, vn, i + 2);
        const LAS unsigned char* kb = lds + AT_K0 + buf * AT_KBUF + r32 * KSTR + hi * 16;
        f32x16 s0, s1;
#pragma unroll
        for (int ks = 0; ks < NKS; ++ks) {
            const bf16x8 a0 = *(const LAS bf16x8*)(kb + ks * 32), a1 = *(const LAS bf16x8*)(kb + 32 * KSTR + ks * 32);
            if (ks == 0) { s0 = __builtin_amdgcn_mfma_f32_32x32x16_bf16(a0, qf[0], negm, 0, 0, 0); s1 = __builtin_amdgcn_mfma_f32_32x32x16_bf16(a1, qf[0], negm, 0, 0, 0); }
            else { s0 = __builtin_amdgcn_mfma_f32_32x32x16_bf16(a0, qf[ks], s0, 0, 0, 0); s1 = __builtin_amdgcn_mfma_f32_32x32x16_bf16(a1, qf[ks], s1, 0, 0, 0); }
        }
        if (WIN && i >= 4) {
            const int jb = AT_TILE(i) * 64 - CTX + 4 * hi, qi = q0lat + wid * 32 + r32;
#pragma unroll
            for (int r = 0; r < 16; ++r) { const int j = jb + (r & 3) + 8 * (r >> 2); const int d0 = qi - j, d1 = qi - (j + 32);
                if (d0 > 128 || d0 < -128) s0[r] = -1e30f; if (d1 > 128 || d1 < -128) s1[r] = -1e30f; }
        }
        float ra = MX3(s0[0], s0[1], s1[0]), rb = MX3(s0[2], s0[3], s1[1]); ra = MX3(ra, s1[2], s1[3]);
#pragma unroll
        for (int r = 4; r < 16; r += 4) { ra = MX3(ra, s0[r], s0[r + 1]); rb = MX3(rb, s0[r + 2], s0[r + 3]); ra = MX3(ra, s1[r], s1[r + 1]); rb = MX3(rb, s1[r + 2], s1[r + 3]); }
        float rm = __builtin_fmaxf(ra, rb);
        rm = __builtin_fmaxf(rm, __shfl_xor(rm, 32));
        if (i == 0 || __any(rm > 8.f)) {
            const float dl = (i == 0) ? rm : __builtin_fmaxf(rm, 0.f);
            mhat += dl;
#pragma unroll
            for (int r = 0; r < 16; ++r) { s0[r] -= dl; s1[r] -= dl; }
#pragma unroll
            for (int r = 0; r < 16; ++r) negm[r] = -mhat;
            asm volatile("" : "+v"(negm));
            if (i != 0) {
                const float f = fexp2(-dl);
                lsum *= f;
                if (hi == 0) wsf[r32] = f;
#pragma unroll
                for (int r = 0; r < 16; ++r) { const float fr_ = wsf[crow(r, hi)]; o[0][r] *= fr_; o[1][r] *= fr_; }
            }
        }
        float ps = 0.f, ps2 = 0.f;
#pragma unroll
        for (int r = 0; r < 16; ++r) { s0[r] = fexp2(s0[r]); s1[r] = fexp2(s1[r]); ps += s0[r]; ps2 += s1[r]; }
        lsum += ps + ps2;
        bf16x8 pa[4];
#pragma unroll
        for (int kk = 0; kk < 4; ++kk) {
            u32x4 w;
            if (kk < 2) { w.x = pg8::cvt_pk_bf16(s0[8 * kk + 0], s0[8 * kk + 1]); w.y = pg8::cvt_pk_bf16(s0[8 * kk + 2], s0[8 * kk + 3]); w.z = pg8::cvt_pk_bf16(s0[8 * kk + 4], s0[8 * kk + 5]); w.w = pg8::cvt_pk_bf16(s0[8 * kk + 6], s0[8 * kk + 7]); }
            else { const int k2 = kk - 2; w.x = pg8::cvt_pk_bf16(s1[8 * k2 + 0], s1[8 * k2 + 1]); w.y = pg8::cvt_pk_bf16(s1[8 * k2 + 2], s1[8 * k2 + 3]); w.z = pg8::cvt_pk_bf16(s1[8 * k2 + 4], s1[8 * k2 + 5]); w.w = pg8::cvt_pk_bf16(s1[8 * k2 + 6], s1[8 * k2 + 7]); }
            pa[kk] = __builtin_bit_cast(bf16x8, w);
        }
        const LAS unsigned char* vb = lds + AT_V0 + buf * AT_VBUF + r32 * AT_VSTR + hi * 8;
#pragma unroll
        for (int dvb = 0; dvb < 2; ++dvb)
#pragma unroll
            for (int kk = 0; kk < 4; ++kk) {
                const u32x2 lo_ = *(const LAS u32x2*)(vb + dvb * 32 * AT_VSTR + kk * 32), hi_ = *(const LAS u32x2*)(vb + dvb * 32 * AT_VSTR + kk * 32 + 16);
                const bf16x8 bv = __builtin_bit_cast(bf16x8, (u32x4){lo_.x, lo_.y, hi_.x, hi_.y});
                o[dvb] = __builtin_amdgcn_mfma_f32_32x32x16_bf16(pa[kk], bv, o[dvb], 0, 0, 0);
            }
        if (i + 1 < NT) AT_LSTORE(kr0, kr1, vr, buf ^ 1);
        __syncthreads();
        kr0 = kn0; kr1 = kn1; vr = vn;
    }
    float lt = lsum + __shfl_xor(lsum, 32);
    if (has_sink) lt += fexp2(sink_l2 - mhat);
    if (hi == 0) wsf[r32] = frcp(lt);
#pragma unroll
    for (int r = 0; r < 16; ++r) { const float fr_ = wsf[crow(r, hi)]; o[0][r] *= fr_; o[1][r] *= fr_; }
#undef AT_TILE
#undef AT_GLOAD
#undef AT_LSTORE
#undef MX3
}

__device__ __forceinline__ void attn_store(bf16_t* O, int row0, int col0, const f32x16 (&o)[2]) {
    const int tid_ = ptid(); const int lane = tid_ & 63, r32 = lane & 31, hi = lane >> 5, wid = tid_ >> 6;
#pragma unroll
    for (int dvb = 0; dvb < 2; ++dvb)
#pragma unroll
        for (int r = 0; r < 16; ++r) O[(size_t)(row0 + wid * 32 + crow(r, hi)) * 1024 + col0 + dvb * 32 + r32] = (bf16_t)f2bf(o[dvb][r]);
}

__device__ __forceinline__ void attn_unit(CArgs& a, int l, int branch, int b, int h, int qb, float lam, float lam_init, LAS unsigned char* lds) {
    const bf16_t* HIN = (const bf16_t*)(a.ws + WS_BIG) + (size_t)b * RPB * NHIN; const bf16_t* MUP = (const bf16_t*)(a.ws + WS_Y) + (size_t)b * RPB * 1024;
    const bf16_t* VT = (const bf16_t*)(a.ws + WS_VT) + (size_t)b * 768 * RPB; bf16_t* OUTS = (bf16_t*)(a.ws + WS_OUTS);
    const bool cq = qb < 0; const int qrow = cq ? 0 : CTX + 256 * qb;
    const int NTd = cq ? 4 : 132;
    const int orow0 = b * RPB + qrow;
    f32x16 o[2];
    AttnSrc s;
    if (branch == 0) {
        s.Q = HIN + (size_t)qrow * NHIN + 64 * h; s.ldq = NHIN; s.K1 = HIN + 256 + 64 * (h >> 1); s.ldk1 = NHIN; s.K2 = nullptr; s.ldk2 = 0; s.VT = VT + (size_t)(0 + 64 * (h >> 1)) * RPB;
        attn_pass<64, false>(s, NTd, 4, 0, 0.f, false, lds, o);
        attn_store(OUTS, orow0, 0 + 64 * h, o);
    } else if (branch == 1) {
        s.Q = MUP + (size_t)qrow * 1024 + 96 * h; s.ldq = 1024; s.K1 = MUP + 384 + 128 * h; s.ldk1 = 1024; s.K2 = MUP + 896; s.ldk2 = 1024; s.VT = VT + (size_t)(128 + 64 * h) * RPB;
        attn_pass<96, false>(s, NTd, 4, 0, 0.f, false, lds, o);
        attn_store(OUTS, orow0, 256 + 64 * h, o);
    } else if (branch == 2) {
        f32x16 o2[2];
        s.Q = HIN + (size_t)qrow * NHIN + 928 + 64 * h; s.ldq = NHIN; s.K1 = HIN + 1184 + 64 * h; s.ldk1 = NHIN; s.K2 = nullptr; s.ldk2 = 0; s.VT = VT + (size_t)(384 + 64 * h) * RPB;
        attn_pass<32, false>(s, NTd, 4, 0, 0.f, false, lds, o);
        s.Q += 32; s.K1 += 32;
        attn_pass<32, false>(s, NTd, 4, 0, 0.f, false, lds, o2);
        const int lane = ptid() & 63, r32 = lane & 31;
        const float g0 = a.dsub[l * 64 + r32] * (1.f - lam_init), g1 = a.dsub[l * 64 + 32 + r32] * (1.f - lam_init);
#pragma unroll
        for (int r = 0; r < 16; ++r) { const float x0 = o[0][r] - lam * o2[0][r], x1 = o[1][r] - lam * o2[1][r];
            float ss = x0 * x0 + x1 * x1;
#pragma unroll
            for (int m = 1; m < 32; m <<= 1) ss += __shfl_xor(ss, m);
            const float rs = __builtin_amdgcn_rsqf(ss * (1.f / 64.f) + EPS);
            o[0][r] = x0 * rs * g0; o[1][r] = x1 * rs * g1; }
        attn_store(OUTS, orow0, 512 + 64 * h, o);
    } else {
        s.Q = HIN + (size_t)qrow * NHIN + 1696 + 64 * h; s.ldq = NHIN; s.K1 = HIN + 1952 + 64 * (h >> 1); s.ldk1 = NHIN; s.K2 = nullptr; s.ldk2 = 0; s.VT = VT + (size_t)(640 + 64 * (h >> 1)) * RPB;
        const float sk = a.sink[l * 4 + h] * LOG2E;
        if (cq) attn_pass<64, false>(s, 4, 4, 0, sk, true, lds, o);
        else { const int q0 = 256 * qb; const int lo = 4 + (q0 >= 128 ? q0 - 128 : 0) / 64, hiT = 4 + ((q0 + 384) < SEQ ? (q0 + 384) : SEQ) / 64;
            attn_pass<64, true>(s, 4 + hiT - lo, lo, q0, sk, true, lds, o); }
        attn_store(OUTS, orow0, 768 + 64 * h, o);
    }
}

__device__ __forceinline__ void attn_phase(CArgs& a, int l, LAS unsigned char* lds) {
    const float lam_init = 0.8f - 0.6f * __expf(-0.3f * (float)l);
    float lam;
    { const float* dl = a.dlam + l * 128; float s1 = 0.f, s2 = 0.f;
        for (int i = 0; i < 32; ++i) { s1 += dl[i] * dl[32 + i]; s2 += dl[64 + i] * dl[96 + i]; }
        lam = __expf(s1) - __expf(s2) + lam_init; }
    const int G = gridDim.x, bx = blockIdx.x;
    const int vcu = (G % 8 == 0) ? (bx % 8) * (G / 8) + bx / 8 : bx;
    for (int ty = 0; ty < 4; ++ty) {
        const int branch = ty == 0 ? 2 : ty == 1 ? 1 : ty == 2 ? 0 : 3;
        for (int idx = vcu; idx < NB * 4 * 32; idx += G) { const int bh = idx >> 5, qb = idx & 31; attn_unit(a, l, branch, bh >> 2, bh & 3, qb, lam, lam_init, lds); }
    }
    for (int idx = vcu; idx < NB * 16; idx += G) attn_unit(a, l, (idx >> 2) & 3, idx >> 4, idx & 3, -1, lam, lam_init, lds);
}

constexpr int NPHASE = 2 + 32;
__global__ void __launch_bounds__(512, 2) fwd_kernel(Args a_) {
    extern __shared__ __attribute__((aligned(16))) unsigned char lds_raw[];
    LAS unsigned char* lds = (LAS unsigned char*)lds_raw;
    cg::grid_group grid = cg::this_grid();
    const int lo = a_.ph_lo, hi = a_.ph_hi < NPHASE ? a_.ph_hi : NPHASE;
    for (int ph = lo; ph < hi; ++ph) {
        CArgs* ap_ = (CArgs*)__builtin_amdgcn_kernarg_segment_ptr(); asm volatile("" : "+s"(ap_) :: "memory"); CArgs& a = *ap_;
        int G = gridDim.x, bx = blockIdx.x; asm volatile("" : "+s"(G), "+s"(bx));
        if (ph == 0) p0_phase(a, lds);
        else if (ph == 1) row_phase(a, 0, true, nullptr, 0, 0.f, (bf16_t*)(a.ws + WS_U), 0, 0);
        else {
            const int l = (ph - 2) / 16, k = (ph - 2) % 16;
            unsigned char* ws = a.ws;
            const unsigned char* wb = ws + WS_W + (size_t)l * W_LAYER;
            bf16_t* U = (bf16_t*)(ws + WS_U); bf16_t* Yb = (bf16_t*)(ws + WS_Y); bf16_t* BIG = (bf16_t*)(ws + WS_BIG);
            if (k == 5) prep_phase(a, l, lds);
#ifndef X_ATTN
            else if (k == 6) attn_phase(a, l, lds);
#endif
            else if (k == 2) row_phase(a, l, l == 0, Yb, 0, 0.5f, U, 1, l);
            else if (k == 12) row_phase(a, l, false, BIG, 1, 1.0f, U, 2, l);
            else if (k == 15) row_phase(a, l, false, Yb, 2, 0.5f, l == 0 ? U : nullptr, 0, l + 1);
            else {
                pg8::Gemm g; pg8::Epi E; int N; int dual = 0; int Mrows = R;
                g.A2 = nullptr; g.Bt2 = nullptr; E.scr = nullptr;
                if (k == 0 || k == 13) { const int s = k == 13; g.A = U; g.Bt = (const bf16_t*)(wb + W_GU + s * W_GU_SZ); g.lda = 1024; g.ldb = 1024; g.K = 1024; N = 5632; E.mode = 1; E.O = BIG; E.ldc = DFF; }
                else if (k == 1 || k == 14) { const int s = k == 14; g.A = BIG; g.Bt = (const bf16_t*)(wb + W_D + s * W_D_SZ); g.lda = DFF; g.ldb = DFF; g.K = DFF; N = 1024; E.mode = 0; E.O = Yb; E.ldc = 1024; }
                else if (k == 3) { g.A = U; g.Bt = (const bf16_t*)(wb + W_IN); g.lda = 1024; g.ldb = 1024; g.K = 1024; N = NHIN; E.mode = 0; E.O = BIG; E.ldc = NHIN; }
                else if (k == 4) { g.A = BIG + 512; g.Bt = (const bf16_t*)(wb + W_MLA); g.lda = NHIN; g.ldb = 384; g.K = 384; N = 1024; E.mode = 0; E.O = Yb; E.ldc = 1024; }
                else if (k == 7 || k == 9) { const size_t ro = (size_t)(k == 9) * 32768 * 1024; Mrows = (k == 9) ? R - 32768 : 32768;
                    g.A = U + ro; g.Bt = (const bf16_t*)(wb + W_G); g.lda = 1024; g.ldb = 1024; g.K = 1024; N = 4096; E.mode = 3; E.O = BIG; E.ldc = 4096; }
                else if (k == 8 || k == 10) { const size_t ro = (size_t)(k == 10) * 32768 * 1024; Mrows = (k == 10) ? R - 32768 : 32768;
                    g.A = (const bf16_t*)(ws + WS_OUTS) + ro; g.Bt = (const bf16_t*)(wb + W_BR); g.lda = 1024; g.ldb = 1024; g.K = 1024; N = 4096; E.mode = 4; E.O = Yb + ro; E.ldc = 1024; E.scr = (u32x4*)BIG; }
                else { g.A = Yb; g.Bt = (const bf16_t*)(wb + W_OUT); g.lda = 1024; g.ldb = 1024; g.K = 1024; N = 1024; E.mode = 0; E.O = BIG; E.ldc = 1024; }
                pg8::StaticOrder S; S.init(Mrows, N, G, bx, dual);
                if (k == 8 || k == 10) pg8::gemm_phase<true>(lds, g, S, E); else pg8::gemm_phase<false>(lds, g, S, E);
            }
        }
        if (ph + 1 < hi) {
            asm volatile("s_waitcnt vmcnt(0) lgkmcnt(0)" ::: "memory");
            __syncthreads();
            if (ptid() < 64) { __builtin_amdgcn_fence(__ATOMIC_RELEASE, "agent"); asm volatile("s_waitcnt vmcnt(0)" ::: "memory"); }
            grid.sync();
            __builtin_amdgcn_fence(__ATOMIC_ACQUIRE, "agent");
            asm volatile("s_waitcnt vmcnt(0)" ::: "memory");
        }
    }
}

extern "C" void kernel_launch(void* const* d_in, const int* in_sizes, int n_in, void* d_out, int out_size, void* d_ws, size_t ws_size, hipStream_t stream) {
    static int grid = 0;
    if (grid == 0) {
        int dev = 0, cus = 0;
        if (hipGetDevice(&dev) != hipSuccess || hipDeviceGetAttribute(&cus, hipDeviceAttributeMultiprocessorCount, dev) != hipSuccess) { grid = -1; return; }
        if (hipFuncSetAttribute((const void*)fwd_kernel, hipFuncAttributeMaxDynamicSharedMemorySize, LDS_BYTES) != hipSuccess) { fprintf(stderr, "hipFuncSetAttribute failed\n"); grid = -1; return; }
        int per_cu = 0;
        if (hipOccupancyMaxActiveBlocksPerMultiprocessor(&per_cu, (const void*)fwd_kernel, 512, LDS_BYTES) != hipSuccess || per_cu < 1) fprintf(stderr, "occupancy query: %d\n", per_cu);
        (void)hipGetLastError();
        grid = cus;
        if (ws_size < WS_END) { fprintf(stderr, "workspace too small\n"); grid = -1; return; }
    }
    if (grid < 0) return;
    Args a{};
    const float** p = (const float**)&a;
    for (int i = 0; i < 23; ++i) p[i] = (const float*)d_in[i];
    a.out = (float*)d_out; a.ws = (unsigned char*)d_ws; a.ph_lo = 0; a.ph_hi = 1000;
    void* args[] = {&a};
    hipError_t e = hipLaunchCooperativeKernel((const void*)fwd_kernel, dim3(grid), dim3(512), args, LDS_BYTES, stream);
    if (e != hipSuccess) fprintf(stderr, "cooperative launch failed: %s\n", hipGetErrorString(e));
}
```

```cpp
#include <hip/hip_runtime.h>
#include <hip/hip_cooperative_groups.h>
#include <cstdio>
#include <cstdint>
namespace cg = cooperative_groups;

#define LAS __attribute__((address_space(3)))
typedef unsigned short bf16_t;
typedef short bf16x8 __attribute__((ext_vector_type(8)));
typedef short s16x4 __attribute__((ext_vector_type(4)));
typedef float f32x4 __attribute__((ext_vector_type(4)));
typedef float f32x16 __attribute__((ext_vector_type(16)));
typedef unsigned u32x4 __attribute__((ext_vector_type(4)));
typedef unsigned u32x2 __attribute__((ext_vector_type(2)));

constexpr int DM = 1024, NB = 8, SEQ = 8192, CTX = 256, RPB = SEQ + CTX, R = NB * RPB, DFF = 2816;
constexpr int NHIN = 2304, INCOLS = 6304, GATE0 = 2208;
constexpr int MODW = 9216;
constexpr float EPS = 1e-6f;
constexpr float LOG2E = 1.4426950408889634f;
constexpr float QS_GQA = 0.125f * LOG2E, QS_MLA = 0.10206207261596577f * LOG2E, QS_DIFF = 0.17677669529663687f * LOG2E;

constexpr size_t MiB = 1u << 20;
constexpr size_t WS_MOD = 0;
constexpr size_t WS_XC = 2 * MiB;
constexpr size_t WS_W = 10 * MiB;
constexpr size_t W_GU = 0, W_GU_SZ = (size_t)5632 * 1024 * 2;
constexpr size_t W_D = W_GU + 2 * W_GU_SZ, W_D_SZ = (size_t)1024 * 2816 * 2;
constexpr size_t W_IN = W_D + 2 * W_D_SZ, W_IN_SZ = (size_t)NHIN * 1024 * 2;
constexpr size_t W_G = W_IN + W_IN_SZ, W_G_SZ = (size_t)4096 * 1024 * 2;
constexpr size_t W_BR = W_G + W_G_SZ;
constexpr size_t W_OUT = W_BR + W_G_SZ, W_OUT_SZ = (size_t)1024 * 1024 * 2;
constexpr size_t W_MLA = W_OUT + W_OUT_SZ, W_MLA_SZ = (size_t)1024 * 384 * 2;
constexpr size_t W_LAYER = W_MLA + W_MLA_SZ;
static_assert(WS_W + 2 * W_LAYER <= 124 * MiB, "weights");
constexpr size_t ROWBUF = (size_t)R * 1024 * 2;
constexpr size_t WS_U = 124 * MiB;
constexpr size_t WS_Y = WS_U + ROWBUF;
constexpr size_t WS_BIG = WS_Y + ROWBUF;
constexpr size_t WS_OUTS = WS_BIG + (size_t)R * NHIN * 2;
constexpr size_t WS_VT = WS_OUTS + ROWBUF;
constexpr size_t WS_GSCR = WS_VT + (size_t)NB * 768 * RPB * 2;
constexpr size_t WS_END = WS_GSCR + 256 * 131072;
static_assert(WS_END <= 1024 * MiB, "ws");
static_assert(WS_BIG + (size_t)R * DFF * 2 <= WS_END, "H");

constexpr int LDS_BYTES = 147456;
constexpr size_t WS_BAR = 1 * MiB;
constexpr int LDS_BARST = 147456 - 64;

__device__ __forceinline__ unsigned f2bf(float f) { unsigned u = __builtin_bit_cast(unsigned, f); return (u + 0x7fffu + ((u >> 16) & 1u)) >> 16; }
__device__ __forceinline__ unsigned pk2(float lo, float hi) { return f2bf(lo) | (f2bf(hi) << 16); }
__device__ __forceinline__ float bf2f(unsigned short h) { return __builtin_bit_cast(float, (unsigned)h << 16); }
__device__ __forceinline__ float bflo(unsigned w) { return __builtin_bit_cast(float, w << 16); }
__device__ __forceinline__ float bfhi(unsigned w) { return __builtin_bit_cast(float, w & 0xffff0000u); }
__device__ __forceinline__ float wave_sum(float v) {
#pragma unroll
    for (int o = 1; o < 64; o <<= 1) v += __shfl_xor(v, o);
    return v;
}
__device__ __forceinline__ int ptid() { int t = threadIdx.x; asm volatile("" : "+v"(t)); return t; }
__device__ __forceinline__ float fexp2(float x) { return __builtin_amdgcn_exp2f(x); }
__device__ __forceinline__ float frcp(float x) { return __builtin_amdgcn_rcpf(x); }
__device__ __forceinline__ float sigmoidf_(float x) { return frcp(1.f + fexp2(-x * LOG2E)); }

namespace pg8 {
constexpr int BM = 256, BK = 64, HALF = 128, HTB = HALF * BK * 2, STAGE_BYTES = 8 * HTB, NXCD = 8, WGM = 8;
__device__ __forceinline__ int lds_byte(int r, int c) { const int st = (r >> 4) * 2 + (c >> 5), rr = r & 15, cc = c & 31, ob = rr * 64 + cc * 2; return st * 1024 + (ob ^ (((ob >> 9) & 1) << 5)); }
__device__ __forceinline__ void stage_rc(int b, int& Rr, int& C) { const int st = b / 1024, sb = b % 1024, swz = sb ^ (((sb >> 9) & 1) << 5); Rr = (st >> 1) * 16 + swz / 64; C = (st & 1) * 32 + (swz % 64) / 2; }
__device__ __forceinline__ int perm32(int rho) { const int n = rho >> 4, i = rho & 15; return 8 * (i >> 2) + 4 * n + (i & 3); }

struct Unit { int pm, pn, kind; };
struct Gemm { const bf16_t* A; const bf16_t* Bt; const bf16_t* A2; const bf16_t* Bt2; int lda, ldb, K; };

struct StaticOrder {
    int nM, nN, nwg, G, c, dual;
    __device__ void init(int M, int N, int G_, int c_, int dual_) { nM = M / BM; nN = N / BM; nwg = nM * nN; G = G_; c = c_; dual = dual_; }
    __device__ bool next(int i, Unit& u) const {
        const int ii = dual ? (i >> 1) : i;
        u.kind = dual ? (i & 1) : 0;
        const long L = (long)ii * G + c; if (L >= nwg) return false;
        int wgid = (int)L; { const int q = nwg / NXCD, r = nwg % NXCD, xcd = wgid % NXCD, off = wgid / NXCD; wgid = (xcd < r ? xcd * (q + 1) : r * (q + 1) + (xcd - r) * q) + off; }
        const int nig = WGM * nN, gid = wgid / nig, fm = gid * WGM, gsz = (nM - fm) < WGM ? (nM - fm) : WGM;
        u.pm = fm + ((wgid % nig) % gsz); u.pn = (wgid % nig) / gsz; return true;
    }
};

typedef float f32x2_t __attribute__((ext_vector_type(2))); typedef __bf16 bf16x2_t __attribute__((ext_vector_type(2)));
__device__ __forceinline__ unsigned cvt_pk_bf16(float lo, float hi) { f32x2_t v = {lo, hi}; bf16x2_t b = __builtin_convertvector(v, bf16x2_t); return __builtin_bit_cast(unsigned, b); }

struct Epi {
    int mode; bf16_t* O; int ldc; u32x4* scr;
    __device__ __forceinline__ void operator()(const f32x4 (&acc)[2][2][4][2], const Unit& u, int wr, int wc, int fr, int fq) const {
        const int row0 = u.pm * BM + wr * 64 + fr;
        if (mode == 0) {
            const int col0 = u.pn * BM + wc * 32 + 8 * fq;
#pragma unroll
            for (int ai = 0; ai < 2; ++ai)
#pragma unroll
                for (int m = 0; m < 4; ++m) { bf16_t* rowp = O + (size_t)(row0 + ai * HALF + m * 16) * ldc + col0;
#pragma unroll
                    for (int bj = 0; bj < 2; ++bj) { const f32x4 v0 = acc[ai][bj][m][0], v1 = acc[ai][bj][m][1];
                        u32x4 w; w.x = cvt_pk_bf16(v0[0], v0[1]); w.y = cvt_pk_bf16(v0[2], v0[3]); w.z = cvt_pk_bf16(v1[0], v1[1]); w.w = cvt_pk_bf16(v1[2], v1[3]);
                        *(u32x4*)(rowp + bj * HALF) = w; } }
        } else if (mode == 1) {
            const int col0 = u.pn * HALF + wc * 32 + 8 * fq;
#pragma unroll
            for (int ai = 0; ai < 2; ++ai)
#pragma unroll
                for (int m = 0; m < 4; ++m) { bf16_t* rowp = O + (size_t)(row0 + ai * HALF + m * 16) * ldc + col0;
                    float h[8];
#pragma unroll
                    for (int n = 0; n < 2; ++n)
#pragma unroll
                        for (int e = 0; e < 4; ++e) { const float g = acc[ai][0][m][n][e], up = acc[ai][1][m][n][e]; h[n * 4 + e] = g * sigmoidf_(g) * up; }
                    u32x4 w; w.x = cvt_pk_bf16(h[0], h[1]); w.y = cvt_pk_bf16(h[2], h[3]); w.z = cvt_pk_bf16(h[4], h[5]); w.w = cvt_pk_bf16(h[6], h[7]);
                    *(u32x4*)rowp = w; }
        } else if (mode == 3) {
            const int col0 = u.pn * BM + wc * 32 + 8 * fq;
#pragma unroll
            for (int ai = 0; ai < 2; ++ai)
#pragma unroll
                for (int m = 0; m < 4; ++m) { bf16_t* rowp = O + (size_t)(row0 + ai * HALF + m * 16) * ldc + col0;
#pragma unroll
                    for (int bj = 0; bj < 2; ++bj) { const f32x4 v0 = acc[ai][bj][m][0], v1 = acc[ai][bj][m][1];
                        u32x4 w; w.x = cvt_pk_bf16(sigmoidf_(v0[0]), sigmoidf_(v0[1])); w.y = cvt_pk_bf16(sigmoidf_(v0[2]), sigmoidf_(v0[3]));
                        w.z = cvt_pk_bf16(sigmoidf_(v1[0]), sigmoidf_(v1[1])); w.w = cvt_pk_bf16(sigmoidf_(v1[2]), sigmoidf_(v1[3]));
                        *(u32x4*)(rowp + bj * HALF) = w; } }
        } else {
            const int gcol0 = u.pn * BM + wc * 32 + 8 * fq, col0 = u.pn * 64 + wc * 16 + 4 * fq;
#pragma unroll
            for (int ai = 0; ai < 2; ++ai)
#pragma unroll
                for (int m = 0; m < 4; ++m) { float y0 = 0.f, y1 = 0.f, y2 = 0.f, y3 = 0.f;
                    const bf16_t* gp = (const bf16_t*)scr + (size_t)(row0 + ai * HALF + m * 16) * 4096 + gcol0;
#pragma unroll
                    for (int bj = 0; bj < 2; ++bj) { const u32x4 w = *(const u32x4*)(gp + bj * HALF); const f32x4 v0 = acc[ai][bj][m][0], v1 = acc[ai][bj][m][1];
                        y0 += bflo(w.x) * v0[0] + bflo(w.z) * v1[0]; y1 += bfhi(w.x) * v0[1] + bfhi(w.z) * v1[1];
                        y2 += bflo(w.y) * v0[2] + bflo(w.w) * v1[2]; y3 += bfhi(w.y) * v0[3] + bfhi(w.w) * v1[3]; }
                    u32x2 o; o.x = cvt_pk_bf16(y0, y1); o.y = cvt_pk_bf16(y2, y3);
                    *(u32x2*)(O + (size_t)(row0 + ai * HALF + m * 16) * ldc + col0) = o; }
        }
    }
};

template <bool ZSKIP, class Sched>
__device__ __forceinline__ void gemm_phase(LAS unsigned char* lds, const Gemm g, const Sched& S, const Epi& E) {
    const int tid = ptid(), wid = __builtin_amdgcn_readfirstlane(tid >> 6), lane = tid & 63, wr = wid >> 2, wc = wid & 3, fr = lane & 15, fq = lane >> 4;
    const int K = g.K, nt = K / BK;
    unsigned voffA[2], voffB[2];
#pragma unroll
    for (int i = 0; i < 2; ++i) { int Rr, C; stage_rc(tid * 16 + i * 8192, Rr, C); const int Rb = (Rr & ~31) + perm32(Rr & 31);
        voffA[i] = (unsigned)(Rr * g.lda + C) * 2u; voffB[i] = (unsigned)(Rb * g.ldb + C) * 2u; }
    const size_t kstep = (size_t)(BK * 2);
    const size_t hsA = (size_t)HALF * g.lda * 2, hsB = (size_t)HALF * g.ldb * 2;
    const size_t tsA = 2 * hsA, tsB = 2 * hsB;
    const unsigned ldsw = (unsigned)wid * 1024u;
    const int aoff = lds_byte(wr * 64 + fr, fq * 8), boff = lds_byte(wc * 32 + fr, fq * 8);
#define PG8_SA(b, h) (((b) * 2 + (h)) * HTB)
#define PG8_SB(b, h) ((4 + (b) * 2 + (h)) * HTB)
#define PG8_STAGE(bufoff, gbase, voff) do { _Pragma("unroll") for (int _i = 0; _i < 2; ++_i) \
        __builtin_amdgcn_global_load_lds((const unsigned*)((const char*)(gbase) + (voff)[_i]), (LAS unsigned*)(lds + (bufoff) + ldsw + _i * 8192), 16, 0, 0); } while (0)
#define PG8_LDA(dst, b, h) do { _Pragma("unroll") for (int m = 0; m < 4; ++m) _Pragma("unroll") for (int k = 0; k < 2; ++k) dst[m][k] = *(const LAS bf16x8*)(lds + PG8_SA(b, h) + aoff + m * 2048 + k * 1024); } while (0)
#define PG8_LDB(dst, b, h) do { _Pragma("unroll") for (int n = 0; n < 2; ++n) _Pragma("unroll") for (int k = 0; k < 2; ++k) dst[n][k] = *(const LAS bf16x8*)(lds + PG8_SB(b, h) + boff + n * 2048 + k * 1024); } while (0)
#define PG8_MMA(ai, bj, At, Bt) do { __builtin_amdgcn_s_setprio(1); _Pragma("unroll") for (int m = 0; m < 4; ++m) _Pragma("unroll") for (int n = 0; n < 2; ++n) _Pragma("unroll") for (int k = 0; k < 2; ++k) \
        acc[ai][bj][m][n] = __builtin_amdgcn_mfma_f32_16x16x32_bf16(Bt[n][k], At[m][k], acc[ai][bj][m][n], 0, 0, 0); __builtin_amdgcn_s_setprio(0); } while (0)
#define PG8_MMA1(ai, bj, nn, At, Bt) do { __builtin_amdgcn_s_setprio(1); _Pragma("unroll") for (int m = 0; m < 4; ++m) _Pragma("unroll") for (int k = 0; k < 2; ++k) \
        acc[ai][bj][m][nn] = __builtin_amdgcn_mfma_f32_16x16x32_bf16(Bt[nn][k], At[m][k], acc[ai][bj][m][nn], 0, 0, 0); __builtin_amdgcn_s_setprio(0); } while (0)
#define PG8_MMAZ(ai, At) do { if (zbr == 0) PG8_MMA1(ai, 0, 0, At, B0); else if (zbr == 1) PG8_MMA1(ai, 0, 1, At, B0); else if (zbr == 2) PG8_MMA1(ai, 1, 0, At, B1); else PG8_MMA1(ai, 1, 1, At, B1); } while (0)
#define PG8_MM2(ai, At) do { if constexpr (ZSKIP) PG8_MMAZ(ai, At); else { PG8_MMA(ai, 0, At, B0); PG8_MMA(ai, 1, At, B1); } } while (0)
#define PG8_WAIT_V(n) asm volatile("s_waitcnt vmcnt(" #n ")" ::: "memory")
#define PG8_WAIT_L(n) asm volatile("s_waitcnt lgkmcnt(" #n ")" ::: "memory")
#define PG8_BAR __builtin_amdgcn_s_barrier()
#define PG8_SCHED __builtin_amdgcn_sched_barrier(0)
#define PG8_UA(u) ((const char*)((u).kind ? g.A2 : g.A) + (size_t)(u).pm * tsA)
#define PG8_UB(u) ((const char*)((u).kind ? g.Bt2 : g.Bt) + (size_t)(u).pn * tsB)
    Unit cur, nxt; int ui = 0;
    if (!S.next(0, cur)) return;
    f32x4 acc[2][2][4][2];
#pragma unroll
    for (int a = 0; a < 2; ++a)
#pragma unroll
        for (int b = 0; b < 2; ++b)
#pragma unroll
            for (int m = 0; m < 4; ++m)
#pragma unroll
                for (int n = 0; n < 2; ++n) acc[a][b][m][n] = (f32x4){0.f, 0.f, 0.f, 0.f};
    bf16x8 At[4][2], B0[2][2], B1[2][2];
    const char* cA = PG8_UA(cur); const char* cB = PG8_UB(cur);
    {
        PG8_STAGE(PG8_SB(0, 0), cB, voffB); PG8_STAGE(PG8_SB(0, 1), cB + hsB, voffB); PG8_STAGE(PG8_SA(0, 0), cA, voffA); PG8_STAGE(PG8_SA(0, 1), cA + hsA, voffA);
        if (wr == 1) PG8_BAR;
        PG8_WAIT_V(2); PG8_BAR;
        PG8_STAGE(PG8_SB(1, 0), cB + kstep, voffB); PG8_STAGE(PG8_SA(1, 0), cA + kstep, voffA); PG8_STAGE(PG8_SB(1, 1), cB + hsB + kstep, voffB);
        PG8_WAIT_V(6); PG8_BAR;
    }
    for (;;) {
        const bool has_next = S.next(ui + 1, nxt);
        const char* nA = has_next ? PG8_UA(nxt) : cA; const char* nB = has_next ? PG8_UB(nxt) : cB;
        for (int t = 0; t < nt; t += 2) {
            const bool last = (t == nt - 2); const int zbr = t >> 2;
            const char* a1 = cA + (size_t)(t + 1) * kstep;
            const char* a2 = last ? nA : cA + (size_t)(t + 2) * kstep; const char* b2 = last ? nB : cB + (size_t)(t + 2) * kstep;
            const char* a3 = a2 + kstep; const char* b3 = b2 + kstep;
            PG8_LDB(B0, 0, 0); PG8_LDB(B1, 0, 1); PG8_SCHED; PG8_LDA(At, 0, 0); PG8_STAGE(PG8_SA(1, 1), a1 + hsA, voffA);
            PG8_WAIT_V(8); PG8_WAIT_L(0); PG8_BAR; PG8_MM2(0, At); PG8_BAR; PG8_SCHED;
            PG8_LDA(At, 0, 1); PG8_STAGE(PG8_SB(0, 0), b2, voffB); PG8_STAGE(PG8_SB(0, 1), b2 + hsB, voffB); PG8_STAGE(PG8_SA(0, 0), a2, voffA);
            PG8_WAIT_V(8); PG8_WAIT_L(0); PG8_BAR; PG8_MM2(1, At); PG8_BAR; PG8_SCHED;
            PG8_LDB(B0, 1, 0); PG8_LDB(B1, 1, 1); PG8_SCHED; PG8_LDA(At, 1, 0); PG8_STAGE(PG8_SA(0, 1), a2 + hsA, voffA);
            PG8_WAIT_V(8); PG8_WAIT_L(0); PG8_BAR; PG8_MM2(0, At); PG8_BAR; PG8_SCHED;
            PG8_LDA(At, 1, 1); PG8_STAGE(PG8_SB(1, 0), b3, voffB); PG8_STAGE(PG8_SB(1, 1), b3 + hsB, voffB); PG8_STAGE(PG8_SA(1, 0), a3, voffA);
            PG8_WAIT_V(8); PG8_WAIT_L(0); PG8_BAR; PG8_MM2(1, At); PG8_BAR; PG8_SCHED;
        }
        if (wr == 0) PG8_BAR;
        E(acc, cur, wr, wc, fr, fq);
        if (!has_next) break;
#pragma unroll
        for (int a = 0; a < 2; ++a)
#pragma unroll
            for (int b = 0; b < 2; ++b)
#pragma unroll
                for (int m = 0; m < 4; ++m)
#pragma unroll
                    for (int n = 0; n < 2; ++n) acc[a][b][m][n] = (f32x4){0.f, 0.f, 0.f, 0.f};
        cur = nxt; cA = nA; cB = nB; ++ui;
        if (wr == 1) PG8_BAR;
    }
    PG8_WAIT_V(0);
    PG8_BAR;
#undef PG8_SA
#undef PG8_SB
#undef PG8_STAGE
#undef PG8_LDA
#undef PG8_LDB
#undef PG8_MMA
#undef PG8_MMA1
#undef PG8_MMAZ
#undef PG8_MM2
#undef PG8_WAIT_V
#undef PG8_WAIT_L
#undef PG8_BAR
#undef PG8_SCHED
#undef PG8_UA
#undef PG8_UB
}
}

struct Args {
    const float* x; const float* c; const float* ctx; const float* c_ctx; const float* w_mod; const float* b_mod; const float* g_pre; const float* g_post;
    const float* w_gate; const float* w_up; const float* w_down; const float* w_in; const float* gqa_qn; const float* gqa_kn; const float* mla_qn; const float* mla_kvn;
    const float* w_uq; const float* w_ukv; const float* dlam; const float* dsub; const float* sink; const float* w_branch; const float* w_out;
    float* out; unsigned char* ws; int ph_lo, ph_hi;
};
typedef const __attribute__((address_space(4))) Args CArgs;

template <class F>
__device__ __forceinline__ void conv_item(bf16_t* WT, int K, int nblk, int item, LAS float* scr, int lane, const F& f) {
    const int kb = item / nblk, nb = item % nblk, k0 = 64 * kb, n0 = 32 * nb;
#pragma unroll 8
    for (int i = 0; i < 32; ++i) { const int kk = 2 * i + (lane >> 5); scr[kk * 33 + (lane & 31)] = f(n0 + (lane & 31), k0 + kk); }
    asm volatile("s_waitcnt lgkmcnt(0)" ::: "memory");
    const int c = lane & 7;
#pragma unroll
    for (int j = 0; j < 4; ++j) { const int n = (lane >> 3) + 8 * j; const LAS float* s = scr + (8 * c) * 33 + n;
        u32x4 o; o.x = pk2(s[0 * 33], s[1 * 33]); o.y = pk2(s[2 * 33], s[3 * 33]); o.z = pk2(s[4 * 33], s[5 * 33]); o.w = pk2(s[6 * 33], s[7 * 33]);
        *(u32x4*)(WT + (size_t)(n0 + n) * K + k0 + 8 * c) = o; }
    asm volatile("s_waitcnt lgkmcnt(0)" ::: "memory");
}

__device__ __forceinline__ void p0_phase(CArgs& a, LAS unsigned char* lds) {
    const int tid = ptid(), lane = tid & 63, wave = tid >> 6;
    float* MOD = (float*)(a.ws + WS_MOD);
    {
        LAS float* sl = (LAS float*)lds;
        LAS float* red = (LAS float*)(lds + 40960);
        for (int i = tid; i < 9 * 1024; i += 512) { const int r = i >> 10, k = i & 1023; const float v = r < 8 ? a.c[r * 1024 + k] : a.c_ctx[k]; sl[i] = v * sigmoidf_(v); }
        __syncthreads();
        for (int it = blockIdx.x; it < 2 * 144; it += gridDim.x) {
            const int l = it / 144, n0 = (it % 144) * 64;
            const float* W = a.w_mod + (size_t)l * 1024 * MODW + n0 + lane;
            float acc[9];
#pragma unroll
            for (int r = 0; r < 9; ++r) acc[r] = 0.f;
#pragma unroll 8
            for (int kk = 0; kk < 128; ++kk) { const int k = wave * 128 + kk; const float wv = W[(size_t)k * MODW];
#pragma unroll
                for (int r = 0; r < 9; ++r) acc[r] += sl[r * 1024 + k] * wv; }
#pragma unroll
            for (int r = 0; r < 9; ++r) red[(wave * 9 + r) * 64 + lane] = acc[r];
            __syncthreads();
            for (int i = tid; i < 9 * 64; i += 512) { const int r = i >> 6, cidx = i & 63; float s = a.b_mod[l * MODW + n0 + cidx];
#pragma unroll
                for (int w = 0; w < 8; ++w) s += red[(w * 9 + r) * 64 + cidx];
                MOD[((size_t)l * 9 + r) * MODW + n0 + cidx] = s; }
            __syncthreads();
        }
        __syncthreads();
    }
    LAS float* scr = (LAS float*)(lds + wave * 8448);
    const int gw = blockIdx.x * 8 + wave, NGW = gridDim.x * 8;
    constexpr int I_GU = 176 * 16, I_D = 32 * 44, I_IN = 72 * 16, I_G = 128 * 16, I_OUT = 32 * 16, I_MLA = 32 * 6;
    constexpr int I_LAYER = 2 * I_GU + 2 * I_D + I_IN + 2 * I_G + I_OUT + I_MLA;
    for (int it = gw; it < 2 * I_LAYER; it += NGW) {
        const int l = it / I_LAYER; int r = it % I_LAYER;
        unsigned char* wb = a.ws + WS_W + (size_t)l * W_LAYER;
        if (r < 2 * I_GU) { const int s = r / I_GU; r %= I_GU;
            const float* wg = a.w_gate + (size_t)(l * 2 + s) * 1024 * DFF; const float* wu = a.w_up + (size_t)(l * 2 + s) * 1024 * DFF;
            conv_item((bf16_t*)(wb + W_GU + s * W_GU_SZ), 1024, 176, r, scr, lane, [=](int n, int k) { const int j = (n >> 8) * 128 + (n & 127); return ((n >> 7) & 1) ? wu[(size_t)k * DFF + j] : wg[(size_t)k * DFF + j]; });
            continue; }
        r -= 2 * I_GU;
        if (r < 2 * I_D) { const int s = r / I_D; r %= I_D;
            const float* wd = a.w_down + (size_t)(l * 2 + s) * DFF * 1024;
            conv_item((bf16_t*)(wb + W_D + s * W_D_SZ), DFF, 32, r, scr, lane, [=](int n, int k) { return wd[(size_t)k * 1024 + n]; });
            continue; }
        r -= 2 * I_D;
        const float* win = a.w_in + (size_t)l * 1024 * INCOLS;
        if (r < I_IN) { conv_item((bf16_t*)(wb + W_IN), 1024, 72, r, scr, lane, [=](int n, int k) { return n < GATE0 ? win[(size_t)k * INCOLS + n] : 0.f; }); continue; }
        r -= I_IN;
        if (r < I_G) { conv_item((bf16_t*)(wb + W_G), 1024, 128, r, scr, lane, [=](int n, int k) {
                const int br = 2 * ((n >> 7) & 1) + ((n >> 2) & 1), ch = 64 * (n >> 8) + 16 * ((n >> 5) & 3) + 4 * ((n >> 3) & 3) + (n & 3);
                return win[(size_t)k * INCOLS + GATE0 + br * 1024 + ch]; }); continue; }
        r -= I_G;
        if (r < I_G) { const float* wbr = a.w_branch + (size_t)l * 4 * 256 * 1024;
            conv_item((bf16_t*)(wb + W_BR), 1024, 128, r, scr, lane, [=](int n, int k) {
                const int br = 2 * ((n >> 7) & 1) + ((n >> 2) & 1), ch = 64 * (n >> 8) + 16 * ((n >> 5) & 3) + 4 * ((n >> 3) & 3) + (n & 3);
                return (k >> 8) == br ? wbr[((size_t)br * 256 + (k & 255)) * 1024 + ch] : 0.f; }); continue; }
        r -= I_G;
        if (r < I_OUT) { const float* wo = a.w_out + (size_t)l * 1024 * 1024;
            conv_item((bf16_t*)(wb + W_OUT), 1024, 32, r, scr, lane, [=](int n, int k) { return wo[(size_t)k * 1024 + n]; }); continue; }
        r -= I_OUT;
        { const float* uq = a.w_uq + (size_t)l * 256 * 384; const float* ukv = a.w_ukv + (size_t)l * 128 * 512; const float* gq = a.mla_qn + l * 256; const float* gkv = a.mla_kvn + l * 128;
            conv_item((bf16_t*)(wb + W_MLA), 384, 32, r, scr, lane, [=](int n, int k) {
                float v = 0.f;
                if (n < 384) { if (k < 256) v = gq[k] * uq[(size_t)k * 384 + n]; }
                else if (n < 896) { if (k >= 256) v = gkv[k - 256] * ukv[(size_t)(k - 256) * 512 + (n - 384)]; }
                return v; }); }
    }
}

__device__ __forceinline__ void row_phase(CArgs& a, int l, bool first, const bf16_t* Y, int sub_y, float gscale, bf16_t* U, int sub_u, int l_u) {
    const int tid_ = ptid(); const int lane = tid_ & 63, wave = tid_ >> 6;
    const int gw = blockIdx.x * 8 + wave, NGW = gridDim.x * 8;
    const float* MOD = (const float*)(a.ws + WS_MOD);
    float* XC = (float*)(a.ws + WS_XC);
    for (int row = gw; row < R; row += NGW) {
        const int b = row / RPB, t = row % RPB; const bool isctx = t < CTX;
        const float* xs; float* xd;
        if (isctx) { const size_t o = (size_t)(b * CTX + t) * DM; xs = (first ? a.ctx : XC) + o; xd = XC + o; }
        else { const size_t o = (size_t)(b * SEQ + (t - CTX)) * DM; xs = (first ? a.x : a.out) + o; xd = a.out + o; }
        const int mrow = isctx ? 8 : b;
        f32x4 v[4];
#pragma unroll
        for (int j = 0; j < 4; ++j) v[j] = *(const f32x4*)(xs + 4 * lane + 256 * j);
        if (Y) {
            const float* md = MOD + ((size_t)l * 9 + mrow) * MODW + (sub_y * 3 + 2) * 1024;
            const float* gp = a.g_post + (l * 3 + sub_y) * 1024;
            f32x4 y[4]; float ss = 0.f;
#pragma unroll
            for (int j = 0; j < 4; ++j) { const u32x2 w = *(const u32x2*)(Y + (size_t)row * DM + 4 * lane + 256 * j);
                y[j] = (f32x4){bflo(w.x), bfhi(w.x), bflo(w.y), bfhi(w.y)}; ss += (y[j].x * y[j].x + y[j].y * y[j].y) + (y[j].z * y[j].z + y[j].w * y[j].w); }
            const float rs = __builtin_amdgcn_rsqf(wave_sum(ss) * (1.f / DM) + EPS) * gscale;
#pragma unroll
            for (int j = 0; j < 4; ++j) { const f32x4 g = *(const f32x4*)(md + 4 * lane + 256 * j), p = *(const f32x4*)(gp + 4 * lane + 256 * j);
                v[j] = v[j] + (y[j] * rs) * p * g; *(f32x4*)(xd + 4 * lane + 256 * j) = v[j]; }
        }
        if (U) {
            const float* md = MOD + ((size_t)l_u * 9 + mrow) * MODW + (sub_u * 3) * 1024;
            const float* gp = a.g_pre + (l_u * 3 + sub_u) * 1024;
            float ss = 0.f;
#pragma unroll
            for (int j = 0; j < 4; ++j) ss += (v[j].x * v[j].x + v[j].y * v[j].y) + (v[j].z * v[j].z + v[j].w * v[j].w);
            const float rs = __builtin_amdgcn_rsqf(wave_sum(ss) * (1.f / DM) + EPS);
#pragma unroll
            for (int j = 0; j < 4; ++j) { const f32x4 sh = *(const f32x4*)(md + 4 * lane + 256 * j), sc = *(const f32x4*)(md + 1024 + 4 * lane + 256 * j), p = *(const f32x4*)(gp + 4 * lane + 256 * j);
                const f32x4 u = (v[j] * rs) * p * (sc + 1.f) + sh;
                u32x2 w; w.x = pk2(u.x, u.y); w.y = pk2(u.z, u.w);
                *(u32x2*)(U + (size_t)row * DM + 4 * lane + 256 * j) = w; }
        }
    }
}

constexpr int VSTR = 136;
constexpr int TAB_OFF = 768 * VSTR;
__device__ __forceinline__ float rope64(float v, int lane, bool lat, const LAS float* tab, int prow, int pcol) {
    if (!lat) return v;
    const float p = __shfl_xor(v, 16);
    const int pos = (lane & 32) ? pcol : prow; const int f = lane & 15;
    const float c = tab[(pos * 16 + f) * 2], s = tab[(pos * 16 + f) * 2 + 1];
    return (lane & 16) ? (v * c + p * s) : (v * c - p * s);
}
__device__ __forceinline__ float rope32(float v, int lane, bool lat, const LAS float* tab, int prow, int pcol) {
    if (!lat) return v;
    const float p = __shfl_xor(v, 8);
    const int pos = (lane & 16) ? pcol : prow; const int f = 2 * (lane & 7);
    const float c = tab[(pos * 16 + f) * 2], s = tab[(pos * 16 + f) * 2 + 1];
    return (lane & 8) ? (v * c + p * s) : (v * c - p * s);
}
__device__ __forceinline__ void prep_phase(CArgs& a, int l, LAS unsigned char* lds) {
    const int tid = ptid(), lane = tid & 63, wave = tid >> 6;
    bf16_t* HIN = (bf16_t*)(a.ws + WS_BIG); bf16_t* MUP = (bf16_t*)(a.ws + WS_Y); bf16_t* VT = (bf16_t*)(a.ws + WS_VT);
    LAS float* tab = (LAS float*)(lds + TAB_OFF);
    for (int i = tid; i < 128 * 16; i += 512) { const int pos = i >> 4, f = i & 15;
        const float invf = fexp2(-(float)(2 * f) * (1.f / 32.f) * 13.287712379549449f);
        float rev = (float)pos * invf * 0.15915494309189535f; rev -= __builtin_floorf(rev);
        tab[i * 2] = __builtin_amdgcn_cosf(rev); tab[i * 2 + 1] = __builtin_amdgcn_sinf(rev); }
    __syncthreads();
    const float gq = a.gqa_qn[l * 64 + lane], gk = a.gqa_kn[l * 64 + lane];
    for (int tile = blockIdx.x; tile < R / 64; tile += gridDim.x) {
        const int row0 = tile * 64, b = row0 / RPB, t0 = row0 % RPB;
        for (int rr = 0; rr < 8; ++rr) {
            const int tk = wave * 8 + rr, row = row0 + tk, t = t0 + tk; const bool lat = t >= CTX;
            const int tl = lat ? t - CTX : 0, prow = tl >> 6, pcol = tl & 63;
            bf16_t* h = HIN + (size_t)row * NHIN; bf16_t* mu = MUP + (size_t)row * 1024;
            LAS bf16_t* vst = (LAS bf16_t*)lds + tk;
#pragma unroll
            for (int c = 0; c < 6; ++c) { float v = bf2f(h[c * 64 + lane]);
                const float ss = wave_sum(v * v); v = v * __builtin_amdgcn_rsqf(ss * (1.f / 64.f) + EPS) * (c < 4 ? gq : gk);
                v = rope64(v, lane, lat, tab, prow, pcol); if (c < 4) v *= QS_GQA;
                h[c * 64 + lane] = (bf16_t)f2bf(v); }
#pragma unroll
            for (int c = 0; c < 2; ++c) vst[(0 + c * 64 + lane) * (VSTR / 2)] = h[384 + c * 64 + lane];
            float sq = 0.f, skv = 0.f;
#pragma unroll
            for (int c = 0; c < 4; ++c) { const float v = bf2f(h[512 + c * 64 + lane]); sq += v * v; }
#pragma unroll
            for (int c = 0; c < 2; ++c) { const float v = bf2f(h[768 + c * 64 + lane]); skv += v * v; }
            const float rq = __builtin_amdgcn_rsqf(wave_sum(sq) * (1.f / 256.f) + EPS) * QS_MLA, rkv = __builtin_amdgcn_rsqf(wave_sum(skv) * (1.f / 128.f) + EPS);
#pragma unroll
            for (int hh = 0; hh < 4; ++hh) {
                { const float v = bf2f(mu[hh * 96 + lane]) * rq; mu[hh * 96 + lane] = (bf16_t)f2bf(v); }
                { float v = bf2f(mu[hh * 96 + 64 + (lane & 31)]) * rq; v = rope32(v, lane, lat, tab, prow, pcol); if (lane < 32) mu[hh * 96 + 64 + lane] = (bf16_t)f2bf(v); }
                { const float v = bf2f(mu[384 + hh * 128 + lane]) * rkv; mu[384 + hh * 128 + lane] = (bf16_t)f2bf(v); }
                { const float v = bf2f(mu[384 + hh * 128 + 64 + lane]) * rkv; vst[(128 + hh * 64 + lane) * (VSTR / 2)] = (bf16_t)f2bf(v); }
            }
            { float v = bf2f(h[896 + (lane & 31)]); v = rope32(v, lane, lat, tab, prow, pcol); if (lane < 32) mu[896 + lane] = (bf16_t)f2bf(v); }
#pragma unroll
            for (int c = 0; c < 8; ++c) { float v = bf2f(h[928 + c * 64 + lane]); v = rope32(v, lane, lat, tab, prow, pcol); if (c < 4) v *= QS_DIFF; h[928 + c * 64 + lane] = (bf16_t)f2bf(v); }
#pragma unroll
            for (int c = 0; c < 4; ++c) vst[(384 + c * 64 + lane) * (VSTR / 2)] = h[1440 + c * 64 + lane];
#pragma unroll
            for (int c = 0; c < 6; ++c) { float v = bf2f(h[1696 + c * 64 + lane]); v = rope64(v, lane, lat, tab, prow, pcol); if (c < 4) v *= QS_GQA; h[1696 + c * 64 + lane] = (bf16_t)f2bf(v); }
#pragma unroll
            for (int c = 0; c < 2; ++c) vst[(640 + c * 64 + lane) * (VSTR / 2)] = h[2080 + c * 64 + lane];
        }
        __syncthreads();
        bf16_t* vt = VT + (size_t)b * 768 * RPB + t0;
        for (int p = tid; p < 768 * 8; p += 512) { const int vr = p >> 3, seg = p & 7;
            const LAS u32x2* s = (const LAS u32x2*)(lds + vr * VSTR + seg * 16); const u32x2 lo = s[0], hi = s[1];
            *(u32x4*)(vt + (size_t)vr * RPB + seg * 8) = (u32x4){lo.x, lo.y, hi.x, hi.y}; }
        __syncthreads();
    }
}

__device__ __forceinline__ int crow(int r, int hi) { return (r & 3) + 8 * (r >> 2) + 4 * hi; }
constexpr int AT_KBUF = 64 * (96 * 2 + 16);
constexpr int AT_VSTR = 144, AT_VBUF = 64 * AT_VSTR;
constexpr int AT_K0 = 0, AT_V0 = 2 * AT_KBUF, AT_WS = AT_V0 + 2 * AT_VBUF;

struct AttnSrc { const bf16_t* Q; int ldq; const bf16_t* K1; int ldk1; const bf16_t* K2; int ldk2; const bf16_t* VT; };

template <int DQK, bool WIN>
__device__ __forceinline__ void attn_pass(const AttnSrc& s, int NT, int lo, int q0lat, float sink_l2, bool has_sink, LAS unsigned char* lds, f32x16 (&o)[2]) {
    constexpr int KSTR = DQK * 2 + 16, NCH = DQK / 8, NKS = DQK / 16;
    const int tid = ptid(), lane = tid & 63, r32 = lane & 31, hi = lane >> 5; const int wid = __builtin_amdgcn_readfirstlane(tid >> 6);
    LAS float* wsf = (LAS float*)(lds + AT_WS) + wid * 32;
    bf16x8 qf[NKS];
    { const bf16_t* qp = s.Q + (size_t)(wid * 32 + r32) * s.ldq + 8 * hi;
#pragma unroll
        for (int ks = 0; ks < NKS; ++ks) qf[ks] = *(const bf16x8*)(qp + 16 * ks); }
    o[0] = (f32x16){}; o[1] = (f32x16){};
    f32x16 negm = (f32x16){}; asm volatile("" : "+v"(negm));
    float mhat = 0.f, lsum = 0.f;
    const int kkey0 = tid / NCH, kc0 = tid % NCH;
    const int kkey1 = (tid + 512) / NCH, kc1 = (tid + 512) % NCH;
    const bool kv0 = tid < 64 * NCH, kv1 = (DQK == 96) && (tid < 256);
    const int vdv = tid >> 3, vseg = tid & 7;
    u32x4 kr0 = (u32x4){}, kr1 = (u32x4){}, vr = (u32x4){}, kn0 = (u32x4){}, kn1 = (u32x4){}, vn = (u32x4){};
    auto kaddr = [&](int key, int c) -> const bf16_t* { return (DQK == 96 && c >= 8) ? s.K2 + (size_t)key * s.ldk2 + (c - 8) * 8 : s.K1 + (size_t)key * s.ldk1 + c * 8; };
#define AT_TILE(i) ((i) < 4 ? (i) : lo - 4 + (i))
#define AT_GLOAD(K0, K1, V, i) do { const int key0_ = AT_TILE(i) * 64; \
        if (kv0) K0 = *(const u32x4*)kaddr(key0_ + kkey0, kc0); if (kv1) K1 = *(const u32x4*)kaddr(key0_ + kkey1, kc1); \
        V = *(const u32x4*)(s.VT + (size_t)vdv * RPB + key0_ + vseg * 8); } while (0)
#define AT_LSTORE(K0, K1, V, buf) do { if (kv0) *(LAS u32x4*)(lds + AT_K0 + (buf) * AT_KBUF + kkey0 * KSTR + kc0 * 16) = K0; \
        if (kv1) *(LAS u32x4*)(lds + AT_K0 + (buf) * AT_KBUF + kkey1 * KSTR + kc1 * 16) = K1; \
        *(LAS u32x4*)(lds + AT_V0 + (buf) * AT_VBUF + vdv * AT_VSTR + vseg * 16) = V; } while (0)
#define MX3(a, b, c) __builtin_fmaxf(__builtin_fmaxf((a), (b)), (c))
    AT_GLOAD(kr0, kr1, vr, 0); AT_LSTORE(kr0, kr1, vr, 0);
    if (NT > 1) AT_GLOAD(kr0, kr1, vr, 1);
    __syncthreads();
    for (int i = 0; i < NT; ++i) {
        const int buf = i & 1;
        if (i + 2 < NT) AT_GLOAD(kn0, kn1, vn, i + 2);
        const LAS unsigned char* kb = lds + AT_K0 + buf * AT_KBUF + r32 * KSTR + hi * 16;
        f32x16 s0, s1;
#pragma unroll
        for (int ks = 0; ks < NKS; ++ks) {
            const bf16x8 a0 = *(const LAS bf16x8*)(kb + ks * 32), a1 = *(const LAS bf16x8*)(kb + 32 * KSTR + ks * 32);
            if (ks == 0) { s0 = __builtin_amdgcn_mfma_f32_32x32x16_bf16(a0, qf[0], negm, 0, 0, 0); s1 = __builtin_amdgcn_mfma_f32_32x32x16_bf16(a1, qf[0], negm, 0, 0, 0); }
            else { s0 = __builtin_amdgcn_mfma_f32_32x32x16_bf16(a0, qf[ks], s0, 0, 0, 0); s1 = __builtin_amdgcn_mfma_f32_32x32x16_bf16(a1, qf[ks], s1, 0, 0, 0); }
        }
        if (WIN && i >= 4) {
            const int jb = AT_TILE(i) * 64 - CTX + 4 * hi, qi = q0lat + wid * 32 + r32;
#pragma unroll
            for (int r = 0; r < 16; ++r) { const int j = jb + (r & 3) + 8 * (r >> 2); const int d0 = qi - j, d1 = qi - (j + 32);
                if (d0 > 128 || d0 < -128) s0[r] = -1e30f; if (d1 > 128 || d1 < -128) s1[r] = -1e30f; }
        }
        float ra = MX3(s0[0], s0[1], s1[0]), rb = MX3(s0[2], s0[3], s1[1]); ra = MX3(ra, s1[2], s1[3]);
#pragma unroll
        for (int r = 4; r < 16; r += 4) { ra = MX3(ra, s0[r], s0[r + 1]); rb = MX3(rb, s0[r + 2], s0[r + 3]); ra = MX3(ra, s1[r], s1[r + 1]); rb = MX3(rb, s1[r + 2], s1[r + 3]); }
        float rm = __builtin_fmaxf(ra, rb);
        rm = __builtin_fmaxf(rm, __shfl_xor(rm, 32));
        if (i == 0 || __any(rm > 8.f)) {
            const float dl = (i == 0) ? rm : __builtin_fmaxf(rm, 0.f);
            mhat += dl;
#pragma unroll
            for (int r = 0; r < 16; ++r) { s0[r] -= dl; s1[r] -= dl; }
#pragma unroll
            for (int r = 0; r < 16; ++r) negm[r] = -mhat;
            asm volatile("" : "+v"(negm));
            if (i != 0) {
                const float f = fexp2(-dl);
                lsum *= f;
                if (hi == 0) wsf[r32] = f;
#pragma unroll
                for (int r = 0; r < 16; ++r) { const float fr_ = wsf[crow(r, hi)]; o[0][r] *= fr_; o[1][r] *= fr_; }
            }
        }
        float ps = 0.f, ps2 = 0.f;
#pragma unroll
        for (int r = 0; r < 16; ++r) { s0[r] = fexp2(s0[r]); s1[r] = fexp2(s1[r]); ps += s0[r]; ps2 += s1[r]; }
        lsum += ps + ps2;
        bf16x8 pa[4];
#pragma unroll
        for (int kk = 0; kk < 4; ++kk) {
            u32x4 w;
            if (kk < 2) { w.x = pg8::cvt_pk_bf16(s0[8 * kk + 0], s0[8 * kk + 1]); w.y = pg8::cvt_pk_bf16(s0[8 * kk + 2], s0[8 * kk + 3]); w.z = pg8::cvt_pk_bf16(s0[8 * kk + 4], s0[8 * kk + 5]); w.w = pg8::cvt_pk_bf16(s0[8 * kk + 6], s0[8 * kk + 7]); }
            else { const int k2 = kk - 2; w.x = pg8::cvt_pk_bf16(s1[8 * k2 + 0], s1[8 * k2 + 1]); w.y = pg8::cvt_pk_bf16(s1[8 * k2 + 2], s1[8 * k2 + 3]); w.z = pg8::cvt_pk_bf16(s1[8 * k2 + 4], s1[8 * k2 + 5]); w.w = pg8::cvt_pk_bf16(s1[8 * k2 + 6], s1[8 * k2 + 7]); }
            pa[kk] = __builtin_bit_cast(bf16x8, w);
        }
        const LAS unsigned char* vb = lds + AT_V0 + buf * AT_VBUF + r32 * AT_VSTR + hi * 8;
#pragma unroll
        for (int dvb = 0; dvb < 2; ++dvb)
#pragma unroll
            for (int kk = 0; kk < 4; ++kk) {
                const u32x2 lo_ = *(const LAS u32x2*)(vb + dvb * 32 * AT_VSTR + kk * 32), hi_ = *(const LAS u32x2*)(vb + dvb * 32 * AT_VSTR + kk * 32 + 16);
                const bf16x8 bv = __builtin_bit_cast(bf16x8, (u32x4){lo_.x, lo_.y, hi_.x, hi_.y});
                o[dvb] = __builtin_amdgcn_mfma_f32_32x32x16_bf16(pa[kk], bv, o[dvb], 0, 0, 0);
            }
        if (i + 1 < NT) AT_LSTORE(kr0, kr1, vr, buf ^ 1);
        __syncthreads();
        kr0 = kn0; kr1 = kn1; vr = vn;
    }
    float lt = lsum + __shfl_xor(lsum, 32);
    if (has_sink) lt += fexp2(sink_l2 - mhat);
    if (hi == 0) wsf[r32] = frcp(lt);
#pragma unroll
    for (int r = 0; r < 16; ++r) { const float fr_ = wsf[crow(r, hi)]; o[0][r] *= fr_; o[1][r] *= fr_; }
#undef AT_TILE
#undef AT_GLOAD
#undef AT_LSTORE
#undef MX3
}

__device__ __forceinline__ void attn_store(bf16_t* O, int row0, int col0, const f32x16 (&o)[2]) {
    const int tid_ = ptid(); const int lane = tid_ & 63, r32 = lane & 31, hi = lane >> 5, wid = tid_ >> 6;
#pragma unroll
    for (int dvb = 0; dvb < 2; ++dvb)
#pragma unroll
        for (int r = 0; r < 16; ++r) O[(size_t)(row0 + wid * 32 + crow(r, hi)) * 1024 + col0 + dvb * 32 + r32] = (bf16_t)f2bf(o[dvb][r]);
}

__device__ __forceinline__ void attn_unit(CArgs& a, int l, int branch, int b, int h, int qb, float lam, float lam_init, LAS unsigned char* lds) {
    const bf16_t* HIN = (const bf16_t*)(a.ws + WS_BIG) + (size_t)b * RPB * NHIN; const bf16_t* MUP = (const bf16_t*)(a.ws + WS_Y) + (size_t)b * RPB * 1024;
    const bf16_t* VT = (const bf16_t*)(a.ws + WS_VT) + (size_t)b * 768 * RPB; bf16_t* OUTS = (bf16_t*)(a.ws + WS_OUTS);
    const bool cq = qb < 0; const int qrow = cq ? 0 : CTX + 256 * qb;
    const int NTd = cq ? 4 : 132;
    const int orow0 = b * RPB + qrow;
    f32x16 o[2];
    AttnSrc s;
    if (branch == 0) {
        s.Q = HIN + (size_t)qrow * NHIN + 64 * h; s.ldq = NHIN; s.K1 = HIN + 256 + 64 * (h >> 1); s.ldk1 = NHIN; s.K2 = nullptr; s.ldk2 = 0; s.VT = VT + (size_t)(0 + 64 * (h >> 1)) * RPB;
        attn_pass<64, false>(s, NTd, 4, 0, 0.f, false, lds, o);
        attn_store(OUTS, orow0, 0 + 64 * h, o);
    } else if (branch == 1) {
        s.Q = MUP + (size_t)qrow * 1024 + 96 * h; s.ldq = 1024; s.K1 = MUP + 384 + 128 * h; s.ldk1 = 1024; s.K2 = MUP + 896; s.ldk2 = 1024; s.VT = VT + (size_t)(128 + 64 * h) * RPB;
        attn_pass<96, false>(s, NTd, 4, 0, 0.f, false, lds, o);
        attn_store(OUTS, orow0, 256 + 64 * h, o);
    } else if (branch == 2) {
        f32x16 o2[2];
        s.Q = HIN + (size_t)qrow * NHIN + 928 + 64 * h; s.ldq = NHIN; s.K1 = HIN + 1184 + 64 * h; s.ldk1 = NHIN; s.K2 = nullptr; s.ldk2 = 0; s.VT = VT + (size_t)(384 + 64 * h) * RPB;
        attn_pass<32, false>(s, NTd, 4, 0, 0.f, false, lds, o);
        s.Q += 32; s.K1 += 32;
        attn_pass<32, false>(s, NTd, 4, 0, 0.f, false, lds, o2);
        const int lane = ptid() & 63, r32 = lane & 31;
        const float g0 = a.dsub[l * 64 + r32] * (1.f - lam_init), g1 = a.dsub[l * 64 + 32 + r32] * (1.f - lam_init);
#pragma unroll
        for (int r = 0; r < 16; ++r) { const float x0 = o[0][r] - lam * o2[0][r], x1 = o[1][r] - lam * o2[1][r];
            float ss = x0 * x0 + x1 * x1;
#pragma unroll
            for (int m = 1; m < 32; m <<= 1) ss += __shfl_xor(ss, m);
            const float rs = __builtin_amdgcn_rsqf(ss * (1.f / 64.f) + EPS);
            o[0][r] = x0 * rs * g0; o[1][r] = x1 * rs * g1; }
        attn_store(OUTS, orow0, 512 + 64 * h, o);
    } else {
        s.Q = HIN + (size_t)qrow * NHIN + 1696 + 64 * h; s.ldq = NHIN; s.K1 = HIN + 1952 + 64 * (h >> 1); s.ldk1 = NHIN; s.K2 = nullptr; s.ldk2 = 0; s.VT = VT + (size_t)(640 + 64 * (h >> 1)) * RPB;
        const float sk = a.sink[l * 4 + h] * LOG2E;
        if (cq) attn_pass<64, false>(s, 4, 4, 0, sk, true, lds, o);
        else { const int q0 = 256 * qb; const int lo = 4 + (q0 >= 128 ? q0 - 128 : 0) / 64, hiT = 4 + ((q0 + 384) < SEQ ? (q0 + 384) : SEQ) / 64;
            attn_pass<64, true>(s, 4 + hiT - lo, lo, q0, sk, true, lds, o); }
        attn_store(OUTS, orow0, 768 + 64 * h, o);
    }
}

__device__ __forceinline__ void attn_phase(CArgs& a, int l, LAS unsigned char* lds) {
    const float lam_init = 0.8f - 0.6f * __expf(-0.3f * (float)l);
    float lam;
    { const float* dl = a.dlam + l * 128; float s1 = 0.f, s2 = 0.f;
        for (int i = 0; i < 32; ++i) { s1 += dl[i] * dl[32 + i]; s2 += dl[64 + i] * dl[96 + i]; }
        lam = __expf(s1) - __expf(s2) + lam_init; }
    const int G = gridDim.x, bx = blockIdx.x;
    const int vcu = (G % 8 == 0) ? (bx % 8) * (G / 8) + bx / 8 : bx;
    for (int ty = 0; ty < 4; ++ty) {
        const int branch = ty == 0 ? 2 : ty == 1 ? 1 : ty == 2 ? 0 : 3;
        for (int idx = vcu; idx < NB * 4 * 32; idx += G) { const int bh = idx >> 5, qb = idx & 31; attn_unit(a, l, branch, bh >> 2, bh & 3, qb, lam, lam_init, lds); }
    }
    for (int idx = vcu; idx < NB * 16; idx += G) attn_unit(a, l, (idx >> 2) & 3, idx >> 4, idx & 3, -1, lam, lam_init, lds);
}

#define GAS __attribute__((address_space(1)))
#define XB_TMO      128
#define XB_XCNT(j)  (256  + 64 * (j))
#define XB_XSUB(j)  (1280 + 64 * (j))
#define XB_XGEN(j)  (2304 + 64 * (j))
#define XB_TOP      3328
#define XB_TOPGEN   3392
#define XCD_BAR_WORDS 3456
#define XB_SPIN_CAP (1u << 18)

__device__ __forceinline__ unsigned xb_ld(unsigned* p)              { return __hip_atomic_load(p, __ATOMIC_RELAXED, __HIP_MEMORY_SCOPE_AGENT); }
__device__ __forceinline__ unsigned xb_add(unsigned* p, unsigned v) { return __hip_atomic_fetch_add(p, v, __ATOMIC_RELAXED, __HIP_MEMORY_SCOPE_AGENT); }
__device__ __forceinline__ unsigned xb_xcc_id() { return (unsigned)__builtin_amdgcn_s_getreg((3 << 11) | 20) & 0xFu; }
#define XB_SPIN(cond, bar) do { unsigned _sp = 0; while (cond) { __builtin_amdgcn_s_sleep(1); \
    if ((++_sp & 255u) == 0u) { if (xb_ld(&(bar)[XB_TMO])) break; if (_sp > XB_SPIN_CAP) { atomicAdd(&(bar)[XB_TMO], 1u); break; } } } } while (0)

struct XcdBarrier {
    unsigned* bar; unsigned x;
    volatile LAS unsigned* st;
};

__device__ __forceinline__ XcdBarrier xcd_barrier_post(unsigned* bar, volatile LAS unsigned* st) {
    XcdBarrier b; b.bar = bar; b.x = xb_xcc_id(); b.st = st;
    if (threadIdx.x == 0) (void)xb_add(&bar[XB_XCNT(b.x)], 1u);
    return b;
}
__device__ __forceinline__ void xcd_barrier_complete(unsigned* bar, unsigned x, unsigned& nloc, unsigned& nx) {
    const unsigned G = gridDim.x * gridDim.y * gridDim.z;
    unsigned sum, cnt, mine, sp = 0u;
    for (;;) {
        sum = 0u; cnt = 0u; mine = 0u;
#pragma unroll
        for (unsigned j = 0; j < 16; ++j) { const unsigned c = xb_ld(&bar[XB_XCNT(j)]); sum += c; cnt += (c > 0u) ? 1u : 0u; mine = (j == x) ? c : mine; }
        if (sum == G) break;
        __builtin_amdgcn_s_sleep(1);
        if ((++sp & 255u) == 0u) { if (xb_ld(&bar[XB_TMO])) break; if (sp > XB_SPIN_CAP) { atomicAdd(&bar[XB_TMO], 1u); break; } }
    }
    nloc = mine > 0u ? mine : 1u; nx = cnt > 0u ? cnt : 1u;
}

__device__ __forceinline__ void xcd_barrier(const XcdBarrier& b) {
    asm volatile("s_waitcnt vmcnt(0)" ::: "memory");
    __syncthreads();
    if (threadIdx.x == 0) {
        unsigned* bar = b.bar;
        __builtin_amdgcn_s_waitcnt(0);
        unsigned nloc = b.st[0], nx = b.st[1];
        if (nloc == 0u) { xcd_barrier_complete(bar, b.x, nloc, nx); b.st[0] = nloc; b.st[1] = nx; }
        const unsigned old = xb_add(&bar[XB_XSUB(b.x)], 1u);
        const unsigned gen = old / nloc;
        if (old + 1u == (gen + 1u) * nloc) {
            __builtin_amdgcn_fence(__ATOMIC_RELEASE, "agent");
            asm volatile("s_waitcnt vmcnt(0)" ::: "memory");
            const unsigned og = xb_add(&bar[XB_TOP], 1u);
            const unsigned tg = og / nx;
            if (og + 1u == (tg + 1u) * nx) xb_add(&bar[XB_TOPGEN], 1u);
            else XB_SPIN(xb_ld(&bar[XB_TOPGEN]) == tg, bar);
            __builtin_amdgcn_fence(__ATOMIC_ACQUIRE, "agent");
            xb_add(&bar[XB_XGEN(b.x)], 1u);
            asm volatile("s_waitcnt vmcnt(0)" ::: "memory");
        } else {
            XB_SPIN(xb_ld(&bar[XB_XGEN(b.x)]) == gen, bar);
            __builtin_amdgcn_fence(__ATOMIC_ACQUIRE, "agent");
            asm volatile("s_waitcnt vmcnt(0)" ::: "memory");
        }
    }
    __syncthreads();
}


constexpr int NPHASE = 2 + 32;
__global__ void __launch_bounds__(512, 2) fwd_kernel(Args a_) {
    extern __shared__ __attribute__((aligned(16))) unsigned char lds_raw[];
    LAS unsigned char* lds = (LAS unsigned char*)lds_raw;
    cg::grid_group grid = cg::this_grid();
    const int lo = a_.ph_lo, hi = a_.ph_hi < NPHASE ? a_.ph_hi : NPHASE;
    { volatile LAS unsigned* st0 = (volatile LAS unsigned*)(lds + LDS_BARST); if (threadIdx.x < 2) st0[threadIdx.x] = 0u; }
    __syncthreads();
    { XcdBarrier b0 = xcd_barrier_post((unsigned*)(a_.ws + WS_BAR), (volatile LAS unsigned*)(lds + LDS_BARST)); (void)b0; }
    for (int ph = lo; ph < hi; ++ph) {
        CArgs* ap_ = (CArgs*)__builtin_amdgcn_kernarg_segment_ptr(); asm volatile("" : "+s"(ap_) :: "memory"); CArgs& a = *ap_;
        int G = gridDim.x, bx = blockIdx.x; asm volatile("" : "+s"(G), "+s"(bx));
        if (ph == 0) p0_phase(a, lds);
        else if (ph == 1) row_phase(a, 0, true, nullptr, 0, 0.f, (bf16_t*)(a.ws + WS_U), 0, 0);
        else {
            const int l = (ph - 2) / 16, k = (ph - 2) % 16;
            unsigned char* ws = a.ws;
            const unsigned char* wb = ws + WS_W + (size_t)l * W_LAYER;
            bf16_t* U = (bf16_t*)(ws + WS_U); bf16_t* Yb = (bf16_t*)(ws + WS_Y); bf16_t* BIG = (bf16_t*)(ws + WS_BIG);
            if (k == 5) prep_phase(a, l, lds);
#ifndef X_ATTN
            else if (k == 6) attn_phase(a, l, lds);
#endif
            else if (k == 2) row_phase(a, l, l == 0, Yb, 0, 0.5f, U, 1, l);
            else if (k == 12) row_phase(a, l, false, BIG, 1, 1.0f, U, 2, l);
            else if (k == 15) row_phase(a, l, false, Yb, 2, 0.5f, l == 0 ? U : nullptr, 0, l + 1);
            else {
                pg8::Gemm g; pg8::Epi E; int N; int dual = 0; int Mrows = R;
                g.A2 = nullptr; g.Bt2 = nullptr; E.scr = nullptr;
                if (k == 0 || k == 13) { const int s = k == 13; g.A = U; g.Bt = (const bf16_t*)(wb + W_GU + s * W_GU_SZ); g.lda = 1024; g.ldb = 1024; g.K = 1024; N = 5632; E.mode = 1; E.O = BIG; E.ldc = DFF; }
                else if (k == 1 || k == 14) { const int s = k == 14; g.A = BIG; g.Bt = (const bf16_t*)(wb + W_D + s * W_D_SZ); g.lda = DFF; g.ldb = DFF; g.K = DFF; N = 1024; E.mode = 0; E.O = Yb; E.ldc = 1024; }
                else if (k == 3) { g.A = U; g.Bt = (const bf16_t*)(wb + W_IN); g.lda = 1024; g.ldb = 1024; g.K = 1024; N = NHIN; E.mode = 0; E.O = BIG; E.ldc = NHIN; }
                else if (k == 4) { g.A = BIG + 512; g.Bt = (const bf16_t*)(wb + W_MLA); g.lda = NHIN; g.ldb = 384; g.K = 384; N = 1024; E.mode = 0; E.O = Yb; E.ldc = 1024; }
                else if (k == 7 || k == 9) { const size_t ro = (size_t)(k == 9) * 32768 * 1024; Mrows = (k == 9) ? R - 32768 : 32768;
                    g.A = U + ro; g.Bt = (const bf16_t*)(wb + W_G); g.lda = 1024; g.ldb = 1024; g.K = 1024; N = 4096; E.mode = 3; E.O = BIG; E.ldc = 4096; }
                else if (k == 8 || k == 10) { const size_t ro = (size_t)(k == 10) * 32768 * 1024; Mrows = (k == 10) ? R - 32768 : 32768;
                    g.A = (const bf16_t*)(ws + WS_OUTS) + ro; g.Bt = (const bf16_t*)(wb + W_BR); g.lda = 1024; g.ldb = 1024; g.K = 1024; N = 4096; E.mode = 4; E.O = Yb + ro; E.ldc = 1024; E.scr = (u32x4*)BIG; }
                else { g.A = Yb; g.Bt = (const bf16_t*)(wb + W_OUT); g.lda = 1024; g.ldb = 1024; g.K = 1024; N = 1024; E.mode = 0; E.O = BIG; E.ldc = 1024; }
                pg8::StaticOrder S; S.init(Mrows, N, G, bx, dual);
                if (k == 8 || k == 10) pg8::gemm_phase<true>(lds, g, S, E); else pg8::gemm_phase<false>(lds, g, S, E);
            }
        }
        if (ph + 1 < hi) {
            if (ph == lo) {
                asm volatile("s_waitcnt vmcnt(0) lgkmcnt(0)" ::: "memory");
                __syncthreads();
                if (ptid() < 64) { __builtin_amdgcn_fence(__ATOMIC_RELEASE, "agent"); asm volatile("s_waitcnt vmcnt(0)" ::: "memory"); }
                grid.sync();
                __builtin_amdgcn_fence(__ATOMIC_ACQUIRE, "agent");
                asm volatile("s_waitcnt vmcnt(0)" ::: "memory");
            } else {
                XcdBarrier bar; bar.bar = (unsigned*)(a.ws + WS_BAR); bar.x = xb_xcc_id(); bar.st = (volatile LAS unsigned*)(lds + LDS_BARST);
                xcd_barrier(bar);
                __builtin_amdgcn_fence(__ATOMIC_ACQUIRE, "agent");
                asm volatile("s_waitcnt vmcnt(0)" ::: "memory");
            }
        }
    }
}

extern "C" void kernel_launch(void* const* d_in, const int* in_sizes, int n_in, void* d_out, int out_size, void* d_ws, size_t ws_size, hipStream_t stream) {
    static int grid = 0;
    if (grid == 0) {
        int dev = 0, cus = 0;
        if (hipGetDevice(&dev) != hipSuccess || hipDeviceGetAttribute(&cus, hipDeviceAttributeMultiprocessorCount, dev) != hipSuccess) { grid = -1; return; }
        if (hipFuncSetAttribute((const void*)fwd_kernel, hipFuncAttributeMaxDynamicSharedMemorySize, LDS_BYTES) != hipSuccess) { fprintf(stderr, "hipFuncSetAttribute failed\n"); grid = -1; return; }
        int per_cu = 0;
        if (hipOccupancyMaxActiveBlocksPerMultiprocessor(&per_cu, (const void*)fwd_kernel, 512, LDS_BYTES) != hipSuccess || per_cu < 1) fprintf(stderr, "occupancy query: %d\n", per_cu);
        (void)hipGetLastError();
        grid = cus;
        if (ws_size < WS_END) { fprintf(stderr, "workspace too small\n"); grid = -1; return; }
    }
    if (grid < 0) return;
    if (hipMemsetAsync((char*)d_ws + WS_BAR, 0, 16384, stream) != hipSuccess) { fprintf(stderr, "memset failed\n"); return; }
    Args a{};
    const float** p = (const float**)&a;
    for (int i = 0; i < 23; ++i) p[i] = (const float*)d_in[i];
    a.out = (float*)d_out; a.ws = (unsigned char*)d_ws; a.ph_lo = 0; a.ph_hi = 1000;
    void* args[] = {&a};
    hipError_t e = hipLaunchCooperativeKernel((const void*)fwd_kernel, dim3(grid), dim3(512), args, LDS_BYTES, stream);
    if (e != hipSuccess) fprintf(stderr, "cooperative launch failed: %s\n", hipGetErrorString(e));
}
```

```cpp
#include <hip/hip_runtime.h>
#include <hip/hip_cooperative_groups.h>
#include <cstdio>
#include <cstdint>
namespace cg = cooperative_groups;

#define LAS __attribute__((address_space(3)))
typedef unsigned short bf16_t;
typedef short bf16x8 __attribute__((ext_vector_type(8)));
typedef short s16x4 __attribute__((ext_vector_type(4)));
typedef float f32x4 __attribute__((ext_vector_type(4)));
typedef float f32x16 __attribute__((ext_vector_type(16)));
typedef unsigned u32x4 __attribute__((ext_vector_type(4)));
typedef unsigned u32x2 __attribute__((ext_vector_type(2)));

constexpr int DM = 1024, NB = 8, SEQ = 8192, CTX = 256, RPB = SEQ + CTX, R = NB * RPB, DFF = 2816;
constexpr int NHIN = 2304, INCOLS = 6304, GATE0 = 2208;
constexpr int MODW = 9216;
constexpr float EPS = 1e-6f;
constexpr float LOG2E = 1.4426950408889634f;
constexpr float QS_GQA = 0.125f * LOG2E, QS_MLA = 0.10206207261596577f * LOG2E, QS_DIFF = 0.17677669529663687f * LOG2E;

constexpr size_t MiB = 1u << 20;
constexpr size_t WS_MOD = 0;
constexpr size_t WS_XC = 2 * MiB;
constexpr size_t WS_W = 10 * MiB;
constexpr size_t W_GU = 0, W_GU_SZ = (size_t)5632 * 1024 * 2;
constexpr size_t W_D = W_GU + 2 * W_GU_SZ, W_D_SZ = (size_t)1024 * 2816 * 2;
constexpr size_t W_IN = W_D + 2 * W_D_SZ, W_IN_SZ = (size_t)NHIN * 1024 * 2;
constexpr size_t W_G = W_IN + W_IN_SZ, W_G_SZ = (size_t)4096 * 1024 * 2;
constexpr size_t W_BR = W_G + W_G_SZ;
constexpr size_t W_OUT = W_BR + W_G_SZ, W_OUT_SZ = (size_t)1024 * 1024 * 2;
constexpr size_t W_MLA = W_OUT + W_OUT_SZ, W_MLA_SZ = (size_t)1024 * 384 * 2;
constexpr size_t W_LAYER = W_MLA + W_MLA_SZ;
static_assert(WS_W + 2 * W_LAYER <= 124 * MiB, "weights");
constexpr size_t ROWBUF = (size_t)R * 1024 * 2;
constexpr size_t WS_U = 124 * MiB;
constexpr size_t WS_Y = WS_U + ROWBUF;
constexpr size_t WS_BIG = WS_Y + ROWBUF;
constexpr size_t WS_OUTS = WS_BIG + (size_t)R * NHIN * 2;
constexpr size_t WS_VT = WS_OUTS + ROWBUF;
constexpr size_t WS_GSCR = WS_VT + (size_t)NB * 768 * RPB * 2;
constexpr size_t WS_END = WS_GSCR + 256 * 131072;
static_assert(WS_END <= 1024 * MiB, "ws");
static_assert(WS_BIG + (size_t)R * DFF * 2 <= WS_END, "H");

constexpr int LDS_BYTES = 147456;
constexpr size_t WS_BAR = 1 * MiB;
constexpr int LDS_BARST = 147456 - 64;

__device__ __forceinline__ unsigned f2bf(float f) { unsigned u = __builtin_bit_cast(unsigned, f); return (u + 0x7fffu + ((u >> 16) & 1u)) >> 16; }
__device__ __forceinline__ unsigned pk2(float lo, float hi) { return f2bf(lo) | (f2bf(hi) << 16); }
__device__ __forceinline__ float bf2f(unsigned short h) { return __builtin_bit_cast(float, (unsigned)h << 16); }
__device__ __forceinline__ float bflo(unsigned w) { return __builtin_bit_cast(float, w << 16); }
__device__ __forceinline__ float bfhi(unsigned w) { return __builtin_bit_cast(float, w & 0xffff0000u); }
__device__ __forceinline__ float wave_sum(float v) {
#pragma unroll
    for (int o = 1; o < 64; o <<= 1) v += __shfl_xor(v, o);
    return v;
}
__device__ __forceinline__ int ptid() { int t = threadIdx.x; asm volatile("" : "+v"(t)); return t; }
__device__ __forceinline__ float fexp2(float x) { return __builtin_amdgcn_exp2f(x); }
__device__ __forceinline__ float frcp(float x) { return __builtin_amdgcn_rcpf(x); }
__device__ __forceinline__ float sigmoidf_(float x) { return frcp(1.f + fexp2(-x * LOG2E)); }

namespace pg8 {
constexpr int BM = 256, BK = 64, HALF = 128, HTB = HALF * BK * 2, STAGE_BYTES = 8 * HTB, NXCD = 8, WGM = 8;
__device__ __forceinline__ int lds_byte(int r, int c) { const int st = (r >> 4) * 2 + (c >> 5), rr = r & 15, cc = c & 31, ob = rr * 64 + cc * 2; return st * 1024 + (ob ^ (((ob >> 9) & 1) << 5)); }
__device__ __forceinline__ void stage_rc(int b, int& Rr, int& C) { const int st = b / 1024, sb = b % 1024, swz = sb ^ (((sb >> 9) & 1) << 5); Rr = (st >> 1) * 16 + swz / 64; C = (st & 1) * 32 + (swz % 64) / 2; }
__device__ __forceinline__ int perm32(int rho) { const int n = rho >> 4, i = rho & 15; return 8 * (i >> 2) + 4 * n + (i & 3); }

struct Unit { int pm, pn, kind; };
struct Gemm { const bf16_t* A; const bf16_t* Bt; const bf16_t* A2; const bf16_t* Bt2; int lda, ldb, K; };

struct StaticOrder {
    int nM, nN, nwg, G, c, dual;
    __device__ void init(int M, int N, int G_, int c_, int dual_) { nM = M / BM; nN = N / BM; nwg = nM * nN; G = G_; c = c_; dual = dual_; }
    __device__ bool next(int i, Unit& u) const {
        const int ii = dual ? (i >> 1) : i;
        u.kind = dual ? (i & 1) : 0;
        const long L = (long)ii * G + c; if (L >= nwg) return false;
        int wgid = (int)L; { const int q = nwg / NXCD, r = nwg % NXCD, xcd = wgid % NXCD, off = wgid / NXCD; wgid = (xcd < r ? xcd * (q + 1) : r * (q + 1) + (xcd - r) * q) + off; }
        const int nig = WGM * nN, gid = wgid / nig, fm = gid * WGM, gsz = (nM - fm) < WGM ? (nM - fm) : WGM;
        u.pm = fm + ((wgid % nig) % gsz); u.pn = (wgid % nig) / gsz; return true;
    }
};

typedef float f32x2_t __attribute__((ext_vector_type(2))); typedef __bf16 bf16x2_t __attribute__((ext_vector_type(2)));
__device__ __forceinline__ unsigned cvt_pk_bf16(float lo, float hi) { f32x2_t v = {lo, hi}; bf16x2_t b = __builtin_convertvector(v, bf16x2_t); return __builtin_bit_cast(unsigned, b); }

struct Epi {
    int mode; bf16_t* O; int ldc; u32x4* scr;
    __device__ __forceinline__ void operator()(const f32x4 (&acc)[2][2][4][2], const Unit& u, int wr, int wc, int fr, int fq) const {
        const int row0 = u.pm * BM + wr * 64 + fr;
        if (mode == 0) {
            const int col0 = u.pn * BM + wc * 32 + 8 * fq;
#pragma unroll
            for (int ai = 0; ai < 2; ++ai)
#pragma unroll
                for (int m = 0; m < 4; ++m) { bf16_t* rowp = O + (size_t)(row0 + ai * HALF + m * 16) * ldc + col0;
#pragma unroll
                    for (int bj = 0; bj < 2; ++bj) { const f32x4 v0 = acc[ai][bj][m][0], v1 = acc[ai][bj][m][1];
                        u32x4 w; w.x = cvt_pk_bf16(v0[0], v0[1]); w.y = cvt_pk_bf16(v0[2], v0[3]); w.z = cvt_pk_bf16(v1[0], v1[1]); w.w = cvt_pk_bf16(v1[2], v1[3]);
                        *(u32x4*)(rowp + bj * HALF) = w; } }
        } else if (mode == 1) {
            const int col0 = u.pn * HALF + wc * 32 + 8 * fq;
#pragma unroll
            for (int ai = 0; ai < 2; ++ai)
#pragma unroll
                for (int m = 0; m < 4; ++m) { bf16_t* rowp = O + (size_t)(row0 + ai * HALF + m * 16) * ldc + col0;
                    float h[8];
#pragma unroll
                    for (int n = 0; n < 2; ++n)
#pragma unroll
                        for (int e = 0; e < 4; ++e) { const float g = acc[ai][0][m][n][e], up = acc[ai][1][m][n][e]; h[n * 4 + e] = g * sigmoidf_(g) * up; }
                    u32x4 w; w.x = cvt_pk_bf16(h[0], h[1]); w.y = cvt_pk_bf16(h[2], h[3]); w.z = cvt_pk_bf16(h[4], h[5]); w.w = cvt_pk_bf16(h[6], h[7]);
                    *(u32x4*)rowp = w; }
        } else if (mode == 3) {
            const int col0 = u.pn * BM + wc * 32 + 8 * fq;
#pragma unroll
            for (int ai = 0; ai < 2; ++ai)
#pragma unroll
                for (int m = 0; m < 4; ++m) { bf16_t* rowp = O + (size_t)(row0 + ai * HALF + m * 16) * ldc + col0;
#pragma unroll
                    for (int bj = 0; bj < 2; ++bj) { const f32x4 v0 = acc[ai][bj][m][0], v1 = acc[ai][bj][m][1];
                        u32x4 w; w.x = cvt_pk_bf16(sigmoidf_(v0[0]), sigmoidf_(v0[1])); w.y = cvt_pk_bf16(sigmoidf_(v0[2]), sigmoidf_(v0[3]));
                        w.z = cvt_pk_bf16(sigmoidf_(v1[0]), sigmoidf_(v1[1])); w.w = cvt_pk_bf16(sigmoidf_(v1[2]), sigmoidf_(v1[3]));
                        *(u32x4*)(rowp + bj * HALF) = w; } }
        } else {
            const int gcol0 = u.pn * BM + wc * 32 + 8 * fq, col0 = u.pn * 64 + wc * 16 + 4 * fq;
#pragma unroll
            for (int ai = 0; ai < 2; ++ai)
#pragma unroll
                for (int m = 0; m < 4; ++m) { float y0 = 0.f, y1 = 0.f, y2 = 0.f, y3 = 0.f;
                    const bf16_t* gp = (const bf16_t*)scr + (size_t)(row0 + ai * HALF + m * 16) * 4096 + gcol0;
#pragma unroll
                    for (int bj = 0; bj < 2; ++bj) { const u32x4 w = *(const u32x4*)(gp + bj * HALF); const f32x4 v0 = acc[ai][bj][m][0], v1 = acc[ai][bj][m][1];
                        y0 += bflo(w.x) * v0[0] + bflo(w.z) * v1[0]; y1 += bfhi(w.x) * v0[1] + bfhi(w.z) * v1[1];
                        y2 += bflo(w.y) * v0[2] + bflo(w.w) * v1[2]; y3 += bfhi(w.y) * v0[3] + bfhi(w.w) * v1[3]; }
                    u32x2 o; o.x = cvt_pk_bf16(y0, y1); o.y = cvt_pk_bf16(y2, y3);
                    *(u32x2*)(O + (size_t)(row0 + ai * HALF + m * 16) * ldc + col0) = o; }
        }
    }
};

template <bool ZSKIP, class Sched>
__device__ __forceinline__ void gemm_phase(LAS unsigned char* lds, const Gemm g, const Sched& S, const Epi& E) {
    const int tid = ptid(), wid = __builtin_amdgcn_readfirstlane(tid >> 6), lane = tid & 63, wr = wid >> 2, wc = wid & 3, fr = lane & 15, fq = lane >> 4;
    const int K = g.K, nt = K / BK;
    unsigned voffA[2], voffB[2];
#pragma unroll
    for (int i = 0; i < 2; ++i) { int Rr, C; stage_rc(tid * 16 + i * 8192, Rr, C); const int Rb = (Rr & ~31) + perm32(Rr & 31);
        voffA[i] = (unsigned)(Rr * g.lda + C) * 2u; voffB[i] = (unsigned)(Rb * g.ldb + C) * 2u; }
    const size_t kstep = (size_t)(BK * 2);
    const size_t hsA = (size_t)HALF * g.lda * 2, hsB = (size_t)HALF * g.ldb * 2;
    const size_t tsA = 2 * hsA, tsB = 2 * hsB;
    const unsigned ldsw = (unsigned)wid * 1024u;
    const int aoff = lds_byte(wr * 64 + fr, fq * 8), boff = lds_byte(wc * 32 + fr, fq * 8);
#define PG8_SA(b, h) (((b) * 2 + (h)) * HTB)
#define PG8_SB(b, h) ((4 + (b) * 2 + (h)) * HTB)
#define PG8_STAGE(bufoff, gbase, voff) do { _Pragma("unroll") for (int _i = 0; _i < 2; ++_i) \
        __builtin_amdgcn_global_load_lds((const unsigned*)((const char*)(gbase) + (voff)[_i]), (LAS unsigned*)(lds + (bufoff) + ldsw + _i * 8192), 16, 0, 0); } while (0)
#define PG8_LDA(dst, b, h) do { _Pragma("unroll") for (int m = 0; m < 4; ++m) _Pragma("unroll") for (int k = 0; k < 2; ++k) dst[m][k] = *(const LAS bf16x8*)(lds + PG8_SA(b, h) + aoff + m * 2048 + k * 1024); } while (0)
#define PG8_LDB(dst, b, h) do { _Pragma("unroll") for (int n = 0; n < 2; ++n) _Pragma("unroll") for (int k = 0; k < 2; ++k) dst[n][k] = *(const LAS bf16x8*)(lds + PG8_SB(b, h) + boff + n * 2048 + k * 1024); } while (0)
#define PG8_MMA(ai, bj, At, Bt) do { __builtin_amdgcn_s_setprio(1); _Pragma("unroll") for (int m = 0; m < 4; ++m) _Pragma("unroll") for (int n = 0; n < 2; ++n) _Pragma("unroll") for (int k = 0; k < 2; ++k) \
        acc[ai][bj][m][n] = __builtin_amdgcn_mfma_f32_16x16x32_bf16(Bt[n][k], At[m][k], acc[ai][bj][m][n], 0, 0, 0); __builtin_amdgcn_s_setprio(0); } while (0)
#define PG8_MMA1(ai, bj, nn, At, Bt) do { __builtin_amdgcn_s_setprio(1); _Pragma("unroll") for (int m = 0; m < 4; ++m) _Pragma("unroll") for (int k = 0; k < 2; ++k) \
        acc[ai][bj][m][nn] = __builtin_amdgcn_mfma_f32_16x16x32_bf16(Bt[nn][k], At[m][k], acc[ai][bj][m][nn], 0, 0, 0); __builtin_amdgcn_s_setprio(0); } while (0)
#define PG8_MMAZ(ai, At) do { if (zbr == 0) PG8_MMA1(ai, 0, 0, At, B0); else if (zbr == 1) PG8_MMA1(ai, 0, 1, At, B0); else if (zbr == 2) PG8_MMA1(ai, 1, 0, At, B1); else PG8_MMA1(ai, 1, 1, At, B1); } while (0)
#define PG8_MM2(ai, At) do { if constexpr (ZSKIP) PG8_MMAZ(ai, At); else { PG8_MMA(ai, 0, At, B0); PG8_MMA(ai, 1, At, B1); } } while (0)
#define PG8_WAIT_V(n) asm volatile("s_waitcnt vmcnt(" #n ")" ::: "memory")
#define PG8_WAIT_L(n) asm volatile("s_waitcnt lgkmcnt(" #n ")" ::: "memory")
#define PG8_BAR __builtin_amdgcn_s_barrier()
#define PG8_SCHED __builtin_amdgcn_sched_barrier(0)
#define PG8_UA(u) ((const char*)((u).kind ? g.A2 : g.A) + (size_t)(u).pm * tsA)
#define PG8_UB(u) ((const char*)((u).kind ? g.Bt2 : g.Bt) + (size_t)(u).pn * tsB)
    Unit cur, nxt; int ui = 0;
    if (!S.next(0, cur)) return;
    f32x4 acc[2][2][4][2];
#pragma unroll
    for (int a = 0; a < 2; ++a)
#pragma unroll
        for (int b = 0; b < 2; ++b)
#pragma unroll
            for (int m = 0; m < 4; ++m)
#pragma unroll
                for (int n = 0; n < 2; ++n) acc[a][b][m][n] = (f32x4){0.f, 0.f, 0.f, 0.f};
    bf16x8 At[4][2], B0[2][2], B1[2][2];
    const char* cA = PG8_UA(cur); const char* cB = PG8_UB(cur);
    {
        PG8_STAGE(PG8_SB(0, 0), cB, voffB); PG8_STAGE(PG8_SB(0, 1), cB + hsB, voffB); PG8_STAGE(PG8_SA(0, 0), cA, voffA); PG8_STAGE(PG8_SA(0, 1), cA + hsA, voffA);
        if (wr == 1) PG8_BAR;
        PG8_WAIT_V(2); PG8_BAR;
        PG8_STAGE(PG8_SB(1, 0), cB + kstep, voffB); PG8_STAGE(PG8_SA(1, 0), cA + kstep, voffA); PG8_STAGE(PG8_SB(1, 1), cB + hsB + kstep, voffB);
        PG8_WAIT_V(6); PG8_BAR;
    }
    for (;;) {
        const bool has_next = S.next(ui + 1, nxt);
        const char* nA = has_next ? PG8_UA(nxt) : cA; const char* nB = has_next ? PG8_UB(nxt) : cB;
        for (int t = 0; t < nt; t += 2) {
            const bool last = (t == nt - 2); const int zbr = t >> 2;
            const char* a1 = cA + (size_t)(t + 1) * kstep;
            const char* a2 = last ? nA : cA + (size_t)(t + 2) * kstep; const char* b2 = last ? nB : cB + (size_t)(t + 2) * kstep;
            const char* a3 = a2 + kstep; const char* b3 = b2 + kstep;
            PG8_LDB(B0, 0, 0); PG8_LDB(B1, 0, 1); PG8_SCHED; PG8_LDA(At, 0, 0); PG8_STAGE(PG8_SA(1, 1), a1 + hsA, voffA);
            PG8_WAIT_V(8); PG8_WAIT_L(0); PG8_BAR; PG8_MM2(0, At); PG8_BAR; PG8_SCHED;
            PG8_LDA(At, 0, 1); PG8_STAGE(PG8_SB(0, 0), b2, voffB); PG8_STAGE(PG8_SB(0, 1), b2 + hsB, voffB); PG8_STAGE(PG8_SA(0, 0), a2, voffA);
            PG8_WAIT_V(8); PG8_WAIT_L(0); PG8_BAR; PG8_MM2(1, At); PG8_BAR; PG8_SCHED;
            PG8_LDB(B0, 1, 0); PG8_LDB(B1, 1, 1); PG8_SCHED; PG8_LDA(At, 1, 0); PG8_STAGE(PG8_SA(0, 1), a2 + hsA, voffA);
            PG8_WAIT_V(8); PG8_WAIT_L(0); PG8_BAR; PG8_MM2(0, At); PG8_BAR; PG8_SCHED;
            PG8_LDA(At, 1, 1); PG8_STAGE(PG8_SB(1, 0), b3, voffB); PG8_STAGE(PG8_SB(1, 1), b3 + hsB, voffB); PG8_STAGE(PG8_SA(1, 0), a3, voffA);
            PG8_WAIT_V(8); PG8_WAIT_L(0); PG8_BAR; PG8_MM2(1, At); PG8_BAR; PG8_SCHED;
        }
        if (wr == 0) PG8_BAR;
        E(acc, cur, wr, wc, fr, fq);
        if (!has_next) break;
#pragma unroll
        for (int a = 0; a < 2; ++a)
#pragma unroll
            for (int b = 0; b < 2; ++b)
#pragma unroll
                for (int m = 0; m < 4; ++m)
#pragma unroll
                    for (int n = 0; n < 2; ++n) acc[a][b][m][n] = (f32x4){0.f, 0.f, 0.f, 0.f};
        cur = nxt; cA = nA; cB = nB; ++ui;
        if (wr == 1) PG8_BAR;
    }
    PG8_WAIT_V(0);
    PG8_BAR;
#undef PG8_SA
#undef PG8_SB
#undef PG8_STAGE
#undef PG8_LDA
#undef PG8_LDB
#undef PG8_MMA
#undef PG8_MMA1
#undef PG8_MMAZ
#undef PG8_MM2
#undef PG8_WAIT_V
#undef PG8_WAIT_L
#undef PG8_BAR
#undef PG8_SCHED
#undef PG8_UA
#undef PG8_UB
}
}

struct Args {
    const float* x; const float* c; const float* ctx; const float* c_ctx; const float* w_mod; const float* b_mod; const float* g_pre; const float* g_post;
    const float* w_gate; const float* w_up; const float* w_down; const float* w_in; const float* gqa_qn; const float* gqa_kn; const float* mla_qn; const float* mla_kvn;
    const float* w_uq; const float* w_ukv; const float* dlam; const float* dsub; const float* sink; const float* w_branch; const float* w_out;
    float* out; unsigned char* ws; int ph_lo, ph_hi;
};
typedef const __attribute__((address_space(4))) Args CArgs;

template <class F>
__device__ __forceinline__ void conv_item(bf16_t* WT, int K, int nblk, int item, LAS float* scr, int lane, const F& f) {
    const int kb = item / nblk, nb = item % nblk, k0 = 64 * kb, n0 = 32 * nb;
#pragma unroll 8
    for (int i = 0; i < 32; ++i) { const int kk = 2 * i + (lane >> 5); scr[kk * 33 + (lane & 31)] = f(n0 + (lane & 31), k0 + kk); }
    asm volatile("s_waitcnt lgkmcnt(0)" ::: "memory");
    const int c = lane & 7;
#pragma unroll
    for (int j = 0; j < 4; ++j) { const int n = (lane >> 3) + 8 * j; const LAS float* s = scr + (8 * c) * 33 + n;
        u32x4 o; o.x = pk2(s[0 * 33], s[1 * 33]); o.y = pk2(s[2 * 33], s[3 * 33]); o.z = pk2(s[4 * 33], s[5 * 33]); o.w = pk2(s[6 * 33], s[7 * 33]);
        *(u32x4*)(WT + (size_t)(n0 + n) * K + k0 + 8 * c) = o; }
    asm volatile("s_waitcnt lgkmcnt(0)" ::: "memory");
}

__device__ __forceinline__ void p0_phase(CArgs& a, LAS unsigned char* lds) {
    const int tid = ptid(), lane = tid & 63, wave = tid >> 6;
    float* MOD = (float*)(a.ws + WS_MOD);
    {
        LAS float* sl = (LAS float*)lds;
        LAS float* red = (LAS float*)(lds + 40960);
        for (int i = tid; i < 9 * 1024; i += 512) { const int r = i >> 10, k = i & 1023; const float v = r < 8 ? a.c[r * 1024 + k] : a.c_ctx[k]; sl[i] = v * sigmoidf_(v); }
        __syncthreads();
        for (int it = blockIdx.x; it < 2 * 144; it += gridDim.x) {
            const int l = it / 144, n0 = (it % 144) * 64;
            const float* W = a.w_mod + (size_t)l * 1024 * MODW + n0 + lane;
            float acc[9];
#pragma unroll
            for (int r = 0; r < 9; ++r) acc[r] = 0.f;
#pragma unroll 8
            for (int kk = 0; kk < 128; ++kk) { const int k = wave * 128 + kk; const float wv = W[(size_t)k * MODW];
#pragma unroll
                for (int r = 0; r < 9; ++r) acc[r] += sl[r * 1024 + k] * wv; }
#pragma unroll
            for (int r = 0; r < 9; ++r) red[(wave * 9 + r) * 64 + lane] = acc[r];
            __syncthreads();
            for (int i = tid; i < 9 * 64; i += 512) { const int r = i >> 6, cidx = i & 63; float s = a.b_mod[l * MODW + n0 + cidx];
#pragma unroll
                for (int w = 0; w < 8; ++w) s += red[(w * 9 + r) * 64 + cidx];
                MOD[((size_t)l * 9 + r) * MODW + n0 + cidx] = s; }
            __syncthreads();
        }
        __syncthreads();
    }
    LAS float* scr = (LAS float*)(lds + wave * 8448);
    const int gw = blockIdx.x * 8 + wave, NGW = gridDim.x * 8;
    constexpr int I_GU = 176 * 16, I_D = 32 * 44, I_IN = 72 * 16, I_G = 128 * 16, I_OUT = 32 * 16, I_MLA = 32 * 6;
    constexpr int I_LAYER = 2 * I_GU + 2 * I_D + I_IN + 2 * I_G + I_OUT + I_MLA;
    for (int it = gw; it < 2 * I_LAYER; it += NGW) {
        const int l = it / I_LAYER; int r = it % I_LAYER;
        unsigned char* wb = a.ws + WS_W + (size_t)l * W_LAYER;
        if (r < 2 * I_GU) { const int s = r / I_GU; r %= I_GU;
            const float* wg = a.w_gate + (size_t)(l * 2 + s) * 1024 * DFF; const float* wu = a.w_up + (size_t)(l * 2 + s) * 1024 * DFF;
            conv_item((bf16_t*)(wb + W_GU + s * W_GU_SZ), 1024, 176, r, scr, lane, [=](int n, int k) { const int j = (n >> 8) * 128 + (n & 127); return ((n >> 7) & 1) ? wu[(size_t)k * DFF + j] : wg[(size_t)k * DFF + j]; });
            continue; }
        r -= 2 * I_GU;
        if (r < 2 * I_D) { const int s = r / I_D; r %= I_D;
            const float* wd = a.w_down + (size_t)(l * 2 + s) * DFF * 1024;
            conv_item((bf16_t*)(wb + W_D + s * W_D_SZ), DFF, 32, r, scr, lane, [=](int n, int k) { return wd[(size_t)k * 1024 + n]; });
            continue; }
        r -= 2 * I_D;
        const float* win = a.w_in + (size_t)l * 1024 * INCOLS;
        if (r < I_IN) { conv_item((bf16_t*)(wb + W_IN), 1024, 72, r, scr, lane, [=](int n, int k) { return n < GATE0 ? win[(size_t)k * INCOLS + n] : 0.f; }); continue; }
        r -= I_IN;
        if (r < I_G) { conv_item((bf16_t*)(wb + W_G), 1024, 128, r, scr, lane, [=](int n, int k) {
                const int br = 2 * ((n >> 7) & 1) + ((n >> 2) & 1), ch = 64 * (n >> 8) + 16 * ((n >> 5) & 3) + 4 * ((n >> 3) & 3) + (n & 3);
                return win[(size_t)k * INCOLS + GATE0 + br * 1024 + ch]; }); continue; }
        r -= I_G;
        if (r < I_G) { const float* wbr = a.w_branch + (size_t)l * 4 * 256 * 1024;
            conv_item((bf16_t*)(wb + W_BR), 1024, 128, r, scr, lane, [=](int n, int k) {
                const int br = 2 * ((n >> 7) & 1) + ((n >> 2) & 1), ch = 64 * (n >> 8) + 16 * ((n >> 5) & 3) + 4 * ((n >> 3) & 3) + (n & 3);
                return (k >> 8) == br ? wbr[((size_t)br * 256 + (k & 255)) * 1024 + ch] : 0.f; }); continue; }
        r -= I_G;
        if (r < I_OUT) { const float* wo = a.w_out + (size_t)l * 1024 * 1024;
            conv_item((bf16_t*)(wb + W_OUT), 1024, 32, r, scr, lane, [=](int n, int k) { return wo[(size_t)k * 1024 + n]; }); continue; }
        r -= I_OUT;
        { const float* uq = a.w_uq + (size_t)l * 256 * 384; const float* ukv = a.w_ukv + (size_t)l * 128 * 512; const float* gq = a.mla_qn + l * 256; const float* gkv = a.mla_kvn + l * 128;
            conv_item((bf16_t*)(wb + W_MLA), 384, 32, r, scr, lane, [=](int n, int k) {
                float v = 0.f;
                if (n < 384) { if (k < 256) v = gq[k] * uq[(size_t)k * 384 + n]; }
                else if (n < 896) { if (k >= 256) v = gkv[k - 256] * ukv[(size_t)(k - 256) * 512 + (n - 384)]; }
                return v; }); }
    }
}

__device__ __forceinline__ void row_phase(CArgs& a, int l, bool first, const bf16_t* Y, int sub_y, float gscale, bf16_t* U, int sub_u, int l_u) {
    const int tid_ = ptid(); const int lane = tid_ & 63, wave = tid_ >> 6;
    const int gw = blockIdx.x * 8 + wave, NGW = gridDim.x * 8;
    const float* MOD = (const float*)(a.ws + WS_MOD);
    float* XC = (float*)(a.ws + WS_XC);
#pragma unroll 2
    for (int row = gw; row < R; row += NGW) {
        const int b = row / RPB, t = row % RPB; const bool isctx = t < CTX;
        const float* xs; float* xd;
        if (isctx) { const size_t o = (size_t)(b * CTX + t) * DM; xs = (first ? a.ctx : XC) + o; xd = XC + o; }
        else { const size_t o = (size_t)(b * SEQ + (t - CTX)) * DM; xs = (first ? a.x : a.out) + o; xd = a.out + o; }
        const int mrow = isctx ? 8 : b;
        f32x4 v[4];
#pragma unroll
        for (int j = 0; j < 4; ++j) v[j] = *(const f32x4*)(xs + 4 * lane + 256 * j);
        if (Y) {
            const float* md = MOD + ((size_t)l * 9 + mrow) * MODW + (sub_y * 3 + 2) * 1024;
            const float* gp = a.g_post + (l * 3 + sub_y) * 1024;
            f32x4 y[4]; float ss = 0.f;
#pragma unroll
            for (int j = 0; j < 4; ++j) { const u32x2 w = *(const u32x2*)(Y + (size_t)row * DM + 4 * lane + 256 * j);
                y[j] = (f32x4){bflo(w.x), bfhi(w.x), bflo(w.y), bfhi(w.y)}; ss += (y[j].x * y[j].x + y[j].y * y[j].y) + (y[j].z * y[j].z + y[j].w * y[j].w); }
            const float rs = __builtin_amdgcn_rsqf(wave_sum(ss) * (1.f / DM) + EPS) * gscale;
#pragma unroll
            for (int j = 0; j < 4; ++j) { const f32x4 g = *(const f32x4*)(md + 4 * lane + 256 * j), p = *(const f32x4*)(gp + 4 * lane + 256 * j);
                v[j] = v[j] + (y[j] * rs) * p * g; *(f32x4*)(xd + 4 * lane + 256 * j) = v[j]; }
        }
        if (U) {
            const float* md = MOD + ((size_t)l_u * 9 + mrow) * MODW + (sub_u * 3) * 1024;
            const float* gp = a.g_pre + (l_u * 3 + sub_u) * 1024;
            float ss = 0.f;
#pragma unroll
            for (int j = 0; j < 4; ++j) ss += (v[j].x * v[j].x + v[j].y * v[j].y) + (v[j].z * v[j].z + v[j].w * v[j].w);
            const float rs = __builtin_amdgcn_rsqf(wave_sum(ss) * (1.f / DM) + EPS);
#pragma unroll
            for (int j = 0; j < 4; ++j) { const f32x4 sh = *(const f32x4*)(md + 4 * lane + 256 * j), sc = *(const f32x4*)(md + 1024 + 4 * lane + 256 * j), p = *(const f32x4*)(gp + 4 * lane + 256 * j);
                const f32x4 u = (v[j] * rs) * p * (sc + 1.f) + sh;
                u32x2 w; w.x = pk2(u.x, u.y); w.y = pk2(u.z, u.w);
                *(u32x2*)(U + (size_t)row * DM + 4 * lane + 256 * j) = w; }
        }
    }
}

constexpr int VSTR = 136;
constexpr int TAB_OFF = 768 * VSTR;
__device__ __forceinline__ void rope64p(float& v0, float& v1, int l, bool lat, const LAS float* tab, int prow, int pcol) {
    if (!lat) return;
    const float p0 = __shfl_xor(v0, 8), p1 = __shfl_xor(v1, 8);
    const int lh = l & 31, pos = (lh & 16) ? pcol : prow, i0 = (2 * lh) & 15;
    const f32x4 cs = *(const LAS f32x4*)(tab + (pos * 16 + i0) * 2);
    const bool sec = (lh >> 3) & 1;
    v0 = sec ? v0 * cs[0] + p0 * cs[1] : v0 * cs[0] - p0 * cs[1];
    v1 = sec ? v1 * cs[2] + p1 * cs[3] : v1 * cs[2] - p1 * cs[3];
}
__device__ __forceinline__ void rope32p(float& v0, float& v1, int d0, bool lat, const LAS float* tab, int prow, int pcol) {
    if (!lat) return;
    const float p0 = __shfl_xor(v0, 4), p1 = __shfl_xor(v1, 4);
    const int pos = (d0 & 16) ? pcol : prow, i0 = d0 & 7;
    const LAS float* t = tab + (pos * 16 + 2 * i0) * 2;
    const float c0 = t[0], s0 = t[1], c1 = t[4], s1 = t[5];
    const bool sec = (d0 >> 3) & 1;
    v0 = sec ? v0 * c0 + p0 * s0 : v0 * c0 - p0 * s0;
    v1 = sec ? v1 * c1 + p1 * s1 : v1 * c1 - p1 * s1;
}
__device__ __forceinline__ float half_sum(float v) {
#pragma unroll
    for (int o = 1; o < 32; o <<= 1) v += __shfl_xor(v, o);
    return v;
}
__device__ __forceinline__ void prep_phase(CArgs& a, int l, LAS unsigned char* lds) {
    const int tid = ptid(), lane = tid & 63, wave = tid >> 6;
    bf16_t* HIN = (bf16_t*)(a.ws + WS_BIG); bf16_t* MUP = (bf16_t*)(a.ws + WS_Y); bf16_t* VT = (bf16_t*)(a.ws + WS_VT);
    LAS float* tab = (LAS float*)(lds + TAB_OFF);
    for (int i = tid; i < 128 * 16; i += 512) { const int pos = i >> 4, f = i & 15;
        const float invf = fexp2(-(float)(2 * f) * (1.f / 32.f) * 13.287712379549449f);
        float rev = (float)pos * invf * 0.15915494309189535f; rev -= __builtin_floorf(rev);
        tab[i * 2] = __builtin_amdgcn_cosf(rev); tab[i * 2 + 1] = __builtin_amdgcn_sinf(rev); }
    __syncthreads();
    const int lh = lane & 31;
    const float gq0 = a.gqa_qn[l * 64 + 2 * lh], gq1 = a.gqa_qn[l * 64 + 2 * lh + 1], gk0 = a.gqa_kn[l * 64 + 2 * lh], gk1 = a.gqa_kn[l * 64 + 2 * lh + 1];
#define LD2(p, v0, v1) do { const unsigned w_ = *(const unsigned*)(p); v0 = bflo(w_); v1 = bfhi(w_); } while (0)
#define ST2(p, v0, v1) do { *(unsigned*)(p) = pg8::cvt_pk_bf16(v0, v1); } while (0)
    for (int tile = blockIdx.x; tile < R / 64; tile += gridDim.x) {
        const int row0 = tile * 64, b = row0 / RPB, t0 = row0 % RPB;
        for (int rr = 0; rr < 8; ++rr) {
            const int tk = wave * 8 + rr, row = row0 + tk, t = t0 + tk; const bool lat = t >= CTX;
            const int tl = lat ? t - CTX : 0, prow = tl >> 6, pcol = tl & 63;
            bf16_t* __restrict__ h = HIN + (size_t)row * NHIN; bf16_t* __restrict__ mu = MUP + (size_t)row * 1024;
            LAS bf16_t* vst = (LAS bf16_t*)lds + tk;
#pragma unroll
            for (int j = 0; j < 3; ++j) { float v0, v1; LD2(h + 128 * j + 2 * lane, v0, v1);
                const float rs = __builtin_amdgcn_rsqf(half_sum(v0 * v0 + v1 * v1) * (1.f / 64.f) + EPS);
                v0 = v0 * rs * (j < 2 ? gq0 : gk0); v1 = v1 * rs * (j < 2 ? gq1 : gk1);
                rope64p(v0, v1, lane, lat, tab, prow, pcol);
                if (j < 2) { v0 *= QS_GQA; v1 *= QS_GQA; }
                ST2(h + 128 * j + 2 * lane, v0, v1); }
            { const unsigned w = *(const unsigned*)(h + 384 + 2 * lane); vst[(0 + 2 * lane) * (VSTR / 2)] = (bf16_t)(w & 0xffffu); vst[(0 + 2 * lane + 1) * (VSTR / 2)] = (bf16_t)(w >> 16); }
            float sq = 0.f, skv = 0.f;
#pragma unroll
            for (int j = 0; j < 2; ++j) { float v0, v1; LD2(h + 512 + 128 * j + 2 * lane, v0, v1); sq += v0 * v0 + v1 * v1; }
            { float v0, v1; LD2(h + 768 + 2 * lane, v0, v1); skv = v0 * v0 + v1 * v1; }
            const float rq = __builtin_amdgcn_rsqf(wave_sum(sq) * (1.f / 256.f) + EPS) * QS_MLA, rkv = __builtin_amdgcn_rsqf(wave_sum(skv) * (1.f / 128.f) + EPS);
#pragma unroll
            for (int j = 0; j < 3; ++j) { const int c = 128 * j + 2 * lane, e = c % 96; float v0, v1; LD2(mu + c, v0, v1); v0 *= rq; v1 *= rq;
                float r0 = v0, r1 = v1; rope32p(r0, r1, (e - 64) & 30, lat, tab, prow, pcol);
                if (e >= 64) { v0 = r0; v1 = r1; }
                ST2(mu + c, v0, v1); }
#pragma unroll
            for (int hh = 0; hh < 4; ++hh) { const int c = 384 + 128 * hh + 2 * lane; float v0, v1; LD2(mu + c, v0, v1); v0 *= rkv; v1 *= rkv;
                const unsigned w = pg8::cvt_pk_bf16(v0, v1);
                if (lane < 32) *(unsigned*)(mu + c) = w;
                else { vst[(128 + 64 * hh + 2 * (lane - 32)) * (VSTR / 2)] = (bf16_t)(w & 0xffffu); vst[(128 + 64 * hh + 2 * (lane - 32) + 1) * (VSTR / 2)] = (bf16_t)(w >> 16); } }
            { float v0, v1; LD2(h + 896 + 2 * (lane & 15), v0, v1); rope32p(v0, v1, 2 * (lane & 15), lat, tab, prow, pcol); if (lane < 16) ST2(mu + 896 + 2 * lane, v0, v1); }
#pragma unroll
            for (int j = 0; j < 4; ++j) { float v0, v1; LD2(h + 928 + 128 * j + 2 * lane, v0, v1); rope32p(v0, v1, (2 * lane) & 31, lat, tab, prow, pcol);
                if (j < 2) { v0 *= QS_DIFF; v1 *= QS_DIFF; }
                ST2(h + 928 + 128 * j + 2 * lane, v0, v1); }
#pragma unroll
            for (int j = 0; j < 2; ++j) { const unsigned w = *(const unsigned*)(h + 1440 + 128 * j + 2 * lane); vst[(384 + 128 * j + 2 * lane) * (VSTR / 2)] = (bf16_t)(w & 0xffffu); vst[(384 + 128 * j + 2 * lane + 1) * (VSTR / 2)] = (bf16_t)(w >> 16); }
#pragma unroll
            for (int j = 0; j < 3; ++j) { float v0, v1; LD2(h + 1696 + 128 * j + 2 * lane, v0, v1); rope64p(v0, v1, lane, lat, tab, prow, pcol);
                if (j < 2) { v0 *= QS_GQA; v1 *= QS_GQA; }
                ST2(h + 1696 + 128 * j + 2 * lane, v0, v1); }
            { const unsigned w = *(const unsigned*)(h + 2080 + 2 * lane); vst[(640 + 2 * lane) * (VSTR / 2)] = (bf16_t)(w & 0xffffu); vst[(640 + 2 * lane + 1) * (VSTR / 2)] = (bf16_t)(w >> 16); }
        }
#undef LD2
#undef ST2
        __syncthreads();
        bf16_t* vt = VT + (size_t)b * 768 * RPB + t0;
        for (int p = tid; p < 768 * 8; p += 512) { const int vr = p >> 3, seg = p & 7;
            const LAS u32x2* s = (const LAS u32x2*)(lds + vr * VSTR + seg * 16); const u32x2 lo = s[0], hi = s[1];
            *(u32x4*)(vt + (size_t)vr * RPB + seg * 8) = (u32x4){lo.x, lo.y, hi.x, hi.y}; }
        __syncthreads();
    }
}

__device__ __forceinline__ int crow(int r, int hi) { return (r & 3) + 8 * (r >> 2) + 4 * hi; }
constexpr int AT_KBUF = 64 * (96 * 2 + 16);
constexpr int AT_VSTR = 144, AT_VBUF = 64 * AT_VSTR;
constexpr int AT_K0 = 0, AT_V0 = 2 * AT_KBUF, AT_WS = AT_V0 + 2 * AT_VBUF;

struct AttnSrc { const bf16_t* Q; int ldq; const bf16_t* K1; int ldk1; const bf16_t* K2; int ldk2; const bf16_t* VT; };

template <int DQK, bool WIN>
__device__ __forceinline__ void attn_pass(const AttnSrc& s, int NT, int lo, int q0lat, float sink_l2, bool has_sink, LAS unsigned char* lds, f32x16 (&o)[2]) {
    constexpr int KSTR = DQK * 2 + 16, NCH = DQK / 8, NKS = DQK / 16;
    const int tid = ptid(), lane = tid & 63, r32 = lane & 31, hi = lane >> 5; const int wid = __builtin_amdgcn_readfirstlane(tid >> 6);
    LAS float* wsf = (LAS float*)(lds + AT_WS) + wid * 32;
    bf16x8 qf[NKS];
    { const bf16_t* qp = s.Q + (size_t)(wid * 32 + r32) * s.ldq + 8 * hi;
#pragma unroll
        for (int ks = 0; ks < NKS; ++ks) qf[ks] = *(const bf16x8*)(qp + 16 * ks); }
    o[0] = (f32x16){}; o[1] = (f32x16){};
    f32x16 negm = (f32x16){}; asm volatile("" : "+v"(negm));
    float mhat = 0.f, lsum = 0.f;
    const int kkey0 = tid / NCH, kc0 = tid % NCH;
    const int kkey1 = (tid + 512) / NCH, kc1 = (tid + 512) % NCH;
    const bool kv0 = tid < 64 * NCH, kv1 = (DQK == 96) && (tid < 256);
    const int vdv = tid >> 3, vseg = tid & 7;
    u32x4 kr0 = (u32x4){}, kr1 = (u32x4){}, vr = (u32x4){}, kn0 = (u32x4){}, kn1 = (u32x4){}, vn = (u32x4){};
    auto kaddr = [&](int key, int c) -> const bf16_t* { return (DQK == 96 && c >= 8) ? s.K2 + (size_t)key * s.ldk2 + (c - 8) * 8 : s.K1 + (size_t)key * s.ldk1 + c * 8; };
#define AT_TILE(i) ((i) < 4 ? (i) : lo - 4 + (i))
#define AT_GLOAD(K0, K1, V, i) do { const int key0_ = AT_TILE(i) * 64; \
        if (kv0) K0 = *(const u32x4*)kaddr(key0_ + kkey0, kc0); if (kv1) K1 = *(const u32x4*)kaddr(key0_ + kkey1, kc1); \
        V = *(const u32x4*)(s.VT + (size_t)vdv * RPB + key0_ + vseg * 8); } while (0)
#define AT_LSTORE(K0, K1, V, buf) do { if (kv0) *(LAS u32x4*)(lds + AT_K0 + (buf) * AT_KBUF + kkey0 * KSTR + kc0 * 16) = K0; \
        if (kv1) *(LAS u32x4*)(lds + AT_K0 + (buf) * AT_KBUF + kkey1 * KSTR + kc1 * 16) = K1; \
        *(LAS u32x4*)(lds + AT_V0 + (buf) * AT_VBUF + vdv * AT_VSTR + vseg * 16) = V; } while (0)
#define MX3(a, b, c) __builtin_fmaxf(__builtin_fmaxf((a), (b)), (c))
    AT_GLOAD(kr0, kr1, vr, 0); AT_LSTORE(kr0, kr1, vr, 0);
    if (NT > 1) AT_GLOAD(kr0, kr1, vr, 1);
    __syncthreads();
    for (int i = 0; i < NT; ++i) {
        const int buf = i & 1;
        if (i + 2 < NT) AT_GLOAD(kn0, kn1, vn, i + 2);
        const LAS unsigned char* kb = lds + AT_K0 + buf * AT_KBUF + r32 * KSTR + hi * 16;
        f32x16 s0, s1;
#pragma unroll
        for (int ks = 0; ks < NKS; ++ks) {
            const bf16x8 a0 = *(const LAS bf16x8*)(kb + ks * 32), a1 = *(const LAS bf16x8*)(kb + 32 * KSTR + ks * 32);
            if (ks == 0) { s0 = __builtin_amdgcn_mfma_f32_32x32x16_bf16(a0, qf[0], negm, 0, 0, 0); s1 = __builtin_amdgcn_mfma_f32_32x32x16_bf16(a1, qf[0], negm, 0, 0, 0); }
            else { s0 = __builtin_amdgcn_mfma_f32_32x32x16_bf16(a0, qf[ks], s0, 0, 0, 0); s1 = __builtin_amdgcn_mfma_f32_32x32x16_bf16(a1, qf[ks], s1, 0, 0, 0); }
        }
        if (WIN && i >= 4) {
            const int jb = AT_TILE(i) * 64 - CTX + 4 * hi, qi = q0lat + wid * 32 + r32;
#pragma unroll
            for (int r = 0; r < 16; ++r) { const int j = jb + (r & 3) + 8 * (r >> 2); const int d0 = qi - j, d1 = qi - (j + 32);
                if (d0 > 128 || d0 < -128) s0[r] = -1e30f; if (d1 > 128 || d1 < -128) s1[r] = -1e30f; }
        }
        float ra = MX3(s0[0], s0[1], s1[0]), rb = MX3(s0[2], s0[3], s1[1]); ra = MX3(ra, s1[2], s1[3]);
#pragma unroll
        for (int r = 4; r < 16; r += 4) { ra = MX3(ra, s0[r], s0[r + 1]); rb = MX3(rb, s0[r + 2], s0[r + 3]); ra = MX3(ra, s1[r], s1[r + 1]); rb = MX3(rb, s1[r + 2], s1[r + 3]); }
        float rm = __builtin_fmaxf(ra, rb);
        rm = __builtin_fmaxf(rm, __shfl_xor(rm, 32));
        if (i == 0 || __any(rm > 8.f)) {
            const float dl = (i == 0) ? rm : __builtin_fmaxf(rm, 0.f);
            mhat += dl;
#pragma unroll
            for (int r = 0; r < 16; ++r) { s0[r] -= dl; s1[r] -= dl; }
#pragma unroll
            for (int r = 0; r < 16; ++r) negm[r] = -mhat;
            asm volatile("" : "+v"(negm));
            if (i != 0) {
                const float f = fexp2(-dl);
                lsum *= f;
                if (hi == 0) wsf[r32] = f;
#pragma unroll
                for (int r = 0; r < 16; ++r) { const float fr_ = wsf[crow(r, hi)]; o[0][r] *= fr_; o[1][r] *= fr_; }
            }
        }
        float ps = 0.f, ps2 = 0.f;
#pragma unroll
        for (int r = 0; r < 16; ++r) { s0[r] = fexp2(s0[r]); s1[r] = fexp2(s1[r]); ps += s0[r]; ps2 += s1[r]; }
        lsum += ps + ps2;
        bf16x8 pa[4];
#pragma unroll
        for (int kk = 0; kk < 4; ++kk) {
            u32x4 w;
            if (kk < 2) { w.x = pg8::cvt_pk_bf16(s0[8 * kk + 0], s0[8 * kk + 1]); w.y = pg8::cvt_pk_bf16(s0[8 * kk + 2], s0[8 * kk + 3]); w.z = pg8::cvt_pk_bf16(s0[8 * kk + 4], s0[8 * kk + 5]); w.w = pg8::cvt_pk_bf16(s0[8 * kk + 6], s0[8 * kk + 7]); }
            else { const int k2 = kk - 2; w.x = pg8::cvt_pk_bf16(s1[8 * k2 + 0], s1[8 * k2 + 1]); w.y = pg8::cvt_pk_bf16(s1[8 * k2 + 2], s1[8 * k2 + 3]); w.z = pg8::cvt_pk_bf16(s1[8 * k2 + 4], s1[8 * k2 + 5]); w.w = pg8::cvt_pk_bf16(s1[8 * k2 + 6], s1[8 * k2 + 7]); }
            pa[kk] = __builtin_bit_cast(bf16x8, w);
        }
        const LAS unsigned char* vb = lds + AT_V0 + buf * AT_VBUF + r32 * AT_VSTR + hi * 8;
#pragma unroll
        for (int dvb = 0; dvb < 2; ++dvb)
#pragma unroll
            for (int kk = 0; kk < 4; ++kk) {
                const u32x2 lo_ = *(const LAS u32x2*)(vb + dvb * 32 * AT_VSTR + kk * 32), hi_ = *(const LAS u32x2*)(vb + dvb * 32 * AT_VSTR + kk * 32 + 16);
                const bf16x8 bv = __builtin_bit_cast(bf16x8, (u32x4){lo_.x, lo_.y, hi_.x, hi_.y});
                o[dvb] = __builtin_amdgcn_mfma_f32_32x32x16_bf16(pa[kk], bv, o[dvb], 0, 0, 0);
            }
        if (i + 1 < NT) AT_LSTORE(kr0, kr1, vr, buf ^ 1);
        __syncthreads();
        kr0 = kn0; kr1 = kn1; vr = vn;
    }
    float lt = lsum + __shfl_xor(lsum, 32);
    if (has_sink) lt += fexp2(sink_l2 - mhat);
    if (hi == 0) wsf[r32] = frcp(lt);
#pragma unroll
    for (int r = 0; r < 16; ++r) { const float fr_ = wsf[crow(r, hi)]; o[0][r] *= fr_; o[1][r] *= fr_; }
#undef AT_TILE
#undef AT_GLOAD
#undef AT_LSTORE
#undef MX3
}

__device__ __forceinline__ void attn_store(bf16_t* O, int row0, int col0, const f32x16 (&o)[2]) {
    const int tid_ = ptid(); const int lane = tid_ & 63, r32 = lane & 31, hi = lane >> 5, wid = tid_ >> 6;
#pragma unroll
    for (int dvb = 0; dvb < 2; ++dvb)
#pragma unroll
        for (int r = 0; r < 16; ++r) O[(size_t)(row0 + wid * 32 + crow(r, hi)) * 1024 + col0 + dvb * 32 + r32] = (bf16_t)f2bf(o[dvb][r]);
}

__device__ __forceinline__ void attn_unit(CArgs& a, int l, int branch, int b, int h, int qb, float lam, float lam_init, LAS unsigned char* lds) {
    const bf16_t* HIN = (const bf16_t*)(a.ws + WS_BIG) + (size_t)b * RPB * NHIN; const bf16_t* MUP = (const bf16_t*)(a.ws + WS_Y) + (size_t)b * RPB * 1024;
    const bf16_t* VT = (const bf16_t*)(a.ws + WS_VT) + (size_t)b * 768 * RPB; bf16_t* OUTS = (bf16_t*)(a.ws + WS_OUTS);
    const bool cq = qb < 0; const int qrow = cq ? 0 : CTX + 256 * qb;
    const int NTd = cq ? 4 : 132;
    const int orow0 = b * RPB + qrow;
    f32x16 o[2];
    AttnSrc s;
    if (branch == 0) {
        s.Q = HIN + (size_t)qrow * NHIN + 64 * h; s.ldq = NHIN; s.K1 = HIN + 256 + 64 * (h >> 1); s.ldk1 = NHIN; s.K2 = nullptr; s.ldk2 = 0; s.VT = VT + (size_t)(0 + 64 * (h >> 1)) * RPB;
        attn_pass<64, false>(s, NTd, 4, 0, 0.f, false, lds, o);
        attn_store(OUTS, orow0, 0 + 64 * h, o);
    } else if (branch == 1) {
        s.Q = MUP + (size_t)qrow * 1024 + 96 * h; s.ldq = 1024; s.K1 = MUP + 384 + 128 * h; s.ldk1 = 1024; s.K2 = MUP + 896; s.ldk2 = 1024; s.VT = VT + (size_t)(128 + 64 * h) * RPB;
        attn_pass<96, false>(s, NTd, 4, 0, 0.f, false, lds, o);
        attn_store(OUTS, orow0, 256 + 64 * h, o);
    } else if (branch == 2) {
        f32x16 o2[2];
        s.Q = HIN + (size_t)qrow * NHIN + 928 + 64 * h; s.ldq = NHIN; s.K1 = HIN + 1184 + 64 * h; s.ldk1 = NHIN; s.K2 = nullptr; s.ldk2 = 0; s.VT = VT + (size_t)(384 + 64 * h) * RPB;
        attn_pass<32, false>(s, NTd, 4, 0, 0.f, false, lds, o);
        s.Q += 32; s.K1 += 32;
        attn_pass<32, false>(s, NTd, 4, 0, 0.f, false, lds, o2);
        const int lane = ptid() & 63, r32 = lane & 31;
        const float g0 = a.dsub[l * 64 + r32] * (1.f - lam_init), g1 = a.dsub[l * 64 + 32 + r32] * (1.f - lam_init);
#pragma unroll
        for (int r = 0; r < 16; ++r) { const float x0 = o[0][r] - lam * o2[0][r], x1 = o[1][r] - lam * o2[1][r];
            float ss = x0 * x0 + x1 * x1;
#pragma unroll
            for (int m = 1; m < 32; m <<= 1) ss += __shfl_xor(ss, m);
            const float rs = __builtin_amdgcn_rsqf(ss * (1.f / 64.f) + EPS);
            o[0][r] = x0 * rs * g0; o[1][r] = x1 * rs * g1; }
        attn_store(OUTS, orow0, 512 + 64 * h, o);
    } else {
        s.Q = HIN + (size_t)qrow * NHIN + 1696 + 64 * h; s.ldq = NHIN; s.K1 = HIN + 1952 + 64 * (h >> 1); s.ldk1 = NHIN; s.K2 = nullptr; s.ldk2 = 0; s.VT = VT + (size_t)(640 + 64 * (h >> 1)) * RPB;
        const float sk = a.sink[l * 4 + h] * LOG2E;
        if (cq) attn_pass<64, false>(s, 4, 4, 0, sk, true, lds, o);
        else { const int q0 = 256 * qb; const int lo = 4 + (q0 >= 128 ? q0 - 128 : 0) / 64, hiT = 4 + ((q0 + 384) < SEQ ? (q0 + 384) : SEQ) / 64;
            attn_pass<64, true>(s, 4 + hiT - lo, lo, q0, sk, true, lds, o); }
        attn_store(OUTS, orow0, 768 + 64 * h, o);
    }
}

__device__ __forceinline__ void attn_phase(CArgs& a, int l, LAS unsigned char* lds) {
    const float lam_init = 0.8f - 0.6f * __expf(-0.3f * (float)l);
    float lam;
    { const float* dl = a.dlam + l * 128; float s1 = 0.f, s2 = 0.f;
        for (int i = 0; i < 32; ++i) { s1 += dl[i] * dl[32 + i]; s2 += dl[64 + i] * dl[96 + i]; }
        lam = __expf(s1) - __expf(s2) + lam_init; }
    const int G = gridDim.x, bx = blockIdx.x;
    const int vcu = (G % 8 == 0) ? (bx % 8) * (G / 8) + bx / 8 : bx;
    for (int ty = 0; ty < 4; ++ty) {
        const int branch = ty == 0 ? 2 : ty == 1 ? 1 : ty == 2 ? 0 : 3;
        for (int idx = vcu; idx < NB * 4 * 32; idx += G) { const int bh = idx >> 5, qb = idx & 31; attn_unit(a, l, branch, bh >> 2, bh & 3, qb, lam, lam_init, lds); }
    }
    for (int idx = vcu; idx < NB * 16; idx += G) attn_unit(a, l, (idx >> 2) & 3, idx >> 4, idx & 3, -1, lam, lam_init, lds);
}

#define GAS __attribute__((address_space(1)))
#define XB_TMO      128
#define XB_XCNT(j)  (256  + 64 * (j))
#define XB_XSUB(j)  (1280 + 64 * (j))
#define XB_XGEN(j)  (2304 + 64 * (j))
#define XB_TOP      3328
#define XB_TOPGEN   3392
#define XCD_BAR_WORDS 3456
#define XB_SPIN_CAP (1u << 18)

__device__ __forceinline__ unsigned xb_ld(unsigned* p)              { return __hip_atomic_load(p, __ATOMIC_RELAXED, __HIP_MEMORY_SCOPE_AGENT); }
__device__ __forceinline__ unsigned xb_add(unsigned* p, unsigned v) { return __hip_atomic_fetch_add(p, v, __ATOMIC_RELAXED, __HIP_MEMORY_SCOPE_AGENT); }
__device__ __forceinline__ unsigned xb_xcc_id() { return (unsigned)__builtin_amdgcn_s_getreg((3 << 11) | 20) & 0xFu; }
#define XB_SPIN(cond, bar) do { unsigned _sp = 0; while (cond) { __builtin_amdgcn_s_sleep(1); \
    if ((++_sp & 255u) == 0u) { if (xb_ld(&(bar)[XB_TMO])) break; if (_sp > XB_SPIN_CAP) { atomicAdd(&(bar)[XB_TMO], 1u); break; } } } } while (0)

struct XcdBarrier {
    unsigned* bar; unsigned x;
    volatile LAS unsigned* st;
};

__device__ __forceinline__ XcdBarrier xcd_barrier_post(unsigned* bar, volatile LAS unsigned* st) {
    XcdBarrier b; b.bar = bar; b.x = xb_xcc_id(); b.st = st;
    if (threadIdx.x == 0) (void)xb_add(&bar[XB_XCNT(b.x)], 1u);
    return b;
}
__device__ __forceinline__ void xcd_barrier_complete(unsigned* bar, unsigned x, unsigned& nloc, unsigned& nx) {
    const unsigned G = gridDim.x * gridDim.y * gridDim.z;
    unsigned sum, cnt, mine, sp = 0u;
    for (;;) {
        sum = 0u; cnt = 0u; mine = 0u;
#pragma unroll
        for (unsigned j = 0; j < 16; ++j) { const unsigned c = xb_ld(&bar[XB_XCNT(j)]); sum += c; cnt += (c > 0u) ? 1u : 0u; mine = (j == x) ? c : mine; }
        if (sum == G) break;
        __builtin_amdgcn_s_sleep(1);
        if ((++sp & 255u) == 0u) { if (xb_ld(&bar[XB_TMO])) break; if (sp > XB_SPIN_CAP) { atomicAdd(&bar[XB_TMO], 1u); break; } }
    }
    nloc = mine > 0u ? mine : 1u; nx = cnt > 0u ? cnt : 1u;
}

__device__ __forceinline__ void xcd_barrier(const XcdBarrier& b) {
    asm volatile("s_waitcnt vmcnt(0)" ::: "memory");
    __syncthreads();
    if (threadIdx.x == 0) {
        unsigned* bar = b.bar;
        __builtin_amdgcn_s_waitcnt(0);
        unsigned nloc = b.st[0], nx = b.st[1];
        if (nloc == 0u) { xcd_barrier_complete(bar, b.x, nloc, nx); b.st[0] = nloc; b.st[1] = nx; }
        const unsigned old = xb_add(&bar[XB_XSUB(b.x)], 1u);
        const unsigned gen = old / nloc;
        if (old + 1u == (gen + 1u) * nloc) {
            __builtin_amdgcn_fence(__ATOMIC_RELEASE, "agent");
            asm volatile("s_waitcnt vmcnt(0)" ::: "memory");
            const unsigned og = xb_add(&bar[XB_TOP], 1u);
            const unsigned tg = og / nx;
            if (og + 1u == (tg + 1u) * nx) xb_add(&bar[XB_TOPGEN], 1u);
            else XB_SPIN(xb_ld(&bar[XB_TOPGEN]) == tg, bar);
            __builtin_amdgcn_fence(__ATOMIC_ACQUIRE, "agent");
            xb_add(&bar[XB_XGEN(b.x)], 1u);
            asm volatile("s_waitcnt vmcnt(0)" ::: "memory");
        } else {
            XB_SPIN(xb_ld(&bar[XB_XGEN(b.x)]) == gen, bar);
            __builtin_amdgcn_fence(__ATOMIC_ACQUIRE, "agent");
            asm volatile("s_waitcnt vmcnt(0)" ::: "memory");
        }
    }
    __syncthreads();
}


constexpr int NPHASE = 2 + 32;
__global__ void __launch_bounds__(512, 2) fwd_kernel(Args a_) {
    extern __shared__ __attribute__((aligned(16))) unsigned char lds_raw[];
    LAS unsigned char* lds = (LAS unsigned char*)lds_raw;
    cg::grid_group grid = cg::this_grid();
    const int lo = a_.ph_lo, hi = a_.ph_hi < NPHASE ? a_.ph_hi : NPHASE;
    { volatile LAS unsigned* st0 = (volatile LAS unsigned*)(lds + LDS_BARST); if (threadIdx.x < 2) st0[threadIdx.x] = 0u; }
    __syncthreads();
    { XcdBarrier b0 = xcd_barrier_post((unsigned*)(a_.ws + WS_BAR), (volatile LAS unsigned*)(lds + LDS_BARST)); (void)b0; }
    for (int ph = lo; ph < hi; ++ph) {
        CArgs* ap_ = (CArgs*)__builtin_amdgcn_kernarg_segment_ptr(); asm volatile("" : "+s"(ap_) :: "memory"); CArgs& a = *ap_;
        int G = gridDim.x, bx = blockIdx.x; asm volatile("" : "+s"(G), "+s"(bx));
        if (ph == 0) p0_phase(a, lds);
        else if (ph == 1) row_phase(a, 0, true, nullptr, 0, 0.f, (bf16_t*)(a.ws + WS_U), 0, 0);
        else {
            const int l = (ph - 2) / 16, k = (ph - 2) % 16;
            unsigned char* ws = a.ws;
            const unsigned char* wb = ws + WS_W + (size_t)l * W_LAYER;
            bf16_t* U = (bf16_t*)(ws + WS_U); bf16_t* Yb = (bf16_t*)(ws + WS_Y); bf16_t* BIG = (bf16_t*)(ws + WS_BIG);
            if (k == 5) prep_phase(a, l, lds);
#ifndef X_ATTN
            else if (k == 6) attn_phase(a, l, lds);
#endif
            else if (k == 2) row_phase(a, l, l == 0, Yb, 0, 0.5f, U, 1, l);
            else if (k == 12) row_phase(a, l, false, BIG, 1, 1.0f, U, 2, l);
            else if (k == 15) row_phase(a, l, false, Yb, 2, 0.5f, l == 0 ? U : nullptr, 0, l + 1);
            else {
                pg8::Gemm g; pg8::Epi E; int N; int dual = 0; int Mrows = R;
                g.A2 = nullptr; g.Bt2 = nullptr; E.scr = nullptr;
                if (k == 0 || k == 13) { const int s = k == 13; g.A = U; g.Bt = (const bf16_t*)(wb + W_GU + s * W_GU_SZ); g.lda = 1024; g.ldb = 1024; g.K = 1024; N = 5632; E.mode = 1; E.O = BIG; E.ldc = DFF; }
                else if (k == 1 || k == 14) { const int s = k == 14; g.A = BIG; g.Bt = (const bf16_t*)(wb + W_D + s * W_D_SZ); g.lda = DFF; g.ldb = DFF; g.K = DFF; N = 1024; E.mode = 0; E.O = Yb; E.ldc = 1024; }
                else if (k == 3) { g.A = U; g.Bt = (const bf16_t*)(wb + W_IN); g.lda = 1024; g.ldb = 1024; g.K = 1024; N = NHIN; E.mode = 0; E.O = BIG; E.ldc = NHIN; }
                else if (k == 4) { g.A = BIG + 512; g.Bt = (const bf16_t*)(wb + W_MLA); g.lda = NHIN; g.ldb = 384; g.K = 384; N = 1024; E.mode = 0; E.O = Yb; E.ldc = 1024; }
                else if (k == 7 || k == 9) { const size_t ro = (size_t)(k == 9) * 32768 * 1024; Mrows = (k == 9) ? R - 32768 : 32768;
                    g.A = U + ro; g.Bt = (const bf16_t*)(wb + W_G); g.lda = 1024; g.ldb = 1024; g.K = 1024; N = 4096; E.mode = 3; E.O = BIG; E.ldc = 4096; }
                else if (k == 8 || k == 10) { const size_t ro = (size_t)(k == 10) * 32768 * 1024; Mrows = (k == 10) ? R - 32768 : 32768;
                    g.A = (const bf16_t*)(ws + WS_OUTS) + ro; g.Bt = (const bf16_t*)(wb + W_BR); g.lda = 1024; g.ldb = 1024; g.K = 1024; N = 4096; E.mode = 4; E.O = Yb + ro; E.ldc = 1024; E.scr = (u32x4*)BIG; }
                else { g.A = Yb; g.Bt = (const bf16_t*)(wb + W_OUT); g.lda = 1024; g.ldb = 1024; g.K = 1024; N = 1024; E.mode = 0; E.O = BIG; E.ldc = 1024; }
                pg8::StaticOrder S; S.init(Mrows, N, G, bx, dual);
                if (k == 8 || k == 10) pg8::gemm_phase<true>(lds, g, S, E); else pg8::gemm_phase<false>(lds, g, S, E);
            }
        }
        if (ph + 1 < hi) {
            if (ph == lo) {
                asm volatile("s_waitcnt vmcnt(0) lgkmcnt(0)" ::: "memory");
                __syncthreads();
                if (ptid() < 64) { __builtin_amdgcn_fence(__ATOMIC_RELEASE, "agent"); asm volatile("s_waitcnt vmcnt(0)" ::: "memory"); }
                grid.sync();
                __builtin_amdgcn_fence(__ATOMIC_ACQUIRE, "agent");
                asm volatile("s_waitcnt vmcnt(0)" ::: "memory");
            } else {
                XcdBarrier bar; bar.bar = (unsigned*)(a.ws + WS_BAR); bar.x = xb_xcc_id(); bar.st = (volatile LAS unsigned*)(lds + LDS_BARST);
                xcd_barrier(bar);
                __builtin_amdgcn_fence(__ATOMIC_ACQUIRE, "agent");
                asm volatile("s_waitcnt vmcnt(0)" ::: "memory");
            }
        }
    }
}

extern "C" void kernel_launch(void* const* d_in, const int* in_sizes, int n_in, void* d_out, int out_size, void* d_ws, size_t ws_size, hipStream_t stream) {
    static int grid = 0;
    if (grid == 0) {
        int dev = 0, cus = 0;
        if (hipGetDevice(&dev) != hipSuccess || hipDeviceGetAttribute(&cus, hipDeviceAttributeMultiprocessorCount, dev) != hipSuccess) { grid = -1; return; }
        if (hipFuncSetAttribute((const void*)fwd_kernel, hipFuncAttributeMaxDynamicSharedMemorySize, LDS_BYTES) != hipSuccess) { fprintf(stderr, "hipFuncSetAttribute failed\n"); grid = -1; return; }
        int per_cu = 0;
        if (hipOccupancyMaxActiveBlocksPerMultiprocessor(&per_cu, (const void*)fwd_kernel, 512, LDS_BYTES) != hipSuccess || per_cu < 1) fprintf(stderr, "occupancy query: %d\n", per_cu);
        (void)hipGetLastError();
        grid = cus;
        if (ws_size < WS_END) { fprintf(stderr, "workspace too small\n"); grid = -1; return; }
    }
    if (grid < 0) return;
    if (hipMemsetAsync((char*)d_ws + WS_BAR, 0, 16384, stream) != hipSuccess) { fprintf(stderr, "memset failed\n"); return; }
    Args a{};
    const float** p = (const float**)&a;
    for (int i = 0; i < 23; ++i) p[i] = (const float*)d_in[i];
    a.out = (float*)d_out; a.ws = (unsigned char*)d_ws; a.ph_lo = 0; a.ph_hi = 1000;
    void* args[] = {&a};
    hipError_t e = hipLaunchCooperativeKernel((const void*)fwd_kernel, dim3(grid), dim3(512), args, LDS_BYTES, stream);
    if (e != hipSuccess) fprintf(stderr, "cooperative launch failed: %s\n", hipGetErrorString(e));
}
```

```cpp
#include <hip/hip_runtime.h>
#include <hip/hip_cooperative_groups.h>
#include <cstdio>
#include <cstdint>
namespace cg = cooperative_groups;

#define LAS __attribute__((address_space(3)))
typedef unsigned short bf16_t;
typedef short bf16x8 __attribute__((ext_vector_type(8)));
typedef short s16x4 __attribute__((ext_vector_type(4)));
typedef float f32x4 __attribute__((ext_vector_type(4)));
typedef float f32x16 __attribute__((ext_vector_type(16)));
typedef unsigned u32x4 __attribute__((ext_vector_type(4)));
typedef unsigned u32x2 __attribute__((ext_vector_type(2)));

constexpr int DM = 1024, NB = 8, SEQ = 8192, CTX = 256, RPB = SEQ + CTX, R = NB * RPB, DFF = 2816;
constexpr int NHIN = 2304, INCOLS = 6304, GATE0 = 2208;
constexpr int MODW = 9216;
constexpr float EPS = 1e-6f;
constexpr float LOG2E = 1.4426950408889634f;
constexpr float QS_GQA = 0.125f * LOG2E, QS_MLA = 0.10206207261596577f * LOG2E, QS_DIFF = 0.17677669529663687f * LOG2E;

constexpr size_t MiB = 1u << 20;
constexpr size_t WS_MOD = 0;
constexpr size_t WS_XC = 2 * MiB;
constexpr size_t WS_W = 10 * MiB;
constexpr size_t W_GU = 0, W_GU_SZ = (size_t)5632 * 1024 * 2;
constexpr size_t W_D = W_GU + 2 * W_GU_SZ, W_D_SZ = (size_t)1024 * 2816 * 2;
constexpr size_t W_IN = W_D + 2 * W_D_SZ, W_IN_SZ = (size_t)NHIN * 1024 * 2;
constexpr size_t W_G = W_IN + W_IN_SZ, W_G_SZ = (size_t)4096 * 1024 * 2;
constexpr size_t W_BR = W_G + W_G_SZ;
constexpr size_t W_OUT = W_BR + W_G_SZ, W_OUT_SZ = (size_t)1024 * 1024 * 2;
constexpr size_t W_MLA = W_OUT + W_OUT_SZ, W_MLA_SZ = (size_t)1024 * 384 * 2;
constexpr size_t W_LAYER = W_MLA + W_MLA_SZ;
static_assert(WS_W + 2 * W_LAYER <= 124 * MiB, "weights");
constexpr size_t ROWBUF = (size_t)R * 1024 * 2;
constexpr size_t WS_U = 124 * MiB;
constexpr size_t WS_Y = WS_U + ROWBUF;
constexpr size_t WS_BIG = WS_Y + ROWBUF;
constexpr size_t WS_OUTS = WS_BIG + (size_t)R * NHIN * 2;
constexpr size_t WS_VT = WS_OUTS + ROWBUF;
constexpr size_t WS_GSCR = WS_VT + (size_t)NB * 768 * RPB * 2;
constexpr size_t WS_END = WS_GSCR + 256 * 131072;
static_assert(WS_END <= 1024 * MiB, "ws");
static_assert(WS_BIG + (size_t)R * DFF * 2 <= WS_END, "H");

constexpr int LDS_BYTES = 147456;
constexpr size_t WS_BAR = 1 * MiB;
constexpr int LDS_BARST = 147456 - 64;

__device__ __forceinline__ unsigned f2bf(float f) { unsigned u = __builtin_bit_cast(unsigned, f); return (u + 0x7fffu + ((u >> 16) & 1u)) >> 16; }
__device__ __forceinline__ unsigned pk2(float lo, float hi) { return f2bf(lo) | (f2bf(hi) << 16); }
__device__ __forceinline__ float bf2f(unsigned short h) { return __builtin_bit_cast(float, (unsigned)h << 16); }
__device__ __forceinline__ float bflo(unsigned w) { return __builtin_bit_cast(float, w << 16); }
__device__ __forceinline__ float bfhi(unsigned w) { return __builtin_bit_cast(float, w & 0xffff0000u); }
__device__ __forceinline__ float wave_sum(float v) {
#pragma unroll
    for (int o = 1; o < 64; o <<= 1) v += __shfl_xor(v, o);
    return v;
}
__device__ __forceinline__ int ptid() { int t = threadIdx.x; asm volatile("" : "+v"(t)); return t; }
__device__ __forceinline__ float fexp2(float x) { return __builtin_amdgcn_exp2f(x); }
__device__ __forceinline__ float frcp(float x) { return __builtin_amdgcn_rcpf(x); }
__device__ __forceinline__ float sigmoidf_(float x) { return frcp(1.f + fexp2(-x * LOG2E)); }

namespace pg8 {
constexpr int BM = 256, BK = 64, HALF = 128, HTB = HALF * BK * 2, STAGE_BYTES = 8 * HTB, NXCD = 8, WGM = 8;
__device__ __forceinline__ int lds_byte(int r, int c) { const int st = (r >> 4) * 2 + (c >> 5), rr = r & 15, cc = c & 31, ob = rr * 64 + cc * 2; return st * 1024 + (ob ^ (((ob >> 9) & 1) << 5)); }
__device__ __forceinline__ void stage_rc(int b, int& Rr, int& C) { const int st = b / 1024, sb = b % 1024, swz = sb ^ (((sb >> 9) & 1) << 5); Rr = (st >> 1) * 16 + swz / 64; C = (st & 1) * 32 + (swz % 64) / 2; }
__device__ __forceinline__ int perm32(int rho) { const int n = rho >> 4, i = rho & 15; return 8 * (i >> 2) + 4 * n + (i & 3); }

struct Unit { int pm, pn, kind; };
struct Gemm { const bf16_t* A; const bf16_t* Bt; const bf16_t* A2; const bf16_t* Bt2; int lda, ldb, K; };

struct StaticOrder {
    int nM, nN, nwg, G, c, dual;
    __device__ void init(int M, int N, int G_, int c_, int dual_) { nM = M / BM; nN = N / BM; nwg = nM * nN; G = G_; c = c_; dual = dual_; }
    __device__ bool next(int i, Unit& u) const {
        const int ii = dual ? (i >> 1) : i;
        u.kind = dual ? (i & 1) : 0;
        const long L = (long)ii * G + c; if (L >= nwg) return false;
        int wgid = (int)L; { const int q = nwg / NXCD, r = nwg % NXCD, xcd = wgid % NXCD, off = wgid / NXCD; wgid = (xcd < r ? xcd * (q + 1) : r * (q + 1) + (xcd - r) * q) + off; }
        const int nig = WGM * nN, gid = wgid / nig, fm = gid * WGM, gsz = (nM - fm) < WGM ? (nM - fm) : WGM;
        u.pm = fm + ((wgid % nig) % gsz); u.pn = (wgid % nig) / gsz; return true;
    }
};

typedef float f32x2_t __attribute__((ext_vector_type(2))); typedef __bf16 bf16x2_t __attribute__((ext_vector_type(2)));
__device__ __forceinline__ unsigned cvt_pk_bf16(float lo, float hi) { f32x2_t v = {lo, hi}; bf16x2_t b = __builtin_convertvector(v, bf16x2_t); return __builtin_bit_cast(unsigned, b); }

struct Epi {
    int mode; bf16_t* O; int ldc; u32x4* scr;
    __device__ __forceinline__ void operator()(const f32x4 (&acc)[2][2][4][2], const Unit& u, int wr, int wc, int fr, int fq) const {
        const int row0 = u.pm * BM + wr * 64 + fr;
        if (mode == 0) {
            const int col0 = u.pn * BM + wc * 32 + 8 * fq;
#pragma unroll
            for (int ai = 0; ai < 2; ++ai)
#pragma unroll
                for (int m = 0; m < 4; ++m) { bf16_t* rowp = O + (size_t)(row0 + ai * HALF + m * 16) * ldc + col0;
#pragma unroll
                    for (int bj = 0; bj < 2; ++bj) { const f32x4 v0 = acc[ai][bj][m][0], v1 = acc[ai][bj][m][1];
                        u32x4 w; w.x = cvt_pk_bf16(v0[0], v0[1]); w.y = cvt_pk_bf16(v0[2], v0[3]); w.z = cvt_pk_bf16(v1[0], v1[1]); w.w = cvt_pk_bf16(v1[2], v1[3]);
                        *(u32x4*)(rowp + bj * HALF) = w; } }
        } else if (mode == 1) {
            const int col0 = u.pn * HALF + wc * 32 + 8 * fq;
#pragma unroll
            for (int ai = 0; ai < 2; ++ai)
#pragma unroll
                for (int m = 0; m < 4; ++m) { bf16_t* rowp = O + (size_t)(row0 + ai * HALF + m * 16) * ldc + col0;
                    float h[8];
#pragma unroll
                    for (int n = 0; n < 2; ++n)
#pragma unroll
                        for (int e = 0; e < 4; ++e) { const float g = acc[ai][0][m][n][e], up = acc[ai][1][m][n][e]; h[n * 4 + e] = g * sigmoidf_(g) * up; }
                    u32x4 w; w.x = cvt_pk_bf16(h[0], h[1]); w.y = cvt_pk_bf16(h[2], h[3]); w.z = cvt_pk_bf16(h[4], h[5]); w.w = cvt_pk_bf16(h[6], h[7]);
                    *(u32x4*)rowp = w; }
        } else if (mode == 3) {
            const int col0 = u.pn * BM + wc * 32 + 8 * fq;
#pragma unroll
            for (int ai = 0; ai < 2; ++ai)
#pragma unroll
                for (int m = 0; m < 4; ++m) { bf16_t* rowp = O + (size_t)(row0 + ai * HALF + m * 16) * ldc + col0;
#pragma unroll
                    for (int bj = 0; bj < 2; ++bj) { const f32x4 v0 = acc[ai][bj][m][0], v1 = acc[ai][bj][m][1];
                        u32x4 w; w.x = cvt_pk_bf16(sigmoidf_(v0[0]), sigmoidf_(v0[1])); w.y = cvt_pk_bf16(sigmoidf_(v0[2]), sigmoidf_(v0[3]));
                        w.z = cvt_pk_bf16(sigmoidf_(v1[0]), sigmoidf_(v1[1])); w.w = cvt_pk_bf16(sigmoidf_(v1[2]), sigmoidf_(v1[3]));
                        *(u32x4*)(rowp + bj * HALF) = w; } }
        } else {
            const int col0 = u.pn * BM + wc * 32 + 8 * fq;
#pragma unroll
            for (int ai = 0; ai < 2; ++ai)
#pragma unroll
                for (int m = 0; m < 4; ++m) { const size_t r = (size_t)(row0 + ai * HALF + m * 16);
                    const bf16_t* gp = (const bf16_t*)scr + r * 4096 + 3 * 1024 + col0; bf16_t* rowp = O + r * ldc + col0;
#pragma unroll
                    for (int bj = 0; bj < 2; ++bj) { const u32x4 g = *(const u32x4*)(gp + bj * HALF); const f32x4 v0 = acc[ai][bj][m][0], v1 = acc[ai][bj][m][1];
                        u32x4 w; w.x = cvt_pk_bf16(v0[0] * gclamp(bflo(g.x)), v0[1] * gclamp(bfhi(g.x))); w.y = cvt_pk_bf16(v0[2] * gclamp(bflo(g.y)), v0[3] * gclamp(bfhi(g.y)));
                        w.z = cvt_pk_bf16(v1[0] * gclamp(bflo(g.z)), v1[1] * gclamp(bfhi(g.z))); w.w = cvt_pk_bf16(v1[2] * gclamp(bflo(g.w)), v1[3] * gclamp(bfhi(g.w)));
                        *(u32x4*)(rowp + bj * HALF) = w; } }
        }
    }
    static __device__ __forceinline__ float gclamp(float g) { return __builtin_fmaxf(g, 1e-6f); }
    __device__ __forceinline__ void rescale(f32x4 (&acc)[2][2][4][2], const Unit& u, int i, int wr, int wc, int fr, int fq) const {
        int row0 = u.pm * BM + wr * 64 + fr; const int col0 = u.pn * BM + wc * 32 + 8 * fq;
        asm volatile("" : "+v"(row0));
#pragma unroll
        for (int ai = 0; ai < 2; ++ai)
#pragma unroll
            for (int m = 0; m < 4; ++m) { const bf16_t* gp = (const bf16_t*)scr + (size_t)(row0 + ai * HALF + m * 16) * 4096 + i * 1024 + col0;
#pragma unroll
                for (int bj = 0; bj < 2; ++bj) { const u32x4 ga = *(const u32x4*)(gp + bj * HALF), gb = *(const u32x4*)(gp + 1024 + bj * HALF);
                    f32x4 r0, r1;
                    r0[0] = gclamp(bflo(ga.x)) * frcp(gclamp(bflo(gb.x))); r0[1] = gclamp(bfhi(ga.x)) * frcp(gclamp(bfhi(gb.x)));
                    r0[2] = gclamp(bflo(ga.y)) * frcp(gclamp(bflo(gb.y))); r0[3] = gclamp(bfhi(ga.y)) * frcp(gclamp(bfhi(gb.y)));
                    r1[0] = gclamp(bflo(ga.z)) * frcp(gclamp(bflo(gb.z))); r1[1] = gclamp(bfhi(ga.z)) * frcp(gclamp(bfhi(gb.z)));
                    r1[2] = gclamp(bflo(ga.w)) * frcp(gclamp(bflo(gb.w))); r1[3] = gclamp(bfhi(ga.w)) * frcp(gclamp(bfhi(gb.w)));
                    acc[ai][bj][m][0] = acc[ai][bj][m][0] * r0; acc[ai][bj][m][1] = acc[ai][bj][m][1] * r1; }
                if (m == 3) asm volatile("" ::: "memory"); }
    }
};

template <bool HOOK, class Sched>
__device__ __forceinline__ void gemm_phase(LAS unsigned char* lds, const Gemm g, const Sched& S, const Epi& E) {
    const int tid = ptid(), wid = __builtin_amdgcn_readfirstlane(tid >> 6), lane = tid & 63, wr = wid >> 2, wc = wid & 3, fr = lane & 15, fq = lane >> 4;
    const int K = g.K, nt = K / BK;
    unsigned voffA[2], voffB[2];
#pragma unroll
    for (int i = 0; i < 2; ++i) { int Rr, C; stage_rc(tid * 16 + i * 8192, Rr, C); const int Rb = (Rr & ~31) + perm32(Rr & 31);
        voffA[i] = (unsigned)(Rr * g.lda + C) * 2u; voffB[i] = (unsigned)(Rb * g.ldb + C) * 2u; }
    const size_t kstep = (size_t)(BK * 2);
    const size_t hsA = (size_t)HALF * g.lda * 2, hsB = (size_t)HALF * g.ldb * 2;
    const size_t tsA = 2 * hsA, tsB = 2 * hsB;
    const unsigned ldsw = (unsigned)wid * 1024u;
    const int aoff = lds_byte(wr * 64 + fr, fq * 8), boff = lds_byte(wc * 32 + fr, fq * 8);
#define PG8_SA(b, h) (((b) * 2 + (h)) * HTB)
#define PG8_SB(b, h) ((4 + (b) * 2 + (h)) * HTB)
#define PG8_STAGE(bufoff, gbase, voff) do { _Pragma("unroll") for (int _i = 0; _i < 2; ++_i) \
        __builtin_amdgcn_global_load_lds((const unsigned*)((const char*)(gbase) + (voff)[_i]), (LAS unsigned*)(lds + (bufoff) + ldsw + _i * 8192), 16, 0, 0); } while (0)
#define PG8_LDA(dst, b, h) do { _Pragma("unroll") for (int m = 0; m < 4; ++m) _Pragma("unroll") for (int k = 0; k < 2; ++k) dst[m][k] = *(const LAS bf16x8*)(lds + PG8_SA(b, h) + aoff + m * 2048 + k * 1024); } while (0)
#define PG8_LDB(dst, b, h) do { _Pragma("unroll") for (int n = 0; n < 2; ++n) _Pragma("unroll") for (int k = 0; k < 2; ++k) dst[n][k] = *(const LAS bf16x8*)(lds + PG8_SB(b, h) + boff + n * 2048 + k * 1024); } while (0)
#define PG8_MMA(ai, bj, At, Bt) do { __builtin_amdgcn_s_setprio(1); _Pragma("unroll") for (int m = 0; m < 4; ++m) _Pragma("unroll") for (int n = 0; n < 2; ++n) _Pragma("unroll") for (int k = 0; k < 2; ++k) \
        acc[ai][bj][m][n] = __builtin_amdgcn_mfma_f32_16x16x32_bf16(Bt[n][k], At[m][k], acc[ai][bj][m][n], 0, 0, 0); __builtin_amdgcn_s_setprio(0); } while (0)
#define PG8_MMA1(ai, bj, nn, At, Bt) do { __builtin_amdgcn_s_setprio(1); _Pragma("unroll") for (int m = 0; m < 4; ++m) _Pragma("unroll") for (int k = 0; k < 2; ++k) \
        acc[ai][bj][m][nn] = __builtin_amdgcn_mfma_f32_16x16x32_bf16(Bt[nn][k], At[m][k], acc[ai][bj][m][nn], 0, 0, 0); __builtin_amdgcn_s_setprio(0); } while (0)
#define PG8_MMAZ(ai, At) do { if (zbr == 0) PG8_MMA1(ai, 0, 0, At, B0); else if (zbr == 1) PG8_MMA1(ai, 0, 1, At, B0); else if (zbr == 2) PG8_MMA1(ai, 1, 0, At, B1); else PG8_MMA1(ai, 1, 1, At, B1); } while (0)
#define PG8_MM2(ai, At) do { PG8_MMA(ai, 0, At, B0); PG8_MMA(ai, 1, At, B1); } while (0)
#define PG8_WAIT_V(n) asm volatile("s_waitcnt vmcnt(" #n ")" ::: "memory")
#define PG8_WAIT_L(n) asm volatile("s_waitcnt lgkmcnt(" #n ")" ::: "memory")
#define PG8_BAR __builtin_amdgcn_s_barrier()
#define PG8_SCHED __builtin_amdgcn_sched_barrier(0)
#define PG8_UA(u) ((const char*)((u).kind ? g.A2 : g.A) + (size_t)(u).pm * tsA)
#define PG8_UB(u) ((const char*)((u).kind ? g.Bt2 : g.Bt) + (size_t)(u).pn * tsB)
    Unit cur, nxt; int ui = 0;
    if (!S.next(0, cur)) return;
    f32x4 acc[2][2][4][2];
#pragma unroll
    for (int a = 0; a < 2; ++a)
#pragma unroll
        for (int b = 0; b < 2; ++b)
#pragma unroll
            for (int m = 0; m < 4; ++m)
#pragma unroll
                for (int n = 0; n < 2; ++n) acc[a][b][m][n] = (f32x4){0.f, 0.f, 0.f, 0.f};
    bf16x8 At[4][2], B0[2][2], B1[2][2];
    const char* cA = PG8_UA(cur); const char* cB = PG8_UB(cur);
    {
        PG8_STAGE(PG8_SB(0, 0), cB, voffB); PG8_STAGE(PG8_SB(0, 1), cB + hsB, voffB); PG8_STAGE(PG8_SA(0, 0), cA, voffA); PG8_STAGE(PG8_SA(0, 1), cA + hsA, voffA);
        if (wr == 1) PG8_BAR;
        PG8_WAIT_V(2); PG8_BAR;
        PG8_STAGE(PG8_SB(1, 0), cB + kstep, voffB); PG8_STAGE(PG8_SA(1, 0), cA + kstep, voffA); PG8_STAGE(PG8_SB(1, 1), cB + hsB + kstep, voffB);
        PG8_WAIT_V(6); PG8_BAR;
    }
    for (;;) {
        const bool has_next = S.next(ui + 1, nxt);
        const char* nA = has_next ? PG8_UA(nxt) : cA; const char* nB = has_next ? PG8_UB(nxt) : cB;
        for (int t = 0; t < nt; t += 2) {
            const bool last = (t == nt - 2);
            if constexpr (HOOK) { if (t == 4 || t == 8 || t == 12) { PG8_SCHED; E.rescale(acc, cur, (t >> 2) - 1, wr, wc, fr, fq); PG8_SCHED; } }
            const char* a1 = cA + (size_t)(t + 1) * kstep;
            const char* a2 = last ? nA : cA + (size_t)(t + 2) * kstep; const char* b2 = last ? nB : cB + (size_t)(t + 2) * kstep;
            const char* a3 = a2 + kstep; const char* b3 = b2 + kstep;
            PG8_LDB(B0, 0, 0); PG8_LDB(B1, 0, 1); PG8_SCHED; PG8_LDA(At, 0, 0); PG8_STAGE(PG8_SA(1, 1), a1 + hsA, voffA);
            PG8_WAIT_V(8); PG8_WAIT_L(0); PG8_BAR; PG8_MM2(0, At); PG8_BAR; PG8_SCHED;
            PG8_LDA(At, 0, 1); PG8_STAGE(PG8_SB(0, 0), b2, voffB); PG8_STAGE(PG8_SB(0, 1), b2 + hsB, voffB); PG8_STAGE(PG8_SA(0, 0), a2, voffA);
            PG8_WAIT_V(8); PG8_WAIT_L(0); PG8_BAR; PG8_MM2(1, At); PG8_BAR; PG8_SCHED;
            PG8_LDB(B0, 1, 0); PG8_LDB(B1, 1, 1); PG8_SCHED; PG8_LDA(At, 1, 0); PG8_STAGE(PG8_SA(0, 1), a2 + hsA, voffA);
            PG8_WAIT_V(8); PG8_WAIT_L(0); PG8_BAR; PG8_MM2(0, At); PG8_BAR; PG8_SCHED;
            PG8_LDA(At, 1, 1); PG8_STAGE(PG8_SB(1, 0), b3, voffB); PG8_STAGE(PG8_SB(1, 1), b3 + hsB, voffB); PG8_STAGE(PG8_SA(1, 0), a3, voffA);
            PG8_WAIT_V(8); PG8_WAIT_L(0); PG8_BAR; PG8_MM2(1, At); PG8_BAR; PG8_SCHED;
        }
        if (wr == 0) PG8_BAR;
        E(acc, cur, wr, wc, fr, fq);
        if (!has_next) break;
#pragma unroll
        for (int a = 0; a < 2; ++a)
#pragma unroll
            for (int b = 0; b < 2; ++b)
#pragma unroll
                for (int m = 0; m < 4; ++m)
#pragma unroll
                    for (int n = 0; n < 2; ++n) acc[a][b][m][n] = (f32x4){0.f, 0.f, 0.f, 0.f};
        cur = nxt; cA = nA; cB = nB; ++ui;
        if (wr == 1) PG8_BAR;
    }
    PG8_WAIT_V(0);
    PG8_BAR;
#undef PG8_SA
#undef PG8_SB
#undef PG8_STAGE
#undef PG8_LDA
#undef PG8_LDB
#undef PG8_MMA
#undef PG8_MMA1
#undef PG8_MMAZ
#undef PG8_MM2
#undef PG8_WAIT_V
#undef PG8_WAIT_L
#undef PG8_BAR
#undef PG8_SCHED
#undef PG8_UA
#undef PG8_UB
}
}

struct Args {
    const float* x; const float* c; const float* ctx; const float* c_ctx; const float* w_mod; const float* b_mod; const float* g_pre; const float* g_post;
    const float* w_gate; const float* w_up; const float* w_down; const float* w_in; const float* gqa_qn; const float* gqa_kn; const float* mla_qn; const float* mla_kvn;
    const float* w_uq; const float* w_ukv; const float* dlam; const float* dsub; const float* sink; const float* w_branch; const float* w_out;
    float* out; unsigned char* ws; int ph_lo, ph_hi;
};
typedef const __attribute__((address_space(4))) Args CArgs;

template <class F>
__device__ __forceinline__ void conv_item(bf16_t* WT, int K, int nblk, int item, LAS float* scr, int lane, const F& f) {
    const int kb = item / nblk, nb = item % nblk, k0 = 64 * kb, n0 = 32 * nb;
#pragma unroll 8
    for (int i = 0; i < 32; ++i) { const int kk = 2 * i + (lane >> 5); scr[kk * 33 + (lane & 31)] = f(n0 + (lane & 31), k0 + kk); }
    asm volatile("s_waitcnt lgkmcnt(0)" ::: "memory");
    const int c = lane & 7;
#pragma unroll
    for (int j = 0; j < 4; ++j) { const int n = (lane >> 3) + 8 * j; const LAS float* s = scr + (8 * c) * 33 + n;
        u32x4 o; o.x = pk2(s[0 * 33], s[1 * 33]); o.y = pk2(s[2 * 33], s[3 * 33]); o.z = pk2(s[4 * 33], s[5 * 33]); o.w = pk2(s[6 * 33], s[7 * 33]);
        *(u32x4*)(WT + (size_t)(n0 + n) * K + k0 + 8 * c) = o; }
    asm volatile("s_waitcnt lgkmcnt(0)" ::: "memory");
}

__device__ __forceinline__ void p0_phase(CArgs& a, LAS unsigned char* lds) {
    const int tid = ptid(), lane = tid & 63, wave = tid >> 6;
    float* MOD = (float*)(a.ws + WS_MOD);
    {
        LAS float* sl = (LAS float*)lds;
        LAS float* red = (LAS float*)(lds + 40960);
        for (int i = tid; i < 9 * 1024; i += 512) { const int r = i >> 10, k = i & 1023; const float v = r < 8 ? a.c[r * 1024 + k] : a.c_ctx[k]; sl[i] = v * sigmoidf_(v); }
        __syncthreads();
        for (int it = blockIdx.x; it < 2 * 144; it += gridDim.x) {
            const int l = it / 144, n0 = (it % 144) * 64;
            const float* W = a.w_mod + (size_t)l * 1024 * MODW + n0 + lane;
            float acc[9];
#pragma unroll
            for (int r = 0; r < 9; ++r) acc[r] = 0.f;
#pragma unroll 8
            for (int kk = 0; kk < 128; ++kk) { const int k = wave * 128 + kk; const float wv = W[(size_t)k * MODW];
#pragma unroll
                for (int r = 0; r < 9; ++r) acc[r] += sl[r * 1024 + k] * wv; }
#pragma unroll
            for (int r = 0; r < 9; ++r) red[(wave * 9 + r) * 64 + lane] = acc[r];
            __syncthreads();
            for (int i = tid; i < 9 * 64; i += 512) { const int r = i >> 6, cidx = i & 63; float s = a.b_mod[l * MODW + n0 + cidx];
#pragma unroll
                for (int w = 0; w < 8; ++w) s += red[(w * 9 + r) * 64 + cidx];
                MOD[((size_t)l * 9 + r) * MODW + n0 + cidx] = s; }
            __syncthreads();
        }
        __syncthreads();
    }
    LAS float* scr = (LAS float*)(lds + wave * 8448);
    const int gw = blockIdx.x * 8 + wave, NGW = gridDim.x * 8;
    constexpr int I_GU = 176 * 16, I_D = 32 * 44, I_IN = 72 * 16, I_G = 128 * 16, I_BR = 32 * 16, I_OUT = 32 * 16, I_MLA = 32 * 6;
    constexpr int I_LAYER = 2 * I_GU + 2 * I_D + I_IN + I_G + I_BR + I_OUT + I_MLA;
    for (int it = gw; it < 2 * I_LAYER; it += NGW) {
        const int l = it / I_LAYER; int r = it % I_LAYER;
        unsigned char* wb = a.ws + WS_W + (size_t)l * W_LAYER;
        if (r < 2 * I_GU) { const int s = r / I_GU; r %= I_GU;
            const float* wg = a.w_gate + (size_t)(l * 2 + s) * 1024 * DFF; const float* wu = a.w_up + (size_t)(l * 2 + s) * 1024 * DFF;
            conv_item((bf16_t*)(wb + W_GU + s * W_GU_SZ), 1024, 176, r, scr, lane, [=](int n, int k) { const int j = (n >> 8) * 128 + (n & 127); return ((n >> 7) & 1) ? wu[(size_t)k * DFF + j] : wg[(size_t)k * DFF + j]; });
            continue; }
        r -= 2 * I_GU;
        if (r < 2 * I_D) { const int s = r / I_D; r %= I_D;
            const float* wd = a.w_down + (size_t)(l * 2 + s) * DFF * 1024;
            conv_item((bf16_t*)(wb + W_D + s * W_D_SZ), DFF, 32, r, scr, lane, [=](int n, int k) { return wd[(size_t)k * 1024 + n]; });
            continue; }
        r -= 2 * I_D;
        const float* win = a.w_in + (size_t)l * 1024 * INCOLS;
        if (r < I_IN) { conv_item((bf16_t*)(wb + W_IN), 1024, 72, r, scr, lane, [=](int n, int k) { return n < GATE0 ? win[(size_t)k * INCOLS + n] : 0.f; }); continue; }
        r -= I_IN;
        if (r < I_G) { conv_item((bf16_t*)(wb + W_G), 1024, 128, r, scr, lane, [=](int n, int k) { return win[(size_t)k * INCOLS + GATE0 + n]; }); continue; }
        r -= I_G;
        if (r < I_BR) { const float* wbr = a.w_branch + (size_t)l * 4 * 256 * 1024;
            conv_item((bf16_t*)(wb + W_BR), 1024, 32, r, scr, lane, [=](int n, int k) { return wbr[(size_t)k * 1024 + n]; }); continue; }
        r -= I_BR;
        if (r < I_OUT) { const float* wo = a.w_out + (size_t)l * 1024 * 1024;
            conv_item((bf16_t*)(wb + W_OUT), 1024, 32, r, scr, lane, [=](int n, int k) { return wo[(size_t)k * 1024 + n]; }); continue; }
        r -= I_OUT;
        { const float* uq = a.w_uq + (size_t)l * 256 * 384; const float* ukv = a.w_ukv + (size_t)l * 128 * 512; const float* gq = a.mla_qn + l * 256; const float* gkv = a.mla_kvn + l * 128;
            conv_item((bf16_t*)(wb + W_MLA), 384, 32, r, scr, lane, [=](int n, int k) {
                float v = 0.f;
                if (n < 384) { if (k < 256) v = gq[k] * uq[(size_t)k * 384 + n]; }
                else if (n < 896) { if (k >= 256) v = gkv[k - 256] * ukv[(size_t)(k - 256) * 512 + (n - 384)]; }
                return v; }); }
    }
}

__device__ __forceinline__ void row_phase(CArgs& a, int l, bool first, const bf16_t* Y, int sub_y, float gscale, bf16_t* U, int sub_u, int l_u) {
    const int tid_ = ptid(); const int lane = tid_ & 63, wave = tid_ >> 6;
    const int gw = blockIdx.x * 8 + wave, NGW = gridDim.x * 8;
    const float* MOD = (const float*)(a.ws + WS_MOD);
    float* XC = (float*)(a.ws + WS_XC);
#pragma unroll 2
    for (int row = gw; row < R; row += NGW) {
        const int b = row / RPB, t = row % RPB; const bool isctx = t < CTX;
        const float* xs; float* xd;
        if (isctx) { const size_t o = (size_t)(b * CTX + t) * DM; xs = (first ? a.ctx : XC) + o; xd = XC + o; }
        else { const size_t o = (size_t)(b * SEQ + (t - CTX)) * DM; xs = (first ? a.x : a.out) + o; xd = a.out + o; }
        const int mrow = isctx ? 8 : b;
        f32x4 v[4];
#pragma unroll
        for (int j = 0; j < 4; ++j) v[j] = *(const f32x4*)(xs + 4 * lane + 256 * j);
        if (Y) {
            const float* md = MOD + ((size_t)l * 9 + mrow) * MODW + (sub_y * 3 + 2) * 1024;
            const float* gp = a.g_post + (l * 3 + sub_y) * 1024;
            f32x4 y[4]; float ss = 0.f;
#pragma unroll
            for (int j = 0; j < 4; ++j) { const u32x2 w = *(const u32x2*)(Y + (size_t)row * DM + 4 * lane + 256 * j);
                y[j] = (f32x4){bflo(w.x), bfhi(w.x), bflo(w.y), bfhi(w.y)}; ss += (y[j].x * y[j].x + y[j].y * y[j].y) + (y[j].z * y[j].z + y[j].w * y[j].w); }
            const float rs = __builtin_amdgcn_rsqf(wave_sum(ss) * (1.f / DM) + EPS) * gscale;
#pragma unroll
            for (int j = 0; j < 4; ++j) { const f32x4 g = *(const f32x4*)(md + 4 * lane + 256 * j), p = *(const f32x4*)(gp + 4 * lane + 256 * j);
                v[j] = v[j] + (y[j] * rs) * p * g; *(f32x4*)(xd + 4 * lane + 256 * j) = v[j]; }
        }
        if (U) {
            const float* md = MOD + ((size_t)l_u * 9 + mrow) * MODW + (sub_u * 3) * 1024;
            const float* gp = a.g_pre + (l_u * 3 + sub_u) * 1024;
            float ss = 0.f;
#pragma unroll
            for (int j = 0; j < 4; ++j) ss += (v[j].x * v[j].x + v[j].y * v[j].y) + (v[j].z * v[j].z + v[j].w * v[j].w);
            const float rs = __builtin_amdgcn_rsqf(wave_sum(ss) * (1.f / DM) + EPS);
#pragma unroll
            for (int j = 0; j < 4; ++j) { const f32x4 sh = *(const f32x4*)(md + 4 * lane + 256 * j), sc = *(const f32x4*)(md + 1024 + 4 * lane + 256 * j), p = *(const f32x4*)(gp + 4 * lane + 256 * j);
                const f32x4 u = (v[j] * rs) * p * (sc + 1.f) + sh;
                u32x2 w; w.x = pk2(u.x, u.y); w.y = pk2(u.z, u.w);
                *(u32x2*)(U + (size_t)row * DM + 4 * lane + 256 * j) = w; }
        }
    }
}

constexpr int VSTR = 136;
constexpr int TAB_OFF = 768 * VSTR;
__device__ __forceinline__ void rope64p(float& v0, float& v1, int l, bool lat, const LAS float* tab, int prow, int pcol) {
    const float p0 = __shfl_xor(v0, 8), p1 = __shfl_xor(v1, 8);
    const int lh = l & 31, pos = (lh & 16) ? pcol : prow, i0 = (2 * lh) & 15;
    const f32x4 cs = *(const LAS f32x4*)(tab + (pos * 16 + i0) * 2);
    const bool sec = (lh >> 3) & 1;
    const float c0 = lat ? cs[0] : 1.f, s0 = lat ? (sec ? cs[1] : -cs[1]) : 0.f, c1 = lat ? cs[2] : 1.f, s1 = lat ? (sec ? cs[3] : -cs[3]) : 0.f;
    v0 = v0 * c0 + p0 * s0; v1 = v1 * c1 + p1 * s1;
}
__device__ __forceinline__ void rope32p(float& v0, float& v1, int d0, bool lat, const LAS float* tab, int prow, int pcol) {
    const float p0 = __shfl_xor(v0, 4), p1 = __shfl_xor(v1, 4);
    const int pos = (d0 & 16) ? pcol : prow, i0 = d0 & 7;
    const LAS float* t = tab + (pos * 16 + 2 * i0) * 2;
    const bool sec = (d0 >> 3) & 1;
    const float c0 = lat ? t[0] : 1.f, s0 = lat ? (sec ? t[1] : -t[1]) : 0.f, c1 = lat ? t[4] : 1.f, s1 = lat ? (sec ? t[5] : -t[5]) : 0.f;
    v0 = v0 * c0 + p0 * s0; v1 = v1 * c1 + p1 * s1;
}
__device__ __forceinline__ float half_sum(float v) {
#pragma unroll
    for (int o = 1; o < 32; o <<= 1) v += __shfl_xor(v, o);
    return v;
}
__device__ __forceinline__ void prep_phase(CArgs& a, int l, LAS unsigned char* lds) {
    const int tid = ptid(), lane = tid & 63, wave = __builtin_amdgcn_readfirstlane(tid >> 6);
    bf16_t* HIN = (bf16_t*)(a.ws + WS_BIG); bf16_t* MUP = (bf16_t*)(a.ws + WS_Y); bf16_t* VT = (bf16_t*)(a.ws + WS_VT);
    LAS float* tab = (LAS float*)(lds + TAB_OFF);
    for (int i = tid; i < 128 * 16; i += 512) { const int pos = i >> 4, f = i & 15;
        const float invf = fexp2(-(float)(2 * f) * (1.f / 32.f) * 13.287712379549449f);
        float rev = (float)pos * invf * 0.15915494309189535f; rev -= __builtin_floorf(rev);
        tab[i * 2] = __builtin_amdgcn_cosf(rev); tab[i * 2 + 1] = __builtin_amdgcn_sinf(rev); }
    __syncthreads();
    const int lh = lane & 31;
    const float gq0 = a.gqa_qn[l * 64 + 2 * lh], gq1 = a.gqa_qn[l * 64 + 2 * lh + 1], gk0 = a.gqa_kn[l * 64 + 2 * lh], gk1 = a.gqa_kn[l * 64 + 2 * lh + 1];
#define LD2(p, v0, v1) do { const unsigned w_ = *(const unsigned*)(p); v0 = bflo(w_); v1 = bfhi(w_); } while (0)
#define ST2(p, v0, v1) do { *(unsigned*)(p) = pg8::cvt_pk_bf16(v0, v1); } while (0)
    for (int tile = blockIdx.x; tile < R / 64; tile += gridDim.x) {
        const int row0 = tile * 64, b = row0 / RPB, t0 = row0 % RPB;
#pragma unroll 4
        for (int rr = 0; rr < 8; ++rr) {
            const int tk = wave * 8 + rr, row = row0 + tk, t = t0 + tk; const bool lat = t >= CTX;
            const int tl = lat ? t - CTX : 0, prow = tl >> 6, pcol = tl & 63;
            bf16_t* __restrict__ h = HIN + (size_t)row * NHIN; bf16_t* __restrict__ mu = MUP + (size_t)row * 1024;
            LAS bf16_t* vst = (LAS bf16_t*)lds + tk;
#pragma unroll
            for (int j = 0; j < 3; ++j) { float v0, v1; LD2(h + 128 * j + 2 * lane, v0, v1);
                const float rs = __builtin_amdgcn_rsqf(half_sum(v0 * v0 + v1 * v1) * (1.f / 64.f) + EPS);
                v0 = v0 * rs * (j < 2 ? gq0 : gk0); v1 = v1 * rs * (j < 2 ? gq1 : gk1);
                rope64p(v0, v1, lane, lat, tab, prow, pcol);
                if (j < 2) { v0 *= QS_GQA; v1 *= QS_GQA; }
                ST2(h + 128 * j + 2 * lane, v0, v1); }
            { const unsigned w = *(const unsigned*)(h + 384 + 2 * lane); vst[(0 + 2 * lane) * (VSTR / 2)] = (bf16_t)(w & 0xffffu); vst[(0 + 2 * lane + 1) * (VSTR / 2)] = (bf16_t)(w >> 16); }
            float sq = 0.f, skv = 0.f;
#pragma unroll
            for (int j = 0; j < 2; ++j) { float v0, v1; LD2(h + 512 + 128 * j + 2 * lane, v0, v1); sq += v0 * v0 + v1 * v1; }
            { float v0, v1; LD2(h + 768 + 2 * lane, v0, v1); skv = v0 * v0 + v1 * v1; }
            const float rq = __builtin_amdgcn_rsqf(wave_sum(sq) * (1.f / 256.f) + EPS) * QS_MLA, rkv = __builtin_amdgcn_rsqf(wave_sum(skv) * (1.f / 128.f) + EPS);
#pragma unroll
            for (int j = 0; j < 3; ++j) { const int c = 128 * j + 2 * lane, e = c % 96; float v0, v1; LD2(mu + c, v0, v1); v0 *= rq; v1 *= rq;
                float r0 = v0, r1 = v1; rope32p(r0, r1, (e - 64) & 30, lat, tab, prow, pcol);
                if (e >= 64) { v0 = r0; v1 = r1; }
                ST2(mu + c, v0, v1); }
#pragma unroll
            for (int hh = 0; hh < 4; ++hh) { const int c = 384 + 128 * hh + 2 * lane; float v0, v1; LD2(mu + c, v0, v1); v0 *= rkv; v1 *= rkv;
                const unsigned w = pg8::cvt_pk_bf16(v0, v1);
                if (lane < 32) *(unsigned*)(mu + c) = w;
                else { vst[(128 + 64 * hh + 2 * (lane - 32)) * (VSTR / 2)] = (bf16_t)(w & 0xffffu); vst[(128 + 64 * hh + 2 * (lane - 32) + 1) * (VSTR / 2)] = (bf16_t)(w >> 16); } }
            { float v0, v1; LD2(h + 896 + 2 * (lane & 15), v0, v1); rope32p(v0, v1, 2 * (lane & 15), lat, tab, prow, pcol); if (lane < 16) ST2(mu + 896 + 2 * lane, v0, v1); }
#pragma unroll
            for (int j = 0; j < 4; ++j) { float v0, v1; LD2(h + 928 + 128 * j + 2 * lane, v0, v1); rope32p(v0, v1, (2 * lane) & 31, lat, tab, prow, pcol);
                if (j < 2) { v0 *= QS_DIFF; v1 *= QS_DIFF; }
                ST2(h + 928 + 128 * j + 2 * lane, v0, v1); }
#pragma unroll
            for (int j = 0; j < 2; ++j) { const unsigned w = *(const unsigned*)(h + 1440 + 128 * j + 2 * lane); vst[(384 + 128 * j + 2 * lane) * (VSTR / 2)] = (bf16_t)(w & 0xffffu); vst[(384 + 128 * j + 2 * lane + 1) * (VSTR / 2)] = (bf16_t)(w >> 16); }
#pragma unroll
            for (int j = 0; j < 3; ++j) { float v0, v1; LD2(h + 1696 + 128 * j + 2 * lane, v0, v1); rope64p(v0, v1, lane, lat, tab, prow, pcol);
                if (j < 2) { v0 *= QS_GQA; v1 *= QS_GQA; }
                ST2(h + 1696 + 128 * j + 2 * lane, v0, v1); }
            { const unsigned w = *(const unsigned*)(h + 2080 + 2 * lane); vst[(640 + 2 * lane) * (VSTR / 2)] = (bf16_t)(w & 0xffffu); vst[(640 + 2 * lane + 1) * (VSTR / 2)] = (bf16_t)(w >> 16); }
        }
#undef LD2
#undef ST2
        __syncthreads();
        bf16_t* vt = VT + (size_t)b * 768 * RPB + t0;
        for (int p = tid; p < 768 * 8; p += 512) { const int vr = p >> 3, seg = p & 7;
            const LAS u32x2* s = (const LAS u32x2*)(lds + vr * VSTR + seg * 16); const u32x2 lo = s[0], hi = s[1];
            *(u32x4*)(vt + (size_t)vr * RPB + seg * 8) = (u32x4){lo.x, lo.y, hi.x, hi.y}; }
        __syncthreads();
    }
}

__device__ __forceinline__ int crow(int r, int hi) { return (r & 3) + 8 * (r >> 2) + 4 * hi; }
constexpr int AT_KBUF = 64 * (96 * 2 + 16);
constexpr int AT_VSTR = 144, AT_VBUF = 64 * AT_VSTR;
constexpr int AT_K0 = 0, AT_V0 = 2 * AT_KBUF, AT_WS = AT_V0 + 2 * AT_VBUF;

struct AttnSrc { const bf16_t* Q; int ldq; const bf16_t* K1; int ldk1; const bf16_t* K2; int ldk2; const bf16_t* VT; };

template <int DQK, bool WIN>
__device__ __forceinline__ void attn_pass(const AttnSrc& s, int NT, int lo, int q0lat, float sink_l2, bool has_sink, LAS unsigned char* lds, f32x16 (&o)[2]) {
    constexpr int KSTR = DQK * 2 + 16, NCH = DQK / 8, NKS = DQK / 16;
    const int tid = ptid(), lane = tid & 63, r32 = lane & 31, hi = lane >> 5; const int wid = __builtin_amdgcn_readfirstlane(tid >> 6);
    LAS float* wsf = (LAS float*)(lds + AT_WS) + wid * 32;
    bf16x8 qf[NKS];
    { const bf16_t* qp = s.Q + (size_t)(wid * 32 + r32) * s.ldq + 8 * hi;
#pragma unroll
        for (int ks = 0; ks < NKS; ++ks) qf[ks] = *(const bf16x8*)(qp + 16 * ks); }
    o[0] = (f32x16){}; o[1] = (f32x16){};
    f32x16 negm = (f32x16){}; asm volatile("" : "+v"(negm));
    float mhat = 0.f, lsum = 0.f;
    const int kkey0 = tid / NCH, kc0 = tid % NCH;
    const int kkey1 = (tid + 512) / NCH, kc1 = (tid + 512) % NCH;
    const bool kv0 = tid < 64 * NCH, kv1 = (DQK == 96) && (tid < 256);
    const int vdv = tid >> 3, vseg = tid & 7;
    u32x4 kr0 = (u32x4){}, kr1 = (u32x4){}, vr = (u32x4){}, kn0 = (u32x4){}, kn1 = (u32x4){}, vn = (u32x4){};
    auto kaddr = [&](int key, int c) -> const bf16_t* { return (DQK == 96 && c >= 8) ? s.K2 + (size_t)key * s.ldk2 + (c - 8) * 8 : s.K1 + (size_t)key * s.ldk1 + c * 8; };
#define AT_TILE(i) ((i) < 4 ? (i) : lo - 4 + (i))
#define AT_GLOAD(K0, K1, V, i) do { const int key0_ = AT_TILE(i) * 64; \
        if (kv0) K0 = *(const u32x4*)kaddr(key0_ + kkey0, kc0); if (kv1) K1 = *(const u32x4*)kaddr(key0_ + kkey1, kc1); \
        V = *(const u32x4*)(s.VT + (size_t)vdv * RPB + key0_ + vseg * 8); } while (0)
#define AT_LSTORE(K0, K1, V, buf) do { if (kv0) *(LAS u32x4*)(lds + AT_K0 + (buf) * AT_KBUF + kkey0 * KSTR + kc0 * 16) = K0; \
        if (kv1) *(LAS u32x4*)(lds + AT_K0 + (buf) * AT_KBUF + kkey1 * KSTR + kc1 * 16) = K1; \
        *(LAS u32x4*)(lds + AT_V0 + (buf) * AT_VBUF + vdv * AT_VSTR + vseg * 16) = V; } while (0)
#define MX3(a, b, c) __builtin_fmaxf(__builtin_fmaxf((a), (b)), (c))
    AT_GLOAD(kr0, kr1, vr, 0); AT_LSTORE(kr0, kr1, vr, 0);
    if (NT > 1) AT_GLOAD(kr0, kr1, vr, 1);
    __syncthreads();
    for (int i = 0; i < NT; ++i) {
        const int buf = i & 1;
        if (i + 2 < NT) AT_GLOAD(kn0, kn1, vn, i + 2);
        const LAS unsigned char* kb = lds + AT_K0 + buf * AT_KBUF + r32 * KSTR + hi * 16;
        f32x16 s0, s1;
#pragma unroll
        for (int ks = 0; ks < NKS; ++ks) {
            const bf16x8 a0 = *(const LAS bf16x8*)(kb + ks * 32), a1 = *(const LAS bf16x8*)(kb + 32 * KSTR + ks * 32);
            if (ks == 0) { s0 = __builtin_amdgcn_mfma_f32_32x32x16_bf16(a0, qf[0], negm, 0, 0, 0); s1 = __builtin_amdgcn_mfma_f32_32x32x16_bf16(a1, qf[0], negm, 0, 0, 0); }
            else { s0 = __builtin_amdgcn_mfma_f32_32x32x16_bf16(a0, qf[ks], s0, 0, 0, 0); s1 = __builtin_amdgcn_mfma_f32_32x32x16_bf16(a1, qf[ks], s1, 0, 0, 0); }
        }
        if (WIN && i >= 4) {
            const int jb = AT_TILE(i) * 64 - CTX + 4 * hi, qi = q0lat + wid * 32 + r32;
#pragma unroll
            for (int r = 0; r < 16; ++r) { const int j = jb + (r & 3) + 8 * (r >> 2); const int d0 = qi - j, d1 = qi - (j + 32);
                if (d0 > 128 || d0 < -128) s0[r] = -1e30f; if (d1 > 128 || d1 < -128) s1[r] = -1e30f; }
        }
        float ra = MX3(s0[0], s0[1], s1[0]), rb = MX3(s0[2], s0[3], s1[1]); ra = MX3(ra, s1[2], s1[3]);
#pragma unroll
        for (int r = 4; r < 16; r += 4) { ra = MX3(ra, s0[r], s0[r + 1]); rb = MX3(rb, s0[r + 2], s0[r + 3]); ra = MX3(ra, s1[r], s1[r + 1]); rb = MX3(rb, s1[r + 2], s1[r + 3]); }
        float rm = __builtin_fmaxf(ra, rb);
        rm = __builtin_fmaxf(rm, __shfl_xor(rm, 32));
        if (i == 0 || __any(rm > 8.f)) {
            const float dl = (i == 0) ? rm : __builtin_fmaxf(rm, 0.f);
            mhat += dl;
#pragma unroll
            for (int r = 0; r < 16; ++r) { s0[r] -= dl; s1[r] -= dl; }
#pragma unroll
            for (int r = 0; r < 16; ++r) negm[r] = -mhat;
            asm volatile("" : "+v"(negm));
            if (i != 0) {
                const float f = fexp2(-dl);
                lsum *= f;
                if (hi == 0) wsf[r32] = f;
#pragma unroll
                for (int r = 0; r < 16; ++r) { const float fr_ = wsf[crow(r, hi)]; o[0][r] *= fr_; o[1][r] *= fr_; }
            }
        }
        float ps = 0.f, ps2 = 0.f;
#pragma unroll
        for (int r = 0; r < 16; ++r) { s0[r] = fexp2(s0[r]); s1[r] = fexp2(s1[r]); ps += s0[r]; ps2 += s1[r]; }
        lsum += ps + ps2;
        bf16x8 pa[4];
#pragma unroll
        for (int kk = 0; kk < 4; ++kk) {
            u32x4 w;
            if (kk < 2) { w.x = pg8::cvt_pk_bf16(s0[8 * kk + 0], s0[8 * kk + 1]); w.y = pg8::cvt_pk_bf16(s0[8 * kk + 2], s0[8 * kk + 3]); w.z = pg8::cvt_pk_bf16(s0[8 * kk + 4], s0[8 * kk + 5]); w.w = pg8::cvt_pk_bf16(s0[8 * kk + 6], s0[8 * kk + 7]); }
            else { const int k2 = kk - 2; w.x = pg8::cvt_pk_bf16(s1[8 * k2 + 0], s1[8 * k2 + 1]); w.y = pg8::cvt_pk_bf16(s1[8 * k2 + 2], s1[8 * k2 + 3]); w.z = pg8::cvt_pk_bf16(s1[8 * k2 + 4], s1[8 * k2 + 5]); w.w = pg8::cvt_pk_bf16(s1[8 * k2 + 6], s1[8 * k2 + 7]); }
            pa[kk] = __builtin_bit_cast(bf16x8, w);
        }
        const LAS unsigned char* vb = lds + AT_V0 + buf * AT_VBUF + r32 * AT_VSTR + hi * 8;
#pragma unroll
        for (int dvb = 0; dvb < 2; ++dvb)
#pragma unroll
            for (int kk = 0; kk < 4; ++kk) {
                const u32x2 lo_ = *(const LAS u32x2*)(vb + dvb * 32 * AT_VSTR + kk * 32), hi_ = *(const LAS u32x2*)(vb + dvb * 32 * AT_VSTR + kk * 32 + 16);
                const bf16x8 bv = __builtin_bit_cast(bf16x8, (u32x4){lo_.x, lo_.y, hi_.x, hi_.y});
                o[dvb] = __builtin_amdgcn_mfma_f32_32x32x16_bf16(pa[kk], bv, o[dvb], 0, 0, 0);
            }
        if (i + 1 < NT) AT_LSTORE(kr0, kr1, vr, buf ^ 1);
        __syncthreads();
        kr0 = kn0; kr1 = kn1; vr = vn;
    }
    float lt = lsum + __shfl_xor(lsum, 32);
    if (has_sink) lt += fexp2(sink_l2 - mhat);
    if (hi == 0) wsf[r32] = frcp(lt);
#pragma unroll
    for (int r = 0; r < 16; ++r) { const float fr_ = wsf[crow(r, hi)]; o[0][r] *= fr_; o[1][r] *= fr_; }
#undef AT_TILE
#undef AT_GLOAD
#undef AT_LSTORE
#undef MX3
}

__device__ __forceinline__ void attn_store(bf16_t* O, int row0, int col0, const f32x16 (&o)[2]) {
    const int tid_ = ptid(); const int lane = tid_ & 63, r32 = lane & 31, hi = lane >> 5, wid = tid_ >> 6;
#pragma unroll
    for (int dvb = 0; dvb < 2; ++dvb)
#pragma unroll
        for (int r = 0; r < 16; ++r) O[(size_t)(row0 + wid * 32 + crow(r, hi)) * 1024 + col0 + dvb * 32 + r32] = (bf16_t)f2bf(o[dvb][r]);
}

__device__ __forceinline__ void attn_unit(CArgs& a, int l, int branch, int b, int h, int qb, float lam, float lam_init, LAS unsigned char* lds) {
    const bf16_t* HIN = (const bf16_t*)(a.ws + WS_BIG) + (size_t)b * RPB * NHIN; const bf16_t* MUP = (const bf16_t*)(a.ws + WS_Y) + (size_t)b * RPB * 1024;
    const bf16_t* VT = (const bf16_t*)(a.ws + WS_VT) + (size_t)b * 768 * RPB; bf16_t* OUTS = (bf16_t*)(a.ws + WS_OUTS);
    const bool cq = qb < 0; const int qrow = cq ? 0 : CTX + 256 * qb;
    const int NTd = cq ? 4 : 132;
    const int orow0 = b * RPB + qrow;
    f32x16 o[2];
    AttnSrc s;
    if (branch == 0) {
        s.Q = HIN + (size_t)qrow * NHIN + 64 * h; s.ldq = NHIN; s.K1 = HIN + 256 + 64 * (h >> 1); s.ldk1 = NHIN; s.K2 = nullptr; s.ldk2 = 0; s.VT = VT + (size_t)(0 + 64 * (h >> 1)) * RPB;
        attn_pass<64, false>(s, NTd, 4, 0, 0.f, false, lds, o);
        attn_store(OUTS, orow0, 0 + 64 * h, o);
    } else if (branch == 1) {
        s.Q = MUP + (size_t)qrow * 1024 + 96 * h; s.ldq = 1024; s.K1 = MUP + 384 + 128 * h; s.ldk1 = 1024; s.K2 = MUP + 896; s.ldk2 = 1024; s.VT = VT + (size_t)(128 + 64 * h) * RPB;
        attn_pass<96, false>(s, NTd, 4, 0, 0.f, false, lds, o);
        attn_store(OUTS, orow0, 256 + 64 * h, o);
    } else if (branch == 2) {
        f32x16 o2[2];
        s.Q = HIN + (size_t)qrow * NHIN + 928 + 64 * h; s.ldq = NHIN; s.K1 = HIN + 1184 + 64 * h; s.ldk1 = NHIN; s.K2 = nullptr; s.ldk2 = 0; s.VT = VT + (size_t)(384 + 64 * h) * RPB;
        attn_pass<32, false>(s, NTd, 4, 0, 0.f, false, lds, o);
        s.Q += 32; s.K1 += 32;
        attn_pass<32, false>(s, NTd, 4, 0, 0.f, false, lds, o2);
        const int lane = ptid() & 63, r32 = lane & 31;
        const float g0 = a.dsub[l * 64 + r32] * (1.f - lam_init), g1 = a.dsub[l * 64 + 32 + r32] * (1.f - lam_init);
#pragma unroll
        for (int r = 0; r < 16; ++r) { const float x0 = o[0][r] - lam * o2[0][r], x1 = o[1][r] - lam * o2[1][r];
            float ss = x0 * x0 + x1 * x1;
#pragma unroll
            for (int m = 1; m < 32; m <<= 1) ss += __shfl_xor(ss, m);
            const float rs = __builtin_amdgcn_rsqf(ss * (1.f / 64.f) + EPS);
            o[0][r] = x0 * rs * g0; o[1][r] = x1 * rs * g1; }
        attn_store(OUTS, orow0, 512 + 64 * h, o);
    } else {
        s.Q = HIN + (size_t)qrow * NHIN + 1696 + 64 * h; s.ldq = NHIN; s.K1 = HIN + 1952 + 64 * (h >> 1); s.ldk1 = NHIN; s.K2 = nullptr; s.ldk2 = 0; s.VT = VT + (size_t)(640 + 64 * (h >> 1)) * RPB;
        const float sk = a.sink[l * 4 + h] * LOG2E;
        if (cq) attn_pass<64, false>(s, 4, 4, 0, sk, true, lds, o);
        else { const int q0 = 256 * qb; const int lo = 4 + (q0 >= 128 ? q0 - 128 : 0) / 64, hiT = 4 + ((q0 + 384) < SEQ ? (q0 + 384) : SEQ) / 64;
            attn_pass<64, true>(s, 4 + hiT - lo, lo, q0, sk, true, lds, o); }
        attn_store(OUTS, orow0, 768 + 64 * h, o);
    }
}

__device__ __forceinline__ void attn_phase(CArgs& a, int l, LAS unsigned char* lds) {
    const float lam_init = 0.8f - 0.6f * __expf(-0.3f * (float)l);
    float lam;
    { const float* dl = a.dlam + l * 128; float s1 = 0.f, s2 = 0.f;
        for (int i = 0; i < 32; ++i) { s1 += dl[i] * dl[32 + i]; s2 += dl[64 + i] * dl[96 + i]; }
        lam = __expf(s1) - __expf(s2) + lam_init; }
    const int G = gridDim.x, bx = blockIdx.x;
    const int vcu = (G % 8 == 0) ? (bx % 8) * (G / 8) + bx / 8 : bx;
    for (int ty = 0; ty < 4; ++ty) {
        const int branch = ty == 0 ? 2 : ty == 1 ? 1 : ty == 2 ? 0 : 3;
        for (int idx = vcu; idx < NB * 4 * 32; idx += G) { const int bh = idx >> 5, qb = idx & 31; attn_unit(a, l, branch, bh >> 2, bh & 3, qb, lam, lam_init, lds); }
    }
    for (int idx = vcu; idx < NB * 16; idx += G) attn_unit(a, l, (idx >> 2) & 3, idx >> 4, idx & 3, -1, lam, lam_init, lds);
}

#define GAS __attribute__((address_space(1)))
#define XB_TMO      128
#define XB_XCNT(j)  (256  + 64 * (j))
#define XB_XSUB(j)  (1280 + 64 * (j))
#define XB_XGEN(j)  (2304 + 64 * (j))
#define XB_TOP      3328
#define XB_TOPGEN   3392
#define XCD_BAR_WORDS 3456
#define XB_SPIN_CAP (1u << 18)

__device__ __forceinline__ unsigned xb_ld(unsigned* p)              { return __hip_atomic_load(p, __ATOMIC_RELAXED, __HIP_MEMORY_SCOPE_AGENT); }
__device__ __forceinline__ unsigned xb_add(unsigned* p, unsigned v) { return __hip_atomic_fetch_add(p, v, __ATOMIC_RELAXED, __HIP_MEMORY_SCOPE_AGENT); }
__device__ __forceinline__ unsigned xb_xcc_id() { return (unsigned)__builtin_amdgcn_s_getreg((3 << 11) | 20) & 0xFu; }
#define XB_SPIN(cond, bar) do { unsigned _sp = 0; while (cond) { __builtin_amdgcn_s_sleep(1); \
    if ((++_sp & 255u) == 0u) { if (xb_ld(&(bar)[XB_TMO])) break; if (_sp > XB_SPIN_CAP) { atomicAdd(&(bar)[XB_TMO], 1u); break; } } } } while (0)

struct XcdBarrier {
    unsigned* bar; unsigned x;
    volatile LAS unsigned* st;
};

__device__ __forceinline__ XcdBarrier xcd_barrier_post(unsigned* bar, volatile LAS unsigned* st) {
    XcdBarrier b; b.bar = bar; b.x = xb_xcc_id(); b.st = st;
    if (threadIdx.x == 0) (void)xb_add(&bar[XB_XCNT(b.x)], 1u);
    return b;
}
__device__ __forceinline__ void xcd_barrier_complete(unsigned* bar, unsigned x, unsigned& nloc, unsigned& nx) {
    const unsigned G = gridDim.x * gridDim.y * gridDim.z;
    unsigned sum, cnt, mine, sp = 0u;
    for (;;) {
        sum = 0u; cnt = 0u; mine = 0u;
#pragma unroll
        for (unsigned j = 0; j < 16; ++j) { const unsigned c = xb_ld(&bar[XB_XCNT(j)]); sum += c; cnt += (c > 0u) ? 1u : 0u; mine = (j == x) ? c : mine; }
        if (sum == G) break;
        __builtin_amdgcn_s_sleep(1);
        if ((++sp & 255u) == 0u) { if (xb_ld(&bar[XB_TMO])) break; if (sp > XB_SPIN_CAP) { atomicAdd(&bar[XB_TMO], 1u); break; } }
    }
    nloc = mine > 0u ? mine : 1u; nx = cnt > 0u ? cnt : 1u;
}

__device__ __forceinline__ void xcd_barrier(const XcdBarrier& b) {
    asm volatile("s_waitcnt vmcnt(0)" ::: "memory");
    __syncthreads();
    if (threadIdx.x == 0) {
        unsigned* bar = b.bar;
        __builtin_amdgcn_s_waitcnt(0);
        unsigned nloc = b.st[0], nx = b.st[1];
        if (nloc == 0u) { xcd_barrier_complete(bar, b.x, nloc, nx); b.st[0] = nloc; b.st[1] = nx; }
        const unsigned old = xb_add(&bar[XB_XSUB(b.x)], 1u);
        const unsigned gen = old / nloc;
        if (old + 1u == (gen + 1u) * nloc) {
            __builtin_amdgcn_fence(__ATOMIC_RELEASE, "agent");
            asm volatile("s_waitcnt vmcnt(0)" ::: "memory");
            const unsigned og = xb_add(&bar[XB_TOP], 1u);
            const unsigned tg = og / nx;
            if (og + 1u == (tg + 1u) * nx) xb_add(&bar[XB_TOPGEN], 1u);
            else XB_SPIN(xb_ld(&bar[XB_TOPGEN]) == tg, bar);
            __builtin_amdgcn_fence(__ATOMIC_ACQUIRE, "agent");
            xb_add(&bar[XB_XGEN(b.x)], 1u);
            asm volatile("s_waitcnt vmcnt(0)" ::: "memory");
        } else {
            XB_SPIN(xb_ld(&bar[XB_XGEN(b.x)]) == gen, bar);
            __builtin_amdgcn_fence(__ATOMIC_ACQUIRE, "agent");
            asm volatile("s_waitcnt vmcnt(0)" ::: "memory");
        }
    }
    __syncthreads();
}


constexpr int NPHASE = 2 + 32;
__global__ void __launch_bounds__(512, 2) fwd_kernel(Args a_) {
    extern __shared__ __attribute__((aligned(16))) unsigned char lds_raw[];
    LAS unsigned char* lds = (LAS unsigned char*)lds_raw;
    cg::grid_group grid = cg::this_grid();
    const int lo = a_.ph_lo, hi = a_.ph_hi < NPHASE ? a_.ph_hi : NPHASE;
    { volatile LAS unsigned* st0 = (volatile LAS unsigned*)(lds + LDS_BARST); if (threadIdx.x < 2) st0[threadIdx.x] = 0u; }
    __syncthreads();
    { XcdBarrier b0 = xcd_barrier_post((unsigned*)(a_.ws + WS_BAR), (volatile LAS unsigned*)(lds + LDS_BARST)); (void)b0; }
    for (int ph = lo; ph < hi; ++ph) {
        CArgs* ap_ = (CArgs*)__builtin_amdgcn_kernarg_segment_ptr(); asm volatile("" : "+s"(ap_) :: "memory"); CArgs& a = *ap_;
        int G = gridDim.x, bx = blockIdx.x; asm volatile("" : "+s"(G), "+s"(bx));
        if (ph == 0) p0_phase(a, lds);
        else if (ph == 1) row_phase(a, 0, true, nullptr, 0, 0.f, (bf16_t*)(a.ws + WS_U), 0, 0);
        else {
            const int l = (ph - 2) / 16, k = (ph - 2) % 16;
            unsigned char* ws = a.ws;
            const unsigned char* wb = ws + WS_W + (size_t)l * W_LAYER;
            bf16_t* U = (bf16_t*)(ws + WS_U); bf16_t* Yb = (bf16_t*)(ws + WS_Y); bf16_t* BIG = (bf16_t*)(ws + WS_BIG);
            if (k == 5) prep_phase(a, l, lds);
#ifndef X_ATTN
            else if (k == 6) attn_phase(a, l, lds);
#endif
            else if (k == 2) row_phase(a, l, l == 0, Yb, 0, 0.5f, U, 1, l);
            else if (k == 12) row_phase(a, l, false, BIG, 1, 1.0f, U, 2, l);
            else if (k == 15) row_phase(a, l, false, Yb, 2, 0.5f, l == 0 ? U : nullptr, 0, l + 1);
            else {
                pg8::Gemm g; pg8::Epi E; int N; int dual = 0; int Mrows = R;
                g.A2 = nullptr; g.Bt2 = nullptr; E.scr = nullptr;
                if (k == 0 || k == 13) { const int s = k == 13; g.A = U; g.Bt = (const bf16_t*)(wb + W_GU + s * W_GU_SZ); g.lda = 1024; g.ldb = 1024; g.K = 1024; N = 5632; E.mode = 1; E.O = BIG; E.ldc = DFF; }
                else if (k == 1 || k == 14) { const int s = k == 14; g.A = BIG; g.Bt = (const bf16_t*)(wb + W_D + s * W_D_SZ); g.lda = DFF; g.ldb = DFF; g.K = DFF; N = 1024; E.mode = 0; E.O = Yb; E.ldc = 1024; }
                else if (k == 3) { g.A = U; g.Bt = (const bf16_t*)(wb + W_IN); g.lda = 1024; g.ldb = 1024; g.K = 1024; N = NHIN; E.mode = 0; E.O = BIG; E.ldc = NHIN; }
                else if (k == 4) { g.A = BIG + 512; g.Bt = (const bf16_t*)(wb + W_MLA); g.lda = NHIN; g.ldb = 384; g.K = 384; N = 1024; E.mode = 0; E.O = Yb; E.ldc = 1024; }
                else if (k == 7 || k == 9) { const size_t ro = (size_t)(k == 9) * 32768 * 1024; Mrows = (k == 9) ? R - 32768 : 32768;
                    g.A = U + ro; g.Bt = (const bf16_t*)(wb + W_G); g.lda = 1024; g.ldb = 1024; g.K = 1024; N = 4096; E.mode = 3; E.O = BIG; E.ldc = 4096; }
                else if (k == 8 || k == 10) { const size_t ro = (size_t)(k == 10) * 32768 * 1024; Mrows = (k == 10) ? R - 32768 : 32768;
                    g.A = (const bf16_t*)(ws + WS_OUTS) + ro; g.Bt = (const bf16_t*)(wb + W_BR); g.lda = 1024; g.ldb = 1024; g.K = 1024; N = 1024; E.mode = 4; E.O = Yb + ro; E.ldc = 1024; E.scr = (u32x4*)BIG; }
                else { g.A = Yb; g.Bt = (const bf16_t*)(wb + W_OUT); g.lda = 1024; g.ldb = 1024; g.K = 1024; N = 1024; E.mode = 0; E.O = BIG; E.ldc = 1024; }
                pg8::StaticOrder S; S.init(Mrows, N, G, bx, dual);
                if (k == 8 || k == 10) pg8::gemm_phase<true>(lds, g, S, E); else pg8::gemm_phase<false>(lds, g, S, E);
            }
        }
        if (ph + 1 < hi) {
            if (ph == lo) {
                asm volatile("s_waitcnt vmcnt(0) lgkmcnt(0)" ::: "memory");
                __syncthreads();
                if (ptid() < 64) { __builtin_amdgcn_fence(__ATOMIC_RELEASE, "agent"); asm volatile("s_waitcnt vmcnt(0)" ::: "memory"); }
                grid.sync();
                __builtin_amdgcn_fence(__ATOMIC_ACQUIRE, "agent");
                asm volatile("s_waitcnt vmcnt(0)" ::: "memory");
            } else {
                XcdBarrier bar; bar.bar = (unsigned*)(a.ws + WS_BAR); bar.x = xb_xcc_id(); bar.st = (volatile LAS unsigned*)(lds + LDS_BARST);
                xcd_barrier(bar);
                __builtin_amdgcn_fence(__ATOMIC_ACQUIRE, "agent");
                asm volatile("s_waitcnt vmcnt(0)" ::: "memory");
            }
        }
    }
}

extern "C" void kernel_launch(void* const* d_in, const int* in_sizes, int n_in, void* d_out, int out_size, void* d_ws, size_t ws_size, hipStream_t stream) {
    static int grid = 0;
    if (grid == 0) {
        int dev = 0, cus = 0;
        if (hipGetDevice(&dev) != hipSuccess || hipDeviceGetAttribute(&cus, hipDeviceAttributeMultiprocessorCount, dev) != hipSuccess) { grid = -1; return; }
        if (hipFuncSetAttribute((const void*)fwd_kernel, hipFuncAttributeMaxDynamicSharedMemorySize, LDS_BYTES) != hipSuccess) { fprintf(stderr, "hipFuncSetAttribute failed\n"); grid = -1; return; }
        int per_cu = 0;
        if (hipOccupancyMaxActiveBlocksPerMultiprocessor(&per_cu, (const void*)fwd_kernel, 512, LDS_BYTES) != hipSuccess || per_cu < 1) fprintf(stderr, "occupancy query: %d\n", per_cu);
        (void)hipGetLastError();
        grid = cus;
        if (ws_size < WS_END) { fprintf(stderr, "workspace too small\n"); grid = -1; return; }
    }
    if (grid < 0) return;
    if (hipMemsetAsync((char*)d_ws + WS_BAR, 0, 16384, stream) != hipSuccess) { fprintf(stderr, "memset failed\n"); return; }
    Args a{};
    const float** p = (const float**)&a;
    for (int i = 0; i < 23; ++i) p[i] = (const float*)d_in[i];
    a.out = (float*)d_out; a.ws = (unsigned char*)d_ws; a.ph_lo = 0; a.ph_hi = 1000;
    void* args[] = {&a};
    hipError_t e = hipLaunchCooperativeKernel((const void*)fwd_kernel, dim3(grid), dim3(512), args, LDS_BYTES, stream);
    if (e != hipSuccess) fprintf(stderr, "cooperative launch failed: %s\n", hipGetErrorString(e));
}
```

```cpp
#include <hip/hip_runtime.h>
#include <hip/hip_cooperative_groups.h>
#include <cstdio>
#include <cstdint>
namespace cg = cooperative_groups;

#define LAS __attribute__((address_space(3)))
typedef unsigned short bf16_t;
typedef short bf16x8 __attribute__((ext_vector_type(8)));
typedef short s16x4 __attribute__((ext_vector_type(4)));
typedef float f32x4 __attribute__((ext_vector_type(4)));
typedef float f32x16 __attribute__((ext_vector_type(16)));
typedef unsigned u32x4 __attribute__((ext_vector_type(4)));
typedef unsigned u32x2 __attribute__((ext_vector_type(2)));

constexpr int DM = 1024, NB = 8, SEQ = 8192, CTX = 256, RPB = SEQ + CTX, R = NB * RPB, DFF = 2816;
constexpr int NHIN = 2304, INCOLS = 6304, GATE0 = 2208;
constexpr int MODW = 9216;
constexpr float EPS = 1e-6f;
constexpr float LOG2E = 1.4426950408889634f;
constexpr float QS_GQA = 0.125f * LOG2E, QS_MLA = 0.10206207261596577f * LOG2E, QS_DIFF = 0.17677669529663687f * LOG2E;

constexpr size_t MiB = 1u << 20;
constexpr size_t WS_MOD = 0;
constexpr size_t WS_XC = 2 * MiB;
constexpr size_t WS_W = 10 * MiB;
constexpr size_t W_GU = 0, W_GU_SZ = (size_t)5632 * 1024 * 2;
constexpr size_t W_D = W_GU + 2 * W_GU_SZ, W_D_SZ = (size_t)1024 * 2816 * 2;
constexpr size_t W_IN = W_D + 2 * W_D_SZ, W_IN_SZ = (size_t)NHIN * 1024 * 2;
constexpr size_t W_G = W_IN + W_IN_SZ, W_G_SZ = (size_t)4096 * 1024 * 2;
constexpr size_t W_BR = W_G + W_G_SZ;
constexpr size_t W_OUT = W_BR + W_G_SZ, W_OUT_SZ = (size_t)1024 * 1024 * 2;
constexpr size_t W_MLA = W_OUT + W_OUT_SZ, W_MLA_SZ = (size_t)1024 * 384 * 2;
constexpr size_t W_LAYER = W_MLA + W_MLA_SZ;
static_assert(WS_W + 2 * W_LAYER <= 124 * MiB, "weights");
constexpr size_t ROWBUF = (size_t)R * 1024 * 2;
constexpr size_t WS_U = 124 * MiB;
constexpr size_t WS_Y = WS_U + ROWBUF;
constexpr size_t WS_BIG = WS_Y + ROWBUF;
constexpr size_t WS_OUTS = WS_BIG + (size_t)R * NHIN * 2;
constexpr size_t WS_VT = WS_OUTS + ROWBUF;
constexpr size_t WS_GSCR = WS_VT + (size_t)NB * 768 * RPB * 2;
constexpr size_t WS_END = WS_GSCR + 256 * 131072;
static_assert(WS_END <= 1024 * MiB, "ws");
static_assert(WS_BIG + (size_t)R * DFF * 2 <= WS_END, "H");

constexpr int LDS_BYTES = 147456;
constexpr size_t WS_BAR = 1 * MiB;
constexpr int LDS_BARST = 147456 - 64;

__device__ __forceinline__ unsigned f2bf(float f) { unsigned u = __builtin_bit_cast(unsigned, f); return (u + 0x7fffu + ((u >> 16) & 1u)) >> 16; }
__device__ __forceinline__ unsigned pk2(float lo, float hi) { return f2bf(lo) | (f2bf(hi) << 16); }
__device__ __forceinline__ float bf2f(unsigned short h) { return __builtin_bit_cast(float, (unsigned)h << 16); }
__device__ __forceinline__ float bflo(unsigned w) { return __builtin_bit_cast(float, w << 16); }
__device__ __forceinline__ float bfhi(unsigned w) { return __builtin_bit_cast(float, w & 0xffff0000u); }
__device__ __forceinline__ float wave_sum(float v) {
#pragma unroll
    for (int o = 1; o < 64; o <<= 1) v += __shfl_xor(v, o);
    return v;
}
__device__ __forceinline__ int ptid() { int t = threadIdx.x; asm volatile("" : "+v"(t)); return t; }
__device__ __forceinline__ float fexp2(float x) { return __builtin_amdgcn_exp2f(x); }
__device__ __forceinline__ float frcp(float x) { return __builtin_amdgcn_rcpf(x); }
__device__ __forceinline__ float sigmoidf_(float x) { return frcp(1.f + fexp2(-x * LOG2E)); }

namespace pg8 {
constexpr int BM = 256, BK = 64, HALF = 128, HTB = HALF * BK * 2, STAGE_BYTES = 8 * HTB, NXCD = 8, WGM = 8;
__device__ __forceinline__ int lds_byte(int r, int c) { const int st = (r >> 4) * 2 + (c >> 5), rr = r & 15, cc = c & 31, ob = rr * 64 + cc * 2; return st * 1024 + (ob ^ (((ob >> 9) & 1) << 5)); }
__device__ __forceinline__ void stage_rc(int b, int& Rr, int& C) { const int st = b / 1024, sb = b % 1024, swz = sb ^ (((sb >> 9) & 1) << 5); Rr = (st >> 1) * 16 + swz / 64; C = (st & 1) * 32 + (swz % 64) / 2; }
__device__ __forceinline__ int perm32(int rho) { const int n = rho >> 4, i = rho & 15; return 8 * (i >> 2) + 4 * n + (i & 3); }

struct Unit { int pm, pn, kind; };
struct Gemm { const bf16_t* A; const bf16_t* Bt; const bf16_t* A2; const bf16_t* Bt2; int lda, ldb, K; };

struct StaticOrder {
    int nM, nN, nwg, G, c, dual;
    __device__ void init(int M, int N, int G_, int c_, int dual_) { nM = M / BM; nN = N / BM; nwg = nM * nN; G = G_; c = c_; dual = dual_; }
    __device__ bool next(int i, Unit& u) const {
        const int ii = i;
        const long L = (long)ii * G + c; if (L >= nwg) return false;
        int wgid = (int)L; { const int q = nwg / NXCD, r = nwg % NXCD, xcd = wgid % NXCD, off = wgid / NXCD; wgid = (xcd < r ? xcd * (q + 1) : r * (q + 1) + (xcd - r) * q) + off; }
        const int nig = WGM * nN, gid = wgid / nig, fm = gid * WGM, gsz = (nM - fm) < WGM ? (nM - fm) : WGM;
        u.pm = fm + ((wgid % nig) % gsz); u.pn = (wgid % nig) / gsz;
        if (dual) u.pm = (u.pm >> 5) * 33 + 1 + (u.pm & 31);
        u.kind = 0; return true;
    }
};

typedef float f32x2_t __attribute__((ext_vector_type(2))); typedef __bf16 bf16x2_t __attribute__((ext_vector_type(2)));
__device__ __forceinline__ unsigned cvt_pk_bf16(float lo, float hi) { f32x2_t v = {lo, hi}; bf16x2_t b = __builtin_convertvector(v, bf16x2_t); return __builtin_bit_cast(unsigned, b); }

struct Epi {
    int mode; bf16_t* O; int ldc; u32x4* scr;
    __device__ __forceinline__ void operator()(const f32x4 (&acc)[2][2][4][2], const Unit& u, int wr, int wc, int fr, int fq) const {
        const int row0 = u.pm * BM + wr * 64 + fr;
        if (mode == 0) {
            const int col0 = u.pn * BM + wc * 32 + 8 * fq;
#pragma unroll
            for (int ai = 0; ai < 2; ++ai)
#pragma unroll
                for (int m = 0; m < 4; ++m) { bf16_t* rowp = O + (size_t)(row0 + ai * HALF + m * 16) * ldc + col0;
#pragma unroll
                    for (int bj = 0; bj < 2; ++bj) { const f32x4 v0 = acc[ai][bj][m][0], v1 = acc[ai][bj][m][1];
                        u32x4 w; w.x = cvt_pk_bf16(v0[0], v0[1]); w.y = cvt_pk_bf16(v0[2], v0[3]); w.z = cvt_pk_bf16(v1[0], v1[1]); w.w = cvt_pk_bf16(v1[2], v1[3]);
                        *(u32x4*)(rowp + bj * HALF) = w; } }
        } else if (mode == 1) {
            const int col0 = u.pn * HALF + wc * 32 + 8 * fq;
#pragma unroll
            for (int ai = 0; ai < 2; ++ai)
#pragma unroll
                for (int m = 0; m < 4; ++m) { bf16_t* rowp = O + (size_t)(row0 + ai * HALF + m * 16) * ldc + col0;
                    float h[8];
#pragma unroll
                    for (int n = 0; n < 2; ++n)
#pragma unroll
                        for (int e = 0; e < 4; ++e) { const float g = acc[ai][0][m][n][e], up = acc[ai][1][m][n][e]; h[n * 4 + e] = g * sigmoidf_(g) * up; }
                    u32x4 w; w.x = cvt_pk_bf16(h[0], h[1]); w.y = cvt_pk_bf16(h[2], h[3]); w.z = cvt_pk_bf16(h[4], h[5]); w.w = cvt_pk_bf16(h[6], h[7]);
                    *(u32x4*)rowp = w; }
        } else if (mode == 3) {
            const int col0 = u.pn * BM + wc * 32 + 8 * fq;
#pragma unroll
            for (int ai = 0; ai < 2; ++ai)
#pragma unroll
                for (int m = 0; m < 4; ++m) { bf16_t* rowp = O + (size_t)(row0 + ai * HALF + m * 16) * ldc + col0;
#pragma unroll
                    for (int bj = 0; bj < 2; ++bj) { const f32x4 v0 = acc[ai][bj][m][0], v1 = acc[ai][bj][m][1];
                        u32x4 w; w.x = cvt_pk_bf16(sigmoidf_(v0[0]), sigmoidf_(v0[1])); w.y = cvt_pk_bf16(sigmoidf_(v0[2]), sigmoidf_(v0[3]));
                        w.z = cvt_pk_bf16(sigmoidf_(v1[0]), sigmoidf_(v1[1])); w.w = cvt_pk_bf16(sigmoidf_(v1[2]), sigmoidf_(v1[3]));
                        *(u32x4*)(rowp + bj * HALF) = w; } }
        } else {
            const int col0 = u.pn * BM + wc * 32 + 8 * fq;
#pragma unroll
            for (int ai = 0; ai < 2; ++ai)
#pragma unroll
                for (int m = 0; m < 4; ++m) { const size_t r = (size_t)(row0 + ai * HALF + m * 16);
                    const bf16_t* gp = (const bf16_t*)scr + r * 4096 + 3 * 1024 + col0; bf16_t* rowp = O + r * ldc + col0;
#pragma unroll
                    for (int bj = 0; bj < 2; ++bj) { const u32x4 g = *(const u32x4*)(gp + bj * HALF); const f32x4 v0 = acc[ai][bj][m][0], v1 = acc[ai][bj][m][1];
                        u32x4 w; w.x = cvt_pk_bf16(v0[0] * gclamp(bflo(g.x)), v0[1] * gclamp(bfhi(g.x))); w.y = cvt_pk_bf16(v0[2] * gclamp(bflo(g.y)), v0[3] * gclamp(bfhi(g.y)));
                        w.z = cvt_pk_bf16(v1[0] * gclamp(bflo(g.z)), v1[1] * gclamp(bfhi(g.z))); w.w = cvt_pk_bf16(v1[2] * gclamp(bflo(g.w)), v1[3] * gclamp(bfhi(g.w)));
                        *(u32x4*)(rowp + bj * HALF) = w; } }
        }
    }
    static __device__ __forceinline__ float gclamp(float g) { return __builtin_fmaxf(g, 1e-6f); }
    __device__ __forceinline__ void rescale(f32x4 (&acc)[2][2][4][2], const Unit& u, int i, int wr, int wc, int fr, int fq) const {
        int row0 = u.pm * BM + wr * 64 + fr; const int col0 = u.pn * BM + wc * 32 + 8 * fq;
        asm volatile("" : "+v"(row0));
#pragma unroll
        for (int ai = 0; ai < 2; ++ai)
#pragma unroll
            for (int m = 0; m < 4; ++m) { const bf16_t* gp = (const bf16_t*)scr + (size_t)(row0 + ai * HALF + m * 16) * 4096 + i * 1024 + col0;
#pragma unroll
                for (int bj = 0; bj < 2; ++bj) { const u32x4 ga = *(const u32x4*)(gp + bj * HALF), gb = *(const u32x4*)(gp + 1024 + bj * HALF);
                    f32x4 r0, r1;
                    r0[0] = gclamp(bflo(ga.x)) * frcp(gclamp(bflo(gb.x))); r0[1] = gclamp(bfhi(ga.x)) * frcp(gclamp(bfhi(gb.x)));
                    r0[2] = gclamp(bflo(ga.y)) * frcp(gclamp(bflo(gb.y))); r0[3] = gclamp(bfhi(ga.y)) * frcp(gclamp(bfhi(gb.y)));
                    r1[0] = gclamp(bflo(ga.z)) * frcp(gclamp(bflo(gb.z))); r1[1] = gclamp(bfhi(ga.z)) * frcp(gclamp(bfhi(gb.z)));
                    r1[2] = gclamp(bflo(ga.w)) * frcp(gclamp(bflo(gb.w))); r1[3] = gclamp(bfhi(ga.w)) * frcp(gclamp(bfhi(gb.w)));
                    acc[ai][bj][m][0] = acc[ai][bj][m][0] * r0; acc[ai][bj][m][1] = acc[ai][bj][m][1] * r1; }
                if (m == 3) asm volatile("" ::: "memory"); }
    }
};

template <bool HOOK, class Sched>
__device__ __forceinline__ void gemm_phase(LAS unsigned char* lds, const Gemm g, const Sched& S, const Epi& E) {
    const int tid = ptid(), wid = __builtin_amdgcn_readfirstlane(tid >> 6), lane = tid & 63, wr = wid >> 2, wc = wid & 3, fr = lane & 15, fq = lane >> 4;
    const int K = g.K, nt = K / BK;
    unsigned voffA[2], voffB[2];
#pragma unroll
    for (int i = 0; i < 2; ++i) { int Rr, C; stage_rc(tid * 16 + i * 8192, Rr, C); const int Rb = (Rr & ~31) + perm32(Rr & 31);
        voffA[i] = (unsigned)(Rr * g.lda + C) * 2u; voffB[i] = (unsigned)(Rb * g.ldb + C) * 2u; }
    const size_t kstep = (size_t)(BK * 2);
    const size_t hsA = (size_t)HALF * g.lda * 2, hsB = (size_t)HALF * g.ldb * 2;
    const size_t tsA = 2 * hsA, tsB = 2 * hsB;
    const unsigned ldsw = (unsigned)wid * 1024u;
    const int aoff = lds_byte(wr * 64 + fr, fq * 8), boff = lds_byte(wc * 32 + fr, fq * 8);
#define PG8_SA(b, h) (((b) * 2 + (h)) * HTB)
#define PG8_SB(b, h) ((4 + (b) * 2 + (h)) * HTB)
#define PG8_STAGE(bufoff, gbase, voff) do { _Pragma("unroll") for (int _i = 0; _i < 2; ++_i) \
        __builtin_amdgcn_global_load_lds((const unsigned*)((const char*)(gbase) + (voff)[_i]), (LAS unsigned*)(lds + (bufoff) + ldsw + _i * 8192), 16, 0, 0); } while (0)
#define PG8_LDA(dst, b, h) do { _Pragma("unroll") for (int m = 0; m < 4; ++m) _Pragma("unroll") for (int k = 0; k < 2; ++k) dst[m][k] = *(const LAS bf16x8*)(lds + PG8_SA(b, h) + aoff + m * 2048 + k * 1024); } while (0)
#define PG8_LDB(dst, b, h) do { _Pragma("unroll") for (int n = 0; n < 2; ++n) _Pragma("unroll") for (int k = 0; k < 2; ++k) dst[n][k] = *(const LAS bf16x8*)(lds + PG8_SB(b, h) + boff + n * 2048 + k * 1024); } while (0)
#define PG8_MMA(ai, bj, At, Bt) do { __builtin_amdgcn_s_setprio(1); _Pragma("unroll") for (int m = 0; m < 4; ++m) _Pragma("unroll") for (int n = 0; n < 2; ++n) _Pragma("unroll") for (int k = 0; k < 2; ++k) \
        acc[ai][bj][m][n] = __builtin_amdgcn_mfma_f32_16x16x32_bf16(Bt[n][k], At[m][k], acc[ai][bj][m][n], 0, 0, 0); __builtin_amdgcn_s_setprio(0); } while (0)
#define PG8_MMA1(ai, bj, nn, At, Bt) do { __builtin_amdgcn_s_setprio(1); _Pragma("unroll") for (int m = 0; m < 4; ++m) _Pragma("unroll") for (int k = 0; k < 2; ++k) \
        acc[ai][bj][m][nn] = __builtin_amdgcn_mfma_f32_16x16x32_bf16(Bt[nn][k], At[m][k], acc[ai][bj][m][nn], 0, 0, 0); __builtin_amdgcn_s_setprio(0); } while (0)
#define PG8_MMAZ(ai, At) do { if (zbr == 0) PG8_MMA1(ai, 0, 0, At, B0); else if (zbr == 1) PG8_MMA1(ai, 0, 1, At, B0); else if (zbr == 2) PG8_MMA1(ai, 1, 0, At, B1); else PG8_MMA1(ai, 1, 1, At, B1); } while (0)
#define PG8_MM2(ai, At) do { PG8_MMA(ai, 0, At, B0); PG8_MMA(ai, 1, At, B1); } while (0)
#define PG8_WAIT_V(n) asm volatile("s_waitcnt vmcnt(" #n ")" ::: "memory")
#define PG8_WAIT_L(n) asm volatile("s_waitcnt lgkmcnt(" #n ")" ::: "memory")
#define PG8_BAR __builtin_amdgcn_s_barrier()
#define PG8_SCHED __builtin_amdgcn_sched_barrier(0)
#define PG8_UA(u) ((const char*)((u).kind ? g.A2 : g.A) + (size_t)(u).pm * tsA)
#define PG8_UB(u) ((const char*)((u).kind ? g.Bt2 : g.Bt) + (size_t)(u).pn * tsB)
    Unit cur, nxt; int ui = 0;
    if (!S.next(0, cur)) return;
    f32x4 acc[2][2][4][2];
#pragma unroll
    for (int a = 0; a < 2; ++a)
#pragma unroll
        for (int b = 0; b < 2; ++b)
#pragma unroll
            for (int m = 0; m < 4; ++m)
#pragma unroll
                for (int n = 0; n < 2; ++n) acc[a][b][m][n] = (f32x4){0.f, 0.f, 0.f, 0.f};
    bf16x8 At[4][2], B0[2][2], B1[2][2];
    const char* cA = PG8_UA(cur); const char* cB = PG8_UB(cur);
    {
        PG8_STAGE(PG8_SB(0, 0), cB, voffB); PG8_STAGE(PG8_SB(0, 1), cB + hsB, voffB); PG8_STAGE(PG8_SA(0, 0), cA, voffA); PG8_STAGE(PG8_SA(0, 1), cA + hsA, voffA);
        if (wr == 1) PG8_BAR;
        PG8_WAIT_V(2); PG8_BAR;
        PG8_STAGE(PG8_SB(1, 0), cB + kstep, voffB); PG8_STAGE(PG8_SA(1, 0), cA + kstep, voffA); PG8_STAGE(PG8_SB(1, 1), cB + hsB + kstep, voffB);
        PG8_WAIT_V(6); PG8_BAR;
    }
    for (;;) {
        const bool has_next = S.next(ui + 1, nxt);
        const char* nA = has_next ? PG8_UA(nxt) : cA; const char* nB = has_next ? PG8_UB(nxt) : cB;
        for (int t = 0; t < nt; t += 2) {
            const bool last = (t == nt - 2);
            if constexpr (HOOK) { if (t == 4 || t == 8 || t == 12) { PG8_SCHED; E.rescale(acc, cur, (t >> 2) - 1, wr, wc, fr, fq); PG8_SCHED; } }
            const char* a1 = cA + (size_t)(t + 1) * kstep;
            const char* a2 = last ? nA : cA + (size_t)(t + 2) * kstep; const char* b2 = last ? nB : cB + (size_t)(t + 2) * kstep;
            const char* a3 = a2 + kstep; const char* b3 = b2 + kstep;
            PG8_LDB(B0, 0, 0); PG8_LDB(B1, 0, 1); PG8_SCHED; PG8_LDA(At, 0, 0); PG8_STAGE(PG8_SA(1, 1), a1 + hsA, voffA);
            PG8_WAIT_V(8); PG8_WAIT_L(0); PG8_BAR; PG8_MM2(0, At); PG8_BAR; PG8_SCHED;
            PG8_LDA(At, 0, 1); PG8_STAGE(PG8_SB(0, 0), b2, voffB); PG8_STAGE(PG8_SB(0, 1), b2 + hsB, voffB); PG8_STAGE(PG8_SA(0, 0), a2, voffA);
            PG8_WAIT_V(8); PG8_WAIT_L(0); PG8_BAR; PG8_MM2(1, At); PG8_BAR; PG8_SCHED;
            PG8_LDB(B0, 1, 0); PG8_LDB(B1, 1, 1); PG8_SCHED; PG8_LDA(At, 1, 0); PG8_STAGE(PG8_SA(0, 1), a2 + hsA, voffA);
            PG8_WAIT_V(8); PG8_WAIT_L(0); PG8_BAR; PG8_MM2(0, At); PG8_BAR; PG8_SCHED;
            PG8_LDA(At, 1, 1); PG8_STAGE(PG8_SB(1, 0), b3, voffB); PG8_STAGE(PG8_SB(1, 1), b3 + hsB, voffB); PG8_STAGE(PG8_SA(1, 0), a3, voffA);
            PG8_WAIT_V(8); PG8_WAIT_L(0); PG8_BAR; PG8_MM2(1, At); PG8_BAR; PG8_SCHED;
        }
        if (wr == 0) PG8_BAR;
        E(acc, cur, wr, wc, fr, fq);
        if (!has_next) break;
#pragma unroll
        for (int a = 0; a < 2; ++a)
#pragma unroll
            for (int b = 0; b < 2; ++b)
#pragma unroll
                for (int m = 0; m < 4; ++m)
#pragma unroll
                    for (int n = 0; n < 2; ++n) acc[a][b][m][n] = (f32x4){0.f, 0.f, 0.f, 0.f};
        cur = nxt; cA = nA; cB = nB; ++ui;
        if (wr == 1) PG8_BAR;
    }
    PG8_WAIT_V(0);
    PG8_BAR;
#undef PG8_SA
#undef PG8_SB
#undef PG8_STAGE
#undef PG8_LDA
#undef PG8_LDB
#undef PG8_MMA
#undef PG8_MMA1
#undef PG8_MMAZ
#undef PG8_MM2
#undef PG8_WAIT_V
#undef PG8_WAIT_L
#undef PG8_BAR
#undef PG8_SCHED
#undef PG8_UA
#undef PG8_UB
}
}

struct Args {
    const float* x; const float* c; const float* ctx; const float* c_ctx; const float* w_mod; const float* b_mod; const float* g_pre; const float* g_post;
    const float* w_gate; const float* w_up; const float* w_down; const float* w_in; const float* gqa_qn; const float* gqa_kn; const float* mla_qn; const float* mla_kvn;
    const float* w_uq; const float* w_ukv; const float* dlam; const float* dsub; const float* sink; const float* w_branch; const float* w_out;
    float* out; unsigned char* ws; int ph_lo, ph_hi;
};
typedef const __attribute__((address_space(4))) Args CArgs;

template <class F>
__device__ __forceinline__ void conv_item(bf16_t* WT, int K, int nblk, int item, LAS float* scr, int lane, const F& f) {
    const int kb = item / nblk, nb = item % nblk, k0 = 64 * kb, n0 = 32 * nb;
#pragma unroll 8
    for (int i = 0; i < 32; ++i) { const int kk = 2 * i + (lane >> 5); scr[kk * 33 + (lane & 31)] = f(n0 + (lane & 31), k0 + kk); }
    asm volatile("s_waitcnt lgkmcnt(0)" ::: "memory");
    const int c = lane & 7;
#pragma unroll
    for (int j = 0; j < 4; ++j) { const int n = (lane >> 3) + 8 * j; const LAS float* s = scr + (8 * c) * 33 + n;
        u32x4 o; o.x = pk2(s[0 * 33], s[1 * 33]); o.y = pk2(s[2 * 33], s[3 * 33]); o.z = pk2(s[4 * 33], s[5 * 33]); o.w = pk2(s[6 * 33], s[7 * 33]);
        *(u32x4*)(WT + (size_t)(n0 + n) * K + k0 + 8 * c) = o; }
    asm volatile("s_waitcnt lgkmcnt(0)" ::: "memory");
}

__device__ __forceinline__ void p0_phase(CArgs& a, LAS unsigned char* lds) {
    const int tid = ptid(), lane = tid & 63, wave = tid >> 6;
    float* MOD = (float*)(a.ws + WS_MOD);
    {
        LAS float* sl = (LAS float*)lds;
        LAS float* red = (LAS float*)(lds + 40960);
        for (int i = tid; i < 9 * 1024; i += 512) { const int r = i >> 10, k = i & 1023; const float v = r < 8 ? a.c[r * 1024 + k] : a.c_ctx[k]; sl[i] = v * sigmoidf_(v); }
        __syncthreads();
        for (int it = blockIdx.x; it < 2 * 144; it += gridDim.x) {
            const int l = it / 144, n0 = (it % 144) * 64;
            const float* W = a.w_mod + (size_t)l * 1024 * MODW + n0 + lane;
            float acc[9];
#pragma unroll
            for (int r = 0; r < 9; ++r) acc[r] = 0.f;
#pragma unroll 8
            for (int kk = 0; kk < 128; ++kk) { const int k = wave * 128 + kk; const float wv = W[(size_t)k * MODW];
#pragma unroll
                for (int r = 0; r < 9; ++r) acc[r] += sl[r * 1024 + k] * wv; }
#pragma unroll
            for (int r = 0; r < 9; ++r) red[(wave * 9 + r) * 64 + lane] = acc[r];
            __syncthreads();
            for (int i = tid; i < 9 * 64; i += 512) { const int r = i >> 6, cidx = i & 63; float s = a.b_mod[l * MODW + n0 + cidx];
#pragma unroll
                for (int w = 0; w < 8; ++w) s += red[(w * 9 + r) * 64 + cidx];
                MOD[((size_t)l * 9 + r) * MODW + n0 + cidx] = s; }
            __syncthreads();
        }
        __syncthreads();
    }
    LAS float* scr = (LAS float*)(lds + wave * 8448);
    const int gw = blockIdx.x * 8 + wave, NGW = gridDim.x * 8;
    constexpr int I_GU = 176 * 16, I_D = 32 * 44, I_IN = 72 * 16, I_G = 128 * 16, I_BR = 32 * 16, I_OUT = 32 * 16, I_MLA = 32 * 6;
    constexpr int I_LAYER = 2 * I_GU + 2 * I_D + I_IN + I_G + I_BR + I_OUT + I_MLA;
    for (int it = gw; it < 2 * I_LAYER; it += NGW) {
        const int l = it / I_LAYER; int r = it % I_LAYER;
        unsigned char* wb = a.ws + WS_W + (size_t)l * W_LAYER;
        if (r < 2 * I_GU) { const int s = r / I_GU; r %= I_GU;
            const float* wg = a.w_gate + (size_t)(l * 2 + s) * 1024 * DFF; const float* wu = a.w_up + (size_t)(l * 2 + s) * 1024 * DFF;
            conv_item((bf16_t*)(wb + W_GU + s * W_GU_SZ), 1024, 176, r, scr, lane, [=](int n, int k) { const int j = (n >> 8) * 128 + (n & 127); return ((n >> 7) & 1) ? wu[(size_t)k * DFF + j] : wg[(size_t)k * DFF + j]; });
            continue; }
        r -= 2 * I_GU;
        if (r < 2 * I_D) { const int s = r / I_D; r %= I_D;
            const float* wd = a.w_down + (size_t)(l * 2 + s) * DFF * 1024;
            conv_item((bf16_t*)(wb + W_D + s * W_D_SZ), DFF, 32, r, scr, lane, [=](int n, int k) { return wd[(size_t)k * 1024 + n]; });
            continue; }
        r -= 2 * I_D;
        const float* win = a.w_in + (size_t)l * 1024 * INCOLS;
        if (r < I_IN) { conv_item((bf16_t*)(wb + W_IN), 1024, 72, r, scr, lane, [=](int n, int k) { return n < GATE0 ? win[(size_t)k * INCOLS + n] : 0.f; }); continue; }
        r -= I_IN;
        if (r < I_G) { conv_item((bf16_t*)(wb + W_G), 1024, 128, r, scr, lane, [=](int n, int k) { return win[(size_t)k * INCOLS + GATE0 + n]; }); continue; }
        r -= I_G;
        if (r < I_BR) { const float* wbr = a.w_branch + (size_t)l * 4 * 256 * 1024;
            conv_item((bf16_t*)(wb + W_BR), 1024, 32, r, scr, lane, [=](int n, int k) { return wbr[(size_t)k * 1024 + n]; }); continue; }
        r -= I_BR;
        if (r < I_OUT) { const float* wo = a.w_out + (size_t)l * 1024 * 1024;
            conv_item((bf16_t*)(wb + W_OUT), 1024, 32, r, scr, lane, [=](int n, int k) { return wo[(size_t)k * 1024 + n]; }); continue; }
        r -= I_OUT;
        { const float* uq = a.w_uq + (size_t)l * 256 * 384; const float* ukv = a.w_ukv + (size_t)l * 128 * 512; const float* gq = a.mla_qn + l * 256; const float* gkv = a.mla_kvn + l * 128;
            conv_item((bf16_t*)(wb + W_MLA), 384, 32, r, scr, lane, [=](int n, int k) {
                float v = 0.f;
                if (n < 384) { if (k < 256) v = gq[k] * uq[(size_t)k * 384 + n]; }
                else if (n < 896) { if (k >= 256) v = gkv[k - 256] * ukv[(size_t)(k - 256) * 512 + (n - 384)]; }
                return v; }); }
    }
}

__device__ __forceinline__ void row_phase(CArgs& a, int l, bool first, const bf16_t* Y, int sub_y, float gscale, bf16_t* U, int sub_u, int l_u) {
    const int tid_ = ptid(); const int lane = tid_ & 63, wave = tid_ >> 6;
    const int gw = blockIdx.x * 8 + wave, NGW = gridDim.x * 8;
    const float* MOD = (const float*)(a.ws + WS_MOD);
    float* XC = (float*)(a.ws + WS_XC);
#pragma unroll 2
    for (int row = gw; row < R; row += NGW) {
        const int b = row / RPB, t = row % RPB; const bool isctx = t < CTX;
        const float* xs; float* xd;
        if (isctx) { const size_t o = (size_t)(b * CTX + t) * DM; xs = (first ? a.ctx : XC) + o; xd = XC + o; }
        else { const size_t o = (size_t)(b * SEQ + (t - CTX)) * DM; xs = (first ? a.x : a.out) + o; xd = a.out + o; }
        const int mrow = isctx ? 8 : b;
        f32x4 v[4];
#pragma unroll
        for (int j = 0; j < 4; ++j) v[j] = *(const f32x4*)(xs + 4 * lane + 256 * j);
        if (Y) {
            const float* md = MOD + ((size_t)l * 9 + mrow) * MODW + (sub_y * 3 + 2) * 1024;
            const float* gp = a.g_post + (l * 3 + sub_y) * 1024;
            f32x4 y[4]; float ss = 0.f;
#pragma unroll
            for (int j = 0; j < 4; ++j) { const u32x2 w = *(const u32x2*)(Y + (size_t)row * DM + 4 * lane + 256 * j);
                y[j] = (f32x4){bflo(w.x), bfhi(w.x), bflo(w.y), bfhi(w.y)}; ss += (y[j].x * y[j].x + y[j].y * y[j].y) + (y[j].z * y[j].z + y[j].w * y[j].w); }
            const float rs = __builtin_amdgcn_rsqf(wave_sum(ss) * (1.f / DM) + EPS) * gscale;
#pragma unroll
            for (int j = 0; j < 4; ++j) { const f32x4 g = *(const f32x4*)(md + 4 * lane + 256 * j), p = *(const f32x4*)(gp + 4 * lane + 256 * j);
                v[j] = v[j] + (y[j] * rs) * p * g; *(f32x4*)(xd + 4 * lane + 256 * j) = v[j]; }
        }
        if (U) {
            const float* md = MOD + ((size_t)l_u * 9 + mrow) * MODW + (sub_u * 3) * 1024;
            const float* gp = a.g_pre + (l_u * 3 + sub_u) * 1024;
            float ss = 0.f;
#pragma unroll
            for (int j = 0; j < 4; ++j) ss += (v[j].x * v[j].x + v[j].y * v[j].y) + (v[j].z * v[j].z + v[j].w * v[j].w);
            const float rs = __builtin_amdgcn_rsqf(wave_sum(ss) * (1.f / DM) + EPS);
#pragma unroll
            for (int j = 0; j < 4; ++j) { const f32x4 sh = *(const f32x4*)(md + 4 * lane + 256 * j), sc = *(const f32x4*)(md + 1024 + 4 * lane + 256 * j), p = *(const f32x4*)(gp + 4 * lane + 256 * j);
                const f32x4 u = (v[j] * rs) * p * (sc + 1.f) + sh;
                u32x2 w; w.x = pk2(u.x, u.y); w.y = pk2(u.z, u.w);
                *(u32x2*)(U + (size_t)row * DM + 4 * lane + 256 * j) = w; }
        }
    }
}

constexpr int VSTR = 136;
constexpr int TAB_OFF = 768 * VSTR;
__device__ __forceinline__ void rope64p(float& v0, float& v1, int l, bool lat, const LAS float* tab, int prow, int pcol) {
    const float p0 = __shfl_xor(v0, 8), p1 = __shfl_xor(v1, 8);
    const int lh = l & 31, pos = (lh & 16) ? pcol : prow, i0 = (2 * lh) & 15;
    const f32x4 cs = *(const LAS f32x4*)(tab + (pos * 16 + i0) * 2);
    const bool sec = (lh >> 3) & 1;
    const float c0 = lat ? cs[0] : 1.f, s0 = lat ? (sec ? cs[1] : -cs[1]) : 0.f, c1 = lat ? cs[2] : 1.f, s1 = lat ? (sec ? cs[3] : -cs[3]) : 0.f;
    v0 = v0 * c0 + p0 * s0; v1 = v1 * c1 + p1 * s1;
}
__device__ __forceinline__ void rope32p(float& v0, float& v1, int d0, bool lat, const LAS float* tab, int prow, int pcol) {
    const float p0 = __shfl_xor(v0, 4), p1 = __shfl_xor(v1, 4);
    const int pos = (d0 & 16) ? pcol : prow, i0 = d0 & 7;
    const LAS float* t = tab + (pos * 16 + 2 * i0) * 2;
    const bool sec = (d0 >> 3) & 1;
    const float c0 = lat ? t[0] : 1.f, s0 = lat ? (sec ? t[1] : -t[1]) : 0.f, c1 = lat ? t[4] : 1.f, s1 = lat ? (sec ? t[5] : -t[5]) : 0.f;
    v0 = v0 * c0 + p0 * s0; v1 = v1 * c1 + p1 * s1;
}
__device__ __forceinline__ float half_sum(float v) {
#pragma unroll
    for (int o = 1; o < 32; o <<= 1) v += __shfl_xor(v, o);
    return v;
}
__device__ __forceinline__ void prep_phase(CArgs& a, int l, LAS unsigned char* lds) {
    const int tid = ptid(), lane = tid & 63, wave = __builtin_amdgcn_readfirstlane(tid >> 6);
    bf16_t* HIN = (bf16_t*)(a.ws + WS_BIG); bf16_t* MUP = (bf16_t*)(a.ws + WS_Y); bf16_t* VT = (bf16_t*)(a.ws + WS_VT);
    LAS float* tab = (LAS float*)(lds + TAB_OFF);
    for (int i = tid; i < 128 * 16; i += 512) { const int pos = i >> 4, f = i & 15;
        const float invf = fexp2(-(float)(2 * f) * (1.f / 32.f) * 13.287712379549449f);
        float rev = (float)pos * invf * 0.15915494309189535f; rev -= __builtin_floorf(rev);
        tab[i * 2] = __builtin_amdgcn_cosf(rev); tab[i * 2 + 1] = __builtin_amdgcn_sinf(rev); }
    __syncthreads();
    const int lh = lane & 31;
    const float gq0 = a.gqa_qn[l * 64 + 2 * lh], gq1 = a.gqa_qn[l * 64 + 2 * lh + 1], gk0 = a.gqa_kn[l * 64 + 2 * lh], gk1 = a.gqa_kn[l * 64 + 2 * lh + 1];
#define LD2(p, v0, v1) do { const unsigned w_ = *(const unsigned*)(p); v0 = bflo(w_); v1 = bfhi(w_); } while (0)
#define ST2(p, v0, v1) do { *(unsigned*)(p) = pg8::cvt_pk_bf16(v0, v1); } while (0)
    for (int tile = blockIdx.x; tile < R / 64; tile += gridDim.x) {
        const int row0 = tile * 64, b = row0 / RPB, t0 = row0 % RPB;
#pragma unroll 4
        for (int rr = 0; rr < 8; ++rr) {
            const int tk = wave * 8 + rr, row = row0 + tk, t = t0 + tk; const bool lat = t >= CTX;
            const int tl = lat ? t - CTX : 0, prow = tl >> 6, pcol = tl & 63;
            bf16_t* __restrict__ h = HIN + (size_t)row * NHIN; bf16_t* __restrict__ mu = MUP + (size_t)row * 1024;
            LAS bf16_t* vst = (LAS bf16_t*)lds + tk;
#pragma unroll
            for (int j = 0; j < 3; ++j) { float v0, v1; LD2(h + 128 * j + 2 * lane, v0, v1);
                const float rs = __builtin_amdgcn_rsqf(half_sum(v0 * v0 + v1 * v1) * (1.f / 64.f) + EPS);
                v0 = v0 * rs * (j < 2 ? gq0 : gk0); v1 = v1 * rs * (j < 2 ? gq1 : gk1);
                rope64p(v0, v1, lane, lat, tab, prow, pcol);
                if (j < 2) { v0 *= QS_GQA; v1 *= QS_GQA; }
                ST2(h + 128 * j + 2 * lane, v0, v1); }
            { const unsigned w = *(const unsigned*)(h + 384 + 2 * lane); vst[(0 + 2 * lane) * (VSTR / 2)] = (bf16_t)(w & 0xffffu); vst[(0 + 2 * lane + 1) * (VSTR / 2)] = (bf16_t)(w >> 16); }
            float sq = 0.f, skv = 0.f;
#pragma unroll
            for (int j = 0; j < 2; ++j) { float v0, v1; LD2(h + 512 + 128 * j + 2 * lane, v0, v1); sq += v0 * v0 + v1 * v1; }
            { float v0, v1; LD2(h + 768 + 2 * lane, v0, v1); skv = v0 * v0 + v1 * v1; }
            const float rq = __builtin_amdgcn_rsqf(wave_sum(sq) * (1.f / 256.f) + EPS) * QS_MLA, rkv = __builtin_amdgcn_rsqf(wave_sum(skv) * (1.f / 128.f) + EPS);
#pragma unroll
            for (int j = 0; j < 3; ++j) { const int c = 128 * j + 2 * lane, e = c % 96; float v0, v1; LD2(mu + c, v0, v1); v0 *= rq; v1 *= rq;
                float r0 = v0, r1 = v1; rope32p(r0, r1, (e - 64) & 30, lat, tab, prow, pcol);
                if (e >= 64) { v0 = r0; v1 = r1; }
                ST2(mu + c, v0, v1); }
#pragma unroll
            for (int hh = 0; hh < 4; ++hh) { const int c = 384 + 128 * hh + 2 * lane; float v0, v1; LD2(mu + c, v0, v1); v0 *= rkv; v1 *= rkv;
                const unsigned w = pg8::cvt_pk_bf16(v0, v1);
                if (lane < 32) *(unsigned*)(mu + c) = w;
                else { vst[(128 + 64 * hh + 2 * (lane - 32)) * (VSTR / 2)] = (bf16_t)(w & 0xffffu); vst[(128 + 64 * hh + 2 * (lane - 32) + 1) * (VSTR / 2)] = (bf16_t)(w >> 16); } }
            { float v0, v1; LD2(h + 896 + 2 * (lane & 15), v0, v1); rope32p(v0, v1, 2 * (lane & 15), lat, tab, prow, pcol); if (lane < 16) ST2(mu + 896 + 2 * lane, v0, v1); }
#pragma unroll
            for (int j = 0; j < 4; ++j) { float v0, v1; LD2(h + 928 + 128 * j + 2 * lane, v0, v1); rope32p(v0, v1, (2 * lane) & 31, lat, tab, prow, pcol);
                if (j < 2) { v0 *= QS_DIFF; v1 *= QS_DIFF; }
                ST2(h + 928 + 128 * j + 2 * lane, v0, v1); }
#pragma unroll
            for (int j = 0; j < 2; ++j) { const unsigned w = *(const unsigned*)(h + 1440 + 128 * j + 2 * lane); vst[(384 + 128 * j + 2 * lane) * (VSTR / 2)] = (bf16_t)(w & 0xffffu); vst[(384 + 128 * j + 2 * lane + 1) * (VSTR / 2)] = (bf16_t)(w >> 16); }
#pragma unroll
            for (int j = 0; j < 3; ++j) { float v0, v1; LD2(h + 1696 + 128 * j + 2 * lane, v0, v1); rope64p(v0, v1, lane, lat, tab, prow, pcol);
                if (j < 2) { v0 *= QS_GQA; v1 *= QS_GQA; }
                ST2(h + 1696 + 128 * j + 2 * lane, v0, v1); }
            { const unsigned w = *(const unsigned*)(h + 2080 + 2 * lane); vst[(640 + 2 * lane) * (VSTR / 2)] = (bf16_t)(w & 0xffffu); vst[(640 + 2 * lane + 1) * (VSTR / 2)] = (bf16_t)(w >> 16); }
        }
#undef LD2
#undef ST2
        __syncthreads();
        bf16_t* vt = VT + (size_t)b * 768 * RPB + t0;
        for (int p = tid; p < 768 * 8; p += 512) { const int vr = p >> 3, seg = p & 7;
            const LAS u32x2* s = (const LAS u32x2*)(lds + vr * VSTR + seg * 16); const u32x2 lo = s[0], hi = s[1];
            *(u32x4*)(vt + (size_t)vr * RPB + seg * 8) = (u32x4){lo.x, lo.y, hi.x, hi.y}; }
        __syncthreads();
    }
}

__device__ __forceinline__ int crow(int r, int hi) { return (r & 3) + 8 * (r >> 2) + 4 * hi; }
constexpr int AT_KBUF = 128 * (96 * 2 + 16);
constexpr int AT_VSTR = 272, AT_VBUF = 64 * AT_VSTR;
constexpr int AT_K0 = 0, AT_V0 = 2 * AT_KBUF, AT_WS = AT_V0 + 2 * AT_VBUF;

struct AttnSrc { const bf16_t* Q; int ldq; const bf16_t* K1; int ldk1; const bf16_t* K2; int ldk2; const bf16_t* VT; };

template <int DQK, bool WIN>
__device__ __forceinline__ void attn_pass(const AttnSrc& s, int NT, int lo, int q0lat, float sink_l2, bool has_sink, LAS unsigned char* lds, f32x16 (&o)[2]) {
    constexpr int KSTR = DQK * 2 + 16, NCH = DQK / 8, NKS = DQK / 16, NP = (128 * NCH) / 512;
    const int tid = ptid(), lane = tid & 63, r32 = lane & 31, hi = lane >> 5; const int wid = __builtin_amdgcn_readfirstlane(tid >> 6);
    LAS float* wsf = (LAS float*)(lds + AT_WS) + wid * 32;
    bf16x8 qf[NKS];
    { const bf16_t* qp = s.Q + (size_t)(wid * 32 + r32) * s.ldq + 8 * hi;
#pragma unroll
        for (int ks = 0; ks < NKS; ++ks) qf[ks] = *(const bf16x8*)(qp + 16 * ks); }
    o[0] = (f32x16){}; o[1] = (f32x16){};
    f32x16 negm = (f32x16){}; asm volatile("" : "+v"(negm));
    float mhat = 0.f, lsum = 0.f;
    const int NT2 = NT >> 1, lo2 = lo >> 1;
    u32x4 kr[NP], vr[2];
    auto kaddr = [&](int key, int c) -> const bf16_t* { return (DQK == 96 && c >= 8) ? s.K2 + (size_t)key * s.ldk2 + (c - 8) * 8 : s.K1 + (size_t)key * s.ldk1 + c * 8; };
#define AT_TILE(j) ((j) < 2 ? (j) : lo2 - 2 + (j))
#define AT_GLOAD(j) do { const int key0_ = AT_TILE(j) * 128; \
        _Pragma("unroll") for (int p = 0; p < NP; ++p) { const int idx_ = tid + 512 * p; kr[p] = *(const u32x4*)kaddr(key0_ + idx_ / NCH, idx_ % NCH); } \
        _Pragma("unroll") for (int p = 0; p < 2; ++p) { const int idx_ = tid + 512 * p; vr[p] = *(const u32x4*)(s.VT + (size_t)(idx_ >> 4) * RPB + key0_ + (idx_ & 15) * 8); } } while (0)
#define AT_LSTORE(buf) do { \
        _Pragma("unroll") for (int p = 0; p < NP; ++p) { const int idx_ = tid + 512 * p; *(LAS u32x4*)(lds + AT_K0 + (buf) * AT_KBUF + (idx_ / NCH) * KSTR + (idx_ % NCH) * 16) = kr[p]; } \
        _Pragma("unroll") for (int p = 0; p < 2; ++p) { const int idx_ = tid + 512 * p; *(LAS u32x4*)(lds + AT_V0 + (buf) * AT_VBUF + (idx_ >> 4) * AT_VSTR + (idx_ & 15) * 16) = vr[p]; } } while (0)
#define MX3(a, b, c) __builtin_fmaxf(__builtin_fmaxf((a), (b)), (c))
    AT_GLOAD(0); AT_LSTORE(0);
    if (NT2 > 1) AT_GLOAD(1);
    __syncthreads();
    for (int j = 0; j < NT2; ++j) {
        const int buf = j & 1;
#pragma unroll
        for (int sub = 0; sub < 2; ++sub) {
        const LAS unsigned char* kb = lds + AT_K0 + buf * AT_KBUF + (sub * 64 + r32) * KSTR + hi * 16;
        f32x16 s0, s1;
#pragma unroll
        for (int ks = 0; ks < NKS; ++ks) {
            const bf16x8 a0 = *(const LAS bf16x8*)(kb + ks * 32), a1 = *(const LAS bf16x8*)(kb + 32 * KSTR + ks * 32);
            if (ks == 0) { s0 = __builtin_amdgcn_mfma_f32_32x32x16_bf16(a0, qf[0], negm, 0, 0, 0); s1 = __builtin_amdgcn_mfma_f32_32x32x16_bf16(a1, qf[0], negm, 0, 0, 0); }
            else { s0 = __builtin_amdgcn_mfma_f32_32x32x16_bf16(a0, qf[ks], s0, 0, 0, 0); s1 = __builtin_amdgcn_mfma_f32_32x32x16_bf16(a1, qf[ks], s1, 0, 0, 0); }
        }
        if (WIN && j >= 2) {
            const int jb = AT_TILE(j) * 128 + sub * 64 - CTX + 4 * hi, qi = q0lat + wid * 32 + r32;
#pragma unroll
            for (int r = 0; r < 16; ++r) { const int jj = jb + (r & 3) + 8 * (r >> 2); const int d0 = qi - jj, d1 = qi - (jj + 32);
                if (d0 > 128 || d0 < -128) s0[r] = -1e30f; if (d1 > 128 || d1 < -128) s1[r] = -1e30f; }
        }
        float ra = MX3(s0[0], s0[1], s1[0]), rb = MX3(s0[2], s0[3], s1[1]); ra = MX3(ra, s1[2], s1[3]);
#pragma unroll
        for (int r = 4; r < 16; r += 4) { ra = MX3(ra, s0[r], s0[r + 1]); rb = MX3(rb, s0[r + 2], s0[r + 3]); ra = MX3(ra, s1[r], s1[r + 1]); rb = MX3(rb, s1[r + 2], s1[r + 3]); }
        float rm = __builtin_fmaxf(ra, rb);
        rm = __builtin_fmaxf(rm, __shfl_xor(rm, 32));
        const bool first = (j == 0) && (sub == 0);
        if (first || __any(rm > 8.f)) {
            const float dl = first ? rm : __builtin_fmaxf(rm, 0.f);
            mhat += dl;
#pragma unroll
            for (int r = 0; r < 16; ++r) { s0[r] -= dl; s1[r] -= dl; }
#pragma unroll
            for (int r = 0; r < 16; ++r) negm[r] = -mhat;
            asm volatile("" : "+v"(negm));
            if (!first) {
                const float f = fexp2(-dl);
                lsum *= f;
                if (hi == 0) wsf[r32] = f;
#pragma unroll
                for (int r = 0; r < 16; ++r) { const float fr_ = wsf[crow(r, hi)]; o[0][r] *= fr_; o[1][r] *= fr_; }
            }
        }
        float ps = 0.f, ps2 = 0.f;
#pragma unroll
        for (int r = 0; r < 16; ++r) { s0[r] = fexp2(s0[r]); s1[r] = fexp2(s1[r]); ps += s0[r]; ps2 += s1[r]; }
        lsum += ps + ps2;
        bf16x8 pa[4];
#pragma unroll
        for (int kk = 0; kk < 4; ++kk) {
            u32x4 w;
            if (kk < 2) { w.x = pg8::cvt_pk_bf16(s0[8 * kk + 0], s0[8 * kk + 1]); w.y = pg8::cvt_pk_bf16(s0[8 * kk + 2], s0[8 * kk + 3]); w.z = pg8::cvt_pk_bf16(s0[8 * kk + 4], s0[8 * kk + 5]); w.w = pg8::cvt_pk_bf16(s0[8 * kk + 6], s0[8 * kk + 7]); }
            else { const int k2 = kk - 2; w.x = pg8::cvt_pk_bf16(s1[8 * k2 + 0], s1[8 * k2 + 1]); w.y = pg8::cvt_pk_bf16(s1[8 * k2 + 2], s1[8 * k2 + 3]); w.z = pg8::cvt_pk_bf16(s1[8 * k2 + 4], s1[8 * k2 + 5]); w.w = pg8::cvt_pk_bf16(s1[8 * k2 + 6], s1[8 * k2 + 7]); }
            pa[kk] = __builtin_bit_cast(bf16x8, w);
        }
        const LAS unsigned char* vb = lds + AT_V0 + buf * AT_VBUF + r32 * AT_VSTR + sub * 128 + hi * 8;
#pragma unroll
        for (int dvb = 0; dvb < 2; ++dvb)
#pragma unroll
            for (int kk = 0; kk < 4; ++kk) {
                const u32x2 lo_ = *(const LAS u32x2*)(vb + dvb * 32 * AT_VSTR + kk * 32), hi_ = *(const LAS u32x2*)(vb + dvb * 32 * AT_VSTR + kk * 32 + 16);
                const bf16x8 bv = __builtin_bit_cast(bf16x8, (u32x4){lo_.x, lo_.y, hi_.x, hi_.y});
                o[dvb] = __builtin_amdgcn_mfma_f32_32x32x16_bf16(pa[kk], bv, o[dvb], 0, 0, 0);
            }
        }
        if (j + 1 < NT2) AT_LSTORE(buf ^ 1);
        __syncthreads();
        if (j + 2 < NT2) AT_GLOAD(j + 2);
    }
    float lt = lsum + __shfl_xor(lsum, 32);
    if (has_sink) lt += fexp2(sink_l2 - mhat);
    if (hi == 0) wsf[r32] = frcp(lt);
#pragma unroll
    for (int r = 0; r < 16; ++r) { const float fr_ = wsf[crow(r, hi)]; o[0][r] *= fr_; o[1][r] *= fr_; }
#undef AT_TILE
#undef AT_GLOAD
#undef AT_LSTORE
#undef MX3
}

__device__ __forceinline__ void attn_store(bf16_t* O, int row0, int col0, const f32x16 (&o)[2]) {
    const int tid_ = ptid(); const int lane = tid_ & 63, r32 = lane & 31, hi = lane >> 5, wid = tid_ >> 6;
#pragma unroll
    for (int dvb = 0; dvb < 2; ++dvb)
#pragma unroll
        for (int r = 0; r < 16; ++r) O[(size_t)(row0 + wid * 32 + crow(r, hi)) * 1024 + col0 + dvb * 32 + r32] = (bf16_t)f2bf(o[dvb][r]);
}

__device__ __forceinline__ void attn_unit(CArgs& a, int l, int branch, int b, int h, int qb, float lam, float lam_init, LAS unsigned char* lds) {
    const bf16_t* HIN = (const bf16_t*)(a.ws + WS_BIG) + (size_t)b * RPB * NHIN; const bf16_t* MUP = (const bf16_t*)(a.ws + WS_Y) + (size_t)b * RPB * 1024;
    const bf16_t* VT = (const bf16_t*)(a.ws + WS_VT) + (size_t)b * 768 * RPB; bf16_t* OUTS = (bf16_t*)(a.ws + WS_OUTS);
    const bool cq = qb < 0; const int qrow = cq ? 0 : CTX + 256 * qb;
    const int NTd = cq ? 4 : 132;
    const int orow0 = b * RPB + qrow;
    f32x16 o[2];
    AttnSrc s;
    if (branch == 0) {
        s.Q = HIN + (size_t)qrow * NHIN + 64 * h; s.ldq = NHIN; s.K1 = HIN + 256 + 64 * (h >> 1); s.ldk1 = NHIN; s.K2 = nullptr; s.ldk2 = 0; s.VT = VT + (size_t)(0 + 64 * (h >> 1)) * RPB;
        attn_pass<64, false>(s, NTd, 4, 0, 0.f, false, lds, o);
        attn_store(OUTS, orow0, 0 + 64 * h, o);
    } else if (branch == 1) {
        s.Q = MUP + (size_t)qrow * 1024 + 96 * h; s.ldq = 1024; s.K1 = MUP + 384 + 128 * h; s.ldk1 = 1024; s.K2 = MUP + 896; s.ldk2 = 1024; s.VT = VT + (size_t)(128 + 64 * h) * RPB;
        attn_pass<96, false>(s, NTd, 4, 0, 0.f, false, lds, o);
        attn_store(OUTS, orow0, 256 + 64 * h, o);
    } else if (branch == 2) {
        f32x16 o2[2];
        s.Q = HIN + (size_t)qrow * NHIN + 928 + 64 * h; s.ldq = NHIN; s.K1 = HIN + 1184 + 64 * h; s.ldk1 = NHIN; s.K2 = nullptr; s.ldk2 = 0; s.VT = VT + (size_t)(384 + 64 * h) * RPB;
        attn_pass<32, false>(s, NTd, 4, 0, 0.f, false, lds, o);
        s.Q += 32; s.K1 += 32;
        attn_pass<32, false>(s, NTd, 4, 0, 0.f, false, lds, o2);
        const int lane = ptid() & 63, r32 = lane & 31;
        const float g0 = a.dsub[l * 64 + r32] * (1.f - lam_init), g1 = a.dsub[l * 64 + 32 + r32] * (1.f - lam_init);
#pragma unroll
        for (int r = 0; r < 16; ++r) { const float x0 = o[0][r] - lam * o2[0][r], x1 = o[1][r] - lam * o2[1][r];
            float ss = x0 * x0 + x1 * x1;
#pragma unroll
            for (int m = 1; m < 32; m <<= 1) ss += __shfl_xor(ss, m);
            const float rs = __builtin_amdgcn_rsqf(ss * (1.f / 64.f) + EPS);
            o[0][r] = x0 * rs * g0; o[1][r] = x1 * rs * g1; }
        attn_store(OUTS, orow0, 512 + 64 * h, o);
    } else {
        s.Q = HIN + (size_t)qrow * NHIN + 1696 + 64 * h; s.ldq = NHIN; s.K1 = HIN + 1952 + 64 * (h >> 1); s.ldk1 = NHIN; s.K2 = nullptr; s.ldk2 = 0; s.VT = VT + (size_t)(640 + 64 * (h >> 1)) * RPB;
        const float sk = a.sink[l * 4 + h] * LOG2E;
        if (cq) attn_pass<64, false>(s, 4, 4, 0, sk, true, lds, o);
        else { const int q0 = 256 * qb; const int lo = 4 + (q0 >= 128 ? q0 - 128 : 0) / 64, hiT = 4 + ((q0 + 384) < SEQ ? (q0 + 384) : SEQ) / 64;
            attn_pass<64, true>(s, 4 + hiT - lo, lo, q0, sk, true, lds, o); }
        attn_store(OUTS, orow0, 768 + 64 * h, o);
    }
}

__device__ __forceinline__ void attn_phase(CArgs& a, int l, LAS unsigned char* lds) {
    const float lam_init = 0.8f - 0.6f * __expf(-0.3f * (float)l);
    float lam;
    { const float* dl = a.dlam + l * 128; float s1 = 0.f, s2 = 0.f;
        for (int i = 0; i < 32; ++i) { s1 += dl[i] * dl[32 + i]; s2 += dl[64 + i] * dl[96 + i]; }
        lam = __expf(s1) - __expf(s2) + lam_init; }
    const int G = gridDim.x, bx = blockIdx.x;
    const int vcu = (G % 8 == 0) ? (bx % 8) * (G / 8) + bx / 8 : bx;
    for (int ty = 0; ty < 4; ++ty) {
        const int branch = ty == 0 ? 2 : ty == 1 ? 1 : ty == 2 ? 0 : 3;
        for (int idx = vcu; idx < NB * 4 * 32; idx += G) { const int bh = idx >> 5, qb = idx & 31; attn_unit(a, l, branch, bh >> 2, bh & 3, qb, lam, lam_init, lds); }
    }
    for (int idx = vcu; idx < NB * 16; idx += G) attn_unit(a, l, (idx >> 2) & 3, idx >> 4, idx & 3, -1, lam, lam_init, lds);
}

#define GAS __attribute__((address_space(1)))
#define XB_TMO      128
#define XB_XCNT(j)  (256  + 64 * (j))
#define XB_XSUB(j)  (1280 + 64 * (j))
#define XB_XGEN(j)  (2304 + 64 * (j))
#define XB_TOP      3328
#define XB_TOPGEN   3392
#define XCD_BAR_WORDS 3456
#define XB_SPIN_CAP (1u << 18)

__device__ __forceinline__ unsigned xb_ld(unsigned* p)              { return __hip_atomic_load(p, __ATOMIC_RELAXED, __HIP_MEMORY_SCOPE_AGENT); }
__device__ __forceinline__ unsigned xb_add(unsigned* p, unsigned v) { return __hip_atomic_fetch_add(p, v, __ATOMIC_RELAXED, __HIP_MEMORY_SCOPE_AGENT); }
__device__ __forceinline__ unsigned xb_xcc_id() { return (unsigned)__builtin_amdgcn_s_getreg((3 << 11) | 20) & 0xFu; }
#define XB_SPIN(cond, bar) do { unsigned _sp = 0; while (cond) { __builtin_amdgcn_s_sleep(1); \
    if ((++_sp & 255u) == 0u) { if (xb_ld(&(bar)[XB_TMO])) break; if (_sp > XB_SPIN_CAP) { atomicAdd(&(bar)[XB_TMO], 1u); break; } } } } while (0)

struct XcdBarrier {
    unsigned* bar; unsigned x;
    volatile LAS unsigned* st;
};

__device__ __forceinline__ XcdBarrier xcd_barrier_post(unsigned* bar, volatile LAS unsigned* st) {
    XcdBarrier b; b.bar = bar; b.x = xb_xcc_id(); b.st = st;
    if (threadIdx.x == 0) (void)xb_add(&bar[XB_XCNT(b.x)], 1u);
    return b;
}
__device__ __forceinline__ void xcd_barrier_complete(unsigned* bar, unsigned x, unsigned& nloc, unsigned& nx) {
    const unsigned G = gridDim.x * gridDim.y * gridDim.z;
    unsigned sum, cnt, mine, sp = 0u;
    for (;;) {
        sum = 0u; cnt = 0u; mine = 0u;
#pragma unroll
        for (unsigned j = 0; j < 16; ++j) { const unsigned c = xb_ld(&bar[XB_XCNT(j)]); sum += c; cnt += (c > 0u) ? 1u : 0u; mine = (j == x) ? c : mine; }
        if (sum == G) break;
        __builtin_amdgcn_s_sleep(1);
        if ((++sp & 255u) == 0u) { if (xb_ld(&bar[XB_TMO])) break; if (sp > XB_SPIN_CAP) { atomicAdd(&bar[XB_TMO], 1u); break; } }
    }
    nloc = mine > 0u ? mine : 1u; nx = cnt > 0u ? cnt : 1u;
}

__device__ __forceinline__ void xcd_barrier(const XcdBarrier& b) {
    asm volatile("s_waitcnt vmcnt(0)" ::: "memory");
    __syncthreads();
    if (threadIdx.x == 0) {
        unsigned* bar = b.bar;
        __builtin_amdgcn_s_waitcnt(0);
        unsigned nloc = b.st[0], nx = b.st[1];
        if (nloc == 0u) { xcd_barrier_complete(bar, b.x, nloc, nx); b.st[0] = nloc; b.st[1] = nx; }
        const unsigned old = xb_add(&bar[XB_XSUB(b.x)], 1u);
        const unsigned gen = old / nloc;
        if (old + 1u == (gen + 1u) * nloc) {
            __builtin_amdgcn_fence(__ATOMIC_RELEASE, "agent");
            asm volatile("s_waitcnt vmcnt(0)" ::: "memory");
            const unsigned og = xb_add(&bar[XB_TOP], 1u);
            const unsigned tg = og / nx;
            if (og + 1u == (tg + 1u) * nx) xb_add(&bar[XB_TOPGEN], 1u);
            else XB_SPIN(xb_ld(&bar[XB_TOPGEN]) == tg, bar);
            __builtin_amdgcn_fence(__ATOMIC_ACQUIRE, "agent");
            xb_add(&bar[XB_XGEN(b.x)], 1u);
            asm volatile("s_waitcnt vmcnt(0)" ::: "memory");
        } else {
            XB_SPIN(xb_ld(&bar[XB_XGEN(b.x)]) == gen, bar);
            __builtin_amdgcn_fence(__ATOMIC_ACQUIRE, "agent");
            asm volatile("s_waitcnt vmcnt(0)" ::: "memory");
        }
    }
    __syncthreads();
}


constexpr int NPHASE = 2 + 32;
__global__ void __launch_bounds__(512, 2) fwd_kernel(Args a_) {
    extern __shared__ __attribute__((aligned(16))) unsigned char lds_raw[];
    LAS unsigned char* lds = (LAS unsigned char*)lds_raw;
    cg::grid_group grid = cg::this_grid();
    const int lo = a_.ph_lo, hi = a_.ph_hi < NPHASE ? a_.ph_hi : NPHASE;
    { volatile LAS unsigned* st0 = (volatile LAS unsigned*)(lds + LDS_BARST); if (threadIdx.x < 2) st0[threadIdx.x] = 0u; }
    __syncthreads();
    { XcdBarrier b0 = xcd_barrier_post((unsigned*)(a_.ws + WS_BAR), (volatile LAS unsigned*)(lds + LDS_BARST)); (void)b0; }
    for (int ph = lo; ph < hi; ++ph) {
        CArgs* ap_ = (CArgs*)__builtin_amdgcn_kernarg_segment_ptr(); asm volatile("" : "+s"(ap_) :: "memory"); CArgs& a = *ap_;
        int G = gridDim.x, bx = blockIdx.x; asm volatile("" : "+s"(G), "+s"(bx));
        if (ph == 0) p0_phase(a, lds);
        else if (ph == 1) row_phase(a, 0, true, nullptr, 0, 0.f, (bf16_t*)(a.ws + WS_U), 0, 0);
        else {
            const int l = (ph - 2) / 16, k = (ph - 2) % 16;
            unsigned char* ws = a.ws;
            const unsigned char* wb = ws + WS_W + (size_t)l * W_LAYER;
            bf16_t* U = (bf16_t*)(ws + WS_U); bf16_t* Yb = (bf16_t*)(ws + WS_Y); bf16_t* BIG = (bf16_t*)(ws + WS_BIG);
            if (k == 5) prep_phase(a, l, lds);
#ifndef X_ATTN
            else if (k == 6) attn_phase(a, l, lds);
#endif
            else if (k == 2) row_phase(a, l, l == 0, Yb, 0, 0.5f, U, 1, l);
            else if (k == 12) row_phase(a, l, false, BIG, 1, 1.0f, U, 2, l);
            else if (k == 15) row_phase(a, l, false, Yb, 2, 0.5f, l == 0 ? U : nullptr, 0, l + 1);
            else {
                pg8::Gemm g; pg8::Epi E; int N; int dual = 0; int Mrows = R;
                g.A2 = nullptr; g.Bt2 = nullptr; E.scr = nullptr;
                if (k == 0 || k == 13) { const int s = k == 13; g.A = U; g.Bt = (const bf16_t*)(wb + W_GU + s * W_GU_SZ); g.lda = 1024; g.ldb = 1024; g.K = 1024; N = 5632; E.mode = 1; E.O = BIG; E.ldc = DFF; }
                else if (k == 1 || k == 14) { const int s = k == 14; g.A = BIG; g.Bt = (const bf16_t*)(wb + W_D + s * W_D_SZ); g.lda = DFF; g.ldb = DFF; g.K = DFF; N = 1024; E.mode = 0; E.O = Yb; E.ldc = 1024; }
                else if (k == 3) { g.A = U; g.Bt = (const bf16_t*)(wb + W_IN); g.lda = 1024; g.ldb = 1024; g.K = 1024; N = NHIN; E.mode = 0; E.O = BIG; E.ldc = NHIN; }
                else if (k == 4) { g.A = BIG + 512; g.Bt = (const bf16_t*)(wb + W_MLA); g.lda = NHIN; g.ldb = 384; g.K = 384; N = 1024; E.mode = 0; E.O = Yb; E.ldc = 1024; }
                else if (k == 7 || k == 9) { size_t ro = (size_t)(k == 9) * 32768 * 1024; Mrows = (k == 9) ? R - 32768 : 32768; if (l == 1) { ro = (size_t)(k == 9) * 33792 * 1024; Mrows = 32768; dual = 1; }
                    g.A = U + ro; g.Bt = (const bf16_t*)(wb + W_G); g.lda = 1024; g.ldb = 1024; g.K = 1024; N = 4096; E.mode = 3; E.O = BIG; E.ldc = 4096; }
                else if (k == 8 || k == 10) { size_t ro = (size_t)(k == 10) * 32768 * 1024; Mrows = (k == 10) ? R - 32768 : 32768; if (l == 1) { ro = (size_t)(k == 10) * 33792 * 1024; Mrows = 32768; dual = 1; }
                    g.A = (const bf16_t*)(ws + WS_OUTS) + ro; g.Bt = (const bf16_t*)(wb + W_BR); g.lda = 1024; g.ldb = 1024; g.K = 1024; N = 1024; E.mode = 4; E.O = Yb + ro; E.ldc = 1024; E.scr = (u32x4*)BIG; }
                else { g.A = Yb; g.Bt = (const bf16_t*)(wb + W_OUT); g.lda = 1024; g.ldb = 1024; g.K = 1024; N = 1024; E.mode = 0; E.O = BIG; E.ldc = 1024; }
                if (l == 1 && (k == 11 || k == 13 || k == 14)) { dual = 1; Mrows = 65536; }
                pg8::StaticOrder S; S.init(Mrows, N, G, bx, dual);
                if (k == 8 || k == 10) pg8::gemm_phase<true>(lds, g, S, E); else pg8::gemm_phase<false>(lds, g, S, E);
            }
        }
        if (ph + 1 < hi) {
            if (ph == lo) {
                asm volatile("s_waitcnt vmcnt(0) lgkmcnt(0)" ::: "memory");
                __syncthreads();
                if (ptid() < 64) { __builtin_amdgcn_fence(__ATOMIC_RELEASE, "agent"); asm volatile("s_waitcnt vmcnt(0)" ::: "memory"); }
                grid.sync();
                __builtin_amdgcn_fence(__ATOMIC_ACQUIRE, "agent");
                asm volatile("s_waitcnt vmcnt(0)" ::: "memory");
            } else {
                XcdBarrier bar; bar.bar = (unsigned*)(a.ws + WS_BAR); bar.x = xb_xcc_id(); bar.st = (volatile LAS unsigned*)(lds + LDS_BARST);
                xcd_barrier(bar);
                __builtin_amdgcn_fence(__ATOMIC_ACQUIRE, "agent");
                asm volatile("s_waitcnt vmcnt(0)" ::: "memory");
            }
        }
    }
}

extern "C" void kernel_launch(void* const* d_in, const int* in_sizes, int n_in, void* d_out, int out_size, void* d_ws, size_t ws_size, hipStream_t stream) {
    static int grid = 0;
    if (grid == 0) {
        int dev = 0, cus = 0;
        if (hipGetDevice(&dev) != hipSuccess || hipDeviceGetAttribute(&cus, hipDeviceAttributeMultiprocessorCount, dev) != hipSuccess) { grid = -1; return; }
        if (hipFuncSetAttribute((const void*)fwd_kernel, hipFuncAttributeMaxDynamicSharedMemorySize, LDS_BYTES) != hipSuccess) { fprintf(stderr, "hipFuncSetAttribute failed\n"); grid = -1; return; }
        int per_cu = 0;
        if (hipOccupancyMaxActiveBlocksPerMultiprocessor(&per_cu, (const void*)fwd_kernel, 512, LDS_BYTES) != hipSuccess || per_cu < 1) fprintf(stderr, "occupancy query: %d\n", per_cu);
        (void)hipGetLastError();
        grid = cus;
        if (ws_size < WS_END) { fprintf(stderr, "workspace too small\n"); grid = -1; return; }
    }
    if (grid < 0) return;
    if (hipMemsetAsync((char*)d_ws + WS_BAR, 0, 16384, stream) != hipSuccess) { fprintf(stderr, "memset failed\n"); return; }
    Args a{};
    const float** p = (const float**)&a;
    for (int i = 0; i < 23; ++i) p[i] = (const float*)d_in[i];
    a.out = (float*)d_out; a.ws = (unsigned char*)d_ws; a.ph_lo = 0; a.ph_hi = 1000;
    void* args[] = {&a};
    hipError_t e = hipLaunchCooperativeKernel((const void*)fwd_kernel, dim3(grid), dim3(512), args, LDS_BYTES, stream);
    if (e != hipSuccess) fprintf(stderr, "cooperative launch failed: %s\n", hipGetErrorString(e));
}
```

```cpp
#include <hip/hip_runtime.h>
#include <hip/hip_cooperative_groups.h>
#include <cstdio>
#include <cstdint>
namespace cg = cooperative_groups;

#define LAS __attribute__((address_space(3)))
typedef unsigned short bf16_t;
typedef short bf16x8 __attribute__((ext_vector_type(8)));
typedef short s16x4 __attribute__((ext_vector_type(4)));
typedef float f32x4 __attribute__((ext_vector_type(4)));
typedef float f32x16 __attribute__((ext_vector_type(16)));
typedef unsigned u32x4 __attribute__((ext_vector_type(4)));
typedef unsigned u32x2 __attribute__((ext_vector_type(2)));

constexpr int DM = 1024, NB = 8, SEQ = 8192, CTX = 256, RPB = SEQ + CTX, R = NB * RPB, DFF = 2816;
constexpr int NHIN = 2304, INCOLS = 6304, GATE0 = 2208;
constexpr int MODW = 9216;
constexpr float EPS = 1e-6f;
constexpr float LOG2E = 1.4426950408889634f;
constexpr float QS_GQA = 0.125f * LOG2E, QS_MLA = 0.10206207261596577f * LOG2E, QS_DIFF = 0.17677669529663687f * LOG2E;

constexpr size_t MiB = 1u << 20;
constexpr size_t WS_MOD = 0;
constexpr size_t WS_XC = 2 * MiB;
constexpr size_t WS_W = 10 * MiB;
constexpr size_t W_GU = 0, W_GU_SZ = (size_t)5632 * 1024 * 2;
constexpr size_t W_D = W_GU + 2 * W_GU_SZ, W_D_SZ = (size_t)1024 * 2816 * 2;
constexpr size_t W_IN = W_D + 2 * W_D_SZ, W_IN_SZ = (size_t)NHIN * 1024 * 2;
constexpr size_t W_G = W_IN + W_IN_SZ, W_G_SZ = (size_t)4096 * 1024 * 2;
constexpr size_t W_BR = W_G + W_G_SZ;
constexpr size_t W_OUT = W_BR + W_G_SZ, W_OUT_SZ = (size_t)1024 * 1024 * 2;
constexpr size_t W_MLA = W_OUT + W_OUT_SZ, W_MLA_SZ = (size_t)1024 * 384 * 2;
constexpr size_t W_LAYER = W_MLA + W_MLA_SZ;
static_assert(WS_W + 2 * W_LAYER <= 124 * MiB, "weights");
constexpr size_t ROWBUF = (size_t)R * 1024 * 2;
constexpr size_t WS_U = 124 * MiB;
constexpr size_t WS_Y = WS_U + ROWBUF;
constexpr size_t WS_BIG = WS_Y + ROWBUF;
constexpr size_t WS_OUTS = WS_BIG + (size_t)R * NHIN * 2;
constexpr size_t WS_VT = WS_OUTS + ROWBUF;
constexpr size_t WS_GSCR = WS_VT + (size_t)NB * 768 * RPB * 2;
constexpr size_t WS_END = WS_GSCR + 256 * 131072;
static_assert(WS_END <= 1024 * MiB, "ws");
static_assert(WS_BIG + (size_t)R * DFF * 2 <= WS_END, "H");

constexpr int LDS_BYTES = 147456;
constexpr size_t WS_BAR = 1 * MiB;
constexpr int LDS_BARST = 147456 - 64;

__device__ __forceinline__ unsigned f2bf(float f) { unsigned u = __builtin_bit_cast(unsigned, f); return (u + 0x7fffu + ((u >> 16) & 1u)) >> 16; }
__device__ __forceinline__ unsigned pk2(float lo, float hi) { return f2bf(lo) | (f2bf(hi) << 16); }
__device__ __forceinline__ float bf2f(unsigned short h) { return __builtin_bit_cast(float, (unsigned)h << 16); }
__device__ __forceinline__ float bflo(unsigned w) { return __builtin_bit_cast(float, w << 16); }
__device__ __forceinline__ float bfhi(unsigned w) { return __builtin_bit_cast(float, w & 0xffff0000u); }
__device__ __forceinline__ float wave_sum(float v) {
#pragma unroll
    for (int o = 1; o < 64; o <<= 1) v += __shfl_xor(v, o);
    return v;
}
__device__ __forceinline__ int ptid() { int t = threadIdx.x; asm volatile("" : "+v"(t)); return t; }
__device__ __forceinline__ float fexp2(float x) { return __builtin_amdgcn_exp2f(x); }
__device__ __forceinline__ float frcp(float x) { return __builtin_amdgcn_rcpf(x); }
__device__ __forceinline__ float sigmoidf_(float x) { return frcp(1.f + fexp2(-x * LOG2E)); }

namespace pg8 {
constexpr int BM = 256, BK = 64, HALF = 128, HTB = HALF * BK * 2, STAGE_BYTES = 8 * HTB, NXCD = 8, WGM = 8;
__device__ __forceinline__ int lds_byte(int r, int c) { const int st = (r >> 4) * 2 + (c >> 5), rr = r & 15, cc = c & 31, ob = rr * 64 + cc * 2; return st * 1024 + (ob ^ (((ob >> 9) & 1) << 5)); }
__device__ __forceinline__ void stage_rc(int b, int& Rr, int& C) { const int st = b / 1024, sb = b % 1024, swz = sb ^ (((sb >> 9) & 1) << 5); Rr = (st >> 1) * 16 + swz / 64; C = (st & 1) * 32 + (swz % 64) / 2; }
__device__ __forceinline__ int perm32(int rho) { const int n = rho >> 4, i = rho & 15; return 8 * (i >> 2) + 4 * n + (i & 3); }

struct Unit { int pm, pn, kind; };
struct Gemm { const bf16_t* A; const bf16_t* Bt; const bf16_t* A2; const bf16_t* Bt2; int lda, ldb, K; };

struct StaticOrder {
    int nM, nN, nwg, G, c, dual;
    __device__ void init(int M, int N, int G_, int c_, int dual_) { nM = M / BM; nN = N / BM; nwg = nM * nN; G = G_; c = c_; dual = dual_; }
    __device__ bool next(int i, Unit& u) const {
        const int ii = i;
        const long L = (long)ii * G + c; if (L >= nwg) return false;
        int wgid = (int)L; { const int q = nwg / NXCD, r = nwg % NXCD, xcd = wgid % NXCD, off = wgid / NXCD; wgid = (xcd < r ? xcd * (q + 1) : r * (q + 1) + (xcd - r) * q) + off; }
        const int nig = WGM * nN, gid = wgid / nig, fm = gid * WGM, gsz = (nM - fm) < WGM ? (nM - fm) : WGM;
        u.pm = fm + ((wgid % nig) % gsz); u.pn = (wgid % nig) / gsz;
        if (dual) u.pm = (u.pm >> 5) * 33 + 1 + (u.pm & 31);
        u.kind = 0; return true;
    }
};

typedef float f32x2_t __attribute__((ext_vector_type(2))); typedef __bf16 bf16x2_t __attribute__((ext_vector_type(2)));
__device__ __forceinline__ unsigned cvt_pk_bf16(float lo, float hi) { f32x2_t v = {lo, hi}; bf16x2_t b = __builtin_convertvector(v, bf16x2_t); return __builtin_bit_cast(unsigned, b); }

struct Epi {
    int mode; bf16_t* O; int ldc; u32x4* scr;
    __device__ __forceinline__ void operator()(const f32x4 (&acc)[2][2][4][2], const Unit& u, int wr, int wc, int fr, int fq) const {
        const int row0 = u.pm * BM + wr * 64 + fr;
        if (mode == 0) {
            const int col0 = u.pn * BM + wc * 32 + 8 * fq;
#pragma unroll
            for (int ai = 0; ai < 2; ++ai)
#pragma unroll
                for (int m = 0; m < 4; ++m) { bf16_t* rowp = O + (size_t)(row0 + ai * HALF + m * 16) * ldc + col0;
#pragma unroll
                    for (int bj = 0; bj < 2; ++bj) { const f32x4 v0 = acc[ai][bj][m][0], v1 = acc[ai][bj][m][1];
                        u32x4 w; w.x = cvt_pk_bf16(v0[0], v0[1]); w.y = cvt_pk_bf16(v0[2], v0[3]); w.z = cvt_pk_bf16(v1[0], v1[1]); w.w = cvt_pk_bf16(v1[2], v1[3]);
                        *(u32x4*)(rowp + bj * HALF) = w; } }
        } else if (mode == 1) {
            const int col0 = u.pn * HALF + wc * 32 + 8 * fq;
#pragma unroll
            for (int ai = 0; ai < 2; ++ai)
#pragma unroll
                for (int m = 0; m < 4; ++m) { bf16_t* rowp = O + (size_t)(row0 + ai * HALF + m * 16) * ldc + col0;
                    float h[8];
#pragma unroll
                    for (int n = 0; n < 2; ++n)
#pragma unroll
                        for (int e = 0; e < 4; ++e) { const float g = acc[ai][0][m][n][e], up = acc[ai][1][m][n][e]; h[n * 4 + e] = g * sigmoidf_(g) * up; }
                    u32x4 w; w.x = cvt_pk_bf16(h[0], h[1]); w.y = cvt_pk_bf16(h[2], h[3]); w.z = cvt_pk_bf16(h[4], h[5]); w.w = cvt_pk_bf16(h[6], h[7]);
                    *(u32x4*)rowp = w; }
        } else if (mode == 3) {
            const int col0 = u.pn * BM + wc * 32 + 8 * fq;
#pragma unroll
            for (int ai = 0; ai < 2; ++ai)
#pragma unroll
                for (int m = 0; m < 4; ++m) { bf16_t* rowp = O + (size_t)(row0 + ai * HALF + m * 16) * ldc + col0;
#pragma unroll
                    for (int bj = 0; bj < 2; ++bj) { const f32x4 v0 = acc[ai][bj][m][0], v1 = acc[ai][bj][m][1];
                        u32x4 w; w.x = cvt_pk_bf16(sigmoidf_(v0[0]), sigmoidf_(v0[1])); w.y = cvt_pk_bf16(sigmoidf_(v0[2]), sigmoidf_(v0[3]));
                        w.z = cvt_pk_bf16(sigmoidf_(v1[0]), sigmoidf_(v1[1])); w.w = cvt_pk_bf16(sigmoidf_(v1[2]), sigmoidf_(v1[3]));
                        *(u32x4*)(rowp + bj * HALF) = w; } }
        } else {
            const int col0 = u.pn * BM + wc * 32 + 8 * fq;
#pragma unroll
            for (int ai = 0; ai < 2; ++ai)
#pragma unroll
                for (int m = 0; m < 4; ++m) { const size_t r = (size_t)(row0 + ai * HALF + m * 16);
                    const bf16_t* gp = (const bf16_t*)scr + r * 4096 + 3 * 1024 + col0; bf16_t* rowp = O + r * ldc + col0;
#pragma unroll
                    for (int bj = 0; bj < 2; ++bj) { const u32x4 g = *(const u32x4*)(gp + bj * HALF); const f32x4 v0 = acc[ai][bj][m][0], v1 = acc[ai][bj][m][1];
                        u32x4 w; w.x = cvt_pk_bf16(v0[0] * gclamp(bflo(g.x)), v0[1] * gclamp(bfhi(g.x))); w.y = cvt_pk_bf16(v0[2] * gclamp(bflo(g.y)), v0[3] * gclamp(bfhi(g.y)));
                        w.z = cvt_pk_bf16(v1[0] * gclamp(bflo(g.z)), v1[1] * gclamp(bfhi(g.z))); w.w = cvt_pk_bf16(v1[2] * gclamp(bflo(g.w)), v1[3] * gclamp(bfhi(g.w)));
                        *(u32x4*)(rowp + bj * HALF) = w; } }
        }
    }
    static __device__ __forceinline__ float gclamp(float g) { return __builtin_fmaxf(g, 1e-6f); }
    __device__ __forceinline__ void rescale(f32x4 (&acc)[2][2][4][2], const Unit& u, int i, int wr, int wc, int fr, int fq) const {
        int row0 = u.pm * BM + wr * 64 + fr; const int col0 = u.pn * BM + wc * 32 + 8 * fq;
        asm volatile("" : "+v"(row0));
#pragma unroll
        for (int ai = 0; ai < 2; ++ai)
#pragma unroll
            for (int m = 0; m < 4; ++m) { const bf16_t* gp = (const bf16_t*)scr + (size_t)(row0 + ai * HALF + m * 16) * 4096 + i * 1024 + col0;
#pragma unroll
                for (int bj = 0; bj < 2; ++bj) { const u32x4 ga = *(const u32x4*)(gp + bj * HALF), gb = *(const u32x4*)(gp + 1024 + bj * HALF);
                    f32x4 r0, r1;
                    r0[0] = gclamp(bflo(ga.x)) * frcp(gclamp(bflo(gb.x))); r0[1] = gclamp(bfhi(ga.x)) * frcp(gclamp(bfhi(gb.x)));
                    r0[2] = gclamp(bflo(ga.y)) * frcp(gclamp(bflo(gb.y))); r0[3] = gclamp(bfhi(ga.y)) * frcp(gclamp(bfhi(gb.y)));
                    r1[0] = gclamp(bflo(ga.z)) * frcp(gclamp(bflo(gb.z))); r1[1] = gclamp(bfhi(ga.z)) * frcp(gclamp(bfhi(gb.z)));
                    r1[2] = gclamp(bflo(ga.w)) * frcp(gclamp(bflo(gb.w))); r1[3] = gclamp(bfhi(ga.w)) * frcp(gclamp(bfhi(gb.w)));
                    acc[ai][bj][m][0] = acc[ai][bj][m][0] * r0; acc[ai][bj][m][1] = acc[ai][bj][m][1] * r1; }
                if (m == 3) asm volatile("" ::: "memory"); }
    }
};

template <bool HOOK, class Sched>
__device__ __forceinline__ void gemm_phase(LAS unsigned char* lds, const Gemm g, const Sched& S, const Epi& E) {
    const int tid = ptid(), wid = __builtin_amdgcn_readfirstlane(tid >> 6), lane = tid & 63, wr = wid >> 2, wc = wid & 3, fr = lane & 15, fq = lane >> 4;
    const int K = g.K, nt = K / BK;
    unsigned voffA[2], voffB[2];
#pragma unroll
    for (int i = 0; i < 2; ++i) { int Rr, C; stage_rc(tid * 16 + i * 8192, Rr, C); const int Rb = (Rr & ~31) + perm32(Rr & 31);
        voffA[i] = (unsigned)(Rr * g.lda + C) * 2u; voffB[i] = (unsigned)(Rb * g.ldb + C) * 2u; }
    const size_t kstep = (size_t)(BK * 2);
    const size_t hsA = (size_t)HALF * g.lda * 2, hsB = (size_t)HALF * g.ldb * 2;
    const size_t tsA = 2 * hsA, tsB = 2 * hsB;
    const unsigned ldsw = (unsigned)wid * 1024u;
    const int aoff = lds_byte(wr * 64 + fr, fq * 8), boff = lds_byte(wc * 32 + fr, fq * 8);
#define PG8_SA(b, h) (((b) * 2 + (h)) * HTB)
#define PG8_SB(b, h) ((4 + (b) * 2 + (h)) * HTB)
#define PG8_STAGE(bufoff, gbase, voff) do { _Pragma("unroll") for (int _i = 0; _i < 2; ++_i) \
        __builtin_amdgcn_global_load_lds((const unsigned*)((const char*)(gbase) + (voff)[_i]), (LAS unsigned*)(lds + (bufoff) + ldsw + _i * 8192), 16, 0, 0); } while (0)
#define PG8_LDA(dst, b, h) do { _Pragma("unroll") for (int m = 0; m < 4; ++m) _Pragma("unroll") for (int k = 0; k < 2; ++k) dst[m][k] = *(const LAS bf16x8*)(lds + PG8_SA(b, h) + aoff + m * 2048 + k * 1024); } while (0)
#define PG8_LDB(dst, b, h) do { _Pragma("unroll") for (int n = 0; n < 2; ++n) _Pragma("unroll") for (int k = 0; k < 2; ++k) dst[n][k] = *(const LAS bf16x8*)(lds + PG8_SB(b, h) + boff + n * 2048 + k * 1024); } while (0)
#define PG8_MMA(ai, bj, At, Bt) do { __builtin_amdgcn_s_setprio(1); _Pragma("unroll") for (int m = 0; m < 4; ++m) _Pragma("unroll") for (int n = 0; n < 2; ++n) _Pragma("unroll") for (int k = 0; k < 2; ++k) \
        acc[ai][bj][m][n] = __builtin_amdgcn_mfma_f32_16x16x32_bf16(Bt[n][k], At[m][k], acc[ai][bj][m][n], 0, 0, 0); __builtin_amdgcn_s_setprio(0); } while (0)
#define PG8_MMA1(ai, bj, nn, At, Bt) do { __builtin_amdgcn_s_setprio(1); _Pragma("unroll") for (int m = 0; m < 4; ++m) _Pragma("unroll") for (int k = 0; k < 2; ++k) \
        acc[ai][bj][m][nn] = __builtin_amdgcn_mfma_f32_16x16x32_bf16(Bt[nn][k], At[m][k], acc[ai][bj][m][nn], 0, 0, 0); __builtin_amdgcn_s_setprio(0); } while (0)
#define PG8_MMAZ(ai, At) do { if (zbr == 0) PG8_MMA1(ai, 0, 0, At, B0); else if (zbr == 1) PG8_MMA1(ai, 0, 1, At, B0); else if (zbr == 2) PG8_MMA1(ai, 1, 0, At, B1); else PG8_MMA1(ai, 1, 1, At, B1); } while (0)
#define PG8_MM2(ai, At) do { PG8_MMA(ai, 0, At, B0); PG8_MMA(ai, 1, At, B1); } while (0)
#define PG8_WAIT_V(n) asm volatile("s_waitcnt vmcnt(" #n ")" ::: "memory")
#define PG8_WAIT_L(n) asm volatile("s_waitcnt lgkmcnt(" #n ")" ::: "memory")
#define PG8_BAR __builtin_amdgcn_s_barrier()
#define PG8_SCHED __builtin_amdgcn_sched_barrier(0)
#define PG8_UA(u) ((const char*)((u).kind ? g.A2 : g.A) + (size_t)(u).pm * tsA)
#define PG8_UB(u) ((const char*)((u).kind ? g.Bt2 : g.Bt) + (size_t)(u).pn * tsB)
    Unit cur, nxt; int ui = 0;
    if (!S.next(0, cur)) return;
    f32x4 acc[2][2][4][2];
#pragma unroll
    for (int a = 0; a < 2; ++a)
#pragma unroll
        for (int b = 0; b < 2; ++b)
#pragma unroll
            for (int m = 0; m < 4; ++m)
#pragma unroll
                for (int n = 0; n < 2; ++n) acc[a][b][m][n] = (f32x4){0.f, 0.f, 0.f, 0.f};
    bf16x8 At[4][2], B0[2][2], B1[2][2];
    const char* cA = PG8_UA(cur); const char* cB = PG8_UB(cur);
    {
        PG8_STAGE(PG8_SB(0, 0), cB, voffB); PG8_STAGE(PG8_SB(0, 1), cB + hsB, voffB); PG8_STAGE(PG8_SA(0, 0), cA, voffA); PG8_STAGE(PG8_SA(0, 1), cA + hsA, voffA);
        if (wr == 1) PG8_BAR;
        PG8_WAIT_V(2); PG8_BAR;
        PG8_STAGE(PG8_SB(1, 0), cB + kstep, voffB); PG8_STAGE(PG8_SA(1, 0), cA + kstep, voffA); PG8_STAGE(PG8_SB(1, 1), cB + hsB + kstep, voffB);
        PG8_WAIT_V(6); PG8_BAR;
    }
    for (;;) {
        const bool has_next = S.next(ui + 1, nxt);
        const char* nA = has_next ? PG8_UA(nxt) : cA; const char* nB = has_next ? PG8_UB(nxt) : cB;
        for (int t = 0; t < nt; t += 2) {
            const bool last = (t == nt - 2);
            if constexpr (HOOK) { if (t == 4 || t == 8 || t == 12) { PG8_SCHED; E.rescale(acc, cur, (t >> 2) - 1, wr, wc, fr, fq); PG8_SCHED; } }
            const char* a1 = cA + (size_t)(t + 1) * kstep;
            const char* a2 = last ? nA : cA + (size_t)(t + 2) * kstep; const char* b2 = last ? nB : cB + (size_t)(t + 2) * kstep;
            const char* a3 = a2 + kstep; const char* b3 = b2 + kstep;
            PG8_LDB(B0, 0, 0); PG8_LDB(B1, 0, 1); PG8_SCHED; PG8_LDA(At, 0, 0); PG8_STAGE(PG8_SA(1, 1), a1 + hsA, voffA);
            PG8_WAIT_V(8); PG8_WAIT_L(0); PG8_BAR; PG8_MM2(0, At); PG8_BAR; PG8_SCHED;
            PG8_LDA(At, 0, 1); PG8_STAGE(PG8_SB(0, 0), b2, voffB); PG8_STAGE(PG8_SB(0, 1), b2 + hsB, voffB); PG8_STAGE(PG8_SA(0, 0), a2, voffA);
            PG8_WAIT_V(8); PG8_WAIT_L(0); PG8_BAR; PG8_MM2(1, At); PG8_BAR; PG8_SCHED;
            PG8_LDB(B0, 1, 0); PG8_LDB(B1, 1, 1); PG8_SCHED; PG8_LDA(At, 1, 0); PG8_STAGE(PG8_SA(0, 1), a2 + hsA, voffA);
            PG8_WAIT_V(8); PG8_WAIT_L(0); PG8_BAR; PG8_MM2(0, At); PG8_BAR; PG8_SCHED;
            PG8_LDA(At, 1, 1); PG8_STAGE(PG8_SB(1, 0), b3, voffB); PG8_STAGE(PG8_SB(1, 1), b3 + hsB, voffB); PG8_STAGE(PG8_SA(1, 0), a3, voffA);
            PG8_WAIT_V(8); PG8_WAIT_L(0); PG8_BAR; PG8_MM2(1, At); PG8_BAR; PG8_SCHED;
        }
        if (wr == 0) PG8_BAR;
        E(acc, cur, wr, wc, fr, fq);
        if (!has_next) break;
#pragma unroll
        for (int a = 0; a < 2; ++a)
#pragma unroll
            for (int b = 0; b < 2; ++b)
#pragma unroll
                for (int m = 0; m < 4; ++m)
#pragma unroll
                    for (int n = 0; n < 2; ++n) acc[a][b][m][n] = (f32x4){0.f, 0.f, 0.f, 0.f};
        cur = nxt; cA = nA; cB = nB; ++ui;
        if (wr == 1) PG8_BAR;
    }
    PG8_WAIT_V(0);
    PG8_BAR;
#undef PG8_SA
#undef PG8_SB
#undef PG8_STAGE
#undef PG8_LDA
#undef PG8_LDB
#undef PG8_MMA
#undef PG8_MMA1
#undef PG8_MMAZ
#undef PG8_MM2
#undef PG8_WAIT_V
#undef PG8_WAIT_L
#undef PG8_BAR
#undef PG8_SCHED
#undef PG8_UA
#undef PG8_UB
}
}

struct Args {
    const float* x; const float* c; const float* ctx; const float* c_ctx; const float* w_mod; const float* b_mod; const float* g_pre; const float* g_post;
    const float* w_gate; const float* w_up; const float* w_down; const float* w_in; const float* gqa_qn; const float* gqa_kn; const float* mla_qn; const float* mla_kvn;
    const float* w_uq; const float* w_ukv; const float* dlam; const float* dsub; const float* sink; const float* w_branch; const float* w_out;
    float* out; unsigned char* ws; int ph_lo, ph_hi;
};
typedef const __attribute__((address_space(4))) Args CArgs;

template <class F>
__device__ __forceinline__ void conv_item(bf16_t* WT, int K, int nblk, int item, LAS float* scr, int lane, const F& f) {
    const int kb = item / nblk, nb = item % nblk, k0 = 64 * kb, n0 = 32 * nb;
#pragma unroll 8
    for (int i = 0; i < 32; ++i) { const int kk = 2 * i + (lane >> 5); scr[kk * 33 + (lane & 31)] = f(n0 + (lane & 31), k0 + kk); }
    asm volatile("s_waitcnt lgkmcnt(0)" ::: "memory");
    const int c = lane & 7;
#pragma unroll
    for (int j = 0; j < 4; ++j) { const int n = (lane >> 3) + 8 * j; const LAS float* s = scr + (8 * c) * 33 + n;
        u32x4 o; o.x = pk2(s[0 * 33], s[1 * 33]); o.y = pk2(s[2 * 33], s[3 * 33]); o.z = pk2(s[4 * 33], s[5 * 33]); o.w = pk2(s[6 * 33], s[7 * 33]);
        *(u32x4*)(WT + (size_t)(n0 + n) * K + k0 + 8 * c) = o; }
    asm volatile("s_waitcnt lgkmcnt(0)" ::: "memory");
}

__device__ __forceinline__ void p0_phase(CArgs& a, LAS unsigned char* lds) {
    const int tid = ptid(), lane = tid & 63, wave = tid >> 6;
    float* MOD = (float*)(a.ws + WS_MOD);
    {
        LAS float* sl = (LAS float*)lds;
        LAS float* red = (LAS float*)(lds + 40960);
        for (int i = tid; i < 9 * 1024; i += 512) { const int r = i >> 10, k = i & 1023; const float v = r < 8 ? a.c[r * 1024 + k] : a.c_ctx[k]; sl[i] = v * sigmoidf_(v); }
        __syncthreads();
        for (int it = blockIdx.x; it < 2 * 144; it += gridDim.x) {
            const int l = it / 144, n0 = (it % 144) * 64;
            const float* W = a.w_mod + (size_t)l * 1024 * MODW + n0 + lane;
            float acc[9];
#pragma unroll
            for (int r = 0; r < 9; ++r) acc[r] = 0.f;
#pragma unroll 8
            for (int kk = 0; kk < 128; ++kk) { const int k = wave * 128 + kk; const float wv = W[(size_t)k * MODW];
#pragma unroll
                for (int r = 0; r < 9; ++r) acc[r] += sl[r * 1024 + k] * wv; }
#pragma unroll
            for (int r = 0; r < 9; ++r) red[(wave * 9 + r) * 64 + lane] = acc[r];
            __syncthreads();
            for (int i = tid; i < 9 * 64; i += 512) { const int r = i >> 6, cidx = i & 63; float s = a.b_mod[l * MODW + n0 + cidx];
#pragma unroll
                for (int w = 0; w < 8; ++w) s += red[(w * 9 + r) * 64 + cidx];
                MOD[((size_t)l * 9 + r) * MODW + n0 + cidx] = s; }
            __syncthreads();
        }
        __syncthreads();
    }
    LAS float* scr = (LAS float*)(lds + wave * 8448);
    const int gw = blockIdx.x * 8 + wave, NGW = gridDim.x * 8;
    constexpr int I_GU = 176 * 16, I_D = 32 * 44, I_IN = 72 * 16, I_G = 128 * 16, I_BR = 32 * 16, I_OUT = 32 * 16, I_MLA = 32 * 6;
    constexpr int I_LAYER = 2 * I_GU + 2 * I_D + I_IN + I_G + I_BR + I_OUT + I_MLA;
    for (int it = gw; it < 2 * I_LAYER; it += NGW) {
        const int l = it / I_LAYER; int r = it % I_LAYER;
        unsigned char* wb = a.ws + WS_W + (size_t)l * W_LAYER;
        if (r < 2 * I_GU) { const int s = r / I_GU; r %= I_GU;
            const float* wg = a.w_gate + (size_t)(l * 2 + s) * 1024 * DFF; const float* wu = a.w_up + (size_t)(l * 2 + s) * 1024 * DFF;
            conv_item((bf16_t*)(wb + W_GU + s * W_GU_SZ), 1024, 176, r, scr, lane, [=](int n, int k) { const int j = (n >> 8) * 128 + (n & 127); return ((n >> 7) & 1) ? wu[(size_t)k * DFF + j] : wg[(size_t)k * DFF + j]; });
            continue; }
        r -= 2 * I_GU;
        if (r < 2 * I_D) { const int s = r / I_D; r %= I_D;
            const float* wd = a.w_down + (size_t)(l * 2 + s) * DFF * 1024;
            conv_item((bf16_t*)(wb + W_D + s * W_D_SZ), DFF, 32, r, scr, lane, [=](int n, int k) { return wd[(size_t)k * 1024 + n]; });
            continue; }
        r -= 2 * I_D;
        const float* win = a.w_in + (size_t)l * 1024 * INCOLS;
        if (r < I_IN) { conv_item((bf16_t*)(wb + W_IN), 1024, 72, r, scr, lane, [=](int n, int k) { return n < GATE0 ? win[(size_t)k * INCOLS + n] : 0.f; }); continue; }
        r -= I_IN;
        if (r < I_G) { conv_item((bf16_t*)(wb + W_G), 1024, 128, r, scr, lane, [=](int n, int k) { return win[(size_t)k * INCOLS + GATE0 + n]; }); continue; }
        r -= I_G;
        if (r < I_BR) { const float* wbr = a.w_branch + (size_t)l * 4 * 256 * 1024;
            conv_item((bf16_t*)(wb + W_BR), 1024, 32, r, scr, lane, [=](int n, int k) { return wbr[(size_t)k * 1024 + n]; }); continue; }
        r -= I_BR;
        if (r < I_OUT) { const float* wo = a.w_out + (size_t)l * 1024 * 1024;
            conv_item((bf16_t*)(wb + W_OUT), 1024, 32, r, scr, lane, [=](int n, int k) { return wo[(size_t)k * 1024 + n]; }); continue; }
        r -= I_OUT;
        { const float* uq = a.w_uq + (size_t)l * 256 * 384; const float* ukv = a.w_ukv + (size_t)l * 128 * 512; const float* gq = a.mla_qn + l * 256; const float* gkv = a.mla_kvn + l * 128;
            conv_item((bf16_t*)(wb + W_MLA), 384, 32, r, scr, lane, [=](int n, int k) {
                float v = 0.f;
                if (n < 384) { if (k < 256) v = gq[k] * uq[(size_t)k * 384 + n]; }
                else if (n < 896) { if (k >= 256) v = gkv[k - 256] * ukv[(size_t)(k - 256) * 512 + (n - 384)]; }
                return v; }); }
    }
}

__device__ __forceinline__ void row_phase(CArgs& a, int l, bool first, const bf16_t* Y, int sub_y, float gscale, bf16_t* U, int sub_u, int l_u) {
    const int tid_ = ptid(); const int lane = tid_ & 63, wave = tid_ >> 6;
    const int gw = blockIdx.x * 8 + wave, NGW = gridDim.x * 8;
    const float* MOD = (const float*)(a.ws + WS_MOD);
    float* XC = (float*)(a.ws + WS_XC);
#pragma unroll 2
    for (int row = gw; row < R; row += NGW) {
        const int b = row / RPB, t = row % RPB; const bool isctx = t < CTX;
        const float* xs; float* xd;
        if (isctx) { const size_t o = (size_t)(b * CTX + t) * DM; xs = (first ? a.ctx : XC) + o; xd = XC + o; }
        else { const size_t o = (size_t)(b * SEQ + (t - CTX)) * DM; xs = (first ? a.x : a.out) + o; xd = a.out + o; }
        const int mrow = isctx ? 8 : b;
        f32x4 v[4];
#pragma unroll
        for (int j = 0; j < 4; ++j) v[j] = *(const f32x4*)(xs + 4 * lane + 256 * j);
        if (Y) {
            const float* md = MOD + ((size_t)l * 9 + mrow) * MODW + (sub_y * 3 + 2) * 1024;
            const float* gp = a.g_post + (l * 3 + sub_y) * 1024;
            f32x4 y[4]; float ss = 0.f;
#pragma unroll
            for (int j = 0; j < 4; ++j) { const u32x2 w = *(const u32x2*)(Y + (size_t)row * DM + 4 * lane + 256 * j);
                y[j] = (f32x4){bflo(w.x), bfhi(w.x), bflo(w.y), bfhi(w.y)}; ss += (y[j].x * y[j].x + y[j].y * y[j].y) + (y[j].z * y[j].z + y[j].w * y[j].w); }
            const float rs = __builtin_amdgcn_rsqf(wave_sum(ss) * (1.f / DM) + EPS) * gscale;
#pragma unroll
            for (int j = 0; j < 4; ++j) { const f32x4 g = *(const f32x4*)(md + 4 * lane + 256 * j), p = *(const f32x4*)(gp + 4 * lane + 256 * j);
                v[j] = v[j] + (y[j] * rs) * p * g; *(f32x4*)(xd + 4 * lane + 256 * j) = v[j]; }
        }
        if (U) {
            const float* md = MOD + ((size_t)l_u * 9 + mrow) * MODW + (sub_u * 3) * 1024;
            const float* gp = a.g_pre + (l_u * 3 + sub_u) * 1024;
            float ss = 0.f;
#pragma unroll
            for (int j = 0; j < 4; ++j) ss += (v[j].x * v[j].x + v[j].y * v[j].y) + (v[j].z * v[j].z + v[j].w * v[j].w);
            const float rs = __builtin_amdgcn_rsqf(wave_sum(ss) * (1.f / DM) + EPS);
#pragma unroll
            for (int j = 0; j < 4; ++j) { const f32x4 sh = *(const f32x4*)(md + 4 * lane + 256 * j), sc = *(const f32x4*)(md + 1024 + 4 * lane + 256 * j), p = *(const f32x4*)(gp + 4 * lane + 256 * j);
                const f32x4 u = (v[j] * rs) * p * (sc + 1.f) + sh;
                u32x2 w; w.x = pk2(u.x, u.y); w.y = pk2(u.z, u.w);
                *(u32x2*)(U + (size_t)row * DM + 4 * lane + 256 * j) = w; }
        }
    }
}

constexpr int VSTR = 136;
constexpr int TAB_OFF = 768 * VSTR;
__device__ __forceinline__ void rope64p(float& v0, float& v1, int l, bool lat, const LAS float* tab, int prow, int pcol) {
    const float p0 = __shfl_xor(v0, 8), p1 = __shfl_xor(v1, 8);
    const int lh = l & 31, pos = (lh & 16) ? pcol : prow, i0 = (2 * lh) & 15;
    const f32x4 cs = *(const LAS f32x4*)(tab + (pos * 16 + i0) * 2);
    const bool sec = (lh >> 3) & 1;
    const float c0 = lat ? cs[0] : 1.f, s0 = lat ? (sec ? cs[1] : -cs[1]) : 0.f, c1 = lat ? cs[2] : 1.f, s1 = lat ? (sec ? cs[3] : -cs[3]) : 0.f;
    v0 = v0 * c0 + p0 * s0; v1 = v1 * c1 + p1 * s1;
}
__device__ __forceinline__ void rope32p(float& v0, float& v1, int d0, bool lat, const LAS float* tab, int prow, int pcol) {
    const float p0 = __shfl_xor(v0, 4), p1 = __shfl_xor(v1, 4);
    const int pos = (d0 & 16) ? pcol : prow, i0 = d0 & 7;
    const LAS float* t = tab + (pos * 16 + 2 * i0) * 2;
    const bool sec = (d0 >> 3) & 1;
    const float c0 = lat ? t[0] : 1.f, s0 = lat ? (sec ? t[1] : -t[1]) : 0.f, c1 = lat ? t[4] : 1.f, s1 = lat ? (sec ? t[5] : -t[5]) : 0.f;
    v0 = v0 * c0 + p0 * s0; v1 = v1 * c1 + p1 * s1;
}
__device__ __forceinline__ float half_sum(float v) {
#pragma unroll
    for (int o = 1; o < 32; o <<= 1) v += __shfl_xor(v, o);
    return v;
}
__device__ __forceinline__ void prep_phase(CArgs& a, int l, LAS unsigned char* lds) {
    const int tid = ptid(), lane = tid & 63, wave = __builtin_amdgcn_readfirstlane(tid >> 6);
    bf16_t* HIN = (bf16_t*)(a.ws + WS_BIG); bf16_t* MUP = (bf16_t*)(a.ws + WS_Y); bf16_t* VT = (bf16_t*)(a.ws + WS_VT);
    LAS float* tab = (LAS float*)(lds + TAB_OFF);
    for (int i = tid; i < 128 * 16; i += 512) { const int pos = i >> 4, f = i & 15;
        const float invf = fexp2(-(float)(2 * f) * (1.f / 32.f) * 13.287712379549449f);
        float rev = (float)pos * invf * 0.15915494309189535f; rev -= __builtin_floorf(rev);
        tab[i * 2] = __builtin_amdgcn_cosf(rev); tab[i * 2 + 1] = __builtin_amdgcn_sinf(rev); }
    __syncthreads();
    const int lh = lane & 31;
    const float gq0 = a.gqa_qn[l * 64 + 2 * lh], gq1 = a.gqa_qn[l * 64 + 2 * lh + 1], gk0 = a.gqa_kn[l * 64 + 2 * lh], gk1 = a.gqa_kn[l * 64 + 2 * lh + 1];
#define LD2(p, v0, v1) do { const unsigned w_ = *(const unsigned*)(p); v0 = bflo(w_); v1 = bfhi(w_); } while (0)
#define ST2(p, v0, v1) do { *(unsigned*)(p) = pg8::cvt_pk_bf16(v0, v1); } while (0)
    for (int tile = blockIdx.x; tile < R / 64; tile += gridDim.x) {
        const int row0 = tile * 64, b = row0 / RPB, t0 = row0 % RPB;
#pragma unroll 4
        for (int rr = 0; rr < 8; ++rr) {
            const int tk = wave * 8 + rr, row = row0 + tk, t = t0 + tk; const bool lat = t >= CTX;
            const int tl = lat ? t - CTX : 0, prow = tl >> 6, pcol = tl & 63;
            bf16_t* __restrict__ h = HIN + (size_t)row * NHIN; bf16_t* __restrict__ mu = MUP + (size_t)row * 1024;
            LAS bf16_t* vst = (LAS bf16_t*)lds + tk;
#pragma unroll
            for (int j = 0; j < 3; ++j) { float v0, v1; LD2(h + 128 * j + 2 * lane, v0, v1);
                const float rs = __builtin_amdgcn_rsqf(half_sum(v0 * v0 + v1 * v1) * (1.f / 64.f) + EPS);
                v0 = v0 * rs * (j < 2 ? gq0 : gk0); v1 = v1 * rs * (j < 2 ? gq1 : gk1);
                rope64p(v0, v1, lane, lat, tab, prow, pcol);
                if (j < 2) { v0 *= QS_GQA; v1 *= QS_GQA; }
                ST2(h + 128 * j + 2 * lane, v0, v1); }
            { const unsigned w = *(const unsigned*)(h + 384 + 2 * lane); vst[(0 + 2 * lane) * (VSTR / 2)] = (bf16_t)(w & 0xffffu); vst[(0 + 2 * lane + 1) * (VSTR / 2)] = (bf16_t)(w >> 16); }
            float sq = 0.f, skv = 0.f;
#pragma unroll
            for (int j = 0; j < 2; ++j) { float v0, v1; LD2(h + 512 + 128 * j + 2 * lane, v0, v1); sq += v0 * v0 + v1 * v1; }
            { float v0, v1; LD2(h + 768 + 2 * lane, v0, v1); skv = v0 * v0 + v1 * v1; }
            const float rq = __builtin_amdgcn_rsqf(wave_sum(sq) * (1.f / 256.f) + EPS) * QS_MLA, rkv = __builtin_amdgcn_rsqf(wave_sum(skv) * (1.f / 128.f) + EPS);
#pragma unroll
            for (int j = 0; j < 3; ++j) { const int c = 128 * j + 2 * lane, e = c % 96; float v0, v1; LD2(mu + c, v0, v1); v0 *= rq; v1 *= rq;
                float r0 = v0, r1 = v1; rope32p(r0, r1, (e - 64) & 30, lat, tab, prow, pcol);
                if (e >= 64) { v0 = r0; v1 = r1; }
                ST2(mu + c, v0, v1); }
#pragma unroll
            for (int hh = 0; hh < 4; ++hh) { const int c = 384 + 128 * hh + 2 * lane; float v0, v1; LD2(mu + c, v0, v1); v0 *= rkv; v1 *= rkv;
                const unsigned w = pg8::cvt_pk_bf16(v0, v1);
                if (lane < 32) *(unsigned*)(mu + c) = w;
                else { vst[(128 + 64 * hh + 2 * (lane - 32)) * (VSTR / 2)] = (bf16_t)(w & 0xffffu); vst[(128 + 64 * hh + 2 * (lane - 32) + 1) * (VSTR / 2)] = (bf16_t)(w >> 16); } }
            { float v0, v1; LD2(h + 896 + 2 * (lane & 15), v0, v1); rope32p(v0, v1, 2 * (lane & 15), lat, tab, prow, pcol); if (lane < 16) ST2(mu + 896 + 2 * lane, v0, v1); }
#pragma unroll
            for (int j = 0; j < 4; ++j) { float v0, v1; LD2(h + 928 + 128 * j + 2 * lane, v0, v1); rope32p(v0, v1, (2 * lane) & 31, lat, tab, prow, pcol);
                if (j < 2) { v0 *= QS_DIFF; v1 *= QS_DIFF; }
                ST2(h + 928 + 128 * j + 2 * lane, v0, v1); }
#pragma unroll
            for (int j = 0; j < 2; ++j) { const unsigned w = *(const unsigned*)(h + 1440 + 128 * j + 2 * lane); vst[(384 + 128 * j + 2 * lane) * (VSTR / 2)] = (bf16_t)(w & 0xffffu); vst[(384 + 128 * j + 2 * lane + 1) * (VSTR / 2)] = (bf16_t)(w >> 16); }
#pragma unroll
            for (int j = 0; j < 3; ++j) { float v0, v1; LD2(h + 1696 + 128 * j + 2 * lane, v0, v1); rope64p(v0, v1, lane, lat, tab, prow, pcol);
                if (j < 2) { v0 *= QS_GQA; v1 *= QS_GQA; }
                ST2(h + 1696 + 128 * j + 2 * lane, v0, v1); }
            { const unsigned w = *(const unsigned*)(h + 2080 + 2 * lane); vst[(640 + 2 * lane) * (VSTR / 2)] = (bf16_t)(w & 0xffffu); vst[(640 + 2 * lane + 1) * (VSTR / 2)] = (bf16_t)(w >> 16); }
        }
#undef LD2
#undef ST2
        __syncthreads();
        bf16_t* vt = VT + (size_t)b * 768 * RPB + t0;
        for (int p = tid; p < 768 * 8; p += 512) { const int vr = p >> 3, seg = p & 7;
            const LAS u32x2* s = (const LAS u32x2*)(lds + vr * VSTR + seg * 16); const u32x2 lo = s[0], hi = s[1];
            *(u32x4*)(vt + (size_t)vr * RPB + seg * 8) = (u32x4){lo.x, lo.y, hi.x, hi.y}; }
        __syncthreads();
    }
}

__device__ __forceinline__ int crow(int r, int hi) { return (r & 3) + 8 * (r >> 2) + 4 * hi; }
constexpr int AT_KBUF = 128 * (96 * 2 + 16);
constexpr int AT_VSTR = 272, AT_VBUF = 64 * AT_VSTR;
constexpr int AT_K0 = 0, AT_V0 = 2 * AT_KBUF, AT_WS = AT_V0 + 2 * AT_VBUF;

struct AttnSrc { const bf16_t* Q; int ldq; const bf16_t* K1; int ldk1; const bf16_t* K2; int ldk2; const bf16_t* VT; };

template <int DQK, bool WIN>
__device__ __forceinline__ void attn_pass(const AttnSrc& s, int NT, int lo, int q0lat, float sink_l2, bool has_sink, LAS unsigned char* lds, f32x16 (&o)[2]) {
    constexpr int KSTR = DQK * 2 + 16, NCH = DQK / 8, NKS = DQK / 16, NP = (128 * NCH) / 512;
    const int tid = ptid(), lane = tid & 63, r32 = lane & 31, hi = lane >> 5; const int wid = __builtin_amdgcn_readfirstlane(tid >> 6);
    LAS float* wsf = (LAS float*)(lds + AT_WS) + wid * 32;
    bf16x8 qf[NKS];
    { const bf16_t* qp = s.Q + (size_t)(wid * 32 + r32) * s.ldq + 8 * hi;
#pragma unroll
        for (int ks = 0; ks < NKS; ++ks) qf[ks] = *(const bf16x8*)(qp + 16 * ks); }
    o[0] = (f32x16){}; o[1] = (f32x16){};
    f32x16 negm = (f32x16){}; asm volatile("" : "+v"(negm));
    float mhat = 0.f, lsum = 0.f;
    const int NT2 = NT >> 1, lo2 = lo >> 1;
    u32x4 kr[NP], vr[2];
    auto kaddr = [&](int key, int c) -> const bf16_t* { return (DQK == 96 && c >= 8) ? s.K2 + (size_t)key * s.ldk2 + (c - 8) * 8 : s.K1 + (size_t)key * s.ldk1 + c * 8; };
#define AT_TILE(j) ((j) < 2 ? (j) : lo2 - 2 + (j))
#define AT_GLOAD(j) do { const int key0_ = AT_TILE(j) * 128; \
        _Pragma("unroll") for (int p = 0; p < NP; ++p) { const int idx_ = tid + 512 * p; kr[p] = *(const u32x4*)kaddr(key0_ + idx_ / NCH, idx_ % NCH); } \
        _Pragma("unroll") for (int p = 0; p < 2; ++p) { const int idx_ = tid + 512 * p; vr[p] = *(const u32x4*)(s.VT + (size_t)(idx_ >> 4) * RPB + key0_ + (idx_ & 15) * 8); } } while (0)
#define AT_LSTORE(buf) do { \
        _Pragma("unroll") for (int p = 0; p < NP; ++p) { const int idx_ = tid + 512 * p; *(LAS u32x4*)(lds + AT_K0 + (buf) * AT_KBUF + (idx_ / NCH) * KSTR + (idx_ % NCH) * 16) = kr[p]; } \
        _Pragma("unroll") for (int p = 0; p < 2; ++p) { const int idx_ = tid + 512 * p; *(LAS u32x4*)(lds + AT_V0 + (buf) * AT_VBUF + (idx_ >> 4) * AT_VSTR + (idx_ & 15) * 16) = vr[p]; } } while (0)
#define MX3(a, b, c) __builtin_fmaxf(__builtin_fmaxf((a), (b)), (c))
    AT_GLOAD(0); AT_LSTORE(0);
    if (NT2 > 1) AT_GLOAD(1);
    __syncthreads();
    for (int j = 0; j < NT2; ++j) {
        const int buf = j & 1;
        f32x16 sA0, sA1, sB0, sB1;
#define AT_QK(S0, S1, sub) do { const LAS unsigned char* kb = lds + AT_K0 + buf * AT_KBUF + ((sub) * 64 + r32) * KSTR + hi * 16; \
        _Pragma("unroll") for (int ks = 0; ks < NKS; ++ks) { \
            const bf16x8 a0 = *(const LAS bf16x8*)(kb + ks * 32), a1 = *(const LAS bf16x8*)(kb + 32 * KSTR + ks * 32); \
            if (ks == 0) { S0 = __builtin_amdgcn_mfma_f32_32x32x16_bf16(a0, qf[0], negm, 0, 0, 0); S1 = __builtin_amdgcn_mfma_f32_32x32x16_bf16(a1, qf[0], negm, 0, 0, 0); } \
            else { S0 = __builtin_amdgcn_mfma_f32_32x32x16_bf16(a0, qf[ks], S0, 0, 0, 0); S1 = __builtin_amdgcn_mfma_f32_32x32x16_bf16(a1, qf[ks], S1, 0, 0, 0); } } } while (0)
#define AT_SOFT(s0, s1, u0, u1, sub, HASNEXT) do { \
        if (WIN && j >= 2) { \
            const int jb = AT_TILE(j) * 128 + (sub) * 64 - CTX + 4 * hi, qi = q0lat + wid * 32 + r32; \
            _Pragma("unroll") for (int r = 0; r < 16; ++r) { const int jj = jb + (r & 3) + 8 * (r >> 2); const int d0 = qi - jj, d1 = qi - (jj + 32); \
                if (d0 > 128 || d0 < -128) s0[r] = -1e30f; if (d1 > 128 || d1 < -128) s1[r] = -1e30f; } } \
        float ra = MX3(s0[0], s0[1], s1[0]), rb = MX3(s0[2], s0[3], s1[1]); ra = MX3(ra, s1[2], s1[3]); \
        _Pragma("unroll") for (int r = 4; r < 16; r += 4) { ra = MX3(ra, s0[r], s0[r + 1]); rb = MX3(rb, s0[r + 2], s0[r + 3]); ra = MX3(ra, s1[r], s1[r + 1]); rb = MX3(rb, s1[r + 2], s1[r + 3]); } \
        float rm = __builtin_fmaxf(ra, rb); rm = __builtin_fmaxf(rm, __shfl_xor(rm, 32)); \
        const bool first = (j == 0) && ((sub) == 0); \
        if (first || __any(rm > 8.f)) { const float dl = first ? rm : __builtin_fmaxf(rm, 0.f); mhat += dl; \
            _Pragma("unroll") for (int r = 0; r < 16; ++r) { s0[r] -= dl; s1[r] -= dl; } \
            if (HASNEXT) { _Pragma("unroll") for (int r = 0; r < 16; ++r) { u0[r] -= dl; u1[r] -= dl; } }     \
            _Pragma("unroll") for (int r = 0; r < 16; ++r) negm[r] = -mhat; \
            asm volatile("" : "+v"(negm)); \
            if (!first) { const float f = fexp2(-dl); lsum *= f; if (hi == 0) wsf[r32] = f; \
                _Pragma("unroll") for (int r = 0; r < 16; ++r) { const float fr_ = wsf[crow(r, hi)]; o[0][r] *= fr_; o[1][r] *= fr_; } } } \
        float ps = 0.f, ps2 = 0.f; \
        _Pragma("unroll") for (int r = 0; r < 16; ++r) { s0[r] = fexp2(s0[r]); s1[r] = fexp2(s1[r]); ps += s0[r]; ps2 += s1[r]; } \
        lsum += ps + ps2; \
        bf16x8 pa[4]; \
        _Pragma("unroll") for (int kk = 0; kk < 2; ++kk) { u32x4 w; \
            w.x = pg8::cvt_pk_bf16(s0[8 * kk + 0], s0[8 * kk + 1]); w.y = pg8::cvt_pk_bf16(s0[8 * kk + 2], s0[8 * kk + 3]); w.z = pg8::cvt_pk_bf16(s0[8 * kk + 4], s0[8 * kk + 5]); w.w = pg8::cvt_pk_bf16(s0[8 * kk + 6], s0[8 * kk + 7]); pa[kk] = __builtin_bit_cast(bf16x8, w); \
            w.x = pg8::cvt_pk_bf16(s1[8 * kk + 0], s1[8 * kk + 1]); w.y = pg8::cvt_pk_bf16(s1[8 * kk + 2], s1[8 * kk + 3]); w.z = pg8::cvt_pk_bf16(s1[8 * kk + 4], s1[8 * kk + 5]); w.w = pg8::cvt_pk_bf16(s1[8 * kk + 6], s1[8 * kk + 7]); pa[2 + kk] = __builtin_bit_cast(bf16x8, w); } \
        const LAS unsigned char* vb = lds + AT_V0 + buf * AT_VBUF + r32 * AT_VSTR + (sub) * 128 + hi * 8; \
        _Pragma("unroll") for (int dvb = 0; dvb < 2; ++dvb) _Pragma("unroll") for (int kk = 0; kk < 4; ++kk) { \
                const u32x2 lo_ = *(const LAS u32x2*)(vb + dvb * 32 * AT_VSTR + kk * 32), hi_ = *(const LAS u32x2*)(vb + dvb * 32 * AT_VSTR + kk * 32 + 16); \
                const bf16x8 bv = __builtin_bit_cast(bf16x8, (u32x4){lo_.x, lo_.y, hi_.x, hi_.y}); \
                o[dvb] = __builtin_amdgcn_mfma_f32_32x32x16_bf16(pa[kk], bv, o[dvb], 0, 0, 0); } } while (0)
        AT_QK(sA0, sA1, 0); AT_QK(sB0, sB1, 1);
        AT_SOFT(sA0, sA1, sB0, sB1, 0, true);
        AT_SOFT(sB0, sB1, sA0, sA1, 1, false);
#undef AT_QK
#undef AT_SOFT
        if (j + 1 < NT2) AT_LSTORE(buf ^ 1);
        __syncthreads();
        if (j + 2 < NT2) AT_GLOAD(j + 2);
    }
    float lt = lsum + __shfl_xor(lsum, 32);
    if (has_sink) lt += fexp2(sink_l2 - mhat);
    if (hi == 0) wsf[r32] = frcp(lt);
#pragma unroll
    for (int r = 0; r < 16; ++r) { const float fr_ = wsf[crow(r, hi)]; o[0][r] *= fr_; o[1][r] *= fr_; }
#undef AT_TILE
#undef AT_GLOAD
#undef AT_LSTORE
#undef MX3
}

__device__ __forceinline__ void attn_store(bf16_t* O, int row0, int col0, const f32x16 (&o)[2]) {
    const int tid_ = ptid(); const int lane = tid_ & 63, r32 = lane & 31, hi = lane >> 5, wid = tid_ >> 6;
#pragma unroll
    for (int dvb = 0; dvb < 2; ++dvb)
#pragma unroll
        for (int r = 0; r < 16; ++r) O[(size_t)(row0 + wid * 32 + crow(r, hi)) * 1024 + col0 + dvb * 32 + r32] = (bf16_t)f2bf(o[dvb][r]);
}

__device__ __forceinline__ void attn_unit(CArgs& a, int l, int branch, int b, int h, int qb, float lam, float lam_init, LAS unsigned char* lds) {
    const bf16_t* HIN = (const bf16_t*)(a.ws + WS_BIG) + (size_t)b * RPB * NHIN; const bf16_t* MUP = (const bf16_t*)(a.ws + WS_Y) + (size_t)b * RPB * 1024;
    const bf16_t* VT = (const bf16_t*)(a.ws + WS_VT) + (size_t)b * 768 * RPB; bf16_t* OUTS = (bf16_t*)(a.ws + WS_OUTS);
    const bool cq = qb < 0; const int qrow = cq ? 0 : CTX + 256 * qb;
    const int NTd = cq ? 4 : 132;
    const int orow0 = b * RPB + qrow;
    f32x16 o[2];
    AttnSrc s;
    if (branch == 0) {
        s.Q = HIN + (size_t)qrow * NHIN + 64 * h; s.ldq = NHIN; s.K1 = HIN + 256 + 64 * (h >> 1); s.ldk1 = NHIN; s.K2 = nullptr; s.ldk2 = 0; s.VT = VT + (size_t)(0 + 64 * (h >> 1)) * RPB;
        attn_pass<64, false>(s, NTd, 4, 0, 0.f, false, lds, o);
        attn_store(OUTS, orow0, 0 + 64 * h, o);
    } else if (branch == 1) {
        s.Q = MUP + (size_t)qrow * 1024 + 96 * h; s.ldq = 1024; s.K1 = MUP + 384 + 128 * h; s.ldk1 = 1024; s.K2 = MUP + 896; s.ldk2 = 1024; s.VT = VT + (size_t)(128 + 64 * h) * RPB;
        attn_pass<96, false>(s, NTd, 4, 0, 0.f, false, lds, o);
        attn_store(OUTS, orow0, 256 + 64 * h, o);
    } else if (branch == 2) {
        f32x16 o2[2];
        s.Q = HIN + (size_t)qrow * NHIN + 928 + 64 * h; s.ldq = NHIN; s.K1 = HIN + 1184 + 64 * h; s.ldk1 = NHIN; s.K2 = nullptr; s.ldk2 = 0; s.VT = VT + (size_t)(384 + 64 * h) * RPB;
        attn_pass<32, false>(s, NTd, 4, 0, 0.f, false, lds, o);
        s.Q += 32; s.K1 += 32;
        attn_pass<32, false>(s, NTd, 4, 0, 0.f, false, lds, o2);
        const int lane = ptid() & 63, r32 = lane & 31;
        const float g0 = a.dsub[l * 64 + r32] * (1.f - lam_init), g1 = a.dsub[l * 64 + 32 + r32] * (1.f - lam_init);
#pragma unroll
        for (int r = 0; r < 16; ++r) { const float x0 = o[0][r] - lam * o2[0][r], x1 = o[1][r] - lam * o2[1][r];
            float ss = x0 * x0 + x1 * x1;
#pragma unroll
            for (int m = 1; m < 32; m <<= 1) ss += __shfl_xor(ss, m);
            const float rs = __builtin_amdgcn_rsqf(ss * (1.f / 64.f) + EPS);
            o[0][r] = x0 * rs * g0; o[1][r] = x1 * rs * g1; }
        attn_store(OUTS, orow0, 512 + 64 * h, o);
    } else {
        s.Q = HIN + (size_t)qrow * NHIN + 1696 + 64 * h; s.ldq = NHIN; s.K1 = HIN + 1952 + 64 * (h >> 1); s.ldk1 = NHIN; s.K2 = nullptr; s.ldk2 = 0; s.VT = VT + (size_t)(640 + 64 * (h >> 1)) * RPB;
        const float sk = a.sink[l * 4 + h] * LOG2E;
        if (cq) attn_pass<64, false>(s, 4, 4, 0, sk, true, lds, o);
        else { const int q0 = 256 * qb; const int lo = 4 + (q0 >= 128 ? q0 - 128 : 0) / 64, hiT = 4 + ((q0 + 384) < SEQ ? (q0 + 384) : SEQ) / 64;
            attn_pass<64, true>(s, 4 + hiT - lo, lo, q0, sk, true, lds, o); }
        attn_store(OUTS, orow0, 768 + 64 * h, o);
    }
}

__device__ __forceinline__ void attn_phase(CArgs& a, int l, LAS unsigned char* lds) {
    const float lam_init = 0.8f - 0.6f * __expf(-0.3f * (float)l);
    float lam;
    { const float* dl = a.dlam + l * 128; float s1 = 0.f, s2 = 0.f;
        for (int i = 0; i < 32; ++i) { s1 += dl[i] * dl[32 + i]; s2 += dl[64 + i] * dl[96 + i]; }
        lam = __expf(s1) - __expf(s2) + lam_init; }
    const int G = gridDim.x, bx = blockIdx.x;
    const int vcu = (G % 8 == 0) ? (bx % 8) * (G / 8) + bx / 8 : bx;
    for (int ty = 0; ty < 4; ++ty) {
        const int branch = ty == 0 ? 2 : ty == 1 ? 1 : ty == 2 ? 0 : 3;
        for (int idx = vcu; idx < NB * 4 * 32; idx += G) { const int bh = idx >> 5, qb = idx & 31; attn_unit(a, l, branch, bh >> 2, bh & 3, qb, lam, lam_init, lds); }
    }
    for (int idx = vcu; idx < NB * 16; idx += G) attn_unit(a, l, (idx >> 2) & 3, idx >> 4, idx & 3, -1, lam, lam_init, lds);
}

#define GAS __attribute__((address_space(1)))
#define XB_TMO      128
#define XB_XCNT(j)  (256  + 64 * (j))
#define XB_XSUB(j)  (1280 + 64 * (j))
#define XB_XGEN(j)  (2304 + 64 * (j))
#define XB_TOP      3328
#define XB_TOPGEN   3392
#define XCD_BAR_WORDS 3456
#define XB_SPIN_CAP (1u << 18)

__device__ __forceinline__ unsigned xb_ld(unsigned* p)              { return __hip_atomic_load(p, __ATOMIC_RELAXED, __HIP_MEMORY_SCOPE_AGENT); }
__device__ __forceinline__ unsigned xb_add(unsigned* p, unsigned v) { return __hip_atomic_fetch_add(p, v, __ATOMIC_RELAXED, __HIP_MEMORY_SCOPE_AGENT); }
__device__ __forceinline__ unsigned xb_xcc_id() { return (unsigned)__builtin_amdgcn_s_getreg((3 << 11) | 20) & 0xFu; }
#define XB_SPIN(cond, bar) do { unsigned _sp = 0; while (cond) { __builtin_amdgcn_s_sleep(1); \
    if ((++_sp & 255u) == 0u) { if (xb_ld(&(bar)[XB_TMO])) break; if (_sp > XB_SPIN_CAP) { atomicAdd(&(bar)[XB_TMO], 1u); break; } } } } while (0)

struct XcdBarrier {
    unsigned* bar; unsigned x;
    volatile LAS unsigned* st;
};

__device__ __forceinline__ XcdBarrier xcd_barrier_post(unsigned* bar, volatile LAS unsigned* st) {
    XcdBarrier b; b.bar = bar; b.x = xb_xcc_id(); b.st = st;
    if (threadIdx.x == 0) (void)xb_add(&bar[XB_XCNT(b.x)], 1u);
    return b;
}
__device__ __forceinline__ void xcd_barrier_complete(unsigned* bar, unsigned x, unsigned& nloc, unsigned& nx) {
    const unsigned G = gridDim.x * gridDim.y * gridDim.z;
    unsigned sum, cnt, mine, sp = 0u;
    for (;;) {
        sum = 0u; cnt = 0u; mine = 0u;
#pragma unroll
        for (unsigned j = 0; j < 16; ++j) { const unsigned c = xb_ld(&bar[XB_XCNT(j)]); sum += c; cnt += (c > 0u) ? 1u : 0u; mine = (j == x) ? c : mine; }
        if (sum == G) break;
        __builtin_amdgcn_s_sleep(1);
        if ((++sp & 255u) == 0u) { if (xb_ld(&bar[XB_TMO])) break; if (sp > XB_SPIN_CAP) { atomicAdd(&bar[XB_TMO], 1u); break; } }
    }
    nloc = mine > 0u ? mine : 1u; nx = cnt > 0u ? cnt : 1u;
}

__device__ __forceinline__ void xcd_barrier(const XcdBarrier& b) {
    asm volatile("s_waitcnt vmcnt(0)" ::: "memory");
    __syncthreads();
    if (threadIdx.x == 0) {
        unsigned* bar = b.bar;
        __builtin_amdgcn_s_waitcnt(0);
        unsigned nloc = b.st[0], nx = b.st[1];
        if (nloc == 0u) { xcd_barrier_complete(bar, b.x, nloc, nx); b.st[0] = nloc; b.st[1] = nx; }
        const unsigned old = xb_add(&bar[XB_XSUB(b.x)], 1u);
        const unsigned gen = old / nloc;
        if (old + 1u == (gen + 1u) * nloc) {
            __builtin_amdgcn_fence(__ATOMIC_RELEASE, "agent");
            asm volatile("s_waitcnt vmcnt(0)" ::: "memory");
            const unsigned og = xb_add(&bar[XB_TOP], 1u);
            const unsigned tg = og / nx;
            if (og + 1u == (tg + 1u) * nx) xb_add(&bar[XB_TOPGEN], 1u);
            else XB_SPIN(xb_ld(&bar[XB_TOPGEN]) == tg, bar);
            __builtin_amdgcn_fence(__ATOMIC_ACQUIRE, "agent");
            xb_add(&bar[XB_XGEN(b.x)], 1u);
            asm volatile("s_waitcnt vmcnt(0)" ::: "memory");
        } else {
            XB_SPIN(xb_ld(&bar[XB_XGEN(b.x)]) == gen, bar);
            __builtin_amdgcn_fence(__ATOMIC_ACQUIRE, "agent");
            asm volatile("s_waitcnt vmcnt(0)" ::: "memory");
        }
    }
    __syncthreads();
}


constexpr int NPHASE = 2 + 32;
__global__ void __launch_bounds__(512, 2) fwd_kernel(Args a_) {
    extern __shared__ __attribute__((aligned(16))) unsigned char lds_raw[];
    LAS unsigned char* lds = (LAS unsigned char*)lds_raw;
    cg::grid_group grid = cg::this_grid();
    const int lo = a_.ph_lo, hi = a_.ph_hi < NPHASE ? a_.ph_hi : NPHASE;
    { volatile LAS unsigned* st0 = (volatile LAS unsigned*)(lds + LDS_BARST); if (threadIdx.x < 2) st0[threadIdx.x] = 0u; }
    __syncthreads();
    { XcdBarrier b0 = xcd_barrier_post((unsigned*)(a_.ws + WS_BAR), (volatile LAS unsigned*)(lds + LDS_BARST)); (void)b0; }
    for (int ph = lo; ph < hi; ++ph) {
        CArgs* ap_ = (CArgs*)__builtin_amdgcn_kernarg_segment_ptr(); asm volatile("" : "+s"(ap_) :: "memory"); CArgs& a = *ap_;
        int G = gridDim.x, bx = blockIdx.x; asm volatile("" : "+s"(G), "+s"(bx));
        if (ph == 0) p0_phase(a, lds);
        else if (ph == 1) row_phase(a, 0, true, nullptr, 0, 0.f, (bf16_t*)(a.ws + WS_U), 0, 0);
        else {
            const int l = (ph - 2) / 16, k = (ph - 2) % 16;
            unsigned char* ws = a.ws;
            const unsigned char* wb = ws + WS_W + (size_t)l * W_LAYER;
            bf16_t* U = (bf16_t*)(ws + WS_U); bf16_t* Yb = (bf16_t*)(ws + WS_Y); bf16_t* BIG = (bf16_t*)(ws + WS_BIG);
            if (k == 5) prep_phase(a, l, lds);
#ifndef X_ATTN
            else if (k == 6) attn_phase(a, l, lds);
#endif
            else if (k == 2) row_phase(a, l, l == 0, Yb, 0, 0.5f, U, 1, l);
            else if (k == 12) row_phase(a, l, false, BIG, 1, 1.0f, U, 2, l);
            else if (k == 15) row_phase(a, l, false, Yb, 2, 0.5f, l == 0 ? U : nullptr, 0, l + 1);
            else {
                pg8::Gemm g; pg8::Epi E; int N; int dual = 0; int Mrows = R;
                g.A2 = nullptr; g.Bt2 = nullptr; E.scr = nullptr;
                if (k == 0 || k == 13) { const int s = k == 13; g.A = U; g.Bt = (const bf16_t*)(wb + W_GU + s * W_GU_SZ); g.lda = 1024; g.ldb = 1024; g.K = 1024; N = 5632; E.mode = 1; E.O = BIG; E.ldc = DFF; }
                else if (k == 1 || k == 14) { const int s = k == 14; g.A = BIG; g.Bt = (const bf16_t*)(wb + W_D + s * W_D_SZ); g.lda = DFF; g.ldb = DFF; g.K = DFF; N = 1024; E.mode = 0; E.O = Yb; E.ldc = 1024; }
                else if (k == 3) { g.A = U; g.Bt = (const bf16_t*)(wb + W_IN); g.lda = 1024; g.ldb = 1024; g.K = 1024; N = NHIN; E.mode = 0; E.O = BIG; E.ldc = NHIN; }
                else if (k == 4) { g.A = BIG + 512; g.Bt = (const bf16_t*)(wb + W_MLA); g.lda = NHIN; g.ldb = 384; g.K = 384; N = 1024; E.mode = 0; E.O = Yb; E.ldc = 1024; }
                else if (k == 7 || k == 9) { size_t ro = (size_t)(k == 9) * 32768 * 1024; Mrows = (k == 9) ? R - 32768 : 32768; if (l == 1) { ro = (size_t)(k == 9) * 33792 * 1024; Mrows = 32768; dual = 1; }
                    g.A = U + ro; g.Bt = (const bf16_t*)(wb + W_G); g.lda = 1024; g.ldb = 1024; g.K = 1024; N = 4096; E.mode = 3; E.O = BIG; E.ldc = 4096; }
                else if (k == 8 || k == 10) { size_t ro = (size_t)(k == 10) * 32768 * 1024; Mrows = (k == 10) ? R - 32768 : 32768; if (l == 1) { ro = (size_t)(k == 10) * 33792 * 1024; Mrows = 32768; dual = 1; }
                    g.A = (const bf16_t*)(ws + WS_OUTS) + ro; g.Bt = (const bf16_t*)(wb + W_BR); g.lda = 1024; g.ldb = 1024; g.K = 1024; N = 1024; E.mode = 4; E.O = Yb + ro; E.ldc = 1024; E.scr = (u32x4*)BIG; }
                else { g.A = Yb; g.Bt = (const bf16_t*)(wb + W_OUT); g.lda = 1024; g.ldb = 1024; g.K = 1024; N = 1024; E.mode = 0; E.O = BIG; E.ldc = 1024; }
                if (l == 1 && (k == 11 || k == 13 || k == 14)) { dual = 1; Mrows = 65536; }
                pg8::StaticOrder S; S.init(Mrows, N, G, bx, dual);
                if (k == 8 || k == 10) pg8::gemm_phase<true>(lds, g, S, E); else pg8::gemm_phase<false>(lds, g, S, E);
            }
        }
        if (ph + 1 < hi) {
            if (ph == lo) {
                asm volatile("s_waitcnt vmcnt(0) lgkmcnt(0)" ::: "memory");
                __syncthreads();
                if (ptid() < 64) { __builtin_amdgcn_fence(__ATOMIC_RELEASE, "agent"); asm volatile("s_waitcnt vmcnt(0)" ::: "memory"); }
                grid.sync();
                __builtin_amdgcn_fence(__ATOMIC_ACQUIRE, "agent");
                asm volatile("s_waitcnt vmcnt(0)" ::: "memory");
            } else {
                XcdBarrier bar; bar.bar = (unsigned*)(a.ws + WS_BAR); bar.x = xb_xcc_id(); bar.st = (volatile LAS unsigned*)(lds + LDS_BARST);
                xcd_barrier(bar);
                __builtin_amdgcn_fence(__ATOMIC_ACQUIRE, "agent");
                asm volatile("s_waitcnt vmcnt(0)" ::: "memory");
            }
        }
    }
}

extern "C" void kernel_launch(void* const* d_in, const int* in_sizes, int n_in, void* d_out, int out_size, void* d_ws, size_t ws_size, hipStream_t stream) {
    static int grid = 0;
    if (grid == 0) {
        int dev = 0, cus = 0;
        if (hipGetDevice(&dev) != hipSuccess || hipDeviceGetAttribute(&cus, hipDeviceAttributeMultiprocessorCount, dev) != hipSuccess) { grid = -1; return; }
        if (hipFuncSetAttribute((const void*)fwd_kernel, hipFuncAttributeMaxDynamicSharedMemorySize, LDS_BYTES) != hipSuccess) { fprintf(stderr, "hipFuncSetAttribute failed\n"); grid = -1; return; }
        int per_cu = 0;
        if (hipOccupancyMaxActiveBlocksPerMultiprocessor(&per_cu, (const void*)fwd_kernel, 512, LDS_BYTES) != hipSuccess || per_cu < 1) fprintf(stderr, "occupancy query: %d\n", per_cu);
        (void)hipGetLastError();
        grid = cus;
        if (ws_size < WS_END) { fprintf(stderr, "workspace too small\n"); grid = -1; return; }
    }
    if (grid < 0) return;
    if (hipMemsetAsync((char*)d_ws + WS_BAR, 0, 16384, stream) != hipSuccess) { fprintf(stderr, "memset failed\n"); return; }
    Args a{};
    const float** p = (const float**)&a;
    for (int i = 0; i < 23; ++i) p[i] = (const float*)d_in[i];
    a.out = (float*)d_out; a.ws = (unsigned char*)d_ws; a.ph_lo = 0; a.ph_hi = 1000;
    void* args[] = {&a};
    hipError_t e = hipLaunchCooperativeKernel((const void*)fwd_kernel, dim3(grid), dim3(512), args, LDS_BYTES, stream);
    if (e != hipSuccess) fprintf(stderr, "cooperative launch failed: %s\n", hipGetErrorString(e));
}
```

```cpp
#include <hip/hip_runtime.h>
#include <hip/hip_cooperative_groups.h>
#include <cstdio>
#include <cstdint>
namespace cg = cooperative_groups;

#define LAS __attribute__((address_space(3)))
typedef unsigned short bf16_t;
typedef short bf16x8 __attribute__((ext_vector_type(8)));
typedef short s16x4 __attribute__((ext_vector_type(4)));
typedef float f32x4 __attribute__((ext_vector_type(4)));
typedef float f32x16 __attribute__((ext_vector_type(16)));
typedef unsigned u32x4 __attribute__((ext_vector_type(4)));
typedef unsigned u32x2 __attribute__((ext_vector_type(2)));

constexpr int DM = 1024, NB = 8, SEQ = 8192, CTX = 256, RPB = SEQ + CTX, R = NB * RPB, DFF = 2816;
constexpr int NHIN = 2304, INCOLS = 6304, GATE0 = 2208;
constexpr int MODW = 9216;
constexpr float EPS = 1e-6f;
constexpr float LOG2E = 1.4426950408889634f;
constexpr float QS_GQA = 0.125f * LOG2E, QS_MLA = 0.10206207261596577f * LOG2E, QS_DIFF = 0.17677669529663687f * LOG2E;

constexpr size_t MiB = 1u << 20;
constexpr size_t WS_MOD = 0;
constexpr size_t WS_XC = 2 * MiB;
constexpr size_t WS_W = 10 * MiB;
constexpr size_t W_GU = 0, W_GU_SZ = (size_t)5632 * 1024 * 2;
constexpr size_t W_D = W_GU + 2 * W_GU_SZ, W_D_SZ = (size_t)1024 * 2816 * 2;
constexpr size_t W_IN = W_D + 2 * W_D_SZ, W_IN_SZ = (size_t)NHIN * 1024 * 2;
constexpr size_t W_G = W_IN + W_IN_SZ, W_G_SZ = (size_t)4096 * 1024 * 2;
constexpr size_t W_BR = W_G + W_G_SZ;
constexpr size_t W_OUT = W_BR + W_G_SZ, W_OUT_SZ = (size_t)1024 * 1024 * 2;
constexpr size_t W_MLA = W_OUT + W_OUT_SZ, W_MLA_SZ = (size_t)1024 * 384 * 2;
constexpr size_t W_LAYER = W_MLA + W_MLA_SZ;
static_assert(WS_W + 2 * W_LAYER <= 124 * MiB, "weights");
constexpr size_t ROWBUF = (size_t)R * 1024 * 2;
constexpr size_t WS_U = 124 * MiB;
constexpr size_t WS_Y = WS_U + ROWBUF;
constexpr size_t WS_BIG = WS_Y + ROWBUF;
constexpr size_t WS_OUTS = WS_BIG + (size_t)R * NHIN * 2;
constexpr size_t WS_VT = WS_OUTS + ROWBUF;
constexpr size_t WS_GSCR = WS_VT + (size_t)NB * 768 * RPB * 2;
constexpr size_t WS_END = WS_GSCR + 256 * 131072;
static_assert(WS_END <= 1024 * MiB, "ws");
static_assert(WS_BIG + (size_t)R * DFF * 2 <= WS_END, "H");

constexpr int LDS_BYTES = 147456;
constexpr size_t WS_BAR = 1 * MiB;
constexpr int LDS_BARST = 147456 - 64;

__device__ __forceinline__ unsigned f2bf(float f) { unsigned u = __builtin_bit_cast(unsigned, f); return (u + 0x7fffu + ((u >> 16) & 1u)) >> 16; }
__device__ __forceinline__ unsigned pk2(float lo, float hi) { return f2bf(lo) | (f2bf(hi) << 16); }
__device__ __forceinline__ float bf2f(unsigned short h) { return __builtin_bit_cast(float, (unsigned)h << 16); }
__device__ __forceinline__ float bflo(unsigned w) { return __builtin_bit_cast(float, w << 16); }
__device__ __forceinline__ float bfhi(unsigned w) { return __builtin_bit_cast(float, w & 0xffff0000u); }
__device__ __forceinline__ float wave_sum(float v) {
#pragma unroll
    for (int o = 1; o < 64; o <<= 1) v += __shfl_xor(v, o);
    return v;
}
__device__ __forceinline__ int ptid() { int t = threadIdx.x; asm volatile("" : "+v"(t)); return t; }
__device__ __forceinline__ float fexp2(float x) { return __builtin_amdgcn_exp2f(x); }
__device__ __forceinline__ float frcp(float x) { return __builtin_amdgcn_rcpf(x); }
__device__ __forceinline__ float sigmoidf_(float x) { return frcp(1.f + fexp2(-x * LOG2E)); }

namespace pg8 {
constexpr int BM = 256, BK = 64, HALF = 128, HTB = HALF * BK * 2, STAGE_BYTES = 8 * HTB, NXCD = 8, WGM = 8;
__device__ __forceinline__ int lds_byte(int r, int c) { const int st = (r >> 4) * 2 + (c >> 5), rr = r & 15, cc = c & 31, ob = rr * 64 + cc * 2; return st * 1024 + (ob ^ (((ob >> 9) & 1) << 5)); }
__device__ __forceinline__ void stage_rc(int b, int& Rr, int& C) { const int st = b / 1024, sb = b % 1024, swz = sb ^ (((sb >> 9) & 1) << 5); Rr = (st >> 1) * 16 + swz / 64; C = (st & 1) * 32 + (swz % 64) / 2; }
__device__ __forceinline__ int perm32(int rho) { const int n = rho >> 4, i = rho & 15; return 8 * (i >> 2) + 4 * n + (i & 3); }

struct Unit { int pm, pn, kind; };
struct Gemm { const bf16_t* A; const bf16_t* Bt; const bf16_t* A2; const bf16_t* Bt2; int lda, ldb, K; };

struct StaticOrder {
    int nM, nN, nwg, G, c, dual;
    __device__ void init(int M, int N, int G_, int c_, int dual_) { nM = M / BM; nN = N / BM; nwg = nM * nN; G = G_; c = c_; dual = dual_; }
    __device__ bool next(int i, Unit& u) const {
        const int ii = i;
        const long L = (long)ii * G + c; if (L >= nwg) return false;
        int wgid = (int)L; { const int q = nwg / NXCD, r = nwg % NXCD, xcd = wgid % NXCD, off = wgid / NXCD; wgid = (xcd < r ? xcd * (q + 1) : r * (q + 1) + (xcd - r) * q) + off; }
        const int nig = WGM * nN, gid = wgid / nig, fm = gid * WGM, gsz = (nM - fm) < WGM ? (nM - fm) : WGM;
        u.pm = fm + ((wgid % nig) % gsz); u.pn = (wgid % nig) / gsz;
        if (dual) u.pm = (u.pm >> 5) * 33 + 1 + (u.pm & 31);
        u.kind = 0; return true;
    }
};

typedef float f32x2_t __attribute__((ext_vector_type(2))); typedef __bf16 bf16x2_t __attribute__((ext_vector_type(2)));
__device__ __forceinline__ unsigned cvt_pk_bf16(float lo, float hi) { f32x2_t v = {lo, hi}; bf16x2_t b = __builtin_convertvector(v, bf16x2_t); return __builtin_bit_cast(unsigned, b); }

struct Epi {
    int mode; bf16_t* O; int ldc; u32x4* scr;
    __device__ __forceinline__ void operator()(const f32x4 (&acc)[2][2][4][2], const Unit& u, int wr, int wc, int fr, int fq) const {
        const int row0 = u.pm * BM + wr * 64 + fr;
        if (mode == 0) {
            const int col0 = u.pn * BM + wc * 32 + 8 * fq;
#pragma unroll
            for (int ai = 0; ai < 2; ++ai)
#pragma unroll
                for (int m = 0; m < 4; ++m) { bf16_t* rowp = O + (size_t)(row0 + ai * HALF + m * 16) * ldc + col0;
#pragma unroll
                    for (int bj = 0; bj < 2; ++bj) { const f32x4 v0 = acc[ai][bj][m][0], v1 = acc[ai][bj][m][1];
                        u32x4 w; w.x = cvt_pk_bf16(v0[0], v0[1]); w.y = cvt_pk_bf16(v0[2], v0[3]); w.z = cvt_pk_bf16(v1[0], v1[1]); w.w = cvt_pk_bf16(v1[2], v1[3]);
                        *(u32x4*)(rowp + bj * HALF) = w; } }
        } else if (mode == 1) {
            const int col0 = u.pn * HALF + wc * 32 + 8 * fq;
#pragma unroll
            for (int ai = 0; ai < 2; ++ai)
#pragma unroll
                for (int m = 0; m < 4; ++m) { bf16_t* rowp = O + (size_t)(row0 + ai * HALF + m * 16) * ldc + col0;
                    float h[8];
#pragma unroll
                    for (int n = 0; n < 2; ++n)
#pragma unroll
                        for (int e = 0; e < 4; ++e) { const float g = acc[ai][0][m][n][e], up = acc[ai][1][m][n][e]; h[n * 4 + e] = g * sigmoidf_(g) * up; }
                    u32x4 w; w.x = cvt_pk_bf16(h[0], h[1]); w.y = cvt_pk_bf16(h[2], h[3]); w.z = cvt_pk_bf16(h[4], h[5]); w.w = cvt_pk_bf16(h[6], h[7]);
                    *(u32x4*)rowp = w; }
        } else if (mode == 3) {
            const int col0 = u.pn * BM + wc * 32 + 8 * fq;
#pragma unroll
            for (int ai = 0; ai < 2; ++ai)
#pragma unroll
                for (int m = 0; m < 4; ++m) { bf16_t* rowp = O + (size_t)(row0 + ai * HALF + m * 16) * ldc + col0;
#pragma unroll
                    for (int bj = 0; bj < 2; ++bj) { const f32x4 v0 = acc[ai][bj][m][0], v1 = acc[ai][bj][m][1];
                        u32x4 w; w.x = cvt_pk_bf16(sigmoidf_(v0[0]), sigmoidf_(v0[1])); w.y = cvt_pk_bf16(sigmoidf_(v0[2]), sigmoidf_(v0[3]));
                        w.z = cvt_pk_bf16(sigmoidf_(v1[0]), sigmoidf_(v1[1])); w.w = cvt_pk_bf16(sigmoidf_(v1[2]), sigmoidf_(v1[3]));
                        *(u32x4*)(rowp + bj * HALF) = w; } }
        } else {
            const int col0 = u.pn * BM + wc * 32 + 8 * fq;
#pragma unroll
            for (int ai = 0; ai < 2; ++ai)
#pragma unroll
                for (int m = 0; m < 4; ++m) { const size_t r = (size_t)(row0 + ai * HALF + m * 16);
                    const bf16_t* gp = (const bf16_t*)scr + r * 4096 + 3 * 1024 + col0; bf16_t* rowp = O + r * ldc + col0;
#pragma unroll
                    for (int bj = 0; bj < 2; ++bj) { const u32x4 g = *(const u32x4*)(gp + bj * HALF); const f32x4 v0 = acc[ai][bj][m][0], v1 = acc[ai][bj][m][1];
                        u32x4 w; w.x = cvt_pk_bf16(v0[0] * gclamp(bflo(g.x)), v0[1] * gclamp(bfhi(g.x))); w.y = cvt_pk_bf16(v0[2] * gclamp(bflo(g.y)), v0[3] * gclamp(bfhi(g.y)));
                        w.z = cvt_pk_bf16(v1[0] * gclamp(bflo(g.z)), v1[1] * gclamp(bfhi(g.z))); w.w = cvt_pk_bf16(v1[2] * gclamp(bflo(g.w)), v1[3] * gclamp(bfhi(g.w)));
                        *(u32x4*)(rowp + bj * HALF) = w; } }
        }
    }
    static __device__ __forceinline__ float gclamp(float g) { return __builtin_fmaxf(g, 1e-6f); }
    __device__ __forceinline__ void rescale(f32x4 (&acc)[2][2][4][2], const Unit& u, int i, int wr, int wc, int fr, int fq) const {
        int row0 = u.pm * BM + wr * 64 + fr; const int col0 = u.pn * BM + wc * 32 + 8 * fq;
        asm volatile("" : "+v"(row0));
#pragma unroll
        for (int ai = 0; ai < 2; ++ai)
#pragma unroll
            for (int m = 0; m < 4; ++m) { const bf16_t* gp = (const bf16_t*)scr + (size_t)(row0 + ai * HALF + m * 16) * 4096 + i * 1024 + col0;
#pragma unroll
                for (int bj = 0; bj < 2; ++bj) { const u32x4 ga = *(const u32x4*)(gp + bj * HALF), gb = *(const u32x4*)(gp + 1024 + bj * HALF);
                    f32x4 r0, r1;
                    r0[0] = gclamp(bflo(ga.x)) * frcp(gclamp(bflo(gb.x))); r0[1] = gclamp(bfhi(ga.x)) * frcp(gclamp(bfhi(gb.x)));
                    r0[2] = gclamp(bflo(ga.y)) * frcp(gclamp(bflo(gb.y))); r0[3] = gclamp(bfhi(ga.y)) * frcp(gclamp(bfhi(gb.y)));
                    r1[0] = gclamp(bflo(ga.z)) * frcp(gclamp(bflo(gb.z))); r1[1] = gclamp(bfhi(ga.z)) * frcp(gclamp(bfhi(gb.z)));
                    r1[2] = gclamp(bflo(ga.w)) * frcp(gclamp(bflo(gb.w))); r1[3] = gclamp(bfhi(ga.w)) * frcp(gclamp(bfhi(gb.w)));
                    acc[ai][bj][m][0] = acc[ai][bj][m][0] * r0; acc[ai][bj][m][1] = acc[ai][bj][m][1] * r1; }
                if (m == 3) asm volatile("" ::: "memory"); }
    }
};

template <bool HOOK, class Sched>
__device__ __forceinline__ void gemm_phase(LAS unsigned char* lds, const Gemm g, const Sched& S, const Epi& E) {
    const int tid = ptid(), wid = __builtin_amdgcn_readfirstlane(tid >> 6), lane = tid & 63, wr = wid >> 2, wc = wid & 3, fr = lane & 15, fq = lane >> 4;
    const int K = g.K, nt = K / BK;
    unsigned voffA[2], voffB[2];
#pragma unroll
    for (int i = 0; i < 2; ++i) { int Rr, C; stage_rc(tid * 16 + i * 8192, Rr, C); const int Rb = (Rr & ~31) + perm32(Rr & 31);
        voffA[i] = (unsigned)(Rr * g.lda + C) * 2u; voffB[i] = (unsigned)(Rb * g.ldb + C) * 2u; }
    const size_t kstep = (size_t)(BK * 2);
    const size_t hsA = (size_t)HALF * g.lda * 2, hsB = (size_t)HALF * g.ldb * 2;
    const size_t tsA = 2 * hsA, tsB = 2 * hsB;
    const unsigned ldsw = (unsigned)wid * 1024u;
    const int aoff = lds_byte(wr * 64 + fr, fq * 8), boff = lds_byte(wc * 32 + fr, fq * 8);
#define PG8_SA(b, h) (((b) * 2 + (h)) * HTB)
#define PG8_SB(b, h) ((4 + (b) * 2 + (h)) * HTB)
#define PG8_STAGE(bufoff, gbase, voff) do { _Pragma("unroll") for (int _i = 0; _i < 2; ++_i) \
        __builtin_amdgcn_global_load_lds((const unsigned*)((const char*)(gbase) + (voff)[_i]), (LAS unsigned*)(lds + (bufoff) + ldsw + _i * 8192), 16, 0, 0); } while (0)
#define PG8_LDA(dst, b, h) do { _Pragma("unroll") for (int m = 0; m < 4; ++m) _Pragma("unroll") for (int k = 0; k < 2; ++k) dst[m][k] = *(const LAS bf16x8*)(lds + PG8_SA(b, h) + aoff + m * 2048 + k * 1024); } while (0)
#define PG8_LDB(dst, b, h) do { _Pragma("unroll") for (int n = 0; n < 2; ++n) _Pragma("unroll") for (int k = 0; k < 2; ++k) dst[n][k] = *(const LAS bf16x8*)(lds + PG8_SB(b, h) + boff + n * 2048 + k * 1024); } while (0)
#define PG8_MMA(ai, bj, At, Bt) do { __builtin_amdgcn_s_setprio(1); _Pragma("unroll") for (int m = 0; m < 4; ++m) _Pragma("unroll") for (int n = 0; n < 2; ++n) _Pragma("unroll") for (int k = 0; k < 2; ++k) \
        acc[ai][bj][m][n] = __builtin_amdgcn_mfma_f32_16x16x32_bf16(Bt[n][k], At[m][k], acc[ai][bj][m][n], 0, 0, 0); __builtin_amdgcn_s_setprio(0); } while (0)
#define PG8_MMA1(ai, bj, nn, At, Bt) do { __builtin_amdgcn_s_setprio(1); _Pragma("unroll") for (int m = 0; m < 4; ++m) _Pragma("unroll") for (int k = 0; k < 2; ++k) \
        acc[ai][bj][m][nn] = __builtin_amdgcn_mfma_f32_16x16x32_bf16(Bt[nn][k], At[m][k], acc[ai][bj][m][nn], 0, 0, 0); __builtin_amdgcn_s_setprio(0); } while (0)
#define PG8_MMAZ(ai, At) do { if (zbr == 0) PG8_MMA1(ai, 0, 0, At, B0); else if (zbr == 1) PG8_MMA1(ai, 0, 1, At, B0); else if (zbr == 2) PG8_MMA1(ai, 1, 0, At, B1); else PG8_MMA1(ai, 1, 1, At, B1); } while (0)
#define PG8_MM2(ai, At) do { PG8_MMA(ai, 0, At, B0); PG8_MMA(ai, 1, At, B1); } while (0)
#define PG8_WAIT_V(n) asm volatile("s_waitcnt vmcnt(" #n ")" ::: "memory")
#define PG8_WAIT_L(n) asm volatile("s_waitcnt lgkmcnt(" #n ")" ::: "memory")
#define PG8_BAR __builtin_amdgcn_s_barrier()
#define PG8_SCHED __builtin_amdgcn_sched_barrier(0)
#define PG8_UA(u) ((const char*)((u).kind ? g.A2 : g.A) + (size_t)(u).pm * tsA)
#define PG8_UB(u) ((const char*)((u).kind ? g.Bt2 : g.Bt) + (size_t)(u).pn * tsB)
    Unit cur, nxt; int ui = 0;
    if (!S.next(0, cur)) return;
    f32x4 acc[2][2][4][2];
#pragma unroll
    for (int a = 0; a < 2; ++a)
#pragma unroll
        for (int b = 0; b < 2; ++b)
#pragma unroll
            for (int m = 0; m < 4; ++m)
#pragma unroll
                for (int n = 0; n < 2; ++n) acc[a][b][m][n] = (f32x4){0.f, 0.f, 0.f, 0.f};
    bf16x8 At[4][2], B0[2][2], B1[2][2];
    const char* cA = PG8_UA(cur); const char* cB = PG8_UB(cur);
    {
        PG8_STAGE(PG8_SB(0, 0), cB, voffB); PG8_STAGE(PG8_SB(0, 1), cB + hsB, voffB); PG8_STAGE(PG8_SA(0, 0), cA, voffA); PG8_STAGE(PG8_SA(0, 1), cA + hsA, voffA);
        if (wr == 1) PG8_BAR;
        PG8_WAIT_V(2); PG8_BAR;
        PG8_STAGE(PG8_SB(1, 0), cB + kstep, voffB); PG8_STAGE(PG8_SA(1, 0), cA + kstep, voffA); PG8_STAGE(PG8_SB(1, 1), cB + hsB + kstep, voffB);
        PG8_WAIT_V(6); PG8_BAR;
    }
    for (;;) {
        const bool has_next = S.next(ui + 1, nxt);
        const char* nA = has_next ? PG8_UA(nxt) : cA; const char* nB = has_next ? PG8_UB(nxt) : cB;
        for (int t = 0; t < nt; t += 2) {
            const bool last = (t == nt - 2);
            if constexpr (HOOK) { if (t == 4 || t == 8 || t == 12) { PG8_SCHED; E.rescale(acc, cur, (t >> 2) - 1, wr, wc, fr, fq); PG8_SCHED; } }
            const char* a1 = cA + (size_t)(t + 1) * kstep;
            const char* a2 = last ? nA : cA + (size_t)(t + 2) * kstep; const char* b2 = last ? nB : cB + (size_t)(t + 2) * kstep;
            const char* a3 = a2 + kstep; const char* b3 = b2 + kstep;
            PG8_LDB(B0, 0, 0); PG8_LDB(B1, 0, 1); PG8_SCHED; PG8_LDA(At, 0, 0); PG8_STAGE(PG8_SA(1, 1), a1 + hsA, voffA);
            PG8_WAIT_V(8); PG8_WAIT_L(0); PG8_BAR; PG8_MM2(0, At); PG8_BAR; PG8_SCHED;
            PG8_LDA(At, 0, 1); PG8_STAGE(PG8_SB(0, 0), b2, voffB); PG8_STAGE(PG8_SB(0, 1), b2 + hsB, voffB); PG8_STAGE(PG8_SA(0, 0), a2, voffA);
            PG8_WAIT_V(8); PG8_WAIT_L(0); PG8_BAR; PG8_MM2(1, At); PG8_BAR; PG8_SCHED;
            PG8_LDB(B0, 1, 0); PG8_LDB(B1, 1, 1); PG8_SCHED; PG8_LDA(At, 1, 0); PG8_STAGE(PG8_SA(0, 1), a2 + hsA, voffA);
            PG8_WAIT_V(8); PG8_WAIT_L(0); PG8_BAR; PG8_MM2(0, At); PG8_BAR; PG8_SCHED;
            PG8_LDA(At, 1, 1); PG8_STAGE(PG8_SB(1, 0), b3, voffB); PG8_STAGE(PG8_SB(1, 1), b3 + hsB, voffB); PG8_STAGE(PG8_SA(1, 0), a3, voffA);
            PG8_WAIT_V(8); PG8_WAIT_L(0); PG8_BAR; PG8_MM2(1, At); PG8_BAR; PG8_SCHED;
        }
        if (wr == 0) PG8_BAR;
        E(acc, cur, wr, wc, fr, fq);
        if (!has_next) break;
#pragma unroll
        for (int a = 0; a < 2; ++a)
#pragma unroll
            for (int b = 0; b < 2; ++b)
#pragma unroll
                for (int m = 0; m < 4; ++m)
#pragma unroll
                    for (int n = 0; n < 2; ++n) acc[a][b][m][n] = (f32x4){0.f, 0.f, 0.f, 0.f};
        cur = nxt; cA = nA; cB = nB; ++ui;
        if (wr == 1) PG8_BAR;
    }
    PG8_WAIT_V(0);
    PG8_BAR;
#undef PG8_SA
#undef PG8_SB
#undef PG8_STAGE
#undef PG8_LDA
#undef PG8_LDB
#undef PG8_MMA
#undef PG8_MMA1
#undef PG8_MMAZ
#undef PG8_MM2
#undef PG8_WAIT_V
#undef PG8_WAIT_L
#undef PG8_BAR
#undef PG8_SCHED
#undef PG8_UA
#undef PG8_UB
}
}

struct Args {
    const float* x; const float* c; const float* ctx; const float* c_ctx; const float* w_mod; const float* b_mod; const float* g_pre; const float* g_post;
    const float* w_gate; const float* w_up; const float* w_down; const float* w_in; const float* gqa_qn; const float* gqa_kn; const float* mla_qn; const float* mla_kvn;
    const float* w_uq; const float* w_ukv; const float* dlam; const float* dsub; const float* sink; const float* w_branch; const float* w_out;
    float* out; unsigned char* ws; int ph_lo, ph_hi;
};
typedef const __attribute__((address_space(4))) Args CArgs;

template <class F>
__device__ __forceinline__ void conv_item(bf16_t* WT, int K, int nblk, int item, LAS float* scr, int lane, const F& f) {
    const int kb = item / nblk, nb = item % nblk, k0 = 64 * kb, n0 = 32 * nb;
#pragma unroll 8
    for (int i = 0; i < 32; ++i) { const int kk = 2 * i + (lane >> 5); scr[kk * 33 + (lane & 31)] = f(n0 + (lane & 31), k0 + kk); }
    asm volatile("s_waitcnt lgkmcnt(0)" ::: "memory");
    const int c = lane & 7;
#pragma unroll
    for (int j = 0; j < 4; ++j) { const int n = (lane >> 3) + 8 * j; const LAS float* s = scr + (8 * c) * 33 + n;
        u32x4 o; o.x = pk2(s[0 * 33], s[1 * 33]); o.y = pk2(s[2 * 33], s[3 * 33]); o.z = pk2(s[4 * 33], s[5 * 33]); o.w = pk2(s[6 * 33], s[7 * 33]);
        *(u32x4*)(WT + (size_t)(n0 + n) * K + k0 + 8 * c) = o; }
    asm volatile("s_waitcnt lgkmcnt(0)" ::: "memory");
}

__device__ __forceinline__ void p0_phase(CArgs& a, LAS unsigned char* lds) {
    const int tid = ptid(), lane = tid & 63, wave = tid >> 6;
    float* MOD = (float*)(a.ws + WS_MOD);
    {
        LAS float* sl = (LAS float*)lds;
        LAS float* red = (LAS float*)(lds + 40960);
        for (int i = tid; i < 9 * 1024; i += 512) { const int r = i >> 10, k = i & 1023; const float v = r < 8 ? a.c[r * 1024 + k] : a.c_ctx[k]; sl[i] = v * sigmoidf_(v); }
        __syncthreads();
        for (int it = blockIdx.x; it < 2 * 144; it += gridDim.x) {
            const int l = it / 144, n0 = (it % 144) * 64;
            const float* W = a.w_mod + (size_t)l * 1024 * MODW + n0 + lane;
            float acc[9];
#pragma unroll
            for (int r = 0; r < 9; ++r) acc[r] = 0.f;
#pragma unroll 8
            for (int kk = 0; kk < 128; ++kk) { const int k = wave * 128 + kk; const float wv = W[(size_t)k * MODW];
#pragma unroll
                for (int r = 0; r < 9; ++r) acc[r] += sl[r * 1024 + k] * wv; }
#pragma unroll
            for (int r = 0; r < 9; ++r) red[(wave * 9 + r) * 64 + lane] = acc[r];
            __syncthreads();
            for (int i = tid; i < 9 * 64; i += 512) { const int r = i >> 6, cidx = i & 63; float s = a.b_mod[l * MODW + n0 + cidx];
#pragma unroll
                for (int w = 0; w < 8; ++w) s += red[(w * 9 + r) * 64 + cidx];
                MOD[((size_t)l * 9 + r) * MODW + n0 + cidx] = s; }
            __syncthreads();
        }
        __syncthreads();
    }
    LAS float* scr = (LAS float*)(lds + wave * 8448);
    const int gw = blockIdx.x * 8 + wave, NGW = gridDim.x * 8;
    constexpr int I_GU = 176 * 16, I_D = 32 * 44, I_IN = 72 * 16, I_G = 128 * 16, I_BR = 32 * 16, I_OUT = 32 * 16, I_MLA = 32 * 6;
    constexpr int I_LAYER = 2 * I_GU + 2 * I_D + I_IN + I_G + I_BR + I_OUT + I_MLA;
    for (int it = gw; it < 2 * I_LAYER; it += NGW) {
        const int l = it / I_LAYER; int r = it % I_LAYER;
        unsigned char* wb = a.ws + WS_W + (size_t)l * W_LAYER;
        if (r < 2 * I_GU) { const int s = r / I_GU; r %= I_GU;
            const float* wg = a.w_gate + (size_t)(l * 2 + s) * 1024 * DFF; const float* wu = a.w_up + (size_t)(l * 2 + s) * 1024 * DFF;
            conv_item((bf16_t*)(wb + W_GU + s * W_GU_SZ), 1024, 176, r, scr, lane, [=](int n, int k) { const int j = (n >> 8) * 128 + (n & 127); return ((n >> 7) & 1) ? wu[(size_t)k * DFF + j] : wg[(size_t)k * DFF + j]; });
            continue; }
        r -= 2 * I_GU;
        if (r < 2 * I_D) { const int s = r / I_D; r %= I_D;
            const float* wd = a.w_down + (size_t)(l * 2 + s) * DFF * 1024;
            conv_item((bf16_t*)(wb + W_D + s * W_D_SZ), DFF, 32, r, scr, lane, [=](int n, int k) { return wd[(size_t)k * 1024 + n]; });
            continue; }
        r -= 2 * I_D;
        const float* win = a.w_in + (size_t)l * 1024 * INCOLS;
        if (r < I_IN) { conv_item((bf16_t*)(wb + W_IN), 1024, 72, r, scr, lane, [=](int n, int k) { return n < GATE0 ? win[(size_t)k * INCOLS + n] : 0.f; }); continue; }
        r -= I_IN;
        if (r < I_G) { conv_item((bf16_t*)(wb + W_G), 1024, 128, r, scr, lane, [=](int n, int k) { return win[(size_t)k * INCOLS + GATE0 + n]; }); continue; }
        r -= I_G;
        if (r < I_BR) { const float* wbr = a.w_branch + (size_t)l * 4 * 256 * 1024;
            conv_item((bf16_t*)(wb + W_BR), 1024, 32, r, scr, lane, [=](int n, int k) { return wbr[(size_t)k * 1024 + n]; }); continue; }
        r -= I_BR;
        if (r < I_OUT) { const float* wo = a.w_out + (size_t)l * 1024 * 1024;
            conv_item((bf16_t*)(wb + W_OUT), 1024, 32, r, scr, lane, [=](int n, int k) { return wo[(size_t)k * 1024 + n]; }); continue; }
        r -= I_OUT;
        { const float* uq = a.w_uq + (size_t)l * 256 * 384; const float* ukv = a.w_ukv + (size_t)l * 128 * 512; const float* gq = a.mla_qn + l * 256; const float* gkv = a.mla_kvn + l * 128;
            conv_item((bf16_t*)(wb + W_MLA), 384, 32, r, scr, lane, [=](int n, int k) {
                float v = 0.f;
                if (n < 384) { if (k < 256) v = gq[k] * uq[(size_t)k * 384 + n]; }
                else if (n < 896) { if (k >= 256) v = gkv[k - 256] * ukv[(size_t)(k - 256) * 512 + (n - 384)]; }
                return v; }); }
    }
}

__device__ __forceinline__ void row_phase(CArgs& a, int l, bool first, const bf16_t* Y, int sub_y, float gscale, bf16_t* U, int sub_u, int l_u) {
    const int tid_ = ptid(); const int lane = tid_ & 63, wave = tid_ >> 6;
    const int gw = blockIdx.x * 8 + wave, NGW = gridDim.x * 8;
    const float* MOD = (const float*)(a.ws + WS_MOD);
    float* XC = (float*)(a.ws + WS_XC);
#pragma unroll 2
    for (int row = gw; row < R; row += NGW) {
        const int b = row / RPB, t = row % RPB; const bool isctx = t < CTX;
        const float* xs; float* xd;
        if (isctx) { const size_t o = (size_t)(b * CTX + t) * DM; xs = (first ? a.ctx : XC) + o; xd = XC + o; }
        else { const size_t o = (size_t)(b * SEQ + (t - CTX)) * DM; xs = (first ? a.x : a.out) + o; xd = a.out + o; }
        const int mrow = isctx ? 8 : b;
        f32x4 v[4];
#pragma unroll
        for (int j = 0; j < 4; ++j) v[j] = __builtin_nontemporal_load((const f32x4*)(xs + 4 * lane + 256 * j));
        if (Y) {
            const float* md = MOD + ((size_t)l * 9 + mrow) * MODW + (sub_y * 3 + 2) * 1024;
            const float* gp = a.g_post + (l * 3 + sub_y) * 1024;
            f32x4 y[4]; float ss = 0.f;
#pragma unroll
            for (int j = 0; j < 4; ++j) { const u32x2 w = __builtin_nontemporal_load((const u32x2*)(Y + (size_t)row * DM + 4 * lane + 256 * j));
                y[j] = (f32x4){bflo(w.x), bfhi(w.x), bflo(w.y), bfhi(w.y)}; ss += (y[j].x * y[j].x + y[j].y * y[j].y) + (y[j].z * y[j].z + y[j].w * y[j].w); }
            const float rs = __builtin_amdgcn_rsqf(wave_sum(ss) * (1.f / DM) + EPS) * gscale;
#pragma unroll
            for (int j = 0; j < 4; ++j) { const f32x4 g = *(const f32x4*)(md + 4 * lane + 256 * j), p = *(const f32x4*)(gp + 4 * lane + 256 * j);
                v[j] = v[j] + (y[j] * rs) * p * g; __builtin_nontemporal_store(v[j], (f32x4*)(xd + 4 * lane + 256 * j)); }
        }
        if (U) {
            const float* md = MOD + ((size_t)l_u * 9 + mrow) * MODW + (sub_u * 3) * 1024;
            const float* gp = a.g_pre + (l_u * 3 + sub_u) * 1024;
            float ss = 0.f;
#pragma unroll
            for (int j = 0; j < 4; ++j) ss += (v[j].x * v[j].x + v[j].y * v[j].y) + (v[j].z * v[j].z + v[j].w * v[j].w);
            const float rs = __builtin_amdgcn_rsqf(wave_sum(ss) * (1.f / DM) + EPS);
#pragma unroll
            for (int j = 0; j < 4; ++j) { const f32x4 sh = *(const f32x4*)(md + 4 * lane + 256 * j), sc = *(const f32x4*)(md + 1024 + 4 * lane + 256 * j), p = *(const f32x4*)(gp + 4 * lane + 256 * j);
                const f32x4 u = (v[j] * rs) * p * (sc + 1.f) + sh;
                u32x2 w; w.x = pk2(u.x, u.y); w.y = pk2(u.z, u.w);
                *(u32x2*)(U + (size_t)row * DM + 4 * lane + 256 * j) = w; }
        }
    }
}

constexpr int VSTR = 136;
constexpr int TAB_OFF = 768 * VSTR;
__device__ __forceinline__ void rope64p(float& v0, float& v1, int l, bool lat, const LAS float* tab, int prow, int pcol) {
    const float p0 = __shfl_xor(v0, 8), p1 = __shfl_xor(v1, 8);
    const int lh = l & 31, pos = (lh & 16) ? pcol : prow, i0 = (2 * lh) & 15;
    const f32x4 cs = *(const LAS f32x4*)(tab + (pos * 16 + i0) * 2);
    const bool sec = (lh >> 3) & 1;
    const float c0 = lat ? cs[0] : 1.f, s0 = lat ? (sec ? cs[1] : -cs[1]) : 0.f, c1 = lat ? cs[2] : 1.f, s1 = lat ? (sec ? cs[3] : -cs[3]) : 0.f;
    v0 = v0 * c0 + p0 * s0; v1 = v1 * c1 + p1 * s1;
}
__device__ __forceinline__ void rope32p(float& v0, float& v1, int d0, bool lat, const LAS float* tab, int prow, int pcol) {
    const float p0 = __shfl_xor(v0, 4), p1 = __shfl_xor(v1, 4);
    const int pos = (d0 & 16) ? pcol : prow, i0 = d0 & 7;
    const LAS float* t = tab + (pos * 16 + 2 * i0) * 2;
    const bool sec = (d0 >> 3) & 1;
    const float c0 = lat ? t[0] : 1.f, s0 = lat ? (sec ? t[1] : -t[1]) : 0.f, c1 = lat ? t[4] : 1.f, s1 = lat ? (sec ? t[5] : -t[5]) : 0.f;
    v0 = v0 * c0 + p0 * s0; v1 = v1 * c1 + p1 * s1;
}
__device__ __forceinline__ float half_sum(float v) {
#pragma unroll
    for (int o = 1; o < 32; o <<= 1) v += __shfl_xor(v, o);
    return v;
}
__device__ __forceinline__ void prep_phase(CArgs& a, int l, LAS unsigned char* lds) {
    const int tid = ptid(), lane = tid & 63, wave = __builtin_amdgcn_readfirstlane(tid >> 6);
    bf16_t* HIN = (bf16_t*)(a.ws + WS_BIG); bf16_t* MUP = (bf16_t*)(a.ws + WS_Y); bf16_t* VT = (bf16_t*)(a.ws + WS_VT);
    LAS float* tab = (LAS float*)(lds + TAB_OFF);
    for (int i = tid; i < 128 * 16; i += 512) { const int pos = i >> 4, f = i & 15;
        const float invf = fexp2(-(float)(2 * f) * (1.f / 32.f) * 13.287712379549449f);
        float rev = (float)pos * invf * 0.15915494309189535f; rev -= __builtin_floorf(rev);
        tab[i * 2] = __builtin_amdgcn_cosf(rev); tab[i * 2 + 1] = __builtin_amdgcn_sinf(rev); }
    __syncthreads();
    const int lh = lane & 31;
    const float gq0 = a.gqa_qn[l * 64 + 2 * lh], gq1 = a.gqa_qn[l * 64 + 2 * lh + 1], gk0 = a.gqa_kn[l * 64 + 2 * lh], gk1 = a.gqa_kn[l * 64 + 2 * lh + 1];
#define LD2(p, v0, v1) do { const unsigned w_ = *(const unsigned*)(p); v0 = bflo(w_); v1 = bfhi(w_); } while (0)
#define ST2(p, v0, v1) do { *(unsigned*)(p) = pg8::cvt_pk_bf16(v0, v1); } while (0)
    for (int tile = blockIdx.x; tile < R / 64; tile += gridDim.x) {
        const int row0 = tile * 64, b = row0 / RPB, t0 = row0 % RPB;
#pragma unroll 4
        for (int rr = 0; rr < 8; ++rr) {
            const int tk = wave * 8 + rr, row = row0 + tk, t = t0 + tk; const bool lat = t >= CTX;
            const int tl = lat ? t - CTX : 0, prow = tl >> 6, pcol = tl & 63;
            bf16_t* __restrict__ h = HIN + (size_t)row * NHIN; bf16_t* __restrict__ mu = MUP + (size_t)row * 1024;
            LAS bf16_t* vst = (LAS bf16_t*)lds + tk;
#pragma unroll
            for (int j = 0; j < 3; ++j) { float v0, v1; LD2(h + 128 * j + 2 * lane, v0, v1);
                const float rs = __builtin_amdgcn_rsqf(half_sum(v0 * v0 + v1 * v1) * (1.f / 64.f) + EPS);
                v0 = v0 * rs * (j < 2 ? gq0 : gk0); v1 = v1 * rs * (j < 2 ? gq1 : gk1);
                rope64p(v0, v1, lane, lat, tab, prow, pcol);
                if (j < 2) { v0 *= QS_GQA; v1 *= QS_GQA; }
                ST2(h + 128 * j + 2 * lane, v0, v1); }
            { const unsigned w = *(const unsigned*)(h + 384 + 2 * lane); vst[(0 + 2 * lane) * (VSTR / 2)] = (bf16_t)(w & 0xffffu); vst[(0 + 2 * lane + 1) * (VSTR / 2)] = (bf16_t)(w >> 16); }
            float sq = 0.f, skv = 0.f;
#pragma unroll
            for (int j = 0; j < 2; ++j) { float v0, v1; LD2(h + 512 + 128 * j + 2 * lane, v0, v1); sq += v0 * v0 + v1 * v1; }
            { float v0, v1; LD2(h + 768 + 2 * lane, v0, v1); skv = v0 * v0 + v1 * v1; }
            const float rq = __builtin_amdgcn_rsqf(wave_sum(sq) * (1.f / 256.f) + EPS) * QS_MLA, rkv = __builtin_amdgcn_rsqf(wave_sum(skv) * (1.f / 128.f) + EPS);
#pragma unroll
            for (int j = 0; j < 3; ++j) { const int c = 128 * j + 2 * lane, e = c % 96; float v0, v1; LD2(mu + c, v0, v1); v0 *= rq; v1 *= rq;
                float r0 = v0, r1 = v1; rope32p(r0, r1, (e - 64) & 30, lat, tab, prow, pcol);
                if (e >= 64) { v0 = r0; v1 = r1; }
                ST2(mu + c, v0, v1); }
#pragma unroll
            for (int hh = 0; hh < 4; ++hh) { const int c = 384 + 128 * hh + 2 * lane; float v0, v1; LD2(mu + c, v0, v1); v0 *= rkv; v1 *= rkv;
                const unsigned w = pg8::cvt_pk_bf16(v0, v1);
                if (lane < 32) *(unsigned*)(mu + c) = w;
                else { vst[(128 + 64 * hh + 2 * (lane - 32)) * (VSTR / 2)] = (bf16_t)(w & 0xffffu); vst[(128 + 64 * hh + 2 * (lane - 32) + 1) * (VSTR / 2)] = (bf16_t)(w >> 16); } }
            { float v0, v1; LD2(h + 896 + 2 * (lane & 15), v0, v1); rope32p(v0, v1, 2 * (lane & 15), lat, tab, prow, pcol); if (lane < 16) ST2(mu + 896 + 2 * lane, v0, v1); }
#pragma unroll
            for (int j = 0; j < 4; ++j) { float v0, v1; LD2(h + 928 + 128 * j + 2 * lane, v0, v1); rope32p(v0, v1, (2 * lane) & 31, lat, tab, prow, pcol);
                if (j < 2) { v0 *= QS_DIFF; v1 *= QS_DIFF; }
                ST2(h + 928 + 128 * j + 2 * lane, v0, v1); }
#pragma unroll
            for (int j = 0; j < 2; ++j) { const unsigned w = *(const unsigned*)(h + 1440 + 128 * j + 2 * lane); vst[(384 + 128 * j + 2 * lane) * (VSTR / 2)] = (bf16_t)(w & 0xffffu); vst[(384 + 128 * j + 2 * lane + 1) * (VSTR / 2)] = (bf16_t)(w >> 16); }
#pragma unroll
            for (int j = 0; j < 3; ++j) { float v0, v1; LD2(h + 1696 + 128 * j + 2 * lane, v0, v1); rope64p(v0, v1, lane, lat, tab, prow, pcol);
                if (j < 2) { v0 *= QS_GQA; v1 *= QS_GQA; }
                ST2(h + 1696 + 128 * j + 2 * lane, v0, v1); }
            { const unsigned w = *(const unsigned*)(h + 2080 + 2 * lane); vst[(640 + 2 * lane) * (VSTR / 2)] = (bf16_t)(w & 0xffffu); vst[(640 + 2 * lane + 1) * (VSTR / 2)] = (bf16_t)(w >> 16); }
        }
#undef LD2
#undef ST2
        __syncthreads();
        bf16_t* vt = VT + (size_t)b * 768 * RPB + t0;
        for (int p = tid; p < 768 * 8; p += 512) { const int vr = p >> 3, seg = p & 7;
            const LAS u32x2* s = (const LAS u32x2*)(lds + vr * VSTR + seg * 16); const u32x2 lo = s[0], hi = s[1];
            *(u32x4*)(vt + (size_t)vr * RPB + seg * 8) = (u32x4){lo.x, lo.y, hi.x, hi.y}; }
        __syncthreads();
    }
}

__device__ __forceinline__ int crow(int r, int hi) { return (r & 3) + 8 * (r >> 2) + 4 * hi; }
constexpr int AT_KBUF = 128 * (96 * 2 + 16);
constexpr int AT_VSTR = 272, AT_VBUF = 64 * AT_VSTR;
constexpr int AT_K0 = 0, AT_V0 = 2 * AT_KBUF, AT_WS = AT_V0 + 2 * AT_VBUF;

struct AttnSrc { const bf16_t* Q; int ldq; const bf16_t* K1; int ldk1; const bf16_t* K2; int ldk2; const bf16_t* VT; };

template <int DQK, bool WIN>
__device__ __forceinline__ void attn_pass(const AttnSrc& s, int NT, int lo, int q0lat, float sink_l2, bool has_sink, LAS unsigned char* lds, f32x16 (&o)[2]) {
    constexpr int KSTR = DQK * 2 + 16, NCH = DQK / 8, NKS = DQK / 16, NP = (128 * NCH) / 512;
    const int tid = ptid(), lane = tid & 63, r32 = lane & 31, hi = lane >> 5; const int wid = __builtin_amdgcn_readfirstlane(tid >> 6);
    LAS float* wsf = (LAS float*)(lds + AT_WS) + wid * 32;
    bf16x8 qf[NKS];
    { const bf16_t* qp = s.Q + (size_t)(wid * 32 + r32) * s.ldq + 8 * hi;
#pragma unroll
        for (int ks = 0; ks < NKS; ++ks) qf[ks] = *(const bf16x8*)(qp + 16 * ks); }
    o[0] = (f32x16){}; o[1] = (f32x16){};
    f32x16 negm = (f32x16){}; asm volatile("" : "+v"(negm));
    float mhat = 0.f, lsum = 0.f;
    const int NT2 = NT >> 1, lo2 = lo >> 1;
    u32x4 kr[NP], vr[2];
    auto kaddr = [&](int key, int c) -> const bf16_t* { return (DQK == 96 && c >= 8) ? s.K2 + (size_t)key * s.ldk2 + (c - 8) * 8 : s.K1 + (size_t)key * s.ldk1 + c * 8; };
#define AT_TILE(j) ((j) < 2 ? (j) : lo2 - 2 + (j))
#define AT_GLOAD(j) do { const int key0_ = AT_TILE(j) * 128; \
        _Pragma("unroll") for (int p = 0; p < NP; ++p) { const int idx_ = tid + 512 * p; kr[p] = *(const u32x4*)kaddr(key0_ + idx_ / NCH, idx_ % NCH); } \
        _Pragma("unroll") for (int p = 0; p < 2; ++p) { const int idx_ = tid + 512 * p; vr[p] = *(const u32x4*)(s.VT + (size_t)(idx_ >> 4) * RPB + key0_ + (idx_ & 15) * 8); } } while (0)
#define AT_LSTORE(buf) do { \
        _Pragma("unroll") for (int p = 0; p < NP; ++p) { const int idx_ = tid + 512 * p; *(LAS u32x4*)(lds + AT_K0 + (buf) * AT_KBUF + (idx_ / NCH) * KSTR + (idx_ % NCH) * 16) = kr[p]; } \
        _Pragma("unroll") for (int p = 0; p < 2; ++p) { const int idx_ = tid + 512 * p; *(LAS u32x4*)(lds + AT_V0 + (buf) * AT_VBUF + (idx_ >> 4) * AT_VSTR + (idx_ & 15) * 16) = vr[p]; } } while (0)
#define MX3(a, b, c) __builtin_fmaxf(__builtin_fmaxf((a), (b)), (c))
    AT_GLOAD(0); AT_LSTORE(0);
    if (NT2 > 1) AT_GLOAD(1);
    __syncthreads();
    for (int j = 0; j < NT2; ++j) {
        const int buf = j & 1;
        f32x16 sA0, sA1, sB0, sB1;
#define AT_QK(S0, S1, sub) do { const LAS unsigned char* kb = lds + AT_K0 + buf * AT_KBUF + ((sub) * 64 + r32) * KSTR + hi * 16; \
        _Pragma("unroll") for (int ks = 0; ks < NKS; ++ks) { \
            const bf16x8 a0 = *(const LAS bf16x8*)(kb + ks * 32), a1 = *(const LAS bf16x8*)(kb + 32 * KSTR + ks * 32); \
            if (ks == 0) { S0 = __builtin_amdgcn_mfma_f32_32x32x16_bf16(a0, qf[0], negm, 0, 0, 0); S1 = __builtin_amdgcn_mfma_f32_32x32x16_bf16(a1, qf[0], negm, 0, 0, 0); } \
            else { S0 = __builtin_amdgcn_mfma_f32_32x32x16_bf16(a0, qf[ks], S0, 0, 0, 0); S1 = __builtin_amdgcn_mfma_f32_32x32x16_bf16(a1, qf[ks], S1, 0, 0, 0); } } } while (0)
#define AT_SOFT(s0, s1, u0, u1, sub, HASNEXT) do { \
        if (WIN && j >= 2) { \
            const int jb = AT_TILE(j) * 128 + (sub) * 64 - CTX + 4 * hi, qi = q0lat + wid * 32 + r32; \
            _Pragma("unroll") for (int r = 0; r < 16; ++r) { const int jj = jb + (r & 3) + 8 * (r >> 2); const int d0 = qi - jj, d1 = qi - (jj + 32); \
                if (d0 > 128 || d0 < -128) s0[r] = -1e30f; if (d1 > 128 || d1 < -128) s1[r] = -1e30f; } } \
        float ra = MX3(s0[0], s0[1], s1[0]), rb = MX3(s0[2], s0[3], s1[1]); ra = MX3(ra, s1[2], s1[3]); \
        _Pragma("unroll") for (int r = 4; r < 16; r += 4) { ra = MX3(ra, s0[r], s0[r + 1]); rb = MX3(rb, s0[r + 2], s0[r + 3]); ra = MX3(ra, s1[r], s1[r + 1]); rb = MX3(rb, s1[r + 2], s1[r + 3]); } \
        float rm = __builtin_fmaxf(ra, rb); rm = __builtin_fmaxf(rm, __shfl_xor(rm, 32)); \
        const bool first = (j == 0) && ((sub) == 0); \
        if (first || __any(rm > 8.f)) { const float dl = first ? rm : __builtin_fmaxf(rm, 0.f); mhat += dl; \
            _Pragma("unroll") for (int r = 0; r < 16; ++r) { s0[r] -= dl; s1[r] -= dl; } \
            if (HASNEXT) { _Pragma("unroll") for (int r = 0; r < 16; ++r) { u0[r] -= dl; u1[r] -= dl; } }     \
            _Pragma("unroll") for (int r = 0; r < 16; ++r) negm[r] = -mhat; \
            asm volatile("" : "+v"(negm)); \
            if (!first) { const float f = fexp2(-dl); lsum *= f; if (hi == 0) wsf[r32] = f; \
                _Pragma("unroll") for (int r = 0; r < 16; ++r) { const float fr_ = wsf[crow(r, hi)]; o[0][r] *= fr_; o[1][r] *= fr_; } } } \
        float ps = 0.f, ps2 = 0.f; \
        _Pragma("unroll") for (int r = 0; r < 16; ++r) { s0[r] = fexp2(s0[r]); s1[r] = fexp2(s1[r]); ps += s0[r]; ps2 += s1[r]; } \
        lsum += ps + ps2; \
        bf16x8 pa[4]; \
        _Pragma("unroll") for (int kk = 0; kk < 2; ++kk) { u32x4 w; \
            w.x = pg8::cvt_pk_bf16(s0[8 * kk + 0], s0[8 * kk + 1]); w.y = pg8::cvt_pk_bf16(s0[8 * kk + 2], s0[8 * kk + 3]); w.z = pg8::cvt_pk_bf16(s0[8 * kk + 4], s0[8 * kk + 5]); w.w = pg8::cvt_pk_bf16(s0[8 * kk + 6], s0[8 * kk + 7]); pa[kk] = __builtin_bit_cast(bf16x8, w); \
            w.x = pg8::cvt_pk_bf16(s1[8 * kk + 0], s1[8 * kk + 1]); w.y = pg8::cvt_pk_bf16(s1[8 * kk + 2], s1[8 * kk + 3]); w.z = pg8::cvt_pk_bf16(s1[8 * kk + 4], s1[8 * kk + 5]); w.w = pg8::cvt_pk_bf16(s1[8 * kk + 6], s1[8 * kk + 7]); pa[2 + kk] = __builtin_bit_cast(bf16x8, w); } \
        const LAS unsigned char* vb = lds + AT_V0 + buf * AT_VBUF + r32 * AT_VSTR + (sub) * 128 + hi * 8; \
        _Pragma("unroll") for (int dvb = 0; dvb < 2; ++dvb) _Pragma("unroll") for (int kk = 0; kk < 4; ++kk) { \
                const u32x2 lo_ = *(const LAS u32x2*)(vb + dvb * 32 * AT_VSTR + kk * 32), hi_ = *(const LAS u32x2*)(vb + dvb * 32 * AT_VSTR + kk * 32 + 16); \
                const bf16x8 bv = __builtin_bit_cast(bf16x8, (u32x4){lo_.x, lo_.y, hi_.x, hi_.y}); \
                o[dvb] = __builtin_amdgcn_mfma_f32_32x32x16_bf16(pa[kk], bv, o[dvb], 0, 0, 0); } } while (0)
        AT_QK(sA0, sA1, 0); AT_QK(sB0, sB1, 1);
        AT_SOFT(sA0, sA1, sB0, sB1, 0, true);
        AT_SOFT(sB0, sB1, sA0, sA1, 1, false);
#undef AT_QK
#undef AT_SOFT
        if (j + 1 < NT2) AT_LSTORE(buf ^ 1);
        __syncthreads();
        if (j + 2 < NT2) AT_GLOAD(j + 2);
    }
    float lt = lsum + __shfl_xor(lsum, 32);
    if (has_sink) lt += fexp2(sink_l2 - mhat);
    if (hi == 0) wsf[r32] = frcp(lt);
#pragma unroll
    for (int r = 0; r < 16; ++r) { const float fr_ = wsf[crow(r, hi)]; o[0][r] *= fr_; o[1][r] *= fr_; }
#undef AT_TILE
#undef AT_GLOAD
#undef AT_LSTORE
#undef MX3
}

__device__ __forceinline__ void attn_store(bf16_t* O, int row0, int col0, const f32x16 (&o)[2]) {
    const int tid_ = ptid(); const int lane = tid_ & 63, r32 = lane & 31, hi = lane >> 5, wid = tid_ >> 6;
#pragma unroll
    for (int dvb = 0; dvb < 2; ++dvb)
#pragma unroll
        for (int r = 0; r < 16; ++r) O[(size_t)(row0 + wid * 32 + crow(r, hi)) * 1024 + col0 + dvb * 32 + r32] = (bf16_t)f2bf(o[dvb][r]);
}

__device__ __forceinline__ void attn_unit(CArgs& a, int l, int branch, int b, int h, int qb, float lam, float lam_init, LAS unsigned char* lds) {
    const bf16_t* HIN = (const bf16_t*)(a.ws + WS_BIG) + (size_t)b * RPB * NHIN; const bf16_t* MUP = (const bf16_t*)(a.ws + WS_Y) + (size_t)b * RPB * 1024;
    const bf16_t* VT = (const bf16_t*)(a.ws + WS_VT) + (size_t)b * 768 * RPB; bf16_t* OUTS = (bf16_t*)(a.ws + WS_OUTS);
    const bool cq = qb < 0; const int qrow = cq ? 0 : CTX + 256 * qb;
    const int NTd = cq ? 4 : 132;
    const int orow0 = b * RPB + qrow;
    f32x16 o[2];
    AttnSrc s;
    if (branch == 0) {
        s.Q = HIN + (size_t)qrow * NHIN + 64 * h; s.ldq = NHIN; s.K1 = HIN + 256 + 64 * (h >> 1); s.ldk1 = NHIN; s.K2 = nullptr; s.ldk2 = 0; s.VT = VT + (size_t)(0 + 64 * (h >> 1)) * RPB;
        attn_pass<64, false>(s, NTd, 4, 0, 0.f, false, lds, o);
        attn_store(OUTS, orow0, 0 + 64 * h, o);
    } else if (branch == 1) {
        s.Q = MUP + (size_t)qrow * 1024 + 96 * h; s.ldq = 1024; s.K1 = MUP + 384 + 128 * h; s.ldk1 = 1024; s.K2 = MUP + 896; s.ldk2 = 1024; s.VT = VT + (size_t)(128 + 64 * h) * RPB;
        attn_pass<96, false>(s, NTd, 4, 0, 0.f, false, lds, o);
        attn_store(OUTS, orow0, 256 + 64 * h, o);
    } else if (branch == 2) {
        f32x16 o2[2];
        s.Q = HIN + (size_t)qrow * NHIN + 928 + 64 * h; s.ldq = NHIN; s.K1 = HIN + 1184 + 64 * h; s.ldk1 = NHIN; s.K2 = nullptr; s.ldk2 = 0; s.VT = VT + (size_t)(384 + 64 * h) * RPB;
        attn_pass<32, false>(s, NTd, 4, 0, 0.f, false, lds, o);
        s.Q += 32; s.K1 += 32;
        attn_pass<32, false>(s, NTd, 4, 0, 0.f, false, lds, o2);
        const int lane = ptid() & 63, r32 = lane & 31;
        const float g0 = a.dsub[l * 64 + r32] * (1.f - lam_init), g1 = a.dsub[l * 64 + 32 + r32] * (1.f - lam_init);
#pragma unroll
        for (int r = 0; r < 16; ++r) { const float x0 = o[0][r] - lam * o2[0][r], x1 = o[1][r] - lam * o2[1][r];
            float ss = x0 * x0 + x1 * x1;
#pragma unroll
            for (int m = 1; m < 32; m <<= 1) ss += __shfl_xor(ss, m);
            const float rs = __builtin_amdgcn_rsqf(ss * (1.f / 64.f) + EPS);
            o[0][r] = x0 * rs * g0; o[1][r] = x1 * rs * g1; }
        attn_store(OUTS, orow0, 512 + 64 * h, o);
    } else {
        s.Q = HIN + (size_t)qrow * NHIN + 1696 + 64 * h; s.ldq = NHIN; s.K1 = HIN + 1952 + 64 * (h >> 1); s.ldk1 = NHIN; s.K2 = nullptr; s.ldk2 = 0; s.VT = VT + (size_t)(640 + 64 * (h >> 1)) * RPB;
        const float sk = a.sink[l * 4 + h] * LOG2E;
        if (cq) attn_pass<64, false>(s, 4, 4, 0, sk, true, lds, o);
        else { const int q0 = 256 * qb; const int lo = 4 + (q0 >= 128 ? q0 - 128 : 0) / 64, hiT = 4 + ((q0 + 384) < SEQ ? (q0 + 384) : SEQ) / 64;
            attn_pass<64, true>(s, 4 + hiT - lo, lo, q0, sk, true, lds, o); }
        attn_store(OUTS, orow0, 768 + 64 * h, o);
    }
}

__device__ __forceinline__ void attn_phase(CArgs& a, int l, LAS unsigned char* lds) {
    const float lam_init = 0.8f - 0.6f * __expf(-0.3f * (float)l);
    float lam;
    { const float* dl = a.dlam + l * 128; float s1 = 0.f, s2 = 0.f;
        for (int i = 0; i < 32; ++i) { s1 += dl[i] * dl[32 + i]; s2 += dl[64 + i] * dl[96 + i]; }
        lam = __expf(s1) - __expf(s2) + lam_init; }
    const int G = gridDim.x, bx = blockIdx.x;
    const int vcu = (G % 8 == 0) ? (bx % 8) * (G / 8) + bx / 8 : bx;
    for (int ty = 0; ty < 4; ++ty) {
        const int branch = ty == 0 ? 2 : ty == 1 ? 1 : ty == 2 ? 0 : 3;
        for (int idx = vcu; idx < NB * 4 * 32; idx += G) { const int bh = idx >> 5, qb = idx & 31; attn_unit(a, l, branch, bh >> 2, bh & 3, qb, lam, lam_init, lds); }
    }
    for (int idx = vcu; idx < NB * 16; idx += G) attn_unit(a, l, (idx >> 2) & 3, idx >> 4, idx & 3, -1, lam, lam_init, lds);
}

#define GAS __attribute__((address_space(1)))
#define XB_TMO      128
#define XB_XCNT(j)  (256  + 64 * (j))
#define XB_XSUB(j)  (1280 + 64 * (j))
#define XB_XGEN(j)  (2304 + 64 * (j))
#define XB_TOP      3328
#define XB_TOPGEN   3392
#define XCD_BAR_WORDS 3456
#define XB_SPIN_CAP (1u << 18)

__device__ __forceinline__ unsigned xb_ld(unsigned* p)              { return __hip_atomic_load(p, __ATOMIC_RELAXED, __HIP_MEMORY_SCOPE_AGENT); }
__device__ __forceinline__ unsigned xb_add(unsigned* p, unsigned v) { return __hip_atomic_fetch_add(p, v, __ATOMIC_RELAXED, __HIP_MEMORY_SCOPE_AGENT); }
__device__ __forceinline__ unsigned xb_xcc_id() { return (unsigned)__builtin_amdgcn_s_getreg((3 << 11) | 20) & 0xFu; }
#define XB_SPIN(cond, bar) do { unsigned _sp = 0; while (cond) { __builtin_amdgcn_s_sleep(1); \
    if ((++_sp & 255u) == 0u) { if (xb_ld(&(bar)[XB_TMO])) break; if (_sp > XB_SPIN_CAP) { atomicAdd(&(bar)[XB_TMO], 1u); break; } } } } while (0)

struct XcdBarrier {
    unsigned* bar; unsigned x;
    volatile LAS unsigned* st;
};

__device__ __forceinline__ XcdBarrier xcd_barrier_post(unsigned* bar, volatile LAS unsigned* st) {
    XcdBarrier b; b.bar = bar; b.x = xb_xcc_id(); b.st = st;
    if (threadIdx.x == 0) (void)xb_add(&bar[XB_XCNT(b.x)], 1u);
    return b;
}
__device__ __forceinline__ void xcd_barrier_complete(unsigned* bar, unsigned x, unsigned& nloc, unsigned& nx) {
    const unsigned G = gridDim.x * gridDim.y * gridDim.z;
    unsigned sum, cnt, mine, sp = 0u;
    for (;;) {
        sum = 0u; cnt = 0u; mine = 0u;
#pragma unroll
        for (unsigned j = 0; j < 16; ++j) { const unsigned c = xb_ld(&bar[XB_XCNT(j)]); sum += c; cnt += (c > 0u) ? 1u : 0u; mine = (j == x) ? c : mine; }
        if (sum == G) break;
        __builtin_amdgcn_s_sleep(1);
        if ((++sp & 255u) == 0u) { if (xb_ld(&bar[XB_TMO])) break; if (sp > XB_SPIN_CAP) { atomicAdd(&bar[XB_TMO], 1u); break; } }
    }
    nloc = mine > 0u ? mine : 1u; nx = cnt > 0u ? cnt : 1u;
}

__device__ __forceinline__ void xcd_barrier(const XcdBarrier& b) {
    asm volatile("s_waitcnt vmcnt(0)" ::: "memory");
    __syncthreads();
    if (threadIdx.x == 0) {
        unsigned* bar = b.bar;
        __builtin_amdgcn_s_waitcnt(0);
        unsigned nloc = b.st[0], nx = b.st[1];
        if (nloc == 0u) { xcd_barrier_complete(bar, b.x, nloc, nx); b.st[0] = nloc; b.st[1] = nx; }
        const unsigned old = xb_add(&bar[XB_XSUB(b.x)], 1u);
        const unsigned gen = old / nloc;
        if (old + 1u == (gen + 1u) * nloc) {
            __builtin_amdgcn_fence(__ATOMIC_RELEASE, "agent");
            asm volatile("s_waitcnt vmcnt(0)" ::: "memory");
            const unsigned og = xb_add(&bar[XB_TOP], 1u);
            const unsigned tg = og / nx;
            if (og + 1u == (tg + 1u) * nx) xb_add(&bar[XB_TOPGEN], 1u);
            else XB_SPIN(xb_ld(&bar[XB_TOPGEN]) == tg, bar);
            __builtin_amdgcn_fence(__ATOMIC_ACQUIRE, "agent");
            xb_add(&bar[XB_XGEN(b.x)], 1u);
            asm volatile("s_waitcnt vmcnt(0)" ::: "memory");
        } else {
            XB_SPIN(xb_ld(&bar[XB_XGEN(b.x)]) == gen, bar);
            __builtin_amdgcn_fence(__ATOMIC_ACQUIRE, "agent");
            asm volatile("s_waitcnt vmcnt(0)" ::: "memory");
        }
    }
    __syncthreads();
}


constexpr int NPHASE = 2 + 32;
__global__ void __launch_bounds__(512, 2) fwd_kernel(Args a_) {
    extern __shared__ __attribute__((aligned(16))) unsigned char lds_raw[];
    LAS unsigned char* lds = (LAS unsigned char*)lds_raw;
    cg::grid_group grid = cg::this_grid();
    const int lo = a_.ph_lo, hi = a_.ph_hi < NPHASE ? a_.ph_hi : NPHASE;
    { volatile LAS unsigned* st0 = (volatile LAS unsigned*)(lds + LDS_BARST); if (threadIdx.x < 2) st0[threadIdx.x] = 0u; }
    __syncthreads();
    { XcdBarrier b0 = xcd_barrier_post((unsigned*)(a_.ws + WS_BAR), (volatile LAS unsigned*)(lds + LDS_BARST)); (void)b0; }
    for (int ph = lo; ph < hi; ++ph) {
        CArgs* ap_ = (CArgs*)__builtin_amdgcn_kernarg_segment_ptr(); asm volatile("" : "+s"(ap_) :: "memory"); CArgs& a = *ap_;
        int G = gridDim.x, bx = blockIdx.x; asm volatile("" : "+s"(G), "+s"(bx));
        if (ph == 0) p0_phase(a, lds);
        else if (ph == 1) row_phase(a, 0, true, nullptr, 0, 0.f, (bf16_t*)(a.ws + WS_U), 0, 0);
        else {
            const int l = (ph - 2) / 16, k = (ph - 2) % 16;
            unsigned char* ws = a.ws;
            const unsigned char* wb = ws + WS_W + (size_t)l * W_LAYER;
            bf16_t* U = (bf16_t*)(ws + WS_U); bf16_t* Yb = (bf16_t*)(ws + WS_Y); bf16_t* BIG = (bf16_t*)(ws + WS_BIG);
            if (k == 5) prep_phase(a, l, lds);
#ifndef X_ATTN
            else if (k == 6) attn_phase(a, l, lds);
#endif
            else if (k == 2) row_phase(a, l, l == 0, Yb, 0, 0.5f, U, 1, l);
            else if (k == 12) row_phase(a, l, false, BIG, 1, 1.0f, U, 2, l);
            else if (k == 15) row_phase(a, l, false, Yb, 2, 0.5f, l == 0 ? U : nullptr, 0, l + 1);
            else {
                pg8::Gemm g; pg8::Epi E; int N; int dual = 0; int Mrows = R;
                g.A2 = nullptr; g.Bt2 = nullptr; E.scr = nullptr;
                if (k == 0 || k == 13) { const int s = k == 13; g.A = U; g.Bt = (const bf16_t*)(wb + W_GU + s * W_GU_SZ); g.lda = 1024; g.ldb = 1024; g.K = 1024; N = 5632; E.mode = 1; E.O = BIG; E.ldc = DFF; }
                else if (k == 1 || k == 14) { const int s = k == 14; g.A = BIG; g.Bt = (const bf16_t*)(wb + W_D + s * W_D_SZ); g.lda = DFF; g.ldb = DFF; g.K = DFF; N = 1024; E.mode = 0; E.O = Yb; E.ldc = 1024; }
                else if (k == 3) { g.A = U; g.Bt = (const bf16_t*)(wb + W_IN); g.lda = 1024; g.ldb = 1024; g.K = 1024; N = NHIN; E.mode = 0; E.O = BIG; E.ldc = NHIN; }
                else if (k == 4) { g.A = BIG + 512; g.Bt = (const bf16_t*)(wb + W_MLA); g.lda = NHIN; g.ldb = 384; g.K = 384; N = 1024; E.mode = 0; E.O = Yb; E.ldc = 1024; }
                else if (k == 7 || k == 9) { size_t ro = (size_t)(k == 9) * 32768 * 1024; Mrows = (k == 9) ? R - 32768 : 32768; if (l == 1) { ro = (size_t)(k == 9) * 33792 * 1024; Mrows = 32768; dual = 1; }
                    g.A = U + ro; g.Bt = (const bf16_t*)(wb + W_G); g.lda = 1024; g.ldb = 1024; g.K = 1024; N = 4096; E.mode = 3; E.O = BIG; E.ldc = 4096; }
                else if (k == 8 || k == 10) { size_t ro = (size_t)(k == 10) * 32768 * 1024; Mrows = (k == 10) ? R - 32768 : 32768; if (l == 1) { ro = (size_t)(k == 10) * 33792 * 1024; Mrows = 32768; dual = 1; }
                    g.A = (const bf16_t*)(ws + WS_OUTS) + ro; g.Bt = (const bf16_t*)(wb + W_BR); g.lda = 1024; g.ldb = 1024; g.K = 1024; N = 1024; E.mode = 4; E.O = Yb + ro; E.ldc = 1024; E.scr = (u32x4*)BIG; }
                else { g.A = Yb; g.Bt = (const bf16_t*)(wb + W_OUT); g.lda = 1024; g.ldb = 1024; g.K = 1024; N = 1024; E.mode = 0; E.O = BIG; E.ldc = 1024; }
                if (l == 1 && (k == 11 || k == 13 || k == 14)) { dual = 1; Mrows = 65536; }
                pg8::StaticOrder S; S.init(Mrows, N, G, bx, dual);
                if (k == 8 || k == 10) pg8::gemm_phase<true>(lds, g, S, E); else pg8::gemm_phase<false>(lds, g, S, E);
            }
        }
        if (ph + 1 < hi) {
            if (ph == lo) {
                asm volatile("s_waitcnt vmcnt(0) lgkmcnt(0)" ::: "memory");
                __syncthreads();
                if (ptid() < 64) { __builtin_amdgcn_fence(__ATOMIC_RELEASE, "agent"); asm volatile("s_waitcnt vmcnt(0)" ::: "memory"); }
                grid.sync();
                __builtin_amdgcn_fence(__ATOMIC_ACQUIRE, "agent");
                asm volatile("s_waitcnt vmcnt(0)" ::: "memory");
            } else {
                XcdBarrier bar; bar.bar = (unsigned*)(a.ws + WS_BAR); bar.x = xb_xcc_id(); bar.st = (volatile LAS unsigned*)(lds + LDS_BARST);
                xcd_barrier(bar);
                __builtin_amdgcn_fence(__ATOMIC_ACQUIRE, "agent");
                asm volatile("s_waitcnt vmcnt(0)" ::: "memory");
            }
        }
    }
}

extern "C" void kernel_launch(void* const* d_in, const int* in_sizes, int n_in, void* d_out, int out_size, void* d_ws, size_t ws_size, hipStream_t stream) {
    static int grid = 0;
    if (grid == 0) {
        int dev = 0, cus = 0;
        if (hipGetDevice(&dev) != hipSuccess || hipDeviceGetAttribute(&cus, hipDeviceAttributeMultiprocessorCount, dev) != hipSuccess) { grid = -1; return; }
        if (hipFuncSetAttribute((const void*)fwd_kernel, hipFuncAttributeMaxDynamicSharedMemorySize, LDS_BYTES) != hipSuccess) { fprintf(stderr, "hipFuncSetAttribute failed\n"); grid = -1; return; }
        int per_cu = 0;
        if (hipOccupancyMaxActiveBlocksPerMultiprocessor(&per_cu, (const void*)fwd_kernel, 512, LDS_BYTES) != hipSuccess || per_cu < 1) fprintf(stderr, "occupancy query: %d\n", per_cu);
        (void)hipGetLastError();
        grid = cus;
        if (ws_size < WS_END) { fprintf(stderr, "workspace too small\n"); grid = -1; return; }
    }
    if (grid < 0) return;
    if (hipMemsetAsync((char*)d_ws + WS_BAR, 0, 16384, stream) != hipSuccess) { fprintf(stderr, "memset failed\n"); return; }
    Args a{};
    const float** p = (const float**)&a;
    for (int i = 0; i < 23; ++i) p[i] = (const float*)d_in[i];
    a.out = (float*)d_out; a.ws = (unsigned char*)d_ws; a.ph_lo = 0; a.ph_hi = 1000;
    void* args[] = {&a};
    hipError_t e = hipLaunchCooperativeKernel((const void*)fwd_kernel, dim3(grid), dim3(512), args, LDS_BYTES, stream);
    if (e != hipSuccess) fprintf(stderr, "cooperative launch failed: %s\n", hipGetErrorString(e));
}
```

```cpp
#include <hip/hip_runtime.h>
#include <hip/hip_cooperative_groups.h>
#include <cstdio>
#include <cstdint>
namespace cg = cooperative_groups;

#define LAS __attribute__((address_space(3)))
typedef unsigned short bf16_t;
typedef short bf16x8 __attribute__((ext_vector_type(8)));
typedef short s16x4 __attribute__((ext_vector_type(4)));
typedef float f32x4 __attribute__((ext_vector_type(4)));
typedef float f32x16 __attribute__((ext_vector_type(16)));
typedef unsigned u32x4 __attribute__((ext_vector_type(4)));
typedef unsigned u32x2 __attribute__((ext_vector_type(2)));

constexpr int DM = 1024, NB = 8, SEQ = 8192, CTX = 256, RPB = SEQ + CTX, R = NB * RPB, DFF = 2816;
constexpr int NHIN = 2304, INCOLS = 6304, GATE0 = 2208;
constexpr int MODW = 9216;
constexpr float EPS = 1e-6f;
constexpr float LOG2E = 1.4426950408889634f;
constexpr float QS_GQA = 0.125f * LOG2E, QS_MLA = 0.10206207261596577f * LOG2E, QS_DIFF = 0.17677669529663687f * LOG2E;

constexpr size_t MiB = 1u << 20;
constexpr size_t WS_MOD = 0;
constexpr size_t WS_XC = 2 * MiB;
constexpr size_t WS_W = 10 * MiB;
constexpr size_t W_GU = 0, W_GU_SZ = (size_t)5632 * 1024 * 2;
constexpr size_t W_D = W_GU + 2 * W_GU_SZ, W_D_SZ = (size_t)1024 * 2816 * 2;
constexpr size_t W_IN = W_D + 2 * W_D_SZ, W_IN_SZ = (size_t)NHIN * 1024 * 2;
constexpr size_t W_G = W_IN + W_IN_SZ, W_G_SZ = (size_t)4096 * 1024 * 2;
constexpr size_t W_BR = W_G + W_G_SZ;
constexpr size_t W_OUT = W_BR + W_G_SZ, W_OUT_SZ = (size_t)1024 * 1024 * 2;
constexpr size_t W_MLA = W_OUT + W_OUT_SZ, W_MLA_SZ = (size_t)1024 * 384 * 2;
constexpr size_t W_LAYER = W_MLA + W_MLA_SZ;
static_assert(WS_W + 2 * W_LAYER <= 124 * MiB, "weights");
constexpr size_t ROWBUF = (size_t)R * 1024 * 2;
constexpr size_t WS_U = 124 * MiB;
constexpr size_t WS_Y = WS_U + ROWBUF;
constexpr size_t WS_BIG = WS_Y + ROWBUF;
constexpr size_t WS_OUTS = WS_BIG + (size_t)R * NHIN * 2;
constexpr size_t WS_VT = WS_OUTS + ROWBUF;
constexpr size_t WS_GSCR = WS_VT + (size_t)NB * 768 * RPB * 2;
constexpr size_t WS_END = WS_GSCR + 256 * 131072;
static_assert(WS_END <= 1024 * MiB, "ws");
static_assert(WS_BIG + (size_t)R * DFF * 2 <= WS_END, "H");

constexpr int LDS_BYTES = 147456;
constexpr size_t WS_BAR = 1 * MiB;
constexpr int LDS_BARST = 147456 - 64;

__device__ __forceinline__ unsigned f2bf(float f) { unsigned u = __builtin_bit_cast(unsigned, f); return (u + 0x7fffu + ((u >> 16) & 1u)) >> 16; }
__device__ __forceinline__ unsigned pk2(float lo, float hi) { return f2bf(lo) | (f2bf(hi) << 16); }
__device__ __forceinline__ float bf2f(unsigned short h) { return __builtin_bit_cast(float, (unsigned)h << 16); }
__device__ __forceinline__ float bflo(unsigned w) { return __builtin_bit_cast(float, w << 16); }
__device__ __forceinline__ float bfhi(unsigned w) { return __builtin_bit_cast(float, w & 0xffff0000u); }
__device__ __forceinline__ float wave_sum(float v) {
#pragma unroll
    for (int o = 1; o < 64; o <<= 1) v += __shfl_xor(v, o);
    return v;
}
__device__ __forceinline__ int ptid() { int t = threadIdx.x; asm volatile("" : "+v"(t)); return t; }
__device__ __forceinline__ float fexp2(float x) { return __builtin_amdgcn_exp2f(x); }
__device__ __forceinline__ float frcp(float x) { return __builtin_amdgcn_rcpf(x); }
__device__ __forceinline__ float sigmoidf_(float x) { return frcp(1.f + fexp2(-x * LOG2E)); }

namespace pg8 {
constexpr int BM = 256, BK = 64, HALF = 128, HTB = HALF * BK * 2, STAGE_BYTES = 8 * HTB, NXCD = 8, WGM = 8;
__device__ __forceinline__ int lds_byte(int r, int c) { const int st = (r >> 4) * 2 + (c >> 5), rr = r & 15, cc = c & 31, ob = rr * 64 + cc * 2; return st * 1024 + (ob ^ (((ob >> 9) & 1) << 5)); }
__device__ __forceinline__ void stage_rc(int b, int& Rr, int& C) { const int st = b / 1024, sb = b % 1024, swz = sb ^ (((sb >> 9) & 1) << 5); Rr = (st >> 1) * 16 + swz / 64; C = (st & 1) * 32 + (swz % 64) / 2; }
__device__ __forceinline__ int perm32(int rho) { const int n = rho >> 4, i = rho & 15; return 8 * (i >> 2) + 4 * n + (i & 3); }

struct Unit { int pm, pn, kind; };
struct Gemm { const bf16_t* A; const bf16_t* Bt; const bf16_t* A2; const bf16_t* Bt2; int lda, ldb, K; };

struct StaticOrder {
    int nM, nN, nwg, G, c, dual;
    __device__ void init(int M, int N, int G_, int c_, int dual_) { nM = M / BM; nN = N / BM; nwg = nM * nN; G = G_; c = c_; dual = dual_; }
    __device__ bool next(int i, Unit& u) const {
        const int ii = i;
        const long L = (long)ii * G + c; if (L >= nwg) return false;
        int wgid = (int)L; { const int q = nwg / NXCD, r = nwg % NXCD, xcd = wgid % NXCD, off = wgid / NXCD; wgid = (xcd < r ? xcd * (q + 1) : r * (q + 1) + (xcd - r) * q) + off; }
        const int nig = WGM * nN, gid = wgid / nig, fm = gid * WGM, gsz = (nM - fm) < WGM ? (nM - fm) : WGM;
        u.pm = fm + ((wgid % nig) % gsz); u.pn = (wgid % nig) / gsz;
        if (dual) u.pm = (u.pm >> 5) * 33 + 1 + (u.pm & 31);
        u.kind = 0; return true;
    }
};

typedef float f32x2_t __attribute__((ext_vector_type(2))); typedef __bf16 bf16x2_t __attribute__((ext_vector_type(2)));
__device__ __forceinline__ unsigned cvt_pk_bf16(float lo, float hi) { f32x2_t v = {lo, hi}; bf16x2_t b = __builtin_convertvector(v, bf16x2_t); return __builtin_bit_cast(unsigned, b); }

struct Epi {
    int mode; bf16_t* O; int ldc; u32x4* scr;
    __device__ __forceinline__ void operator()(const f32x4 (&acc)[2][2][4][2], const Unit& u, int wr, int wc, int fr, int fq) const {
        const int row0 = u.pm * BM + wr * 64 + fr;
        if (mode == 0) {
            const int col0 = u.pn * BM + wc * 32 + 8 * fq;
#pragma unroll
            for (int ai = 0; ai < 2; ++ai)
#pragma unroll
                for (int m = 0; m < 4; ++m) { bf16_t* rowp = O + (size_t)(row0 + ai * HALF + m * 16) * ldc + col0;
#pragma unroll
                    for (int bj = 0; bj < 2; ++bj) { const f32x4 v0 = acc[ai][bj][m][0], v1 = acc[ai][bj][m][1];
                        u32x4 w; w.x = cvt_pk_bf16(v0[0], v0[1]); w.y = cvt_pk_bf16(v0[2], v0[3]); w.z = cvt_pk_bf16(v1[0], v1[1]); w.w = cvt_pk_bf16(v1[2], v1[3]);
                        *(u32x4*)(rowp + bj * HALF) = w; } }
        } else if (mode == 1) {
            const int col0 = u.pn * HALF + wc * 32 + 8 * fq;
#pragma unroll
            for (int ai = 0; ai < 2; ++ai)
#pragma unroll
                for (int m = 0; m < 4; ++m) { bf16_t* rowp = O + (size_t)(row0 + ai * HALF + m * 16) * ldc + col0;
                    float h[8];
#pragma unroll
                    for (int n = 0; n < 2; ++n)
#pragma unroll
                        for (int e = 0; e < 4; ++e) { const float g = acc[ai][0][m][n][e], up = acc[ai][1][m][n][e]; h[n * 4 + e] = g * sigmoidf_(g) * up; }
                    u32x4 w; w.x = cvt_pk_bf16(h[0], h[1]); w.y = cvt_pk_bf16(h[2], h[3]); w.z = cvt_pk_bf16(h[4], h[5]); w.w = cvt_pk_bf16(h[6], h[7]);
                    *(u32x4*)rowp = w; }
        } else if (mode == 3) {
            const int col0 = u.pn * BM + wc * 32 + 8 * fq;
#pragma unroll
            for (int ai = 0; ai < 2; ++ai)
#pragma unroll
                for (int m = 0; m < 4; ++m) { bf16_t* rowp = O + (size_t)(row0 + ai * HALF + m * 16) * ldc + col0;
#pragma unroll
                    for (int bj = 0; bj < 2; ++bj) { const f32x4 v0 = acc[ai][bj][m][0], v1 = acc[ai][bj][m][1];
                        u32x4 w; w.x = cvt_pk_bf16(sigmoidf_(v0[0]), sigmoidf_(v0[1])); w.y = cvt_pk_bf16(sigmoidf_(v0[2]), sigmoidf_(v0[3]));
                        w.z = cvt_pk_bf16(sigmoidf_(v1[0]), sigmoidf_(v1[1])); w.w = cvt_pk_bf16(sigmoidf_(v1[2]), sigmoidf_(v1[3]));
                        *(u32x4*)(rowp + bj * HALF) = w; } }
        } else {
            const int col0 = u.pn * BM + wc * 32 + 8 * fq;
#pragma unroll
            for (int ai = 0; ai < 2; ++ai)
#pragma unroll
                for (int m = 0; m < 4; ++m) { const size_t r = (size_t)(row0 + ai * HALF + m * 16);
                    const bf16_t* gp = (const bf16_t*)scr + r * 4096 + 3 * 1024 + col0; bf16_t* rowp = O + r * ldc + col0;
#pragma unroll
                    for (int bj = 0; bj < 2; ++bj) { const u32x4 g = *(const u32x4*)(gp + bj * HALF); const f32x4 v0 = acc[ai][bj][m][0], v1 = acc[ai][bj][m][1];
                        u32x4 w; w.x = cvt_pk_bf16(v0[0] * gclamp(bflo(g.x)), v0[1] * gclamp(bfhi(g.x))); w.y = cvt_pk_bf16(v0[2] * gclamp(bflo(g.y)), v0[3] * gclamp(bfhi(g.y)));
                        w.z = cvt_pk_bf16(v1[0] * gclamp(bflo(g.z)), v1[1] * gclamp(bfhi(g.z))); w.w = cvt_pk_bf16(v1[2] * gclamp(bflo(g.w)), v1[3] * gclamp(bfhi(g.w)));
                        *(u32x4*)(rowp + bj * HALF) = w; } }
        }
    }
    static __device__ __forceinline__ float gclamp(float g) { return __builtin_fmaxf(g, 1e-6f); }
    __device__ __forceinline__ void rescale(f32x4 (&acc)[2][2][4][2], const Unit& u, int i, int wr, int wc, int fr, int fq) const {
        int row0 = u.pm * BM + wr * 64 + fr; const int col0 = u.pn * BM + wc * 32 + 8 * fq;
        asm volatile("" : "+v"(row0));
#pragma unroll
        for (int ai = 0; ai < 2; ++ai)
#pragma unroll
            for (int m = 0; m < 4; ++m) { const bf16_t* gp = (const bf16_t*)scr + (size_t)(row0 + ai * HALF + m * 16) * 4096 + i * 1024 + col0;
#pragma unroll
                for (int bj = 0; bj < 2; ++bj) { const u32x4 ga = *(const u32x4*)(gp + bj * HALF), gb = *(const u32x4*)(gp + 1024 + bj * HALF);
                    f32x4 r0, r1;
                    r0[0] = gclamp(bflo(ga.x)) * frcp(gclamp(bflo(gb.x))); r0[1] = gclamp(bfhi(ga.x)) * frcp(gclamp(bfhi(gb.x)));
                    r0[2] = gclamp(bflo(ga.y)) * frcp(gclamp(bflo(gb.y))); r0[3] = gclamp(bfhi(ga.y)) * frcp(gclamp(bfhi(gb.y)));
                    r1[0] = gclamp(bflo(ga.z)) * frcp(gclamp(bflo(gb.z))); r1[1] = gclamp(bfhi(ga.z)) * frcp(gclamp(bfhi(gb.z)));
                    r1[2] = gclamp(bflo(ga.w)) * frcp(gclamp(bflo(gb.w))); r1[3] = gclamp(bfhi(ga.w)) * frcp(gclamp(bfhi(gb.w)));
                    acc[ai][bj][m][0] = acc[ai][bj][m][0] * r0; acc[ai][bj][m][1] = acc[ai][bj][m][1] * r1; }
                if (m == 3) asm volatile("" ::: "memory"); }
    }
};

template <bool HOOK, class Sched>
__device__ __forceinline__ void gemm_phase(LAS unsigned char* lds, const Gemm g, const Sched& S, const Epi& E) {
    const int tid = ptid(), wid = __builtin_amdgcn_readfirstlane(tid >> 6), lane = tid & 63, wr = wid >> 2, wc = wid & 3, fr = lane & 15, fq = lane >> 4;
    const int K = g.K, nt = K / BK;
    unsigned voffA[2], voffB[2];
#pragma unroll
    for (int i = 0; i < 2; ++i) { int Rr, C; stage_rc(tid * 16 + i * 8192, Rr, C); const int Rb = (Rr & ~31) + perm32(Rr & 31);
        voffA[i] = (unsigned)(Rr * g.lda + C) * 2u; voffB[i] = (unsigned)(Rb * g.ldb + C) * 2u; }
    const size_t kstep = (size_t)(BK * 2);
    const size_t hsA = (size_t)HALF * g.lda * 2, hsB = (size_t)HALF * g.ldb * 2;
    const size_t tsA = 2 * hsA, tsB = 2 * hsB;
    const unsigned ldsw = (unsigned)wid * 1024u;
    const int aoff = lds_byte(wr * 64 + fr, fq * 8), boff = lds_byte(wc * 32 + fr, fq * 8);
#define PG8_SA(b, h) (((b) * 2 + (h)) * HTB)
#define PG8_SB(b, h) ((4 + (b) * 2 + (h)) * HTB)
#define PG8_STAGE(bufoff, gbase, voff) do { _Pragma("unroll") for (int _i = 0; _i < 2; ++_i) \
        __builtin_amdgcn_global_load_lds((const unsigned*)((const char*)(gbase) + (voff)[_i]), (LAS unsigned*)(lds + (bufoff) + ldsw + _i * 8192), 16, 0, 0); } while (0)
#define PG8_LDA(dst, b, h) do { _Pragma("unroll") for (int m = 0; m < 4; ++m) _Pragma("unroll") for (int k = 0; k < 2; ++k) dst[m][k] = *(const LAS bf16x8*)(lds + PG8_SA(b, h) + aoff + m * 2048 + k * 1024); } while (0)
#define PG8_LDB(dst, b, h) do { _Pragma("unroll") for (int n = 0; n < 2; ++n) _Pragma("unroll") for (int k = 0; k < 2; ++k) dst[n][k] = *(const LAS bf16x8*)(lds + PG8_SB(b, h) + boff + n * 2048 + k * 1024); } while (0)
#define PG8_MMA(ai, bj, At, Bt) do { __builtin_amdgcn_s_setprio(1); _Pragma("unroll") for (int m = 0; m < 4; ++m) _Pragma("unroll") for (int n = 0; n < 2; ++n) _Pragma("unroll") for (int k = 0; k < 2; ++k) \
        acc[ai][bj][m][n] = __builtin_amdgcn_mfma_f32_16x16x32_bf16(Bt[n][k], At[m][k], acc[ai][bj][m][n], 0, 0, 0); __builtin_amdgcn_s_setprio(0); } while (0)
#define PG8_MMA1(ai, bj, nn, At, Bt) do { __builtin_amdgcn_s_setprio(1); _Pragma("unroll") for (int m = 0; m < 4; ++m) _Pragma("unroll") for (int k = 0; k < 2; ++k) \
        acc[ai][bj][m][nn] = __builtin_amdgcn_mfma_f32_16x16x32_bf16(Bt[nn][k], At[m][k], acc[ai][bj][m][nn], 0, 0, 0); __builtin_amdgcn_s_setprio(0); } while (0)
#define PG8_MMAZ(ai, At) do { if (zbr == 0) PG8_MMA1(ai, 0, 0, At, B0); else if (zbr == 1) PG8_MMA1(ai, 0, 1, At, B0); else if (zbr == 2) PG8_MMA1(ai, 1, 0, At, B1); else PG8_MMA1(ai, 1, 1, At, B1); } while (0)
#define PG8_MM2(ai, At) do { PG8_MMA(ai, 0, At, B0); PG8_MMA(ai, 1, At, B1); } while (0)
#define PG8_WAIT_V(n) asm volatile("s_waitcnt vmcnt(" #n ")" ::: "memory")
#define PG8_WAIT_L(n) asm volatile("s_waitcnt lgkmcnt(" #n ")" ::: "memory")
#define PG8_BAR __builtin_amdgcn_s_barrier()
#define PG8_SCHED __builtin_amdgcn_sched_barrier(0)
#define PG8_UA(u) ((const char*)((u).kind ? g.A2 : g.A) + (size_t)(u).pm * tsA)
#define PG8_UB(u) ((const char*)((u).kind ? g.Bt2 : g.Bt) + (size_t)(u).pn * tsB)
    Unit cur, nxt; int ui = 0;
    if (!S.next(0, cur)) return;
    f32x4 acc[2][2][4][2];
#pragma unroll
    for (int a = 0; a < 2; ++a)
#pragma unroll
        for (int b = 0; b < 2; ++b)
#pragma unroll
            for (int m = 0; m < 4; ++m)
#pragma unroll
                for (int n = 0; n < 2; ++n) acc[a][b][m][n] = (f32x4){0.f, 0.f, 0.f, 0.f};
    bf16x8 At[4][2], B0[2][2], B1[2][2];
    const char* cA = PG8_UA(cur); const char* cB = PG8_UB(cur);
    {
        PG8_STAGE(PG8_SB(0, 0), cB, voffB); PG8_STAGE(PG8_SB(0, 1), cB + hsB, voffB); PG8_STAGE(PG8_SA(0, 0), cA, voffA); PG8_STAGE(PG8_SA(0, 1), cA + hsA, voffA);
        if (wr == 1) PG8_BAR;
        PG8_WAIT_V(2); PG8_BAR;
        PG8_STAGE(PG8_SB(1, 0), cB + kstep, voffB); PG8_STAGE(PG8_SA(1, 0), cA + kstep, voffA); PG8_STAGE(PG8_SB(1, 1), cB + hsB + kstep, voffB);
        PG8_WAIT_V(6); PG8_BAR;
    }
    for (;;) {
        const bool has_next = S.next(ui + 1, nxt);
        const char* nA = has_next ? PG8_UA(nxt) : cA; const char* nB = has_next ? PG8_UB(nxt) : cB;
        for (int t = 0; t < nt; t += 2) {
            const bool last = (t == nt - 2);
            if constexpr (HOOK) { if (t == 4 || t == 8 || t == 12) { PG8_SCHED; E.rescale(acc, cur, (t >> 2) - 1, wr, wc, fr, fq); PG8_SCHED; } }
            const char* a1 = cA + (size_t)(t + 1) * kstep;
            const char* a2 = last ? nA : cA + (size_t)(t + 2) * kstep; const char* b2 = last ? nB : cB + (size_t)(t + 2) * kstep;
            const char* a3 = a2 + kstep; const char* b3 = b2 + kstep;
            PG8_LDB(B0, 0, 0); PG8_LDB(B1, 0, 1); PG8_SCHED; PG8_LDA(At, 0, 0); PG8_STAGE(PG8_SA(1, 1), a1 + hsA, voffA);
            PG8_WAIT_V(8); PG8_WAIT_L(0); PG8_BAR; PG8_MM2(0, At); PG8_BAR; PG8_SCHED;
            PG8_LDA(At, 0, 1); PG8_STAGE(PG8_SB(0, 0), b2, voffB); PG8_STAGE(PG8_SB(0, 1), b2 + hsB, voffB); PG8_STAGE(PG8_SA(0, 0), a2, voffA);
            PG8_WAIT_V(8); PG8_WAIT_L(0); PG8_BAR; PG8_MM2(1, At); PG8_BAR; PG8_SCHED;
            PG8_LDB(B0, 1, 0); PG8_LDB(B1, 1, 1); PG8_SCHED; PG8_LDA(At, 1, 0); PG8_STAGE(PG8_SA(0, 1), a2 + hsA, voffA);
            PG8_WAIT_V(8); PG8_WAIT_L(0); PG8_BAR; PG8_MM2(0, At); PG8_BAR; PG8_SCHED;
            PG8_LDA(At, 1, 1); PG8_STAGE(PG8_SB(1, 0), b3, voffB); PG8_STAGE(PG8_SB(1, 1), b3 + hsB, voffB); PG8_STAGE(PG8_SA(1, 0), a3, voffA);
            PG8_WAIT_V(8); PG8_WAIT_L(0); PG8_BAR; PG8_MM2(1, At); PG8_BAR; PG8_SCHED;
        }
        if (wr == 0) PG8_BAR;
        E(acc, cur, wr, wc, fr, fq);
        if (!has_next) break;
#pragma unroll
        for (int a = 0; a < 2; ++a)
#pragma unroll
            for (int b = 0; b < 2; ++b)
#pragma unroll
                for (int m = 0; m < 4; ++m)
#pragma unroll
                    for (int n = 0; n < 2; ++n) acc[a][b][m][n] = (f32x4){0.f, 0.f, 0.f, 0.f};
        cur = nxt; cA = nA; cB = nB; ++ui;
        if (wr == 1) PG8_BAR;
    }
    PG8_WAIT_V(0);
    PG8_BAR;
#undef PG8_SA
#undef PG8_SB
#undef PG8_STAGE
#undef PG8_LDA
#undef PG8_LDB
#undef PG8_MMA
#undef PG8_MMA1
#undef PG8_MMAZ
#undef PG8_MM2
#undef PG8_WAIT_V
#undef PG8_WAIT_L
#undef PG8_BAR
#undef PG8_SCHED
#undef PG8_UA
#undef PG8_UB
}
}

struct Args {
    const float* x; const float* c; const float* ctx; const float* c_ctx; const float* w_mod; const float* b_mod; const float* g_pre; const float* g_post;
    const float* w_gate; const float* w_up; const float* w_down; const float* w_in; const float* gqa_qn; const float* gqa_kn; const float* mla_qn; const float* mla_kvn;
    const float* w_uq; const float* w_ukv; const float* dlam; const float* dsub; const float* sink; const float* w_branch; const float* w_out;
    float* out; unsigned char* ws; int ph_lo, ph_hi;
};
typedef const __attribute__((address_space(4))) Args CArgs;

template <class F>
__device__ __forceinline__ void conv_item(bf16_t* WT, int K, int nblk, int item, LAS float* scr, int lane, const F& f) {
    const int kb = item / nblk, nb = item % nblk, k0 = 64 * kb, n0 = 32 * nb;
#pragma unroll 8
    for (int i = 0; i < 32; ++i) { const int kk = 2 * i + (lane >> 5); scr[kk * 33 + (lane & 31)] = f(n0 + (lane & 31), k0 + kk); }
    asm volatile("s_waitcnt lgkmcnt(0)" ::: "memory");
    const int c = lane & 7;
#pragma unroll
    for (int j = 0; j < 4; ++j) { const int n = (lane >> 3) + 8 * j; const LAS float* s = scr + (8 * c) * 33 + n;
        u32x4 o; o.x = pk2(s[0 * 33], s[1 * 33]); o.y = pk2(s[2 * 33], s[3 * 33]); o.z = pk2(s[4 * 33], s[5 * 33]); o.w = pk2(s[6 * 33], s[7 * 33]);
        *(u32x4*)(WT + (size_t)(n0 + n) * K + k0 + 8 * c) = o; }
    asm volatile("s_waitcnt lgkmcnt(0)" ::: "memory");
}

__device__ __forceinline__ void p0_phase(CArgs& a, LAS unsigned char* lds) {
    const int tid = ptid(), lane = tid & 63, wave = tid >> 6;
    float* MOD = (float*)(a.ws + WS_MOD);
    {
        LAS float* sl = (LAS float*)lds;
        LAS float* red = (LAS float*)(lds + 40960);
        for (int i = tid; i < 9 * 1024; i += 512) { const int r = i >> 10, k = i & 1023; const float v = r < 8 ? a.c[r * 1024 + k] : a.c_ctx[k]; sl[i] = v * sigmoidf_(v); }
        __syncthreads();
        for (int it = blockIdx.x; it < 2 * 144; it += gridDim.x) {
            const int l = it / 144, n0 = (it % 144) * 64;
            const float* W = a.w_mod + (size_t)l * 1024 * MODW + n0 + lane;
            float acc[9];
#pragma unroll
            for (int r = 0; r < 9; ++r) acc[r] = 0.f;
#pragma unroll 8
            for (int kk = 0; kk < 128; ++kk) { const int k = wave * 128 + kk; const float wv = W[(size_t)k * MODW];
#pragma unroll
                for (int r = 0; r < 9; ++r) acc[r] += sl[r * 1024 + k] * wv; }
#pragma unroll
            for (int r = 0; r < 9; ++r) red[(wave * 9 + r) * 64 + lane] = acc[r];
            __syncthreads();
            for (int i = tid; i < 9 * 64; i += 512) { const int r = i >> 6, cidx = i & 63; float s = a.b_mod[l * MODW + n0 + cidx];
#pragma unroll
                for (int w = 0; w < 8; ++w) s += red[(w * 9 + r) * 64 + cidx];
                MOD[((size_t)l * 9 + r) * MODW + n0 + cidx] = s; }
            __syncthreads();
        }
        __syncthreads();
    }
    LAS float* scr = (LAS float*)(lds + wave * 8448);
    const int gw = blockIdx.x * 8 + wave, NGW = gridDim.x * 8;
    constexpr int I_GU = 176 * 16, I_D = 32 * 44, I_IN = 72 * 16, I_G = 128 * 16, I_BR = 32 * 16, I_OUT = 32 * 16, I_MLA = 32 * 6;
    constexpr int I_LAYER = 2 * I_GU + 2 * I_D + I_IN + I_G + I_BR + I_OUT + I_MLA;
    for (int it = gw; it < 2 * I_LAYER; it += NGW) {
        const int l = it / I_LAYER; int r = it % I_LAYER;
        unsigned char* wb = a.ws + WS_W + (size_t)l * W_LAYER;
        if (r < 2 * I_GU) { const int s = r / I_GU; r %= I_GU;
            const float* wg = a.w_gate + (size_t)(l * 2 + s) * 1024 * DFF; const float* wu = a.w_up + (size_t)(l * 2 + s) * 1024 * DFF;
            conv_item((bf16_t*)(wb + W_GU + s * W_GU_SZ), 1024, 176, r, scr, lane, [=](int n, int k) { const int j = (n >> 8) * 128 + (n & 127); return ((n >> 7) & 1) ? wu[(size_t)k * DFF + j] : wg[(size_t)k * DFF + j]; });
            continue; }
        r -= 2 * I_GU;
        if (r < 2 * I_D) { const int s = r / I_D; r %= I_D;
            const float* wd = a.w_down + (size_t)(l * 2 + s) * DFF * 1024;
            conv_item((bf16_t*)(wb + W_D + s * W_D_SZ), DFF, 32, r, scr, lane, [=](int n, int k) { return wd[(size_t)k * 1024 + n]; });
            continue; }
        r -= 2 * I_D;
        const float* win = a.w_in + (size_t)l * 1024 * INCOLS;
        if (r < I_IN) { conv_item((bf16_t*)(wb + W_IN), 1024, 72, r, scr, lane, [=](int n, int k) { return n < GATE0 ? win[(size_t)k * INCOLS + n] : 0.f; }); continue; }
        r -= I_IN;
        if (r < I_G) { conv_item((bf16_t*)(wb + W_G), 1024, 128, r, scr, lane, [=](int n, int k) { return win[(size_t)k * INCOLS + GATE0 + n]; }); continue; }
        r -= I_G;
        if (r < I_BR) { const float* wbr = a.w_branch + (size_t)l * 4 * 256 * 1024;
            conv_item((bf16_t*)(wb + W_BR), 1024, 32, r, scr, lane, [=](int n, int k) { return wbr[(size_t)k * 1024 + n]; }); continue; }
        r -= I_BR;
        if (r < I_OUT) { const float* wo = a.w_out + (size_t)l * 1024 * 1024;
            conv_item((bf16_t*)(wb + W_OUT), 1024, 32, r, scr, lane, [=](int n, int k) { return wo[(size_t)k * 1024 + n]; }); continue; }
        r -= I_OUT;
        { const float* uq = a.w_uq + (size_t)l * 256 * 384; const float* ukv = a.w_ukv + (size_t)l * 128 * 512; const float* gq = a.mla_qn + l * 256; const float* gkv = a.mla_kvn + l * 128;
            conv_item((bf16_t*)(wb + W_MLA), 384, 32, r, scr, lane, [=](int n, int k) {
                float v = 0.f;
                if (n < 384) { if (k < 256) v = gq[k] * uq[(size_t)k * 384 + n]; }
                else if (n < 896) { if (k >= 256) v = gkv[k - 256] * ukv[(size_t)(k - 256) * 512 + (n - 384)]; }
                return v; }); }
    }
}

__device__ __forceinline__ void row_phase(CArgs& a, int l, bool first, const bf16_t* Y, int sub_y, float gscale, bf16_t* U, int sub_u, int l_u) {
    const int tid_ = ptid(); const int lane = tid_ & 63, wave = tid_ >> 6;
    const int gw = blockIdx.x * 8 + wave, NGW = gridDim.x * 8;
    const float* MOD = (const float*)(a.ws + WS_MOD);
    float* XC = (float*)(a.ws + WS_XC);
#pragma unroll 2
    for (int row = gw; row < R; row += NGW) {
        const int b = row / RPB, t = row % RPB; const bool isctx = t < CTX;
        const float* xs; float* xd;
        if (isctx) { const size_t o = (size_t)(b * CTX + t) * DM; xs = (first ? a.ctx : XC) + o; xd = XC + o; }
        else { const size_t o = (size_t)(b * SEQ + (t - CTX)) * DM; xs = (first ? a.x : a.out) + o; xd = a.out + o; }
        const int mrow = isctx ? 8 : b;
        f32x4 v[4];
#pragma unroll
        for (int j = 0; j < 4; ++j) v[j] = __builtin_nontemporal_load((const f32x4*)(xs + 4 * lane + 256 * j));
        if (Y) {
            const float* md = MOD + ((size_t)l * 9 + mrow) * MODW + (sub_y * 3 + 2) * 1024;
            const float* gp = a.g_post + (l * 3 + sub_y) * 1024;
            f32x4 y[4]; float ss = 0.f;
#pragma unroll
            for (int j = 0; j < 4; ++j) { const u32x2 w = __builtin_nontemporal_load((const u32x2*)(Y + (size_t)row * DM + 4 * lane + 256 * j));
                y[j] = (f32x4){bflo(w.x), bfhi(w.x), bflo(w.y), bfhi(w.y)}; ss += (y[j].x * y[j].x + y[j].y * y[j].y) + (y[j].z * y[j].z + y[j].w * y[j].w); }
            const float rs = __builtin_amdgcn_rsqf(wave_sum(ss) * (1.f / DM) + EPS) * gscale;
#pragma unroll
            for (int j = 0; j < 4; ++j) { const f32x4 g = *(const f32x4*)(md + 4 * lane + 256 * j), p = *(const f32x4*)(gp + 4 * lane + 256 * j);
                v[j] = v[j] + (y[j] * rs) * p * g; __builtin_nontemporal_store(v[j], (f32x4*)(xd + 4 * lane + 256 * j)); }
        }
        if (U) {
            const float* md = MOD + ((size_t)l_u * 9 + mrow) * MODW + (sub_u * 3) * 1024;
            const float* gp = a.g_pre + (l_u * 3 + sub_u) * 1024;
            float ss = 0.f;
#pragma unroll
            for (int j = 0; j < 4; ++j) ss += (v[j].x * v[j].x + v[j].y * v[j].y) + (v[j].z * v[j].z + v[j].w * v[j].w);
            const float rs = __builtin_amdgcn_rsqf(wave_sum(ss) * (1.f / DM) + EPS);
#pragma unroll
            for (int j = 0; j < 4; ++j) { const f32x4 sh = *(const f32x4*)(md + 4 * lane + 256 * j), sc = *(const f32x4*)(md + 1024 + 4 * lane + 256 * j), p = *(const f32x4*)(gp + 4 * lane + 256 * j);
                const f32x4 u = (v[j] * rs) * p * (sc + 1.f) + sh;
                u32x2 w; w.x = pk2(u.x, u.y); w.y = pk2(u.z, u.w);
                *(u32x2*)(U + (size_t)row * DM + 4 * lane + 256 * j) = w; }
        }
    }
}

constexpr int VSTR = 136;
constexpr int TAB_OFF = 768 * VSTR;
__device__ __forceinline__ void rope64p(float& v0, float& v1, int l, bool lat, const LAS float* tab, int prow, int pcol) {
    const float p0 = __shfl_xor(v0, 8), p1 = __shfl_xor(v1, 8);
    const int lh = l & 31, pos = (lh & 16) ? pcol : prow, i0 = (2 * lh) & 15;
    const f32x4 cs = *(const LAS f32x4*)(tab + (pos * 16 + i0) * 2);
    const bool sec = (lh >> 3) & 1;
    const float c0 = lat ? cs[0] : 1.f, s0 = lat ? (sec ? cs[1] : -cs[1]) : 0.f, c1 = lat ? cs[2] : 1.f, s1 = lat ? (sec ? cs[3] : -cs[3]) : 0.f;
    v0 = v0 * c0 + p0 * s0; v1 = v1 * c1 + p1 * s1;
}
__device__ __forceinline__ void rope32p(float& v0, float& v1, int d0, bool lat, const LAS float* tab, int prow, int pcol) {
    const float p0 = __shfl_xor(v0, 4), p1 = __shfl_xor(v1, 4);
    const int pos = (d0 & 16) ? pcol : prow, i0 = d0 & 7;
    const LAS float* t = tab + (pos * 16 + 2 * i0) * 2;
    const bool sec = (d0 >> 3) & 1;
    const float c0 = lat ? t[0] : 1.f, s0 = lat ? (sec ? t[1] : -t[1]) : 0.f, c1 = lat ? t[4] : 1.f, s1 = lat ? (sec ? t[5] : -t[5]) : 0.f;
    v0 = v0 * c0 + p0 * s0; v1 = v1 * c1 + p1 * s1;
}
__device__ __forceinline__ float half_sum(float v) {
#pragma unroll
    for (int o = 1; o < 32; o <<= 1) v += __shfl_xor(v, o);
    return v;
}
__device__ __forceinline__ void prep_phase(CArgs& a, int l, LAS unsigned char* lds) {
    const int tid = ptid(), lane = tid & 63, wave = __builtin_amdgcn_readfirstlane(tid >> 6);
    bf16_t* HIN = (bf16_t*)(a.ws + WS_BIG); bf16_t* MUP = (bf16_t*)(a.ws + WS_Y); bf16_t* VT = (bf16_t*)(a.ws + WS_VT);
    LAS float* tab = (LAS float*)(lds + TAB_OFF);
    for (int i = tid; i < 128 * 16; i += 512) { const int pos = i >> 4, f = i & 15;
        const float invf = fexp2(-(float)(2 * f) * (1.f / 32.f) * 13.287712379549449f);
        float rev = (float)pos * invf * 0.15915494309189535f; rev -= __builtin_floorf(rev);
        tab[i * 2] = __builtin_amdgcn_cosf(rev); tab[i * 2 + 1] = __builtin_amdgcn_sinf(rev); }
    __syncthreads();
    const int lh = lane & 31;
    const float gq0 = a.gqa_qn[l * 64 + 2 * lh], gq1 = a.gqa_qn[l * 64 + 2 * lh + 1], gk0 = a.gqa_kn[l * 64 + 2 * lh], gk1 = a.gqa_kn[l * 64 + 2 * lh + 1];
#define LD2(p, v0, v1) do { const unsigned w_ = *(const unsigned*)(p); v0 = bflo(w_); v1 = bfhi(w_); } while (0)
#define ST2(p, v0, v1) do { *(unsigned*)(p) = pg8::cvt_pk_bf16(v0, v1); } while (0)
    for (int tile = blockIdx.x; tile < R / 64; tile += gridDim.x) {
        const int row0 = tile * 64, b = row0 / RPB, t0 = row0 % RPB;
#pragma unroll 4
        for (int rr = 0; rr < 8; ++rr) {
            const int tk = wave * 8 + rr, row = row0 + tk, t = t0 + tk; const bool lat = t >= CTX;
            const int tl = lat ? t - CTX : 0, prow = tl >> 6, pcol = tl & 63;
            bf16_t* __restrict__ h = HIN + (size_t)row * NHIN; bf16_t* __restrict__ mu = MUP + (size_t)row * 1024;
            LAS bf16_t* vst = (LAS bf16_t*)lds + tk;
#pragma unroll
            for (int j = 0; j < 3; ++j) { float v0, v1; LD2(h + 128 * j + 2 * lane, v0, v1);
                const float rs = __builtin_amdgcn_rsqf(half_sum(v0 * v0 + v1 * v1) * (1.f / 64.f) + EPS);
                v0 = v0 * rs * (j < 2 ? gq0 : gk0); v1 = v1 * rs * (j < 2 ? gq1 : gk1);
                rope64p(v0, v1, lane, lat, tab, prow, pcol);
                if (j < 2) { v0 *= QS_GQA; v1 *= QS_GQA; }
                ST2(h + 128 * j + 2 * lane, v0, v1); }
            { const unsigned w = *(const unsigned*)(h + 384 + 2 * lane); vst[(0 + 2 * lane) * (VSTR / 2)] = (bf16_t)(w & 0xffffu); vst[(0 + 2 * lane + 1) * (VSTR / 2)] = (bf16_t)(w >> 16); }
            float sq = 0.f, skv = 0.f;
#pragma unroll
            for (int j = 0; j < 2; ++j) { float v0, v1; LD2(h + 512 + 128 * j + 2 * lane, v0, v1); sq += v0 * v0 + v1 * v1; }
            { float v0, v1; LD2(h + 768 + 2 * lane, v0, v1); skv = v0 * v0 + v1 * v1; }
            const float rq = __builtin_amdgcn_rsqf(wave_sum(sq) * (1.f / 256.f) + EPS) * QS_MLA, rkv = __builtin_amdgcn_rsqf(wave_sum(skv) * (1.f / 128.f) + EPS);
#pragma unroll
            for (int j = 0; j < 3; ++j) { const int c = 128 * j + 2 * lane, e = c % 96; float v0, v1; LD2(mu + c, v0, v1); v0 *= rq; v1 *= rq;
                float r0 = v0, r1 = v1; rope32p(r0, r1, (e - 64) & 30, lat, tab, prow, pcol);
                if (e >= 64) { v0 = r0; v1 = r1; }
                ST2(mu + c, v0, v1); }
#pragma unroll
            for (int hh = 0; hh < 4; ++hh) { const int c = 384 + 128 * hh + 2 * lane; float v0, v1; LD2(mu + c, v0, v1); v0 *= rkv; v1 *= rkv;
                const unsigned w = pg8::cvt_pk_bf16(v0, v1);
                if (lane < 32) *(unsigned*)(mu + c) = w;
                else { vst[(128 + 64 * hh + 2 * (lane - 32)) * (VSTR / 2)] = (bf16_t)(w & 0xffffu); vst[(128 + 64 * hh + 2 * (lane - 32) + 1) * (VSTR / 2)] = (bf16_t)(w >> 16); } }
            { float v0, v1; LD2(h + 896 + 2 * (lane & 15), v0, v1); rope32p(v0, v1, 2 * (lane & 15), lat, tab, prow, pcol); if (lane < 16) ST2(mu + 896 + 2 * lane, v0, v1); }
#pragma unroll
            for (int j = 0; j < 4; ++j) { float v0, v1; LD2(h + 928 + 128 * j + 2 * lane, v0, v1); rope32p(v0, v1, (2 * lane) & 31, lat, tab, prow, pcol);
                if (j < 2) { v0 *= QS_DIFF; v1 *= QS_DIFF; }
                ST2(h + 928 + 128 * j + 2 * lane, v0, v1); }
#pragma unroll
            for (int j = 0; j < 2; ++j) { const unsigned w = *(const unsigned*)(h + 1440 + 128 * j + 2 * lane); vst[(384 + 128 * j + 2 * lane) * (VSTR / 2)] = (bf16_t)(w & 0xffffu); vst[(384 + 128 * j + 2 * lane + 1) * (VSTR / 2)] = (bf16_t)(w >> 16); }
#pragma unroll
            for (int j = 0; j < 3; ++j) { float v0, v1; LD2(h + 1696 + 128 * j + 2 * lane, v0, v1); rope64p(v0, v1, lane, lat, tab, prow, pcol);
                if (j < 2) { v0 *= QS_GQA; v1 *= QS_GQA; }
                ST2(h + 1696 + 128 * j + 2 * lane, v0, v1); }
            { const unsigned w = *(const unsigned*)(h + 2080 + 2 * lane); vst[(640 + 2 * lane) * (VSTR / 2)] = (bf16_t)(w & 0xffffu); vst[(640 + 2 * lane + 1) * (VSTR / 2)] = (bf16_t)(w >> 16); }
        }
#undef LD2
#undef ST2
        __syncthreads();
        bf16_t* vt = VT + (size_t)b * 768 * RPB + t0;
        for (int p = tid; p < 768 * 8; p += 512) { const int vr = p >> 3, seg = p & 7;
            const LAS u32x2* s = (const LAS u32x2*)(lds + vr * VSTR + seg * 16); const u32x2 lo = s[0], hi = s[1];
            *(u32x4*)(vt + (size_t)vr * RPB + seg * 8) = (u32x4){lo.x, lo.y, hi.x, hi.y}; }
        __syncthreads();
    }
}

__device__ __forceinline__ int crow(int r, int hi) { return (r & 3) + 8 * (r >> 2) + 4 * hi; }
constexpr int AT_KBUF = 128 * (96 * 2 + 16);
constexpr int AT_VSTR = 264, AT_VBUF = 64 * AT_VSTR;
constexpr int AT_K0 = 0, AT_V0 = 2 * AT_KBUF, AT_WS = AT_V0 + 2 * AT_VBUF;

struct AttnSrc { const bf16_t* Q; int ldq; const bf16_t* K1; int ldk1; const bf16_t* K2; int ldk2; const bf16_t* VT; };

template <int DQK, bool WIN>
__device__ __forceinline__ void attn_pass(const AttnSrc& s, int NT, int lo, int q0lat, float sink_l2, bool has_sink, LAS unsigned char* lds, f32x16 (&o)[2]) {
    constexpr int KSTR = DQK * 2 + 16, NCH = DQK / 8, NKS = DQK / 16, NP = (128 * NCH) / 512;
    const int tid = ptid(), lane = tid & 63, r32 = lane & 31, hi = lane >> 5; const int wid = __builtin_amdgcn_readfirstlane(tid >> 6);
    LAS float* wsf = (LAS float*)(lds + AT_WS) + wid * 32;
    bf16x8 qf[NKS];
    { const bf16_t* qp = s.Q + (size_t)(wid * 32 + r32) * s.ldq + 8 * hi;
#pragma unroll
        for (int ks = 0; ks < NKS; ++ks) qf[ks] = *(const bf16x8*)(qp + 16 * ks); }
    o[0] = (f32x16){}; o[1] = (f32x16){};
    f32x16 negm = (f32x16){}; asm volatile("" : "+v"(negm));
    float mhat = 0.f, lsum = 0.f;
    const int NT2 = NT >> 1, lo2 = lo >> 1;
    u32x4 kr[NP], vr[2];
    auto kaddr = [&](int key, int c) -> const bf16_t* { return (DQK == 96 && c >= 8) ? s.K2 + (size_t)key * s.ldk2 + (c - 8) * 8 : s.K1 + (size_t)key * s.ldk1 + c * 8; };
#define AT_TILE(j) ((j) < 2 ? (j) : lo2 - 2 + (j))
#define AT_GLOAD(j) do { const int key0_ = AT_TILE(j) * 128; \
        _Pragma("unroll") for (int p = 0; p < NP; ++p) { const int idx_ = tid + 512 * p; kr[p] = *(const u32x4*)kaddr(key0_ + idx_ / NCH, idx_ % NCH); } \
        _Pragma("unroll") for (int p = 0; p < 2; ++p) { const int idx_ = tid + 512 * p; vr[p] = *(const u32x4*)(s.VT + (size_t)(idx_ >> 4) * RPB + key0_ + (idx_ & 15) * 8); } } while (0)
#define AT_LSTORE(buf) do { \
        _Pragma("unroll") for (int p = 0; p < NP; ++p) { const int idx_ = tid + 512 * p; *(LAS u32x4*)(lds + AT_K0 + (buf) * AT_KBUF + (idx_ / NCH) * KSTR + (idx_ % NCH) * 16) = kr[p]; } \
        _Pragma("unroll") for (int p = 0; p < 2; ++p) { const int idx_ = tid + 512 * p; LAS u32x2* vd_ = (LAS u32x2*)(lds + AT_V0 + (buf) * AT_VBUF + (idx_ >> 4) * AT_VSTR + (idx_ & 15) * 16); vd_[0] = (u32x2){vr[p].x, vr[p].y}; vd_[1] = (u32x2){vr[p].z, vr[p].w}; } } while (0)
#define MX3(a, b, c) __builtin_fmaxf(__builtin_fmaxf((a), (b)), (c))
    AT_GLOAD(0); AT_LSTORE(0);
    if (NT2 > 1) AT_GLOAD(1);
    __syncthreads();
    for (int j = 0; j < NT2; ++j) {
        const int buf = j & 1;
        f32x16 sA0, sA1, sB0, sB1;
#define AT_QK(S0, S1, sub) do { const LAS unsigned char* kb = lds + AT_K0 + buf * AT_KBUF + ((sub) * 64 + r32) * KSTR + hi * 16; \
        _Pragma("unroll") for (int ks = 0; ks < NKS; ++ks) { \
            const bf16x8 a0 = *(const LAS bf16x8*)(kb + ks * 32), a1 = *(const LAS bf16x8*)(kb + 32 * KSTR + ks * 32); \
            if (ks == 0) { S0 = __builtin_amdgcn_mfma_f32_32x32x16_bf16(a0, qf[0], negm, 0, 0, 0); S1 = __builtin_amdgcn_mfma_f32_32x32x16_bf16(a1, qf[0], negm, 0, 0, 0); } \
            else { S0 = __builtin_amdgcn_mfma_f32_32x32x16_bf16(a0, qf[ks], S0, 0, 0, 0); S1 = __builtin_amdgcn_mfma_f32_32x32x16_bf16(a1, qf[ks], S1, 0, 0, 0); } } } while (0)
#define AT_SOFT(s0, s1, u0, u1, sub, HASNEXT) do { \
        if (WIN && j >= 2) { \
            const int jb = AT_TILE(j) * 128 + (sub) * 64 - CTX + 4 * hi, qi = q0lat + wid * 32 + r32; \
            _Pragma("unroll") for (int r = 0; r < 16; ++r) { const int jj = jb + (r & 3) + 8 * (r >> 2); const int d0 = qi - jj, d1 = qi - (jj + 32); \
                if (d0 > 128 || d0 < -128) s0[r] = -1e30f; if (d1 > 128 || d1 < -128) s1[r] = -1e30f; } } \
        float ra = MX3(s0[0], s0[1], s1[0]), rb = MX3(s0[2], s0[3], s1[1]); ra = MX3(ra, s1[2], s1[3]); \
        _Pragma("unroll") for (int r = 4; r < 16; r += 4) { ra = MX3(ra, s0[r], s0[r + 1]); rb = MX3(rb, s0[r + 2], s0[r + 3]); ra = MX3(ra, s1[r], s1[r + 1]); rb = MX3(rb, s1[r + 2], s1[r + 3]); } \
        float rm = __builtin_fmaxf(ra, rb); rm = __builtin_fmaxf(rm, __shfl_xor(rm, 32)); \
        const bool first = (j == 0) && ((sub) == 0); \
        if (first || __any(rm > 8.f)) { const float dl = first ? rm : __builtin_fmaxf(rm, 0.f); mhat += dl; \
            _Pragma("unroll") for (int r = 0; r < 16; ++r) { s0[r] -= dl; s1[r] -= dl; } \
            if (HASNEXT) { _Pragma("unroll") for (int r = 0; r < 16; ++r) { u0[r] -= dl; u1[r] -= dl; } }     \
            _Pragma("unroll") for (int r = 0; r < 16; ++r) negm[r] = -mhat; \
            asm volatile("" : "+v"(negm)); \
            if (!first) { const float f = fexp2(-dl); lsum *= f; if (hi == 0) wsf[r32] = f; \
                _Pragma("unroll") for (int r = 0; r < 16; ++r) { const float fr_ = wsf[crow(r, hi)]; o[0][r] *= fr_; o[1][r] *= fr_; } } } \
        float ps = 0.f, ps2 = 0.f; \
        _Pragma("unroll") for (int r = 0; r < 16; ++r) { s0[r] = fexp2(s0[r]); s1[r] = fexp2(s1[r]); ps += s0[r]; ps2 += s1[r]; } \
        lsum += ps + ps2; \
        bf16x8 pa[4]; \
        _Pragma("unroll") for (int kk = 0; kk < 2; ++kk) { u32x4 w; \
            w.x = pg8::cvt_pk_bf16(s0[8 * kk + 0], s0[8 * kk + 1]); w.y = pg8::cvt_pk_bf16(s0[8 * kk + 2], s0[8 * kk + 3]); w.z = pg8::cvt_pk_bf16(s0[8 * kk + 4], s0[8 * kk + 5]); w.w = pg8::cvt_pk_bf16(s0[8 * kk + 6], s0[8 * kk + 7]); pa[kk] = __builtin_bit_cast(bf16x8, w); \
            w.x = pg8::cvt_pk_bf16(s1[8 * kk + 0], s1[8 * kk + 1]); w.y = pg8::cvt_pk_bf16(s1[8 * kk + 2], s1[8 * kk + 3]); w.z = pg8::cvt_pk_bf16(s1[8 * kk + 4], s1[8 * kk + 5]); w.w = pg8::cvt_pk_bf16(s1[8 * kk + 6], s1[8 * kk + 7]); pa[2 + kk] = __builtin_bit_cast(bf16x8, w); } \
        const LAS unsigned char* vb = lds + AT_V0 + buf * AT_VBUF + r32 * AT_VSTR + (sub) * 128 + hi * 8; \
        _Pragma("unroll") for (int dvb = 0; dvb < 2; ++dvb) _Pragma("unroll") for (int kk = 0; kk < 4; ++kk) { \
                const u32x2 lo_ = *(const LAS u32x2*)(vb + dvb * 32 * AT_VSTR + kk * 32), hi_ = *(const LAS u32x2*)(vb + dvb * 32 * AT_VSTR + kk * 32 + 16); \
                const bf16x8 bv = __builtin_bit_cast(bf16x8, (u32x4){lo_.x, lo_.y, hi_.x, hi_.y}); \
                o[dvb] = __builtin_amdgcn_mfma_f32_32x32x16_bf16(pa[kk], bv, o[dvb], 0, 0, 0); } } while (0)
        AT_QK(sA0, sA1, 0); AT_QK(sB0, sB1, 1);
        AT_SOFT(sA0, sA1, sB0, sB1, 0, true);
        AT_SOFT(sB0, sB1, sA0, sA1, 1, false);
#undef AT_QK
#undef AT_SOFT
        if (j + 1 < NT2) AT_LSTORE(buf ^ 1);
        __syncthreads();
        if (j + 2 < NT2) AT_GLOAD(j + 2);
    }
    float lt = lsum + __shfl_xor(lsum, 32);
    if (has_sink) lt += fexp2(sink_l2 - mhat);
    if (hi == 0) wsf[r32] = frcp(lt);
#pragma unroll
    for (int r = 0; r < 16; ++r) { const float fr_ = wsf[crow(r, hi)]; o[0][r] *= fr_; o[1][r] *= fr_; }
#undef AT_TILE
#undef AT_GLOAD
#undef AT_LSTORE
#undef MX3
}

__device__ __forceinline__ void attn_store(bf16_t* O, int row0, int col0, const f32x16 (&o)[2]) {
    const int tid_ = ptid(); const int lane = tid_ & 63, r32 = lane & 31, hi = lane >> 5, wid = tid_ >> 6;
#pragma unroll
    for (int dvb = 0; dvb < 2; ++dvb)
#pragma unroll
        for (int r = 0; r < 16; ++r) O[(size_t)(row0 + wid * 32 + crow(r, hi)) * 1024 + col0 + dvb * 32 + r32] = (bf16_t)f2bf(o[dvb][r]);
}

__device__ __forceinline__ void attn_unit(CArgs& a, int l, int branch, int b, int h, int qb, float lam, float lam_init, LAS unsigned char* lds) {
    const bf16_t* HIN = (const bf16_t*)(a.ws + WS_BIG) + (size_t)b * RPB * NHIN; const bf16_t* MUP = (const bf16_t*)(a.ws + WS_Y) + (size_t)b * RPB * 1024;
    const bf16_t* VT = (const bf16_t*)(a.ws + WS_VT) + (size_t)b * 768 * RPB; bf16_t* OUTS = (bf16_t*)(a.ws + WS_OUTS);
    const bool cq = qb < 0; const int qrow = cq ? 0 : CTX + 256 * qb;
    const int NTd = cq ? 4 : 132;
    const int orow0 = b * RPB + qrow;
    f32x16 o[2];
    AttnSrc s;
    if (branch == 0) {
        s.Q = HIN + (size_t)qrow * NHIN + 64 * h; s.ldq = NHIN; s.K1 = HIN + 256 + 64 * (h >> 1); s.ldk1 = NHIN; s.K2 = nullptr; s.ldk2 = 0; s.VT = VT + (size_t)(0 + 64 * (h >> 1)) * RPB;
        attn_pass<64, false>(s, NTd, 4, 0, 0.f, false, lds, o);
        attn_store(OUTS, orow0, 0 + 64 * h, o);
    } else if (branch == 1) {
        s.Q = MUP + (size_t)qrow * 1024 + 96 * h; s.ldq = 1024; s.K1 = MUP + 384 + 128 * h; s.ldk1 = 1024; s.K2 = MUP + 896; s.ldk2 = 1024; s.VT = VT + (size_t)(128 + 64 * h) * RPB;
        attn_pass<96, false>(s, NTd, 4, 0, 0.f, false, lds, o);
        attn_store(OUTS, orow0, 256 + 64 * h, o);
    } else if (branch == 2) {
        f32x16 o2[2];
        s.Q = HIN + (size_t)qrow * NHIN + 928 + 64 * h; s.ldq = NHIN; s.K1 = HIN + 1184 + 64 * h; s.ldk1 = NHIN; s.K2 = nullptr; s.ldk2 = 0; s.VT = VT + (size_t)(384 + 64 * h) * RPB;
        attn_pass<32, false>(s, NTd, 4, 0, 0.f, false, lds, o);
        s.Q += 32; s.K1 += 32;
        attn_pass<32, false>(s, NTd, 4, 0, 0.f, false, lds, o2);
        const int lane = ptid() & 63, r32 = lane & 31;
        const float g0 = a.dsub[l * 64 + r32] * (1.f - lam_init), g1 = a.dsub[l * 64 + 32 + r32] * (1.f - lam_init);
#pragma unroll
        for (int r = 0; r < 16; ++r) { const float x0 = o[0][r] - lam * o2[0][r], x1 = o[1][r] - lam * o2[1][r];
            float ss = x0 * x0 + x1 * x1;
#pragma unroll
            for (int m = 1; m < 32; m <<= 1) ss += __shfl_xor(ss, m);
            const float rs = __builtin_amdgcn_rsqf(ss * (1.f / 64.f) + EPS);
            o[0][r] = x0 * rs * g0; o[1][r] = x1 * rs * g1; }
        attn_store(OUTS, orow0, 512 + 64 * h, o);
    } else {
        s.Q = HIN + (size_t)qrow * NHIN + 1696 + 64 * h; s.ldq = NHIN; s.K1 = HIN + 1952 + 64 * (h >> 1); s.ldk1 = NHIN; s.K2 = nullptr; s.ldk2 = 0; s.VT = VT + (size_t)(640 + 64 * (h >> 1)) * RPB;
        const float sk = a.sink[l * 4 + h] * LOG2E;
        if (cq) attn_pass<64, false>(s, 4, 4, 0, sk, true, lds, o);
        else { const int q0 = 256 * qb; const int lo = 4 + (q0 >= 128 ? q0 - 128 : 0) / 64, hiT = 4 + ((q0 + 384) < SEQ ? (q0 + 384) : SEQ) / 64;
            attn_pass<64, true>(s, 4 + hiT - lo, lo, q0, sk, true, lds, o); }
        attn_store(OUTS, orow0, 768 + 64 * h, o);
    }
}

__device__ __forceinline__ void attn_phase(CArgs& a, int l, LAS unsigned char* lds) {
    const float lam_init = 0.8f - 0.6f * __expf(-0.3f * (float)l);
    float lam;
    { const float* dl = a.dlam + l * 128; float s1 = 0.f, s2 = 0.f;
        for (int i = 0; i < 32; ++i) { s1 += dl[i] * dl[32 + i]; s2 += dl[64 + i] * dl[96 + i]; }
        lam = __expf(s1) - __expf(s2) + lam_init; }
    const int G = gridDim.x, bx = blockIdx.x;
    const int vcu = (G % 8 == 0) ? (bx % 8) * (G / 8) + bx / 8 : bx;
    for (int ty = 0; ty < 4; ++ty) {
        const int branch = ty == 0 ? 2 : ty == 1 ? 1 : ty == 2 ? 0 : 3;
        for (int idx = vcu; idx < NB * 4 * 32; idx += G) { const int bh = idx >> 5, qb = idx & 31; attn_unit(a, l, branch, bh >> 2, bh & 3, qb, lam, lam_init, lds); }
    }
    for (int idx = vcu; idx < NB * 16; idx += G) attn_unit(a, l, (idx >> 2) & 3, idx >> 4, idx & 3, -1, lam, lam_init, lds);
}

#define GAS __attribute__((address_space(1)))
#define XB_TMO      128
#define XB_XCNT(j)  (256  + 64 * (j))
#define XB_XSUB(j)  (1280 + 64 * (j))
#define XB_XGEN(j)  (2304 + 64 * (j))
#define XB_TOP      3328
#define XB_TOPGEN   3392
#define XCD_BAR_WORDS 3456
#define XB_SPIN_CAP (1u << 18)

__device__ __forceinline__ unsigned xb_ld(unsigned* p)              { return __hip_atomic_load(p, __ATOMIC_RELAXED, __HIP_MEMORY_SCOPE_AGENT); }
__device__ __forceinline__ unsigned xb_add(unsigned* p, unsigned v) { return __hip_atomic_fetch_add(p, v, __ATOMIC_RELAXED, __HIP_MEMORY_SCOPE_AGENT); }
__device__ __forceinline__ unsigned xb_xcc_id() { return (unsigned)__builtin_amdgcn_s_getreg((3 << 11) | 20) & 0xFu; }
#define XB_SPIN(cond, bar) do { unsigned _sp = 0; while (cond) { __builtin_amdgcn_s_sleep(1); \
    if ((++_sp & 255u) == 0u) { if (xb_ld(&(bar)[XB_TMO])) break; if (_sp > XB_SPIN_CAP) { atomicAdd(&(bar)[XB_TMO], 1u); break; } } } } while (0)

struct XcdBarrier {
    unsigned* bar; unsigned x;
    volatile LAS unsigned* st;
};

__device__ __forceinline__ XcdBarrier xcd_barrier_post(unsigned* bar, volatile LAS unsigned* st) {
    XcdBarrier b; b.bar = bar; b.x = xb_xcc_id(); b.st = st;
    if (threadIdx.x == 0) (void)xb_add(&bar[XB_XCNT(b.x)], 1u);
    return b;
}
__device__ __forceinline__ void xcd_barrier_complete(unsigned* bar, unsigned x, unsigned& nloc, unsigned& nx) {
    const unsigned G = gridDim.x * gridDim.y * gridDim.z;
    unsigned sum, cnt, mine, sp = 0u;
    for (;;) {
        sum = 0u; cnt = 0u; mine = 0u;
#pragma unroll
        for (unsigned j = 0; j < 16; ++j) { const unsigned c = xb_ld(&bar[XB_XCNT(j)]); sum += c; cnt += (c > 0u) ? 1u : 0u; mine = (j == x) ? c : mine; }
        if (sum == G) break;
        __builtin_amdgcn_s_sleep(1);
        if ((++sp & 255u) == 0u) { if (xb_ld(&bar[XB_TMO])) break; if (sp > XB_SPIN_CAP) { atomicAdd(&bar[XB_TMO], 1u); break; } }
    }
    nloc = mine > 0u ? mine : 1u; nx = cnt > 0u ? cnt : 1u;
}

__device__ __forceinline__ void xcd_barrier(const XcdBarrier& b) {
    asm volatile("s_waitcnt vmcnt(0)" ::: "memory");
    __syncthreads();
    if (threadIdx.x == 0) {
        unsigned* bar = b.bar;
        __builtin_amdgcn_s_waitcnt(0);
        unsigned nloc = b.st[0], nx = b.st[1];
        if (nloc == 0u) { xcd_barrier_complete(bar, b.x, nloc, nx); b.st[0] = nloc; b.st[1] = nx; }
        const unsigned old = xb_add(&bar[XB_XSUB(b.x)], 1u);
        const unsigned gen = old / nloc;
        if (old + 1u == (gen + 1u) * nloc) {
            __builtin_amdgcn_fence(__ATOMIC_RELEASE, "agent");
            asm volatile("s_waitcnt vmcnt(0)" ::: "memory");
            const unsigned og = xb_add(&bar[XB_TOP], 1u);
            const unsigned tg = og / nx;
            if (og + 1u == (tg + 1u) * nx) xb_add(&bar[XB_TOPGEN], 1u);
            else XB_SPIN(xb_ld(&bar[XB_TOPGEN]) == tg, bar);
            __builtin_amdgcn_fence(__ATOMIC_ACQUIRE, "agent");
            xb_add(&bar[XB_XGEN(b.x)], 1u);
            asm volatile("s_waitcnt vmcnt(0)" ::: "memory");
        } else {
            XB_SPIN(xb_ld(&bar[XB_XGEN(b.x)]) == gen, bar);
            __builtin_amdgcn_fence(__ATOMIC_ACQUIRE, "agent");
            asm volatile("s_waitcnt vmcnt(0)" ::: "memory");
        }
    }
    __syncthreads();
}


constexpr int NPHASE = 2 + 32;
__global__ void __launch_bounds__(512, 2) fwd_kernel(Args a_) {
    extern __shared__ __attribute__((aligned(16))) unsigned char lds_raw[];
    LAS unsigned char* lds = (LAS unsigned char*)lds_raw;
    cg::grid_group grid = cg::this_grid();
    const int lo = a_.ph_lo, hi = a_.ph_hi < NPHASE ? a_.ph_hi : NPHASE;
    { volatile LAS unsigned* st0 = (volatile LAS unsigned*)(lds + LDS_BARST); if (threadIdx.x < 2) st0[threadIdx.x] = 0u; }
    __syncthreads();
    { XcdBarrier b0 = xcd_barrier_post((unsigned*)(a_.ws + WS_BAR), (volatile LAS unsigned*)(lds + LDS_BARST)); (void)b0; }
    for (int ph = lo; ph < hi; ++ph) {
        CArgs* ap_ = (CArgs*)__builtin_amdgcn_kernarg_segment_ptr(); asm volatile("" : "+s"(ap_) :: "memory"); CArgs& a = *ap_;
        int G = gridDim.x, bx = blockIdx.x; asm volatile("" : "+s"(G), "+s"(bx));
        if (ph == 0) p0_phase(a, lds);
        else if (ph == 1) row_phase(a, 0, true, nullptr, 0, 0.f, (bf16_t*)(a.ws + WS_U), 0, 0);
        else {
            const int l = (ph - 2) / 16, k = (ph - 2) % 16;
            unsigned char* ws = a.ws;
            const unsigned char* wb = ws + WS_W + (size_t)l * W_LAYER;
            bf16_t* U = (bf16_t*)(ws + WS_U); bf16_t* Yb = (bf16_t*)(ws + WS_Y); bf16_t* BIG = (bf16_t*)(ws + WS_BIG);
            if (k == 5) prep_phase(a, l, lds);
#ifndef X_ATTN
            else if (k == 6) attn_phase(a, l, lds);
#endif
            else if (k == 2) row_phase(a, l, l == 0, Yb, 0, 0.5f, U, 1, l);
            else if (k == 12) row_phase(a, l, false, BIG, 1, 1.0f, U, 2, l);
            else if (k == 15) row_phase(a, l, false, Yb, 2, 0.5f, l == 0 ? U : nullptr, 0, l + 1);
            else {
                pg8::Gemm g; pg8::Epi E; int N; int dual = 0; int Mrows = R;
                g.A2 = nullptr; g.Bt2 = nullptr; E.scr = nullptr;
                if (k == 0 || k == 13) { const int s = k == 13; g.A = U; g.Bt = (const bf16_t*)(wb + W_GU + s * W_GU_SZ); g.lda = 1024; g.ldb = 1024; g.K = 1024; N = 5632; E.mode = 1; E.O = BIG; E.ldc = DFF; }
                else if (k == 1 || k == 14) { const int s = k == 14; g.A = BIG; g.Bt = (const bf16_t*)(wb + W_D + s * W_D_SZ); g.lda = DFF; g.ldb = DFF; g.K = DFF; N = 1024; E.mode = 0; E.O = Yb; E.ldc = 1024; }
                else if (k == 3) { g.A = U; g.Bt = (const bf16_t*)(wb + W_IN); g.lda = 1024; g.ldb = 1024; g.K = 1024; N = NHIN; E.mode = 0; E.O = BIG; E.ldc = NHIN; }
                else if (k == 4) { g.A = BIG + 512; g.Bt = (const bf16_t*)(wb + W_MLA); g.lda = NHIN; g.ldb = 384; g.K = 384; N = 1024; E.mode = 0; E.O = Yb; E.ldc = 1024; }
                else if (k == 7 || k == 9) { size_t ro = (size_t)(k == 9) * 32768 * 1024; Mrows = (k == 9) ? R - 32768 : 32768; if (l == 1) { ro = (size_t)(k == 9) * 33792 * 1024; Mrows = 32768; dual = 1; }
                    g.A = U + ro; g.Bt = (const bf16_t*)(wb + W_G); g.lda = 1024; g.ldb = 1024; g.K = 1024; N = 4096; E.mode = 3; E.O = BIG; E.ldc = 4096; }
                else if (k == 8 || k == 10) { size_t ro = (size_t)(k == 10) * 32768 * 1024; Mrows = (k == 10) ? R - 32768 : 32768; if (l == 1) { ro = (size_t)(k == 10) * 33792 * 1024; Mrows = 32768; dual = 1; }
                    g.A = (const bf16_t*)(ws + WS_OUTS) + ro; g.Bt = (const bf16_t*)(wb + W_BR); g.lda = 1024; g.ldb = 1024; g.K = 1024; N = 1024; E.mode = 4; E.O = Yb + ro; E.ldc = 1024; E.scr = (u32x4*)BIG; }
                else { g.A = Yb; g.Bt = (const bf16_t*)(wb + W_OUT); g.lda = 1024; g.ldb = 1024; g.K = 1024; N = 1024; E.mode = 0; E.O = BIG; E.ldc = 1024; }
                if (l == 1 && (k == 11 || k == 13 || k == 14)) { dual = 1; Mrows = 65536; }
                pg8::StaticOrder S; S.init(Mrows, N, G, bx, dual);
                if (k == 8 || k == 10) pg8::gemm_phase<true>(lds, g, S, E); else pg8::gemm_phase<false>(lds, g, S, E);
            }
        }
        if (ph + 1 < hi) {
            if (ph == lo) {
                asm volatile("s_waitcnt vmcnt(0) lgkmcnt(0)" ::: "memory");
                __syncthreads();
                if (ptid() < 64) { __builtin_amdgcn_fence(__ATOMIC_RELEASE, "agent"); asm volatile("s_waitcnt vmcnt(0)" ::: "memory"); }
                grid.sync();
                __builtin_amdgcn_fence(__ATOMIC_ACQUIRE, "agent");
                asm volatile("s_waitcnt vmcnt(0)" ::: "memory");
            } else {
                XcdBarrier bar; bar.bar = (unsigned*)(a.ws + WS_BAR); bar.x = xb_xcc_id(); bar.st = (volatile LAS unsigned*)(lds + LDS_BARST);
                xcd_barrier(bar);
                __builtin_amdgcn_fence(__ATOMIC_ACQUIRE, "agent");
                asm volatile("s_waitcnt vmcnt(0)" ::: "memory");
            }
        }
    }
}

extern "C" void kernel_launch(void* const* d_in, const int* in_sizes, int n_in, void* d_out, int out_size, void* d_ws, size_t ws_size, hipStream_t stream) {
    static int grid = 0;
    if (grid == 0) {
        int dev = 0, cus = 0;
        if (hipGetDevice(&dev) != hipSuccess || hipDeviceGetAttribute(&cus, hipDeviceAttributeMultiprocessorCount, dev) != hipSuccess) { grid = -1; return; }
        if (hipFuncSetAttribute((const void*)fwd_kernel, hipFuncAttributeMaxDynamicSharedMemorySize, LDS_BYTES) != hipSuccess) { fprintf(stderr, "hipFuncSetAttribute failed\n"); grid = -1; return; }
        int per_cu = 0;
        if (hipOccupancyMaxActiveBlocksPerMultiprocessor(&per_cu, (const void*)fwd_kernel, 512, LDS_BYTES) != hipSuccess || per_cu < 1) fprintf(stderr, "occupancy query: %d\n", per_cu);
        (void)hipGetLastError();
        grid = cus;
        if (ws_size < WS_END) { fprintf(stderr, "workspace too small\n"); grid = -1; return; }
    }
    if (grid < 0) return;
    if (hipMemsetAsync((char*)d_ws + WS_BAR, 0, 16384, stream) != hipSuccess) { fprintf(stderr, "memset failed\n"); return; }
    Args a{};
    const float** p = (const float**)&a;
    for (int i = 0; i < 23; ++i) p[i] = (const float*)d_in[i];
    a.out = (float*)d_out; a.ws = (unsigned char*)d_ws; a.ph_lo = 0; a.ph_hi = 1000;
    void* args[] = {&a};
    hipError_t e = hipLaunchCooperativeKernel((const void*)fwd_kernel, dim3(grid), dim3(512), args, LDS_BYTES, stream);
    if (e != hipSuccess) fprintf(stderr, "cooperative launch failed: %s\n", hipGetErrorString(e));
}
```

```cpp
#include <hip/hip_runtime.h>
#include <hip/hip_cooperative_groups.h>
#include <cstdio>
#include <cstdint>
namespace cg = cooperative_groups;

#define LAS __attribute__((address_space(3)))
typedef unsigned short bf16_t;
typedef short bf16x8 __attribute__((ext_vector_type(8)));
typedef short s16x4 __attribute__((ext_vector_type(4)));
typedef float f32x4 __attribute__((ext_vector_type(4)));
typedef float f32x16 __attribute__((ext_vector_type(16)));
typedef unsigned u32x4 __attribute__((ext_vector_type(4)));
typedef unsigned u32x2 __attribute__((ext_vector_type(2)));

constexpr int DM = 1024, NB = 8, SEQ = 8192, CTX = 256, RPB = SEQ + CTX, R = NB * RPB, DFF = 2816;
constexpr int NHIN = 2304, INCOLS = 6304, GATE0 = 2208;
constexpr int MODW = 9216;
constexpr float EPS = 1e-6f;
constexpr float LOG2E = 1.4426950408889634f;
constexpr float QS_GQA = 0.125f * LOG2E, QS_MLA = 0.10206207261596577f * LOG2E, QS_DIFF = 0.17677669529663687f * LOG2E;

constexpr size_t MiB = 1u << 20;
constexpr size_t WS_MOD = 0;
constexpr size_t WS_XC = 2 * MiB;
constexpr size_t WS_W = 10 * MiB;
constexpr size_t W_GU = 0, W_GU_SZ = (size_t)5632 * 1024 * 2;
constexpr size_t W_D = W_GU + 2 * W_GU_SZ, W_D_SZ = (size_t)1024 * 2816 * 2;
constexpr size_t W_IN = W_D + 2 * W_D_SZ, W_IN_SZ = (size_t)NHIN * 1024 * 2;
constexpr size_t W_G = W_IN + W_IN_SZ, W_G_SZ = (size_t)4096 * 1024 * 2;
constexpr size_t W_BR = W_G + W_G_SZ;
constexpr size_t W_OUT = W_BR + W_G_SZ, W_OUT_SZ = (size_t)1024 * 1024 * 2;
constexpr size_t W_MLA = W_OUT + W_OUT_SZ, W_MLA_SZ = (size_t)1024 * 384 * 2;
constexpr size_t W_LAYER = W_MLA + W_MLA_SZ;
static_assert(WS_W + 2 * W_LAYER <= 124 * MiB, "weights");
constexpr size_t ROWBUF = (size_t)R * 1024 * 2;
constexpr size_t WS_U = 124 * MiB;
constexpr size_t WS_Y = WS_U + ROWBUF;
constexpr size_t WS_BIG = WS_Y + ROWBUF;
constexpr size_t WS_OUTS = WS_BIG + (size_t)R * NHIN * 2;
constexpr size_t WS_VT = WS_OUTS + ROWBUF;
constexpr size_t WS_GSCR = WS_VT + (size_t)NB * 768 * RPB * 2;
constexpr size_t WS_END = WS_GSCR + 256 * 131072;
static_assert(WS_END <= 1024 * MiB, "ws");
static_assert(WS_BIG + (size_t)R * DFF * 2 <= WS_END, "H");

constexpr int LDS_BYTES = 147456;
constexpr size_t WS_BAR = 1 * MiB;
constexpr int LDS_BARST = 147456 - 64;

__device__ __forceinline__ unsigned f2bf(float f) { unsigned u = __builtin_bit_cast(unsigned, f); return (u + 0x7fffu + ((u >> 16) & 1u)) >> 16; }
__device__ __forceinline__ unsigned pk2(float lo, float hi) { return f2bf(lo) | (f2bf(hi) << 16); }
__device__ __forceinline__ float bf2f(unsigned short h) { return __builtin_bit_cast(float, (unsigned)h << 16); }
__device__ __forceinline__ float bflo(unsigned w) { return __builtin_bit_cast(float, w << 16); }
__device__ __forceinline__ float bfhi(unsigned w) { return __builtin_bit_cast(float, w & 0xffff0000u); }
__device__ __forceinline__ float wave_sum(float v) {
#pragma unroll
    for (int o = 1; o < 64; o <<= 1) v += __shfl_xor(v, o);
    return v;
}
__device__ __forceinline__ int ptid() { int t = threadIdx.x; asm volatile("" : "+v"(t)); return t; }
__device__ __forceinline__ float fexp2(float x) { return __builtin_amdgcn_exp2f(x); }
__device__ __forceinline__ float frcp(float x) { return __builtin_amdgcn_rcpf(x); }
__device__ __forceinline__ float sigmoidf_(float x) { return frcp(1.f + fexp2(-x * LOG2E)); }

namespace pg8 {
constexpr int BM = 256, BK = 64, HALF = 128, HTB = HALF * BK * 2, STAGE_BYTES = 8 * HTB, NXCD = 8, WGM = 8;
__device__ __forceinline__ int lds_byte(int r, int c) { const int st = (r >> 4) * 2 + (c >> 5), rr = r & 15, cc = c & 31, ob = rr * 64 + cc * 2; return st * 1024 + (ob ^ (((ob >> 9) & 1) << 5)); }
__device__ __forceinline__ void stage_rc(int b, int& Rr, int& C) { const int st = b / 1024, sb = b % 1024, swz = sb ^ (((sb >> 9) & 1) << 5); Rr = (st >> 1) * 16 + swz / 64; C = (st & 1) * 32 + (swz % 64) / 2; }
__device__ __forceinline__ int perm32(int rho) { const int n = rho >> 4, i = rho & 15; return 8 * (i >> 2) + 4 * n + (i & 3); }

struct Unit { int pm, pn, kind; };
struct Gemm { const bf16_t* A; const bf16_t* Bt; const bf16_t* A2; const bf16_t* Bt2; int lda, ldb, K; };

struct StaticOrder {
    int nM, nN, nwg, G, c, dual;
    __device__ void init(int M, int N, int G_, int c_, int dual_) { nM = M / BM; nN = N / BM; nwg = nM * nN; G = G_; c = c_; dual = dual_; }
    __device__ bool next(int i, Unit& u) const {
        const int ii = i;
        const long L = (long)ii * G + c; if (L >= nwg) return false;
        int wgid = (int)L; { const int q = nwg / NXCD, r = nwg % NXCD, xcd = wgid % NXCD, off = wgid / NXCD; wgid = (xcd < r ? xcd * (q + 1) : r * (q + 1) + (xcd - r) * q) + off; }
        const int nig = WGM * nN, gid = wgid / nig, fm = gid * WGM, gsz = (nM - fm) < WGM ? (nM - fm) : WGM;
        u.pm = fm + ((wgid % nig) % gsz); u.pn = (wgid % nig) / gsz;
        if (dual) u.pm = (u.pm >> 5) * 33 + 1 + (u.pm & 31);
        u.kind = 0; return true;
    }
};

typedef float f32x2_t __attribute__((ext_vector_type(2))); typedef __bf16 bf16x2_t __attribute__((ext_vector_type(2)));
__device__ __forceinline__ unsigned cvt_pk_bf16(float lo, float hi) { f32x2_t v = {lo, hi}; bf16x2_t b = __builtin_convertvector(v, bf16x2_t); return __builtin_bit_cast(unsigned, b); }

struct Epi {
    int mode; bf16_t* O; int ldc; u32x4* scr;
    __device__ __forceinline__ void operator()(const f32x4 (&acc)[2][2][4][2], const Unit& u, int wr, int wc, int fr, int fq) const {
        const int row0 = u.pm * BM + wr * 64 + fr;
        if (mode == 0) {
            const int col0 = u.pn * BM + wc * 32 + 8 * fq;
#pragma unroll
            for (int ai = 0; ai < 2; ++ai)
#pragma unroll
                for (int m = 0; m < 4; ++m) { bf16_t* rowp = O + (size_t)(row0 + ai * HALF + m * 16) * ldc + col0;
#pragma unroll
                    for (int bj = 0; bj < 2; ++bj) { const f32x4 v0 = acc[ai][bj][m][0], v1 = acc[ai][bj][m][1];
                        u32x4 w; w.x = cvt_pk_bf16(v0[0], v0[1]); w.y = cvt_pk_bf16(v0[2], v0[3]); w.z = cvt_pk_bf16(v1[0], v1[1]); w.w = cvt_pk_bf16(v1[2], v1[3]);
                        *(u32x4*)(rowp + bj * HALF) = w; } }
        } else if (mode == 1) {
            const int col0 = u.pn * HALF + wc * 32 + 8 * fq;
#pragma unroll
            for (int ai = 0; ai < 2; ++ai)
#pragma unroll
                for (int m = 0; m < 4; ++m) { bf16_t* rowp = O + (size_t)(row0 + ai * HALF + m * 16) * ldc + col0;
                    float h[8];
#pragma unroll
                    for (int n = 0; n < 2; ++n)
#pragma unroll
                        for (int e = 0; e < 4; ++e) { const float g = acc[ai][0][m][n][e], up = acc[ai][1][m][n][e]; h[n * 4 + e] = g * sigmoidf_(g) * up; }
                    u32x4 w; w.x = cvt_pk_bf16(h[0], h[1]); w.y = cvt_pk_bf16(h[2], h[3]); w.z = cvt_pk_bf16(h[4], h[5]); w.w = cvt_pk_bf16(h[6], h[7]);
                    *(u32x4*)rowp = w; }
        } else if (mode == 3) {
            const int col0 = u.pn * BM + wc * 32 + 8 * fq;
#pragma unroll
            for (int ai = 0; ai < 2; ++ai)
#pragma unroll
                for (int m = 0; m < 4; ++m) { bf16_t* rowp = O + (size_t)(row0 + ai * HALF + m * 16) * ldc + col0;
#pragma unroll
                    for (int bj = 0; bj < 2; ++bj) { const f32x4 v0 = acc[ai][bj][m][0], v1 = acc[ai][bj][m][1];
                        u32x4 w; w.x = cvt_pk_bf16(sigmoidf_(v0[0]), sigmoidf_(v0[1])); w.y = cvt_pk_bf16(sigmoidf_(v0[2]), sigmoidf_(v0[3]));
                        w.z = cvt_pk_bf16(sigmoidf_(v1[0]), sigmoidf_(v1[1])); w.w = cvt_pk_bf16(sigmoidf_(v1[2]), sigmoidf_(v1[3]));
                        *(u32x4*)(rowp + bj * HALF) = w; } }
        } else {
            const int col0 = u.pn * BM + wc * 32 + 8 * fq;
#pragma unroll
            for (int ai = 0; ai < 2; ++ai)
#pragma unroll
                for (int m = 0; m < 4; ++m) { const size_t r = (size_t)(row0 + ai * HALF + m * 16);
                    const bf16_t* gp = (const bf16_t*)scr + r * 4096 + 3 * 1024 + col0; bf16_t* rowp = O + r * ldc + col0;
#pragma unroll
                    for (int bj = 0; bj < 2; ++bj) { const u32x4 g = *(const u32x4*)(gp + bj * HALF); const f32x4 v0 = acc[ai][bj][m][0], v1 = acc[ai][bj][m][1];
                        u32x4 w; w.x = cvt_pk_bf16(v0[0] * gclamp(bflo(g.x)), v0[1] * gclamp(bfhi(g.x))); w.y = cvt_pk_bf16(v0[2] * gclamp(bflo(g.y)), v0[3] * gclamp(bfhi(g.y)));
                        w.z = cvt_pk_bf16(v1[0] * gclamp(bflo(g.z)), v1[1] * gclamp(bfhi(g.z))); w.w = cvt_pk_bf16(v1[2] * gclamp(bflo(g.w)), v1[3] * gclamp(bfhi(g.w)));
                        *(u32x4*)(rowp + bj * HALF) = w; } }
        }
    }
    static __device__ __forceinline__ float gclamp(float g) { return __builtin_fmaxf(g, 1e-6f); }
    __device__ __forceinline__ void rescale(f32x4 (&acc)[2][2][4][2], const Unit& u, int i, int wr, int wc, int fr, int fq) const {
        int row0 = u.pm * BM + wr * 64 + fr; const int col0 = u.pn * BM + wc * 32 + 8 * fq;
        asm volatile("" : "+v"(row0));
#pragma unroll
        for (int ai = 0; ai < 2; ++ai)
#pragma unroll
            for (int m = 0; m < 4; ++m) { const bf16_t* gp = (const bf16_t*)scr + (size_t)(row0 + ai * HALF + m * 16) * 4096 + i * 1024 + col0;
#pragma unroll
                for (int bj = 0; bj < 2; ++bj) { const u32x4 ga = *(const u32x4*)(gp + bj * HALF), gb = *(const u32x4*)(gp + 1024 + bj * HALF);
                    f32x4 r0, r1;
                    r0[0] = gclamp(bflo(ga.x)) * frcp(gclamp(bflo(gb.x))); r0[1] = gclamp(bfhi(ga.x)) * frcp(gclamp(bfhi(gb.x)));
                    r0[2] = gclamp(bflo(ga.y)) * frcp(gclamp(bflo(gb.y))); r0[3] = gclamp(bfhi(ga.y)) * frcp(gclamp(bfhi(gb.y)));
                    r1[0] = gclamp(bflo(ga.z)) * frcp(gclamp(bflo(gb.z))); r1[1] = gclamp(bfhi(ga.z)) * frcp(gclamp(bfhi(gb.z)));
                    r1[2] = gclamp(bflo(ga.w)) * frcp(gclamp(bflo(gb.w))); r1[3] = gclamp(bfhi(ga.w)) * frcp(gclamp(bfhi(gb.w)));
                    acc[ai][bj][m][0] = acc[ai][bj][m][0] * r0; acc[ai][bj][m][1] = acc[ai][bj][m][1] * r1; }
                if (m == 3) asm volatile("" ::: "memory"); }
    }
};

template <bool HOOK, class Sched>
__device__ __forceinline__ void gemm_phase(LAS unsigned char* lds, const Gemm g, const Sched& S, const Epi& E) {
    const int tid = ptid(), wid = __builtin_amdgcn_readfirstlane(tid >> 6), lane = tid & 63, wr = wid >> 2, wc = wid & 3, fr = lane & 15, fq = lane >> 4;
    const int K = g.K, nt = K / BK;
    unsigned voffA[2], voffB[2];
#pragma unroll
    for (int i = 0; i < 2; ++i) { int Rr, C; stage_rc(tid * 16 + i * 8192, Rr, C); const int Rb = (Rr & ~31) + perm32(Rr & 31);
        voffA[i] = (unsigned)(Rr * g.lda + C) * 2u; voffB[i] = (unsigned)(Rb * g.ldb + C) * 2u; }
    const size_t kstep = (size_t)(BK * 2);
    const size_t hsA = (size_t)HALF * g.lda * 2, hsB = (size_t)HALF * g.ldb * 2;
    const size_t tsA = 2 * hsA, tsB = 2 * hsB;
    const unsigned ldsw = (unsigned)wid * 1024u;
    const int aoff = lds_byte(wr * 64 + fr, fq * 8), boff = lds_byte(wc * 32 + fr, fq * 8);
#define PG8_SA(b, h) (((b) * 2 + (h)) * HTB)
#define PG8_SB(b, h) ((4 + (b) * 2 + (h)) * HTB)
#define PG8_STAGE(bufoff, gbase, voff) do { _Pragma("unroll") for (int _i = 0; _i < 2; ++_i) \
        __builtin_amdgcn_global_load_lds((const unsigned*)((const char*)(gbase) + (voff)[_i]), (LAS unsigned*)(lds + (bufoff) + ldsw + _i * 8192), 16, 0, 0); } while (0)
#define PG8_LDA(dst, b, h) do { _Pragma("unroll") for (int m = 0; m < 4; ++m) _Pragma("unroll") for (int k = 0; k < 2; ++k) dst[m][k] = *(const LAS bf16x8*)(lds + PG8_SA(b, h) + aoff + m * 2048 + k * 1024); } while (0)
#define PG8_LDB(dst, b, h) do { _Pragma("unroll") for (int n = 0; n < 2; ++n) _Pragma("unroll") for (int k = 0; k < 2; ++k) dst[n][k] = *(const LAS bf16x8*)(lds + PG8_SB(b, h) + boff + n * 2048 + k * 1024); } while (0)
#define PG8_MMA(ai, bj, At, Bt) do { __builtin_amdgcn_s_setprio(1); _Pragma("unroll") for (int m = 0; m < 4; ++m) _Pragma("unroll") for (int n = 0; n < 2; ++n) _Pragma("unroll") for (int k = 0; k < 2; ++k) \
        acc[ai][bj][m][n] = __builtin_amdgcn_mfma_f32_16x16x32_bf16(Bt[n][k], At[m][k], acc[ai][bj][m][n], 0, 0, 0); __builtin_amdgcn_s_setprio(0); } while (0)
#define PG8_MMA1(ai, bj, nn, At, Bt) do { __builtin_amdgcn_s_setprio(1); _Pragma("unroll") for (int m = 0; m < 4; ++m) _Pragma("unroll") for (int k = 0; k < 2; ++k) \
        acc[ai][bj][m][nn] = __builtin_amdgcn_mfma_f32_16x16x32_bf16(Bt[nn][k], At[m][k], acc[ai][bj][m][nn], 0, 0, 0); __builtin_amdgcn_s_setprio(0); } while (0)
#define PG8_MMAZ(ai, At) do { if (zbr == 0) PG8_MMA1(ai, 0, 0, At, B0); else if (zbr == 1) PG8_MMA1(ai, 0, 1, At, B0); else if (zbr == 2) PG8_MMA1(ai, 1, 0, At, B1); else PG8_MMA1(ai, 1, 1, At, B1); } while (0)
#define PG8_MM2(ai, At) do { PG8_MMA(ai, 0, At, B0); PG8_MMA(ai, 1, At, B1); } while (0)
#define PG8_WAIT_V(n) asm volatile("s_waitcnt vmcnt(" #n ")" ::: "memory")
#define PG8_WAIT_L(n) asm volatile("s_waitcnt lgkmcnt(" #n ")" ::: "memory")
#define PG8_BAR __builtin_amdgcn_s_barrier()
#define PG8_SCHED __builtin_amdgcn_sched_barrier(0)
#define PG8_UA(u) ((const char*)((u).kind ? g.A2 : g.A) + (size_t)(u).pm * tsA)
#define PG8_UB(u) ((const char*)((u).kind ? g.Bt2 : g.Bt) + (size_t)(u).pn * tsB)
    Unit cur, nxt; int ui = 0;
    if (!S.next(0, cur)) return;
    f32x4 acc[2][2][4][2];
#pragma unroll
    for (int a = 0; a < 2; ++a)
#pragma unroll
        for (int b = 0; b < 2; ++b)
#pragma unroll
            for (int m = 0; m < 4; ++m)
#pragma unroll
                for (int n = 0; n < 2; ++n) acc[a][b][m][n] = (f32x4){0.f, 0.f, 0.f, 0.f};
    bf16x8 At[4][2], B0[2][2], B1[2][2];
    const char* cA = PG8_UA(cur); const char* cB = PG8_UB(cur);
    {
        PG8_STAGE(PG8_SB(0, 0), cB, voffB); PG8_STAGE(PG8_SB(0, 1), cB + hsB, voffB); PG8_STAGE(PG8_SA(0, 0), cA, voffA); PG8_STAGE(PG8_SA(0, 1), cA + hsA, voffA);
        if (wr == 1) PG8_BAR;
        PG8_WAIT_V(2); PG8_BAR;
        PG8_STAGE(PG8_SB(1, 0), cB + kstep, voffB); PG8_STAGE(PG8_SA(1, 0), cA + kstep, voffA); PG8_STAGE(PG8_SB(1, 1), cB + hsB + kstep, voffB);
        PG8_WAIT_V(6); PG8_BAR;
    }
    for (;;) {
        const bool has_next = S.next(ui + 1, nxt);
        const char* nA = has_next ? PG8_UA(nxt) : cA; const char* nB = has_next ? PG8_UB(nxt) : cB;
        for (int t = 0; t < nt; t += 2) {
            const bool last = (t == nt - 2);
            if constexpr (HOOK) { if (t == 4 || t == 8 || t == 12) { PG8_SCHED; E.rescale(acc, cur, (t >> 2) - 1, wr, wc, fr, fq); PG8_SCHED; } }
            const char* a1 = cA + (size_t)(t + 1) * kstep;
            const char* a2 = last ? nA : cA + (size_t)(t + 2) * kstep; const char* b2 = last ? nB : cB + (size_t)(t + 2) * kstep;
            const char* a3 = a2 + kstep; const char* b3 = b2 + kstep;
            PG8_LDB(B0, 0, 0); PG8_LDB(B1, 0, 1); PG8_SCHED; PG8_LDA(At, 0, 0); PG8_STAGE(PG8_SA(1, 1), a1 + hsA, voffA);
            PG8_WAIT_V(8); PG8_WAIT_L(0); PG8_BAR; PG8_MM2(0, At); PG8_BAR; PG8_SCHED;
            PG8_LDA(At, 0, 1); PG8_STAGE(PG8_SB(0, 0), b2, voffB); PG8_STAGE(PG8_SB(0, 1), b2 + hsB, voffB); PG8_STAGE(PG8_SA(0, 0), a2, voffA);
            PG8_WAIT_V(8); PG8_WAIT_L(0); PG8_BAR; PG8_MM2(1, At); PG8_BAR; PG8_SCHED;
            PG8_LDB(B0, 1, 0); PG8_LDB(B1, 1, 1); PG8_SCHED; PG8_LDA(At, 1, 0); PG8_STAGE(PG8_SA(0, 1), a2 + hsA, voffA);
            PG8_WAIT_V(8); PG8_WAIT_L(0); PG8_BAR; PG8_MM2(0, At); PG8_BAR; PG8_SCHED;
            PG8_LDA(At, 1, 1); PG8_STAGE(PG8_SB(1, 0), b3, voffB); PG8_STAGE(PG8_SB(1, 1), b3 + hsB, voffB); PG8_STAGE(PG8_SA(1, 0), a3, voffA);
            PG8_WAIT_V(8); PG8_WAIT_L(0); PG8_BAR; PG8_MM2(1, At); PG8_BAR; PG8_SCHED;
        }
        if (wr == 0) PG8_BAR;
        E(acc, cur, wr, wc, fr, fq);
        if (!has_next) break;
#pragma unroll
        for (int a = 0; a < 2; ++a)
#pragma unroll
            for (int b = 0; b < 2; ++b)
#pragma unroll
                for (int m = 0; m < 4; ++m)
#pragma unroll
                    for (int n = 0; n < 2; ++n) acc[a][b][m][n] = (f32x4){0.f, 0.f, 0.f, 0.f};
        cur = nxt; cA = nA; cB = nB; ++ui;
        if (wr == 1) PG8_BAR;
    }
    PG8_WAIT_V(0);
    PG8_BAR;
#undef PG8_SA
#undef PG8_SB
#undef PG8_STAGE
#undef PG8_LDA
#undef PG8_LDB
#undef PG8_MMA
#undef PG8_MMA1
#undef PG8_MMAZ
#undef PG8_MM2
#undef PG8_WAIT_V
#undef PG8_WAIT_L
#undef PG8_BAR
#undef PG8_SCHED
#undef PG8_UA
#undef PG8_UB
}
}

struct Args {
    const float* x; const float* c; const float* ctx; const float* c_ctx; const float* w_mod; const float* b_mod; const float* g_pre; const float* g_post;
    const float* w_gate; const float* w_up; const float* w_down; const float* w_in; const float* gqa_qn; const float* gqa_kn; const float* mla_qn; const float* mla_kvn;
    const float* w_uq; const float* w_ukv; const float* dlam; const float* dsub; const float* sink; const float* w_branch; const float* w_out;
    float* out; unsigned char* ws; int ph_lo, ph_hi;
};
typedef const __attribute__((address_space(4))) Args CArgs;

template <class F>
__device__ __forceinline__ void conv_item(bf16_t* WT, int K, int nblk, int item, LAS float* scr, int lane, const F& f) {
    const int kb = item / nblk, nb = item % nblk, k0 = 64 * kb, n0 = 32 * nb;
#pragma unroll 8
    for (int i = 0; i < 32; ++i) { const int kk = 2 * i + (lane >> 5); scr[kk * 33 + (lane & 31)] = f(n0 + (lane & 31), k0 + kk); }
    asm volatile("s_waitcnt lgkmcnt(0)" ::: "memory");
    const int c = lane & 7;
#pragma unroll
    for (int j = 0; j < 4; ++j) { const int n = (lane >> 3) + 8 * j; const LAS float* s = scr + (8 * c) * 33 + n;
        u32x4 o; o.x = pk2(s[0 * 33], s[1 * 33]); o.y = pk2(s[2 * 33], s[3 * 33]); o.z = pk2(s[4 * 33], s[5 * 33]); o.w = pk2(s[6 * 33], s[7 * 33]);
        *(u32x4*)(WT + (size_t)(n0 + n) * K + k0 + 8 * c) = o; }
    asm volatile("s_waitcnt lgkmcnt(0)" ::: "memory");
}

__device__ __forceinline__ void p0_phase(CArgs& a, LAS unsigned char* lds) {
    const int tid = ptid(), lane = tid & 63, wave = tid >> 6;
    float* MOD = (float*)(a.ws + WS_MOD);
    {
        LAS float* sl = (LAS float*)lds;
        LAS float* red = (LAS float*)(lds + 40960);
        for (int i = tid; i < 9 * 1024; i += 512) { const int r = i >> 10, k = i & 1023; const float v = r < 8 ? a.c[r * 1024 + k] : a.c_ctx[k]; sl[i] = v * sigmoidf_(v); }
        __syncthreads();
        for (int it = blockIdx.x; it < 2 * 144; it += gridDim.x) {
            const int l = it / 144, n0 = (it % 144) * 64;
            const float* W = a.w_mod + (size_t)l * 1024 * MODW + n0 + lane;
            float acc[9];
#pragma unroll
            for (int r = 0; r < 9; ++r) acc[r] = 0.f;
#pragma unroll 8
            for (int kk = 0; kk < 128; ++kk) { const int k = wave * 128 + kk; const float wv = W[(size_t)k * MODW];
#pragma unroll
                for (int r = 0; r < 9; ++r) acc[r] += sl[r * 1024 + k] * wv; }
#pragma unroll
            for (int r = 0; r < 9; ++r) red[(wave * 9 + r) * 64 + lane] = acc[r];
            __syncthreads();
            for (int i = tid; i < 9 * 64; i += 512) { const int r = i >> 6, cidx = i & 63; float s = a.b_mod[l * MODW + n0 + cidx];
#pragma unroll
                for (int w = 0; w < 8; ++w) s += red[(w * 9 + r) * 64 + cidx];
                MOD[((size_t)l * 9 + r) * MODW + n0 + cidx] = s; }
            __syncthreads();
        }
        __syncthreads();
    }
    LAS float* scr = (LAS float*)(lds + wave * 8448);
    const int gw = blockIdx.x * 8 + wave, NGW = gridDim.x * 8;
    constexpr int I_GU = 176 * 16, I_D = 32 * 44, I_IN = 72 * 16, I_G = 128 * 16, I_BR = 32 * 16, I_OUT = 32 * 16, I_MLA = 32 * 6;
    constexpr int I_LAYER = 2 * I_GU + 2 * I_D + I_IN + I_G + I_BR + I_OUT + I_MLA;
    for (int it = gw; it < 2 * I_LAYER; it += NGW) {
        const int l = it / I_LAYER; int r = it % I_LAYER;
        unsigned char* wb = a.ws + WS_W + (size_t)l * W_LAYER;
        if (r < 2 * I_GU) { const int s = r / I_GU; r %= I_GU;
            const float* wg = a.w_gate + (size_t)(l * 2 + s) * 1024 * DFF; const float* wu = a.w_up + (size_t)(l * 2 + s) * 1024 * DFF;
            conv_item((bf16_t*)(wb + W_GU + s * W_GU_SZ), 1024, 176, r, scr, lane, [=](int n, int k) { const int j = (n >> 8) * 128 + (n & 127); return ((n >> 7) & 1) ? wu[(size_t)k * DFF + j] : wg[(size_t)k * DFF + j]; });
            continue; }
        r -= 2 * I_GU;
        if (r < 2 * I_D) { const int s = r / I_D; r %= I_D;
            const float* wd = a.w_down + (size_t)(l * 2 + s) * DFF * 1024;
            conv_item((bf16_t*)(wb + W_D + s * W_D_SZ), DFF, 32, r, scr, lane, [=](int n, int k) { return wd[(size_t)k * 1024 + n]; });
            continue; }
        r -= 2 * I_D;
        const float* win = a.w_in + (size_t)l * 1024 * INCOLS;
        if (r < I_IN) { conv_item((bf16_t*)(wb + W_IN), 1024, 72, r, scr, lane, [=](int n, int k) { return n < GATE0 ? win[(size_t)k * INCOLS + n] : 0.f; }); continue; }
        r -= I_IN;
        if (r < I_G) { conv_item((bf16_t*)(wb + W_G), 1024, 128, r, scr, lane, [=](int n, int k) { return win[(size_t)k * INCOLS + GATE0 + n]; }); continue; }
        r -= I_G;
        if (r < I_BR) { const float* wbr = a.w_branch + (size_t)l * 4 * 256 * 1024;
            conv_item((bf16_t*)(wb + W_BR), 1024, 32, r, scr, lane, [=](int n, int k) { return wbr[(size_t)k * 1024 + n]; }); continue; }
        r -= I_BR;
        if (r < I_OUT) { const float* wo = a.w_out + (size_t)l * 1024 * 1024;
            conv_item((bf16_t*)(wb + W_OUT), 1024, 32, r, scr, lane, [=](int n, int k) { return wo[(size_t)k * 1024 + n]; }); continue; }
        r -= I_OUT;
        { const float* uq = a.w_uq + (size_t)l * 256 * 384; const float* ukv = a.w_ukv + (size_t)l * 128 * 512; const float* gq = a.mla_qn + l * 256; const float* gkv = a.mla_kvn + l * 128;
            conv_item((bf16_t*)(wb + W_MLA), 384, 32, r, scr, lane, [=](int n, int k) {
                float v = 0.f;
                if (n < 384) { if (k < 256) v = gq[k] * uq[(size_t)k * 384 + n]; }
                else if (n < 896) { if (k >= 256) v = gkv[k - 256] * ukv[(size_t)(k - 256) * 512 + (n - 384)]; }
                return v; }); }
    }
}

__device__ __forceinline__ void row_phase(CArgs& a, int l, bool first, const bf16_t* Y, int sub_y, float gscale, bf16_t* U, int sub_u, int l_u) {
    const int tid_ = ptid(); const int lane = tid_ & 63, wave = tid_ >> 6;
    const int gw = blockIdx.x * 8 + wave, NGW = gridDim.x * 8;
    const float* MOD = (const float*)(a.ws + WS_MOD);
    float* XC = (float*)(a.ws + WS_XC);
#pragma unroll 2
    for (int row = gw; row < R; row += NGW) {
        const int b = row / RPB, t = row % RPB; const bool isctx = t < CTX;
        const float* xs; float* xd;
        if (isctx) { const size_t o = (size_t)(b * CTX + t) * DM; xs = (first ? a.ctx : XC) + o; xd = XC + o; }
        else { const size_t o = (size_t)(b * SEQ + (t - CTX)) * DM; xs = (first ? a.x : a.out) + o; xd = a.out + o; }
        const int mrow = isctx ? 8 : b;
        f32x4 v[4];
#pragma unroll
        for (int j = 0; j < 4; ++j) v[j] = __builtin_nontemporal_load((const f32x4*)(xs + 4 * lane + 256 * j));
        if (Y) {
            const float* md = MOD + ((size_t)l * 9 + mrow) * MODW + (sub_y * 3 + 2) * 1024;
            const float* gp = a.g_post + (l * 3 + sub_y) * 1024;
            f32x4 y[4]; float ss = 0.f;
#pragma unroll
            for (int j = 0; j < 4; ++j) { const u32x2 w = __builtin_nontemporal_load((const u32x2*)(Y + (size_t)row * DM + 4 * lane + 256 * j));
                y[j] = (f32x4){bflo(w.x), bfhi(w.x), bflo(w.y), bfhi(w.y)}; ss += (y[j].x * y[j].x + y[j].y * y[j].y) + (y[j].z * y[j].z + y[j].w * y[j].w); }
            const float rs = __builtin_amdgcn_rsqf(wave_sum(ss) * (1.f / DM) + EPS) * gscale;
#pragma unroll
            for (int j = 0; j < 4; ++j) { const f32x4 g = *(const f32x4*)(md + 4 * lane + 256 * j), p = *(const f32x4*)(gp + 4 * lane + 256 * j);
                v[j] = v[j] + (y[j] * rs) * p * g; __builtin_nontemporal_store(v[j], (f32x4*)(xd + 4 * lane + 256 * j)); }
        }
        if (U) {
            const float* md = MOD + ((size_t)l_u * 9 + mrow) * MODW + (sub_u * 3) * 1024;
            const float* gp = a.g_pre + (l_u * 3 + sub_u) * 1024;
            float ss = 0.f;
#pragma unroll
            for (int j = 0; j < 4; ++j) ss += (v[j].x * v[j].x + v[j].y * v[j].y) + (v[j].z * v[j].z + v[j].w * v[j].w);
            const float rs = __builtin_amdgcn_rsqf(wave_sum(ss) * (1.f / DM) + EPS);
#pragma unroll
            for (int j = 0; j < 4; ++j) { const f32x4 sh = *(const f32x4*)(md + 4 * lane + 256 * j), sc = *(const f32x4*)(md + 1024 + 4 * lane + 256 * j), p = *(const f32x4*)(gp + 4 * lane + 256 * j);
                const f32x4 u = (v[j] * rs) * p * (sc + 1.f) + sh;
                u32x2 w; w.x = pk2(u.x, u.y); w.y = pk2(u.z, u.w);
                *(u32x2*)(U + (size_t)row * DM + 4 * lane + 256 * j) = w; }
        }
    }
}

constexpr int VSTR = 136;
constexpr int TAB_OFF = 768 * VSTR;
__device__ __forceinline__ void rope64p(float& v0, float& v1, int l, bool lat, const LAS float* tab, int prow, int pcol) {
    const float p0 = __shfl_xor(v0, 8), p1 = __shfl_xor(v1, 8);
    const int lh = l & 31, pos = (lh & 16) ? pcol : prow, i0 = (2 * lh) & 15;
    const f32x4 cs = *(const LAS f32x4*)(tab + (pos * 16 + i0) * 2);
    const bool sec = (lh >> 3) & 1;
    const float c0 = lat ? cs[0] : 1.f, s0 = lat ? (sec ? cs[1] : -cs[1]) : 0.f, c1 = lat ? cs[2] : 1.f, s1 = lat ? (sec ? cs[3] : -cs[3]) : 0.f;
    v0 = v0 * c0 + p0 * s0; v1 = v1 * c1 + p1 * s1;
}
__device__ __forceinline__ void rope32p(float& v0, float& v1, int d0, bool lat, const LAS float* tab, int prow, int pcol) {
    const float p0 = __shfl_xor(v0, 4), p1 = __shfl_xor(v1, 4);
    const int pos = (d0 & 16) ? pcol : prow, i0 = d0 & 7;
    const LAS float* t = tab + (pos * 16 + 2 * i0) * 2;
    const bool sec = (d0 >> 3) & 1;
    const float c0 = lat ? t[0] : 1.f, s0 = lat ? (sec ? t[1] : -t[1]) : 0.f, c1 = lat ? t[4] : 1.f, s1 = lat ? (sec ? t[5] : -t[5]) : 0.f;
    v0 = v0 * c0 + p0 * s0; v1 = v1 * c1 + p1 * s1;
}
__device__ __forceinline__ float half_sum(float v) {
#pragma unroll
    for (int o = 1; o < 32; o <<= 1) v += __shfl_xor(v, o);
    return v;
}
__device__ __forceinline__ void prep_phase(CArgs& a, int l, LAS unsigned char* lds) {
    const int tid = ptid(), lane = tid & 63, wave = __builtin_amdgcn_readfirstlane(tid >> 6);
    bf16_t* HIN = (bf16_t*)(a.ws + WS_BIG); bf16_t* MUP = (bf16_t*)(a.ws + WS_Y); bf16_t* VT = (bf16_t*)(a.ws + WS_VT);
    LAS float* tab = (LAS float*)(lds + TAB_OFF);
    for (int i = tid; i < 128 * 16; i += 512) { const int pos = i >> 4, f = i & 15;
        const float invf = fexp2(-(float)(2 * f) * (1.f / 32.f) * 13.287712379549449f);
        float rev = (float)pos * invf * 0.15915494309189535f; rev -= __builtin_floorf(rev);
        tab[i * 2] = __builtin_amdgcn_cosf(rev); tab[i * 2 + 1] = __builtin_amdgcn_sinf(rev); }
    __syncthreads();
    const int lh = lane & 31;
    const float gq0 = a.gqa_qn[l * 64 + 2 * lh], gq1 = a.gqa_qn[l * 64 + 2 * lh + 1], gk0 = a.gqa_kn[l * 64 + 2 * lh], gk1 = a.gqa_kn[l * 64 + 2 * lh + 1];
#define LD2(p, v0, v1) do { const unsigned w_ = *(const unsigned*)(p); v0 = bflo(w_); v1 = bfhi(w_); } while (0)
#define ST2(p, v0, v1) do { *(unsigned*)(p) = pg8::cvt_pk_bf16(v0, v1); } while (0)
    for (int tile = blockIdx.x; tile < R / 64; tile += gridDim.x) {
        const int row0 = tile * 64, b = row0 / RPB, t0 = row0 % RPB;
#pragma unroll 4
        for (int rr = 0; rr < 8; ++rr) {
            const int tk = wave * 8 + rr, row = row0 + tk, t = t0 + tk; const bool lat = t >= CTX;
            const int tl = lat ? t - CTX : 0, prow = tl >> 6, pcol = tl & 63;
            bf16_t* __restrict__ h = HIN + (size_t)row * NHIN; bf16_t* __restrict__ mu = MUP + (size_t)row * 1024;
            LAS bf16_t* vst = (LAS bf16_t*)lds + tk;
#pragma unroll
            for (int j = 0; j < 3; ++j) { float v0, v1; LD2(h + 128 * j + 2 * lane, v0, v1);
                const float rs = __builtin_amdgcn_rsqf(half_sum(v0 * v0 + v1 * v1) * (1.f / 64.f) + EPS);
                v0 = v0 * rs * (j < 2 ? gq0 : gk0); v1 = v1 * rs * (j < 2 ? gq1 : gk1);
                rope64p(v0, v1, lane, lat, tab, prow, pcol);
                if (j < 2) { v0 *= QS_GQA; v1 *= QS_GQA; }
                ST2(h + 128 * j + 2 * lane, v0, v1); }
            { const unsigned w = *(const unsigned*)(h + 384 + 2 * lane); vst[(0 + 2 * lane) * (VSTR / 2)] = (bf16_t)(w & 0xffffu); vst[(0 + 2 * lane + 1) * (VSTR / 2)] = (bf16_t)(w >> 16); }
            float sq = 0.f, skv = 0.f;
#pragma unroll
            for (int j = 0; j < 2; ++j) { float v0, v1; LD2(h + 512 + 128 * j + 2 * lane, v0, v1); sq += v0 * v0 + v1 * v1; }
            { float v0, v1; LD2(h + 768 + 2 * lane, v0, v1); skv = v0 * v0 + v1 * v1; }
            const float rq = __builtin_amdgcn_rsqf(wave_sum(sq) * (1.f / 256.f) + EPS) * QS_MLA, rkv = __builtin_amdgcn_rsqf(wave_sum(skv) * (1.f / 128.f) + EPS);
#pragma unroll
            for (int j = 0; j < 3; ++j) { const int c = 128 * j + 2 * lane, e = c % 96; float v0, v1; LD2(mu + c, v0, v1); v0 *= rq; v1 *= rq;
                float r0 = v0, r1 = v1; rope32p(r0, r1, (e - 64) & 30, lat, tab, prow, pcol);
                if (e >= 64) { v0 = r0; v1 = r1; }
                ST2(mu + c, v0, v1); }
#pragma unroll
            for (int hh = 0; hh < 4; ++hh) { const int c = 384 + 128 * hh + 2 * lane; float v0, v1; LD2(mu + c, v0, v1); v0 *= rkv; v1 *= rkv;
                const unsigned w = pg8::cvt_pk_bf16(v0, v1);
                if (lane < 32) *(unsigned*)(mu + c) = w;
                else { vst[(128 + 64 * hh + 2 * (lane - 32)) * (VSTR / 2)] = (bf16_t)(w & 0xffffu); vst[(128 + 64 * hh + 2 * (lane - 32) + 1) * (VSTR / 2)] = (bf16_t)(w >> 16); } }
            { float v0, v1; LD2(h + 896 + 2 * (lane & 15), v0, v1); rope32p(v0, v1, 2 * (lane & 15), lat, tab, prow, pcol); if (lane < 16) ST2(mu + 896 + 2 * lane, v0, v1); }
#pragma unroll
            for (int j = 0; j < 4; ++j) { float v0, v1; LD2(h + 928 + 128 * j + 2 * lane, v0, v1); rope32p(v0, v1, (2 * lane) & 31, lat, tab, prow, pcol);
                if (j < 2) { v0 *= QS_DIFF; v1 *= QS_DIFF; }
                ST2(h + 928 + 128 * j + 2 * lane, v0, v1); }
#pragma unroll
            for (int j = 0; j < 2; ++j) { const unsigned w = *(const unsigned*)(h + 1440 + 128 * j + 2 * lane); vst[(384 + 128 * j + 2 * lane) * (VSTR / 2)] = (bf16_t)(w & 0xffffu); vst[(384 + 128 * j + 2 * lane + 1) * (VSTR / 2)] = (bf16_t)(w >> 16); }
#pragma unroll
            for (int j = 0; j < 3; ++j) { float v0, v1; LD2(h + 1696 + 128 * j + 2 * lane, v0, v1); rope64p(v0, v1, lane, lat, tab, prow, pcol);
                if (j < 2) { v0 *= QS_GQA; v1 *= QS_GQA; }
                ST2(h + 1696 + 128 * j + 2 * lane, v0, v1); }
            { const unsigned w = *(const unsigned*)(h + 2080 + 2 * lane); vst[(640 + 2 * lane) * (VSTR / 2)] = (bf16_t)(w & 0xffffu); vst[(640 + 2 * lane + 1) * (VSTR / 2)] = (bf16_t)(w >> 16); }
        }
#undef LD2
#undef ST2
        __syncthreads();
        bf16_t* vt = VT + (size_t)b * 768 * RPB + t0;
        for (int p = tid; p < 768 * 8; p += 512) { const int vr = p >> 3, seg = p & 7;
            const LAS u32x2* s = (const LAS u32x2*)(lds + vr * VSTR + seg * 16); const u32x2 lo = s[0], hi = s[1];
            *(u32x4*)(vt + (size_t)vr * RPB + seg * 8) = (u32x4){lo.x, lo.y, hi.x, hi.y}; }
        __syncthreads();
    }
}

__device__ __forceinline__ int crow(int r, int hi) { return (r & 3) + 8 * (r >> 2) + 4 * hi; }
constexpr int AT_KBUF = 128 * (96 * 2 + 16);
constexpr int AT_VSTR = 264, AT_VBUF = 64 * AT_VSTR;
constexpr int AT_K0 = 0, AT_V0 = 2 * AT_KBUF, AT_WS = AT_V0 + 2 * AT_VBUF;

struct AttnSrc { const bf16_t* Q; int ldq; const bf16_t* K1; int ldk1; const bf16_t* K2; int ldk2; const bf16_t* VT; };

template <int DQK, bool WIN>
__device__ __forceinline__ void attn_pass(const AttnSrc& s, int NT, int lo, int q0lat, float sink_l2, bool has_sink, LAS unsigned char* lds, f32x16 (&o)[2]) {
    constexpr int KSTR = DQK * 2 + 16, NCH = DQK / 8, NKS = DQK / 16, NP = (128 * NCH) / 512;
    const int tid = ptid(), lane = tid & 63, r32 = lane & 31, hi = lane >> 5; const int wid = __builtin_amdgcn_readfirstlane(tid >> 6);
    LAS float* wsf = (LAS float*)(lds + AT_WS) + wid * 32;
    bf16x8 qf[NKS];
    { const bf16_t* qp = s.Q + (size_t)(wid * 32 + r32) * s.ldq + 8 * hi;
#pragma unroll
        for (int ks = 0; ks < NKS; ++ks) qf[ks] = *(const bf16x8*)(qp + 16 * ks); }
    o[0] = (f32x16){}; o[1] = (f32x16){};
    f32x16 negm = (f32x16){}; asm volatile("" : "+v"(negm));
    float mhat = 0.f, lsum = 0.f;
    const int NT2 = NT >> 1, lo2 = lo >> 1;
    u32x4 kr[NP], vr[2];
    auto kaddr = [&](int key, int c) -> const bf16_t* { return (DQK == 96 && c >= 8) ? s.K2 + (size_t)key * s.ldk2 + (c - 8) * 8 : s.K1 + (size_t)key * s.ldk1 + c * 8; };
#define AT_TILE(j) ((j) < 2 ? (j) : lo2 - 2 + (j))
#define AT_GLOAD(j) do { const int key0_ = AT_TILE(j) * 128; \
        _Pragma("unroll") for (int p = 0; p < NP; ++p) { const int idx_ = tid + 512 * p; kr[p] = *(const u32x4*)kaddr(key0_ + idx_ / NCH, idx_ % NCH); } \
        _Pragma("unroll") for (int p = 0; p < 2; ++p) { const int idx_ = tid + 512 * p; vr[p] = *(const u32x4*)(s.VT + (size_t)(idx_ >> 4) * RPB + key0_ + (idx_ & 15) * 8); } } while (0)
#define AT_LSTORE(buf) do { \
        _Pragma("unroll") for (int p = 0; p < NP; ++p) { const int idx_ = tid + 512 * p; *(LAS u32x4*)(lds + AT_K0 + (buf) * AT_KBUF + (idx_ / NCH) * KSTR + (idx_ % NCH) * 16) = kr[p]; } \
        _Pragma("unroll") for (int p = 0; p < 2; ++p) { const int idx_ = tid + 512 * p; LAS u32x2* vd_ = (LAS u32x2*)(lds + AT_V0 + (buf) * AT_VBUF + (idx_ >> 4) * AT_VSTR + (idx_ & 15) * 16); vd_[0] = (u32x2){vr[p].x, vr[p].y}; vd_[1] = (u32x2){vr[p].z, vr[p].w}; } } while (0)
#define MX3(a, b, c) __builtin_fmaxf(__builtin_fmaxf((a), (b)), (c))
    AT_GLOAD(0); AT_LSTORE(0);
    if (NT2 > 1) AT_GLOAD(1);
    __syncthreads();
    for (int j = 0; j < NT2; ++j) {
        const int buf = j & 1;
        f32x16 sA0, sA1, sB0, sB1;
#define AT_QK(S0, S1, sub) do { const LAS unsigned char* kb = lds + AT_K0 + buf * AT_KBUF + ((sub) * 64 + r32) * KSTR + hi * 16; \
        _Pragma("unroll") for (int ks = 0; ks < NKS; ++ks) { \
            const bf16x8 a0 = *(const LAS bf16x8*)(kb + ks * 32), a1 = *(const LAS bf16x8*)(kb + 32 * KSTR + ks * 32); \
            if (ks == 0) { S0 = __builtin_amdgcn_mfma_f32_32x32x16_bf16(a0, qf[0], negm, 0, 0, 0); S1 = __builtin_amdgcn_mfma_f32_32x32x16_bf16(a1, qf[0], negm, 0, 0, 0); } \
            else { S0 = __builtin_amdgcn_mfma_f32_32x32x16_bf16(a0, qf[ks], S0, 0, 0, 0); S1 = __builtin_amdgcn_mfma_f32_32x32x16_bf16(a1, qf[ks], S1, 0, 0, 0); } } } while (0)
#define AT_SOFT(s0, s1, u0, u1, sub, HASNEXT) do { \
        if (WIN && j >= 2) { \
            const int jb = AT_TILE(j) * 128 + (sub) * 64 - CTX + 4 * hi, qi = q0lat + wid * 32 + r32; \
            _Pragma("unroll") for (int r = 0; r < 16; ++r) { const int jj = jb + (r & 3) + 8 * (r >> 2); const int d0 = qi - jj, d1 = qi - (jj + 32); \
                if (d0 > 128 || d0 < -128) s0[r] = -1e30f; if (d1 > 128 || d1 < -128) s1[r] = -1e30f; } } \
        float ra = MX3(s0[0], s0[1], s1[0]), rb = MX3(s0[2], s0[3], s1[1]); ra = MX3(ra, s1[2], s1[3]); \
        _Pragma("unroll") for (int r = 4; r < 16; r += 4) { ra = MX3(ra, s0[r], s0[r + 1]); rb = MX3(rb, s0[r + 2], s0[r + 3]); ra = MX3(ra, s1[r], s1[r + 1]); rb = MX3(rb, s1[r + 2], s1[r + 3]); } \
        float rm = __builtin_fmaxf(ra, rb); rm = __builtin_fmaxf(rm, __shfl_xor(rm, 32)); \
        const bool first = (j == 0) && ((sub) == 0); \
        if (first || __any(rm > 8.f)) { const float dl = first ? rm : __builtin_fmaxf(rm, 0.f); mhat += dl; \
            _Pragma("unroll") for (int r = 0; r < 16; ++r) { s0[r] -= dl; s1[r] -= dl; } \
            if (HASNEXT) { _Pragma("unroll") for (int r = 0; r < 16; ++r) { u0[r] -= dl; u1[r] -= dl; } }     \
            _Pragma("unroll") for (int r = 0; r < 16; ++r) negm[r] = -mhat; \
            asm volatile("" : "+v"(negm)); \
            if (!first) { const float f = fexp2(-dl); lsum *= f; if (hi == 0) wsf[r32] = f; \
                _Pragma("unroll") for (int r = 0; r < 16; ++r) { const float fr_ = wsf[crow(r, hi)]; o[0][r] *= fr_; o[1][r] *= fr_; } } } \
        _Pragma("unroll") for (int r = 0; r < 16; ++r) { s0[r] = fexp2(s0[r]); s1[r] = fexp2(s1[r]); } \
        { float ps = s0[0];     \
          _Pragma("unroll") for (int r = 1; r < 16; ++r) ps += s0[r]; \
          _Pragma("unroll") for (int r = 0; r < 16; ++r) ps += s1[r]; \
          lsum += ps; } \
        bf16x8 pa[4]; \
        _Pragma("unroll") for (int kk = 0; kk < 2; ++kk) { u32x4 w; \
            w.x = pg8::cvt_pk_bf16(s0[8 * kk + 0], s0[8 * kk + 1]); w.y = pg8::cvt_pk_bf16(s0[8 * kk + 2], s0[8 * kk + 3]); w.z = pg8::cvt_pk_bf16(s0[8 * kk + 4], s0[8 * kk + 5]); w.w = pg8::cvt_pk_bf16(s0[8 * kk + 6], s0[8 * kk + 7]); pa[kk] = __builtin_bit_cast(bf16x8, w); \
            w.x = pg8::cvt_pk_bf16(s1[8 * kk + 0], s1[8 * kk + 1]); w.y = pg8::cvt_pk_bf16(s1[8 * kk + 2], s1[8 * kk + 3]); w.z = pg8::cvt_pk_bf16(s1[8 * kk + 4], s1[8 * kk + 5]); w.w = pg8::cvt_pk_bf16(s1[8 * kk + 6], s1[8 * kk + 7]); pa[2 + kk] = __builtin_bit_cast(bf16x8, w); } \
        const LAS unsigned char* vb = lds + AT_V0 + buf * AT_VBUF + r32 * AT_VSTR + (sub) * 128 + hi * 8; \
        _Pragma("unroll") for (int dvb = 0; dvb < 2; ++dvb) _Pragma("unroll") for (int kk = 0; kk < 4; ++kk) { \
                const u32x2 lo_ = *(const LAS u32x2*)(vb + dvb * 32 * AT_VSTR + kk * 32), hi_ = *(const LAS u32x2*)(vb + dvb * 32 * AT_VSTR + kk * 32 + 16); \
                const bf16x8 bv = __builtin_bit_cast(bf16x8, (u32x4){lo_.x, lo_.y, hi_.x, hi_.y}); \
                o[dvb] = __builtin_amdgcn_mfma_f32_32x32x16_bf16(pa[kk], bv, o[dvb], 0, 0, 0); } } while (0)
        AT_QK(sA0, sA1, 0); AT_QK(sB0, sB1, 1);
        AT_SOFT(sA0, sA1, sB0, sB1, 0, true);
        AT_SOFT(sB0, sB1, sA0, sA1, 1, false);
#undef AT_QK
#undef AT_SOFT
        if (j + 1 < NT2) AT_LSTORE(buf ^ 1);
        __syncthreads();
        if (j + 2 < NT2) AT_GLOAD(j + 2);
    }
    float lt = lsum + __shfl_xor(lsum, 32);
    if (has_sink) lt += fexp2(sink_l2 - mhat);
    if (hi == 0) wsf[r32] = frcp(lt);
#pragma unroll
    for (int r = 0; r < 16; ++r) { const float fr_ = wsf[crow(r, hi)]; o[0][r] *= fr_; o[1][r] *= fr_; }
#undef AT_TILE
#undef AT_GLOAD
#undef AT_LSTORE
#undef MX3
}

__device__ __forceinline__ void attn_store(bf16_t* O, int row0, int col0, const f32x16 (&o)[2]) {
    const int tid_ = ptid(); const int lane = tid_ & 63, r32 = lane & 31, hi = lane >> 5, wid = tid_ >> 6;
#pragma unroll
    for (int dvb = 0; dvb < 2; ++dvb)
#pragma unroll
        for (int r = 0; r < 16; ++r) O[(size_t)(row0 + wid * 32 + crow(r, hi)) * 1024 + col0 + dvb * 32 + r32] = (bf16_t)f2bf(o[dvb][r]);
}

__device__ __forceinline__ void attn_unit(CArgs& a, int l, int branch, int b, int h, int qb, float lam, float lam_init, LAS unsigned char* lds) {
    const bf16_t* HIN = (const bf16_t*)(a.ws + WS_BIG) + (size_t)b * RPB * NHIN; const bf16_t* MUP = (const bf16_t*)(a.ws + WS_Y) + (size_t)b * RPB * 1024;
    const bf16_t* VT = (const bf16_t*)(a.ws + WS_VT) + (size_t)b * 768 * RPB; bf16_t* OUTS = (bf16_t*)(a.ws + WS_OUTS);
    const bool cq = qb < 0; const int qrow = cq ? 0 : CTX + 256 * qb;
    const int NTd = cq ? 4 : 132;
    const int orow0 = b * RPB + qrow;
    f32x16 o[2];
    AttnSrc s;
    if (branch == 0) {
        s.Q = HIN + (size_t)qrow * NHIN + 64 * h; s.ldq = NHIN; s.K1 = HIN + 256 + 64 * (h >> 1); s.ldk1 = NHIN; s.K2 = nullptr; s.ldk2 = 0; s.VT = VT + (size_t)(0 + 64 * (h >> 1)) * RPB;
        attn_pass<64, false>(s, NTd, 4, 0, 0.f, false, lds, o);
        attn_store(OUTS, orow0, 0 + 64 * h, o);
    } else if (branch == 1) {
        s.Q = MUP + (size_t)qrow * 1024 + 96 * h; s.ldq = 1024; s.K1 = MUP + 384 + 128 * h; s.ldk1 = 1024; s.K2 = MUP + 896; s.ldk2 = 1024; s.VT = VT + (size_t)(128 + 64 * h) * RPB;
        attn_pass<96, false>(s, NTd, 4, 0, 0.f, false, lds, o);
        attn_store(OUTS, orow0, 256 + 64 * h, o);
    } else if (branch == 2) {
        f32x16 o2[2];
        s.Q = HIN + (size_t)qrow * NHIN + 928 + 64 * h; s.ldq = NHIN; s.K1 = HIN + 1184 + 64 * h; s.ldk1 = NHIN; s.K2 = nullptr; s.ldk2 = 0; s.VT = VT + (size_t)(384 + 64 * h) * RPB;
        attn_pass<32, false>(s, NTd, 4, 0, 0.f, false, lds, o);
        s.Q += 32; s.K1 += 32;
        attn_pass<32, false>(s, NTd, 4, 0, 0.f, false, lds, o2);
        const int lane = ptid() & 63, r32 = lane & 31;
        const float g0 = a.dsub[l * 64 + r32] * (1.f - lam_init), g1 = a.dsub[l * 64 + 32 + r32] * (1.f - lam_init);
#pragma unroll
        for (int r = 0; r < 16; ++r) { const float x0 = o[0][r] - lam * o2[0][r], x1 = o[1][r] - lam * o2[1][r];
            float ss = x0 * x0 + x1 * x1;
#pragma unroll
            for (int m = 1; m < 32; m <<= 1) ss += __shfl_xor(ss, m);
            const float rs = __builtin_amdgcn_rsqf(ss * (1.f / 64.f) + EPS);
            o[0][r] = x0 * rs * g0; o[1][r] = x1 * rs * g1; }
        attn_store(OUTS, orow0, 512 + 64 * h, o);
    } else {
        s.Q = HIN + (size_t)qrow * NHIN + 1696 + 64 * h; s.ldq = NHIN; s.K1 = HIN + 1952 + 64 * (h >> 1); s.ldk1 = NHIN; s.K2 = nullptr; s.ldk2 = 0; s.VT = VT + (size_t)(640 + 64 * (h >> 1)) * RPB;
        const float sk = a.sink[l * 4 + h] * LOG2E;
        if (cq) attn_pass<64, false>(s, 4, 4, 0, sk, true, lds, o);
        else { const int q0 = 256 * qb; const int lo = 4 + (q0 >= 128 ? q0 - 128 : 0) / 64, hiT = 4 + ((q0 + 384) < SEQ ? (q0 + 384) : SEQ) / 64;
            attn_pass<64, true>(s, 4 + hiT - lo, lo, q0, sk, true, lds, o); }
        attn_store(OUTS, orow0, 768 + 64 * h, o);
    }
}

__device__ __forceinline__ void attn_phase(CArgs& a, int l, LAS unsigned char* lds) {
    const float lam_init = 0.8f - 0.6f * __expf(-0.3f * (float)l);
    float lam;
    { const float* dl = a.dlam + l * 128; float s1 = 0.f, s2 = 0.f;
        for (int i = 0; i < 32; ++i) { s1 += dl[i] * dl[32 + i]; s2 += dl[64 + i] * dl[96 + i]; }
        lam = __expf(s1) - __expf(s2) + lam_init; }
    const int G = gridDim.x, bx = blockIdx.x;
    const int vcu = (G % 8 == 0) ? (bx % 8) * (G / 8) + bx / 8 : bx;
    for (int ty = 0; ty < 4; ++ty) {
        const int branch = ty == 0 ? 2 : ty == 1 ? 1 : ty == 2 ? 0 : 3;
        for (int idx = vcu; idx < NB * 4 * 32; idx += G) { const int bh = idx >> 5, qb = idx & 31; attn_unit(a, l, branch, bh >> 2, bh & 3, qb, lam, lam_init, lds); }
    }
    for (int idx = vcu; idx < NB * 16; idx += G) attn_unit(a, l, (idx >> 2) & 3, idx >> 4, idx & 3, -1, lam, lam_init, lds);
}

#define GAS __attribute__((address_space(1)))
#define XB_TMO      128
#define XB_XCNT(j)  (256  + 64 * (j))
#define XB_XSUB(j)  (1280 + 64 * (j))
#define XB_XGEN(j)  (2304 + 64 * (j))
#define XB_TOP      3328
#define XB_TOPGEN   3392
#define XCD_BAR_WORDS 3456
#define XB_SPIN_CAP (1u << 18)

__device__ __forceinline__ unsigned xb_ld(unsigned* p)              { return __hip_atomic_load(p, __ATOMIC_RELAXED, __HIP_MEMORY_SCOPE_AGENT); }
__device__ __forceinline__ unsigned xb_add(unsigned* p, unsigned v) { return __hip_atomic_fetch_add(p, v, __ATOMIC_RELAXED, __HIP_MEMORY_SCOPE_AGENT); }
__device__ __forceinline__ unsigned xb_xcc_id() { return (unsigned)__builtin_amdgcn_s_getreg((3 << 11) | 20) & 0xFu; }
#define XB_SPIN(cond, bar) do { unsigned _sp = 0; while (cond) { __builtin_amdgcn_s_sleep(1); \
    if ((++_sp & 255u) == 0u) { if (xb_ld(&(bar)[XB_TMO])) break; if (_sp > XB_SPIN_CAP) { atomicAdd(&(bar)[XB_TMO], 1u); break; } } } } while (0)

struct XcdBarrier {
    unsigned* bar; unsigned x;
    volatile LAS unsigned* st;
};

__device__ __forceinline__ XcdBarrier xcd_barrier_post(unsigned* bar, volatile LAS unsigned* st) {
    XcdBarrier b; b.bar = bar; b.x = xb_xcc_id(); b.st = st;
    if (threadIdx.x == 0) (void)xb_add(&bar[XB_XCNT(b.x)], 1u);
    return b;
}
__device__ __forceinline__ void xcd_barrier_complete(unsigned* bar, unsigned x, unsigned& nloc, unsigned& nx) {
    const unsigned G = gridDim.x * gridDim.y * gridDim.z;
    unsigned sum, cnt, mine, sp = 0u;
    for (;;) {
        sum = 0u; cnt = 0u; mine = 0u;
#pragma unroll
        for (unsigned j = 0; j < 16; ++j) { const unsigned c = xb_ld(&bar[XB_XCNT(j)]); sum += c; cnt += (c > 0u) ? 1u : 0u; mine = (j == x) ? c : mine; }
        if (sum == G) break;
        __builtin_amdgcn_s_sleep(1);
        if ((++sp & 255u) == 0u) { if (xb_ld(&bar[XB_TMO])) break; if (sp > XB_SPIN_CAP) { atomicAdd(&bar[XB_TMO], 1u); break; } }
    }
    nloc = mine > 0u ? mine : 1u; nx = cnt > 0u ? cnt : 1u;
}

__device__ __forceinline__ void xcd_barrier(const XcdBarrier& b) {
    asm volatile("s_waitcnt vmcnt(0)" ::: "memory");
    __syncthreads();
    if (threadIdx.x == 0) {
        unsigned* bar = b.bar;
        __builtin_amdgcn_s_waitcnt(0);
        unsigned nloc = b.st[0], nx = b.st[1];
        if (nloc == 0u) { xcd_barrier_complete(bar, b.x, nloc, nx); b.st[0] = nloc; b.st[1] = nx; }
        const unsigned old = xb_add(&bar[XB_XSUB(b.x)], 1u);
        const unsigned gen = old / nloc;
        if (old + 1u == (gen + 1u) * nloc) {
            __builtin_amdgcn_fence(__ATOMIC_RELEASE, "agent");
            asm volatile("s_waitcnt vmcnt(0)" ::: "memory");
            const unsigned og = xb_add(&bar[XB_TOP], 1u);
            const unsigned tg = og / nx;
            if (og + 1u == (tg + 1u) * nx) xb_add(&bar[XB_TOPGEN], 1u);
            else XB_SPIN(xb_ld(&bar[XB_TOPGEN]) == tg, bar);
            __builtin_amdgcn_fence(__ATOMIC_ACQUIRE, "agent");
            xb_add(&bar[XB_XGEN(b.x)], 1u);
            asm volatile("s_waitcnt vmcnt(0)" ::: "memory");
        } else {
            XB_SPIN(xb_ld(&bar[XB_XGEN(b.x)]) == gen, bar);
            __builtin_amdgcn_fence(__ATOMIC_ACQUIRE, "agent");
            asm volatile("s_waitcnt vmcnt(0)" ::: "memory");
        }
    }
    __syncthreads();
}


constexpr int NPHASE = 2 + 32;
__global__ void __launch_bounds__(512, 2) fwd_kernel(Args a_) {
    extern __shared__ __attribute__((aligned(16))) unsigned char lds_raw[];
    LAS unsigned char* lds = (LAS unsigned char*)lds_raw;
    cg::grid_group grid = cg::this_grid();
    const int lo = a_.ph_lo, hi = a_.ph_hi < NPHASE ? a_.ph_hi : NPHASE;
    { volatile LAS unsigned* st0 = (volatile LAS unsigned*)(lds + LDS_BARST); if (threadIdx.x < 2) st0[threadIdx.x] = 0u; }
    __syncthreads();
    { XcdBarrier b0 = xcd_barrier_post((unsigned*)(a_.ws + WS_BAR), (volatile LAS unsigned*)(lds + LDS_BARST)); (void)b0; }
    for (int ph = lo; ph < hi; ++ph) {
        CArgs* ap_ = (CArgs*)__builtin_amdgcn_kernarg_segment_ptr(); asm volatile("" : "+s"(ap_) :: "memory"); CArgs& a = *ap_;
        int G = gridDim.x, bx = blockIdx.x; asm volatile("" : "+s"(G), "+s"(bx));
        if (ph == 0) p0_phase(a, lds);
        else if (ph == 1) row_phase(a, 0, true, nullptr, 0, 0.f, (bf16_t*)(a.ws + WS_U), 0, 0);
        else {
            const int l = (ph - 2) / 16, k = (ph - 2) % 16;
            unsigned char* ws = a.ws;
            const unsigned char* wb = ws + WS_W + (size_t)l * W_LAYER;
            bf16_t* U = (bf16_t*)(ws + WS_U); bf16_t* Yb = (bf16_t*)(ws + WS_Y); bf16_t* BIG = (bf16_t*)(ws + WS_BIG);
            if (k == 5) prep_phase(a, l, lds);
#ifndef X_ATTN
            else if (k == 6) attn_phase(a, l, lds);
#endif
            else if (k == 2) row_phase(a, l, l == 0, Yb, 0, 0.5f, U, 1, l);
            else if (k == 12) row_phase(a, l, false, BIG, 1, 1.0f, U, 2, l);
            else if (k == 15) row_phase(a, l, false, Yb, 2, 0.5f, l == 0 ? U : nullptr, 0, l + 1);
            else {
                pg8::Gemm g; pg8::Epi E; int N; int dual = 0; int Mrows = R;
                g.A2 = nullptr; g.Bt2 = nullptr; E.scr = nullptr;
                if (k == 0 || k == 13) { const int s = k == 13; g.A = U; g.Bt = (const bf16_t*)(wb + W_GU + s * W_GU_SZ); g.lda = 1024; g.ldb = 1024; g.K = 1024; N = 5632; E.mode = 1; E.O = BIG; E.ldc = DFF; }
                else if (k == 1 || k == 14) { const int s = k == 14; g.A = BIG; g.Bt = (const bf16_t*)(wb + W_D + s * W_D_SZ); g.lda = DFF; g.ldb = DFF; g.K = DFF; N = 1024; E.mode = 0; E.O = Yb; E.ldc = 1024; }
                else if (k == 3) { g.A = U; g.Bt = (const bf16_t*)(wb + W_IN); g.lda = 1024; g.ldb = 1024; g.K = 1024; N = NHIN; E.mode = 0; E.O = BIG; E.ldc = NHIN; }
                else if (k == 4) { g.A = BIG + 512; g.Bt = (const bf16_t*)(wb + W_MLA); g.lda = NHIN; g.ldb = 384; g.K = 384; N = 1024; E.mode = 0; E.O = Yb; E.ldc = 1024; }
                else if (k == 7 || k == 9) { size_t ro = (size_t)(k == 9) * 32768 * 1024; Mrows = (k == 9) ? R - 32768 : 32768; if (l == 1) { ro = (size_t)(k == 9) * 33792 * 1024; Mrows = 32768; dual = 1; }
                    g.A = U + ro; g.Bt = (const bf16_t*)(wb + W_G); g.lda = 1024; g.ldb = 1024; g.K = 1024; N = 4096; E.mode = 3; E.O = BIG; E.ldc = 4096; }
                else if (k == 8 || k == 10) { size_t ro = (size_t)(k == 10) * 32768 * 1024; Mrows = (k == 10) ? R - 32768 : 32768; if (l == 1) { ro = (size_t)(k == 10) * 33792 * 1024; Mrows = 32768; dual = 1; }
                    g.A = (const bf16_t*)(ws + WS_OUTS) + ro; g.Bt = (const bf16_t*)(wb + W_BR); g.lda = 1024; g.ldb = 1024; g.K = 1024; N = 1024; E.mode = 4; E.O = Yb + ro; E.ldc = 1024; E.scr = (u32x4*)BIG; }
                else { g.A = Yb; g.Bt = (const bf16_t*)(wb + W_OUT); g.lda = 1024; g.ldb = 1024; g.K = 1024; N = 1024; E.mode = 0; E.O = BIG; E.ldc = 1024; }
                if (l == 1 && (k == 11 || k == 13 || k == 14)) { dual = 1; Mrows = 65536; }
                pg8::StaticOrder S; S.init(Mrows, N, G, bx, dual);
                if (k == 8 || k == 10) pg8::gemm_phase<true>(lds, g, S, E); else pg8::gemm_phase<false>(lds, g, S, E);
            }
        }
        if (ph + 1 < hi) {
            if (ph == lo) {
                asm volatile("s_waitcnt vmcnt(0) lgkmcnt(0)" ::: "memory");
                __syncthreads();
                if (ptid() < 64) { __builtin_amdgcn_fence(__ATOMIC_RELEASE, "agent"); asm volatile("s_waitcnt vmcnt(0)" ::: "memory"); }
                grid.sync();
                __builtin_amdgcn_fence(__ATOMIC_ACQUIRE, "agent");
                asm volatile("s_waitcnt vmcnt(0)" ::: "memory");
            } else {
                XcdBarrier bar; bar.bar = (unsigned*)(a.ws + WS_BAR); bar.x = xb_xcc_id(); bar.st = (volatile LAS unsigned*)(lds + LDS_BARST);
                xcd_barrier(bar);
                __builtin_amdgcn_fence(__ATOMIC_ACQUIRE, "agent");
                asm volatile("s_waitcnt vmcnt(0)" ::: "memory");
            }
        }
    }
}

extern "C" void kernel_launch(void* const* d_in, const int* in_sizes, int n_in, void* d_out, int out_size, void* d_ws, size_t ws_size, hipStream_t stream) {
    static int grid = 0;
    if (grid == 0) {
        int dev = 0, cus = 0;
        if (hipGetDevice(&dev) != hipSuccess || hipDeviceGetAttribute(&cus, hipDeviceAttributeMultiprocessorCount, dev) != hipSuccess) { grid = -1; return; }
        if (hipFuncSetAttribute((const void*)fwd_kernel, hipFuncAttributeMaxDynamicSharedMemorySize, LDS_BYTES) != hipSuccess) { fprintf(stderr, "hipFuncSetAttribute failed\n"); grid = -1; return; }
        int per_cu = 0;
        if (hipOccupancyMaxActiveBlocksPerMultiprocessor(&per_cu, (const void*)fwd_kernel, 512, LDS_BYTES) != hipSuccess || per_cu < 1) fprintf(stderr, "occupancy query: %d\n", per_cu);
        (void)hipGetLastError();
        grid = cus;
        if (ws_size < WS_END) { fprintf(stderr, "workspace too small\n"); grid = -1; return; }
    }
    if (grid < 0) return;
    if (hipMemsetAsync((char*)d_ws + WS_BAR, 0, 16384, stream) != hipSuccess) { fprintf(stderr, "memset failed\n"); return; }
    Args a{};
    const float** p = (const float**)&a;
    for (int i = 0; i < 23; ++i) p[i] = (const float*)d_in[i];
    a.out = (float*)d_out; a.ws = (unsigned char*)d_ws; a.ph_lo = 0; a.ph_hi = 1000;
    void* args[] = {&a};
    hipError_t e = hipLaunchCooperativeKernel((const void*)fwd_kernel, dim3(grid), dim3(512), args, LDS_BYTES, stream);
    if (e != hipSuccess) fprintf(stderr, "cooperative launch failed: %s\n", hipGetErrorString(e));
}
```

```cpp
#include <hip/hip_runtime.h>
#include <hip/hip_cooperative_groups.h>
#include <cstdio>
#include <cstdint>
namespace cg = cooperative_groups;

#define LAS __attribute__((address_space(3)))
typedef unsigned short bf16_t;
typedef short bf16x8 __attribute__((ext_vector_type(8)));
typedef short s16x4 __attribute__((ext_vector_type(4)));
typedef float f32x4 __attribute__((ext_vector_type(4)));
typedef float f32x16 __attribute__((ext_vector_type(16)));
typedef unsigned u32x4 __attribute__((ext_vector_type(4)));
typedef unsigned u32x2 __attribute__((ext_vector_type(2)));

constexpr int DM = 1024, NB = 8, SEQ = 8192, CTX = 256, RPB = SEQ + CTX, R = NB * RPB, DFF = 2816;
constexpr int NHIN = 2304, INCOLS = 6304, GATE0 = 2208;
constexpr int MODW = 9216;
constexpr float EPS = 1e-6f;
constexpr float LOG2E = 1.4426950408889634f;
constexpr float QS_GQA = 0.125f * LOG2E, QS_MLA = 0.10206207261596577f * LOG2E, QS_DIFF = 0.17677669529663687f * LOG2E;

constexpr size_t MiB = 1u << 20;
constexpr size_t WS_MOD = 0;
constexpr size_t WS_XC = 2 * MiB;
constexpr size_t WS_W = 10 * MiB;
constexpr size_t W_GU = 0, W_GU_SZ = (size_t)5632 * 1024 * 2;
constexpr size_t W_D = W_GU + 2 * W_GU_SZ, W_D_SZ = (size_t)1024 * 2816 * 2;
constexpr size_t W_IN = W_D + 2 * W_D_SZ, W_IN_SZ = (size_t)NHIN * 1024 * 2;
constexpr size_t W_G = W_IN + W_IN_SZ, W_G_SZ = (size_t)4096 * 1024 * 2;
constexpr size_t W_BR = W_G + W_G_SZ;
constexpr size_t W_OUT = W_BR + W_G_SZ, W_OUT_SZ = (size_t)1024 * 1024 * 2;
constexpr size_t W_MLA = W_OUT + W_OUT_SZ, W_MLA_SZ = (size_t)1024 * 384 * 2;
constexpr size_t W_LAYER = W_MLA + W_MLA_SZ;
static_assert(WS_W + 2 * W_LAYER <= 124 * MiB, "weights");
constexpr size_t ROWBUF = (size_t)R * 1024 * 2;
constexpr size_t WS_U = 124 * MiB;
constexpr size_t WS_Y = WS_U + ROWBUF;
constexpr size_t WS_BIG = WS_Y + ROWBUF;
constexpr size_t WS_OUTS = WS_BIG + (size_t)R * NHIN * 2;
constexpr size_t WS_VT = WS_OUTS + ROWBUF;
constexpr size_t WS_GSCR = WS_VT + (size_t)NB * 768 * RPB * 2;
constexpr size_t WS_END = WS_GSCR + 256 * 131072;
static_assert(WS_END <= 1024 * MiB, "ws");
static_assert(WS_BIG + (size_t)R * DFF * 2 <= WS_END, "H");

constexpr int LDS_BYTES = 147456;
constexpr size_t WS_BAR = 1 * MiB;
constexpr int LDS_BARST = 147456 - 64;

__device__ __forceinline__ unsigned f2bf(float f) { unsigned u = __builtin_bit_cast(unsigned, f); return (u + 0x7fffu + ((u >> 16) & 1u)) >> 16; }
__device__ __forceinline__ unsigned pk2(float lo, float hi) { return f2bf(lo) | (f2bf(hi) << 16); }
__device__ __forceinline__ float bf2f(unsigned short h) { return __builtin_bit_cast(float, (unsigned)h << 16); }
__device__ __forceinline__ float bflo(unsigned w) { return __builtin_bit_cast(float, w << 16); }
__device__ __forceinline__ float bfhi(unsigned w) { return __builtin_bit_cast(float, w & 0xffff0000u); }
__device__ __forceinline__ float wave_sum(float v) {
#pragma unroll
    for (int o = 1; o < 64; o <<= 1) v += __shfl_xor(v, o);
    return v;
}
__device__ __forceinline__ int ptid() { int t = threadIdx.x; asm volatile("" : "+v"(t)); return t; }
__device__ __forceinline__ float fexp2(float x) { return __builtin_amdgcn_exp2f(x); }
__device__ __forceinline__ float frcp(float x) { return __builtin_amdgcn_rcpf(x); }
__device__ __forceinline__ float sigmoidf_(float x) { return frcp(1.f + fexp2(-x * LOG2E)); }

namespace pg8 {
constexpr int BM = 256, BK = 64, HALF = 128, HTB = HALF * BK * 2, STAGE_BYTES = 8 * HTB, NXCD = 8, WGM = 8;
__device__ __forceinline__ int lds_byte(int r, int c) { const int st = (r >> 4) * 2 + (c >> 5), rr = r & 15, cc = c & 31, ob = rr * 64 + cc * 2; return st * 1024 + (ob ^ (((ob >> 9) & 1) << 5)); }
__device__ __forceinline__ void stage_rc(int b, int& Rr, int& C) { const int st = b / 1024, sb = b % 1024, swz = sb ^ (((sb >> 9) & 1) << 5); Rr = (st >> 1) * 16 + swz / 64; C = (st & 1) * 32 + (swz % 64) / 2; }
__device__ __forceinline__ int perm32(int rho) { const int n = rho >> 4, i = rho & 15; return 8 * (i >> 2) + 4 * n + (i & 3); }

struct Unit { int pm, pn, kind; };
struct Gemm { const bf16_t* A; const bf16_t* Bt; const bf16_t* A2; const bf16_t* Bt2; int lda, ldb, K; };

struct StaticOrder {
    int nM, nN, nwg, G, c, dual;
    __device__ void init(int M, int N, int G_, int c_, int dual_) { nM = M / BM; nN = N / BM; nwg = nM * nN; G = G_; c = c_; dual = dual_; }
    __device__ bool next(int i, Unit& u) const {
        const int ii = i;
        const long L = (long)ii * G + c; if (L >= nwg) return false;
        int wgid = (int)L; { const int q = nwg / NXCD, r = nwg % NXCD, xcd = wgid % NXCD, off = wgid / NXCD; wgid = (xcd < r ? xcd * (q + 1) : r * (q + 1) + (xcd - r) * q) + off; }
        const int nig = WGM * nN, gid = wgid / nig, fm = gid * WGM, gsz = (nM - fm) < WGM ? (nM - fm) : WGM;
        u.pm = fm + ((wgid % nig) % gsz); u.pn = (wgid % nig) / gsz;
        if (dual) u.pm = (u.pm >> 5) * 33 + 1 + (u.pm & 31);
        u.kind = 0; return true;
    }
};

typedef float f32x2_t __attribute__((ext_vector_type(2))); typedef __bf16 bf16x2_t __attribute__((ext_vector_type(2)));
__device__ __forceinline__ unsigned cvt_pk_bf16(float lo, float hi) { f32x2_t v = {lo, hi}; bf16x2_t b = __builtin_convertvector(v, bf16x2_t); return __builtin_bit_cast(unsigned, b); }

struct Epi {
    int mode; bf16_t* O; int ldc; u32x4* scr;
    __device__ __forceinline__ void operator()(const f32x4 (&acc)[2][2][4][2], const Unit& u, int wr, int wc, int fr, int fq) const {
        const int row0 = u.pm * BM + wr * 64 + fr;
        if (mode == 0) {
            const int col0 = u.pn * BM + wc * 32 + 8 * fq;
#pragma unroll
            for (int ai = 0; ai < 2; ++ai)
#pragma unroll
                for (int m = 0; m < 4; ++m) { bf16_t* rowp = O + (size_t)(row0 + ai * HALF + m * 16) * ldc + col0;
#pragma unroll
                    for (int bj = 0; bj < 2; ++bj) { const f32x4 v0 = acc[ai][bj][m][0], v1 = acc[ai][bj][m][1];
                        u32x4 w; w.x = cvt_pk_bf16(v0[0], v0[1]); w.y = cvt_pk_bf16(v0[2], v0[3]); w.z = cvt_pk_bf16(v1[0], v1[1]); w.w = cvt_pk_bf16(v1[2], v1[3]);
                        *(u32x4*)(rowp + bj * HALF) = w; } }
        } else if (mode == 1) {
            const int col0 = u.pn * HALF + wc * 32 + 8 * fq;
#pragma unroll
            for (int ai = 0; ai < 2; ++ai)
#pragma unroll
                for (int m = 0; m < 4; ++m) { bf16_t* rowp = O + (size_t)(row0 + ai * HALF + m * 16) * ldc + col0;
                    float h[8];
#pragma unroll
                    for (int n = 0; n < 2; ++n)
#pragma unroll
                        for (int e = 0; e < 4; ++e) { const float g = acc[ai][0][m][n][e], up = acc[ai][1][m][n][e]; h[n * 4 + e] = g * sigmoidf_(g) * up; }
                    u32x4 w; w.x = cvt_pk_bf16(h[0], h[1]); w.y = cvt_pk_bf16(h[2], h[3]); w.z = cvt_pk_bf16(h[4], h[5]); w.w = cvt_pk_bf16(h[6], h[7]);
                    *(u32x4*)rowp = w; }
        } else if (mode == 3) {
            const int col0 = u.pn * BM + wc * 32 + 8 * fq;
#pragma unroll
            for (int ai = 0; ai < 2; ++ai)
#pragma unroll
                for (int m = 0; m < 4; ++m) { bf16_t* rowp = O + (size_t)(row0 + ai * HALF + m * 16) * ldc + col0;
#pragma unroll
                    for (int bj = 0; bj < 2; ++bj) { const f32x4 v0 = acc[ai][bj][m][0], v1 = acc[ai][bj][m][1];
                        u32x4 w; w.x = cvt_pk_bf16(sigmoidf_(v0[0]), sigmoidf_(v0[1])); w.y = cvt_pk_bf16(sigmoidf_(v0[2]), sigmoidf_(v0[3]));
                        w.z = cvt_pk_bf16(sigmoidf_(v1[0]), sigmoidf_(v1[1])); w.w = cvt_pk_bf16(sigmoidf_(v1[2]), sigmoidf_(v1[3]));
                        *(u32x4*)(rowp + bj * HALF) = w; } }
        } else {
            const int col0 = u.pn * BM + wc * 32 + 8 * fq;
#pragma unroll
            for (int ai = 0; ai < 2; ++ai)
#pragma unroll
                for (int m = 0; m < 4; ++m) { const size_t r = (size_t)(row0 + ai * HALF + m * 16);
                    const bf16_t* gp = (const bf16_t*)scr + r * 4096 + 3 * 1024 + col0; bf16_t* rowp = O + r * ldc + col0;
#pragma unroll
                    for (int bj = 0; bj < 2; ++bj) { const u32x4 g = *(const u32x4*)(gp + bj * HALF); const f32x4 v0 = acc[ai][bj][m][0], v1 = acc[ai][bj][m][1];
                        u32x4 w; w.x = cvt_pk_bf16(v0[0] * gclamp(bflo(g.x)), v0[1] * gclamp(bfhi(g.x))); w.y = cvt_pk_bf16(v0[2] * gclamp(bflo(g.y)), v0[3] * gclamp(bfhi(g.y)));
                        w.z = cvt_pk_bf16(v1[0] * gclamp(bflo(g.z)), v1[1] * gclamp(bfhi(g.z))); w.w = cvt_pk_bf16(v1[2] * gclamp(bflo(g.w)), v1[3] * gclamp(bfhi(g.w)));
                        *(u32x4*)(rowp + bj * HALF) = w; } }
        }
    }
    static __device__ __forceinline__ float gclamp(float g) { return __builtin_fmaxf(g, 1e-6f); }
    __device__ __forceinline__ void rescale(f32x4 (&acc)[2][2][4][2], const Unit& u, int i, int wr, int wc, int fr, int fq) const {
        int row0 = u.pm * BM + wr * 64 + fr; const int col0 = u.pn * BM + wc * 32 + 8 * fq;
        asm volatile("" : "+v"(row0));
#pragma unroll
        for (int ai = 0; ai < 2; ++ai)
#pragma unroll
            for (int m = 0; m < 4; ++m) { const bf16_t* gp = (const bf16_t*)scr + (size_t)(row0 + ai * HALF + m * 16) * 4096 + i * 1024 + col0;
#pragma unroll
                for (int bj = 0; bj < 2; ++bj) { const u32x4 ga = *(const u32x4*)(gp + bj * HALF), gb = *(const u32x4*)(gp + 1024 + bj * HALF);
                    f32x4 r0, r1;
                    r0[0] = gclamp(bflo(ga.x)) * frcp(gclamp(bflo(gb.x))); r0[1] = gclamp(bfhi(ga.x)) * frcp(gclamp(bfhi(gb.x)));
                    r0[2] = gclamp(bflo(ga.y)) * frcp(gclamp(bflo(gb.y))); r0[3] = gclamp(bfhi(ga.y)) * frcp(gclamp(bfhi(gb.y)));
                    r1[0] = gclamp(bflo(ga.z)) * frcp(gclamp(bflo(gb.z))); r1[1] = gclamp(bfhi(ga.z)) * frcp(gclamp(bfhi(gb.z)));
                    r1[2] = gclamp(bflo(ga.w)) * frcp(gclamp(bflo(gb.w))); r1[3] = gclamp(bfhi(ga.w)) * frcp(gclamp(bfhi(gb.w)));
                    acc[ai][bj][m][0] = acc[ai][bj][m][0] * r0; acc[ai][bj][m][1] = acc[ai][bj][m][1] * r1; }
                if (m == 3) asm volatile("" ::: "memory"); }
    }
};

template <bool HOOK, class Sched>
__device__ __forceinline__ void gemm_phase(LAS unsigned char* lds, const Gemm g, const Sched& S, const Epi& E) {
    const int tid = ptid(), wid = __builtin_amdgcn_readfirstlane(tid >> 6), lane = tid & 63, wr = wid >> 2, wc = wid & 3, fr = lane & 15, fq = lane >> 4;
    const int K = g.K, nt = K / BK;
    unsigned voffA[2], voffB[2];
#pragma unroll
    for (int i = 0; i < 2; ++i) { int Rr, C; stage_rc(tid * 16 + i * 8192, Rr, C); const int Rb = (Rr & ~31) + perm32(Rr & 31);
        voffA[i] = (unsigned)(Rr * g.lda + C) * 2u; voffB[i] = (unsigned)(Rb * g.ldb + C) * 2u; }
    const size_t kstep = (size_t)(BK * 2);
    const size_t hsA = (size_t)HALF * g.lda * 2, hsB = (size_t)HALF * g.ldb * 2;
    const size_t tsA = 2 * hsA, tsB = 2 * hsB;
    const unsigned ldsw = (unsigned)wid * 1024u;
    const int aoff = lds_byte(wr * 64 + fr, fq * 8), boff = lds_byte(wc * 32 + fr, fq * 8);
#define PG8_SA(b, h) (((b) * 2 + (h)) * HTB)
#define PG8_SB(b, h) ((4 + (b) * 2 + (h)) * HTB)
#define PG8_STAGE(bufoff, gbase, voff) do { _Pragma("unroll") for (int _i = 0; _i < 2; ++_i) \
        __builtin_amdgcn_global_load_lds((const unsigned*)((const char*)(gbase) + (voff)[_i]), (LAS unsigned*)(lds + (bufoff) + ldsw + _i * 8192), 16, 0, 0); } while (0)
#define PG8_LDA(dst, b, h) do { _Pragma("unroll") for (int m = 0; m < 4; ++m) _Pragma("unroll") for (int k = 0; k < 2; ++k) dst[m][k] = *(const LAS bf16x8*)(lds + PG8_SA(b, h) + aoff + m * 2048 + k * 1024); } while (0)
#define PG8_LDB(dst, b, h) do { _Pragma("unroll") for (int n = 0; n < 2; ++n) _Pragma("unroll") for (int k = 0; k < 2; ++k) dst[n][k] = *(const LAS bf16x8*)(lds + PG8_SB(b, h) + boff + n * 2048 + k * 1024); } while (0)
#define PG8_MMA(ai, bj, At, Bt) do { __builtin_amdgcn_s_setprio(1); _Pragma("unroll") for (int m = 0; m < 4; ++m) _Pragma("unroll") for (int n = 0; n < 2; ++n) _Pragma("unroll") for (int k = 0; k < 2; ++k) \
        acc[ai][bj][m][n] = __builtin_amdgcn_mfma_f32_16x16x32_bf16(Bt[n][k], At[m][k], acc[ai][bj][m][n], 0, 0, 0); __builtin_amdgcn_s_setprio(0); } while (0)
#define PG8_MMA1(ai, bj, nn, At, Bt) do { __builtin_amdgcn_s_setprio(1); _Pragma("unroll") for (int m = 0; m < 4; ++m) _Pragma("unroll") for (int k = 0; k < 2; ++k) \
        acc[ai][bj][m][nn] = __builtin_amdgcn_mfma_f32_16x16x32_bf16(Bt[nn][k], At[m][k], acc[ai][bj][m][nn], 0, 0, 0); __builtin_amdgcn_s_setprio(0); } while (0)
#define PG8_MMAZ(ai, At) do { if (zbr == 0) PG8_MMA1(ai, 0, 0, At, B0); else if (zbr == 1) PG8_MMA1(ai, 0, 1, At, B0); else if (zbr == 2) PG8_MMA1(ai, 1, 0, At, B1); else PG8_MMA1(ai, 1, 1, At, B1); } while (0)
#define PG8_MM2(ai, At) do { PG8_MMA(ai, 0, At, B0); PG8_MMA(ai, 1, At, B1); } while (0)
#define PG8_WAIT_V(n) asm volatile("s_waitcnt vmcnt(" #n ")" ::: "memory")
#define PG8_WAIT_L(n) asm volatile("s_waitcnt lgkmcnt(" #n ")" ::: "memory")
#define PG8_BAR __builtin_amdgcn_s_barrier()
#define PG8_SCHED __builtin_amdgcn_sched_barrier(0)
#define PG8_UA(u) ((const char*)((u).kind ? g.A2 : g.A) + (size_t)(u).pm * tsA)
#define PG8_UB(u) ((const char*)((u).kind ? g.Bt2 : g.Bt) + (size_t)(u).pn * tsB)
    Unit cur, nxt; int ui = 0;
    if (!S.next(0, cur)) return;
    f32x4 acc[2][2][4][2];
#pragma unroll
    for (int a = 0; a < 2; ++a)
#pragma unroll
        for (int b = 0; b < 2; ++b)
#pragma unroll
            for (int m = 0; m < 4; ++m)
#pragma unroll
                for (int n = 0; n < 2; ++n) acc[a][b][m][n] = (f32x4){0.f, 0.f, 0.f, 0.f};
    bf16x8 At[4][2], B0[2][2], B1[2][2];
    const char* cA = PG8_UA(cur); const char* cB = PG8_UB(cur);
    {
        PG8_STAGE(PG8_SB(0, 0), cB, voffB); PG8_STAGE(PG8_SB(0, 1), cB + hsB, voffB); PG8_STAGE(PG8_SA(0, 0), cA, voffA); PG8_STAGE(PG8_SA(0, 1), cA + hsA, voffA);
        if (wr == 1) PG8_BAR;
        PG8_WAIT_V(2); PG8_BAR;
        PG8_STAGE(PG8_SB(1, 0), cB + kstep, voffB); PG8_STAGE(PG8_SA(1, 0), cA + kstep, voffA); PG8_STAGE(PG8_SB(1, 1), cB + hsB + kstep, voffB);
        PG8_WAIT_V(6); PG8_BAR;
    }
    for (;;) {
        const bool has_next = S.next(ui + 1, nxt);
        const char* nA = has_next ? PG8_UA(nxt) : cA; const char* nB = has_next ? PG8_UB(nxt) : cB;
        for (int t = 0; t < nt; t += 2) {
            const bool last = (t == nt - 2);
            if constexpr (HOOK) { if (t == 4 || t == 8 || t == 12) { PG8_SCHED; E.rescale(acc, cur, (t >> 2) - 1, wr, wc, fr, fq); PG8_SCHED; } }
            const char* a1 = cA + (size_t)(t + 1) * kstep;
            const char* a2 = last ? nA : cA + (size_t)(t + 2) * kstep; const char* b2 = last ? nB : cB + (size_t)(t + 2) * kstep;
            const char* a3 = a2 + kstep; const char* b3 = b2 + kstep;
            PG8_LDB(B0, 0, 0); PG8_LDB(B1, 0, 1); PG8_SCHED; PG8_LDA(At, 0, 0); PG8_STAGE(PG8_SA(1, 1), a1 + hsA, voffA);
            PG8_WAIT_V(8); PG8_WAIT_L(0); PG8_BAR; PG8_MM2(0, At); PG8_BAR; PG8_SCHED;
            PG8_LDA(At, 0, 1); PG8_STAGE(PG8_SB(0, 0), b2, voffB); PG8_STAGE(PG8_SB(0, 1), b2 + hsB, voffB); PG8_STAGE(PG8_SA(0, 0), a2, voffA);
            PG8_WAIT_V(8); PG8_WAIT_L(0); PG8_BAR; PG8_MM2(1, At); PG8_BAR; PG8_SCHED;
            PG8_LDB(B0, 1, 0); PG8_LDB(B1, 1, 1); PG8_SCHED; PG8_LDA(At, 1, 0); PG8_STAGE(PG8_SA(0, 1), a2 + hsA, voffA);
            PG8_WAIT_V(8); PG8_WAIT_L(0); PG8_BAR; PG8_MM2(0, At); PG8_BAR; PG8_SCHED;
            PG8_LDA(At, 1, 1); PG8_STAGE(PG8_SB(1, 0), b3, voffB); PG8_STAGE(PG8_SB(1, 1), b3 + hsB, voffB); PG8_STAGE(PG8_SA(1, 0), a3, voffA);
            PG8_WAIT_V(8); PG8_WAIT_L(0); PG8_BAR; PG8_MM2(1, At); PG8_BAR; PG8_SCHED;
        }
        if (wr == 0) PG8_BAR;
        E(acc, cur, wr, wc, fr, fq);
        if (!has_next) break;
#pragma unroll
        for (int a = 0; a < 2; ++a)
#pragma unroll
            for (int b = 0; b < 2; ++b)
#pragma unroll
                for (int m = 0; m < 4; ++m)
#pragma unroll
                    for (int n = 0; n < 2; ++n) acc[a][b][m][n] = (f32x4){0.f, 0.f, 0.f, 0.f};
        cur = nxt; cA = nA; cB = nB; ++ui;
        if (wr == 1) PG8_BAR;
    }
    PG8_WAIT_V(0);
    PG8_BAR;
#undef PG8_SA
#undef PG8_SB
#undef PG8_STAGE
#undef PG8_LDA
#undef PG8_LDB
#undef PG8_MMA
#undef PG8_MMA1
#undef PG8_MMAZ
#undef PG8_MM2
#undef PG8_WAIT_V
#undef PG8_WAIT_L
#undef PG8_BAR
#undef PG8_SCHED
#undef PG8_UA
#undef PG8_UB
}
}

struct Args {
    const float* x; const float* c; const float* ctx; const float* c_ctx; const float* w_mod; const float* b_mod; const float* g_pre; const float* g_post;
    const float* w_gate; const float* w_up; const float* w_down; const float* w_in; const float* gqa_qn; const float* gqa_kn; const float* mla_qn; const float* mla_kvn;
    const float* w_uq; const float* w_ukv; const float* dlam; const float* dsub; const float* sink; const float* w_branch; const float* w_out;
    float* out; unsigned char* ws; int ph_lo, ph_hi;
};
typedef const __attribute__((address_space(4))) Args CArgs;

template <class F>
__device__ __forceinline__ void conv_item(bf16_t* WT, int K, int nblk, int item, LAS float* scr, int lane, const F& f) {
    const int kb = item / nblk, nb = item % nblk, k0 = 64 * kb, n0 = 32 * nb;
#pragma unroll 8
    for (int i = 0; i < 32; ++i) { const int kk = 2 * i + (lane >> 5); scr[kk * 33 + (lane & 31)] = f(n0 + (lane & 31), k0 + kk); }
    asm volatile("s_waitcnt lgkmcnt(0)" ::: "memory");
    const int c = lane & 7;
#pragma unroll
    for (int j = 0; j < 4; ++j) { const int n = (lane >> 3) + 8 * j; const LAS float* s = scr + (8 * c) * 33 + n;
        u32x4 o; o.x = pk2(s[0 * 33], s[1 * 33]); o.y = pk2(s[2 * 33], s[3 * 33]); o.z = pk2(s[4 * 33], s[5 * 33]); o.w = pk2(s[6 * 33], s[7 * 33]);
        *(u32x4*)(WT + (size_t)(n0 + n) * K + k0 + 8 * c) = o; }
    asm volatile("s_waitcnt lgkmcnt(0)" ::: "memory");
}

__device__ __forceinline__ void p0_phase(CArgs& a, LAS unsigned char* lds) {
    const int tid = ptid(), lane = tid & 63, wave = tid >> 6;
    float* MOD = (float*)(a.ws + WS_MOD);
    {
        LAS float* sl = (LAS float*)lds;
        LAS float* red = (LAS float*)(lds + 40960);
        for (int i = tid; i < 9 * 1024; i += 512) { const int r = i >> 10, k = i & 1023; const float v = r < 8 ? a.c[r * 1024 + k] : a.c_ctx[k]; sl[i] = v * sigmoidf_(v); }
        __syncthreads();
        for (int it = blockIdx.x; it < 2 * 144; it += gridDim.x) {
            const int l = it / 144, n0 = (it % 144) * 64;
            const float* W = a.w_mod + (size_t)l * 1024 * MODW + n0 + lane;
            float acc[9];
#pragma unroll
            for (int r = 0; r < 9; ++r) acc[r] = 0.f;
#pragma unroll 8
            for (int kk = 0; kk < 128; ++kk) { const int k = wave * 128 + kk; const float wv = W[(size_t)k * MODW];
#pragma unroll
                for (int r = 0; r < 9; ++r) acc[r] += sl[r * 1024 + k] * wv; }
#pragma unroll
            for (int r = 0; r < 9; ++r) red[(wave * 9 + r) * 64 + lane] = acc[r];
            __syncthreads();
            for (int i = tid; i < 9 * 64; i += 512) { const int r = i >> 6, cidx = i & 63; float s = a.b_mod[l * MODW + n0 + cidx];
#pragma unroll
                for (int w = 0; w < 8; ++w) s += red[(w * 9 + r) * 64 + cidx];
                MOD[((size_t)l * 9 + r) * MODW + n0 + cidx] = s; }
            __syncthreads();
        }
        __syncthreads();
    }
    LAS float* scr = (LAS float*)(lds + wave * 8448);
    const int gw = blockIdx.x * 8 + wave, NGW = gridDim.x * 8;
    constexpr int I_GU = 176 * 16, I_D = 32 * 44, I_IN = 72 * 16, I_G = 128 * 16, I_BR = 32 * 16, I_OUT = 32 * 16, I_MLA = 32 * 6;
    constexpr int I_LAYER = 2 * I_GU + 2 * I_D + I_IN + I_G + I_BR + I_OUT + I_MLA;
    for (int it = gw; it < 2 * I_LAYER; it += NGW) {
        const int l = it / I_LAYER; int r = it % I_LAYER;
        unsigned char* wb = a.ws + WS_W + (size_t)l * W_LAYER;
        if (r < 2 * I_GU) { const int s = r / I_GU; r %= I_GU;
            const float* wg = a.w_gate + (size_t)(l * 2 + s) * 1024 * DFF; const float* wu = a.w_up + (size_t)(l * 2 + s) * 1024 * DFF;
            conv_item((bf16_t*)(wb + W_GU + s * W_GU_SZ), 1024, 176, r, scr, lane, [=](int n, int k) { const int j = (n >> 8) * 128 + (n & 127); return ((n >> 7) & 1) ? wu[(size_t)k * DFF + j] : wg[(size_t)k * DFF + j]; });
            continue; }
        r -= 2 * I_GU;
        if (r < 2 * I_D) { const int s = r / I_D; r %= I_D;
            const float* wd = a.w_down + (size_t)(l * 2 + s) * DFF * 1024;
            conv_item((bf16_t*)(wb + W_D + s * W_D_SZ), DFF, 32, r, scr, lane, [=](int n, int k) { return wd[(size_t)k * 1024 + n]; });
            continue; }
        r -= 2 * I_D;
        const float* win = a.w_in + (size_t)l * 1024 * INCOLS;
        if (r < I_IN) { conv_item((bf16_t*)(wb + W_IN), 1024, 72, r, scr, lane, [=](int n, int k) { return n < GATE0 ? win[(size_t)k * INCOLS + n] : 0.f; }); continue; }
        r -= I_IN;
        if (r < I_G) { conv_item((bf16_t*)(wb + W_G), 1024, 128, r, scr, lane, [=](int n, int k) { return win[(size_t)k * INCOLS + GATE0 + n]; }); continue; }
        r -= I_G;
        if (r < I_BR) { const float* wbr = a.w_branch + (size_t)l * 4 * 256 * 1024;
            conv_item((bf16_t*)(wb + W_BR), 1024, 32, r, scr, lane, [=](int n, int k) { return wbr[(size_t)k * 1024 + n]; }); continue; }
        r -= I_BR;
        if (r < I_OUT) { const float* wo = a.w_out + (size_t)l * 1024 * 1024;
            conv_item((bf16_t*)(wb + W_OUT), 1024, 32, r, scr, lane, [=](int n, int k) { return wo[(size_t)k * 1024 + n]; }); continue; }
        r -= I_OUT;
        { const float* uq = a.w_uq + (size_t)l * 256 * 384; const float* ukv = a.w_ukv + (size_t)l * 128 * 512; const float* gq = a.mla_qn + l * 256; const float* gkv = a.mla_kvn + l * 128;
            conv_item((bf16_t*)(wb + W_MLA), 384, 32, r, scr, lane, [=](int n, int k) {
                float v = 0.f;
                if (n < 384) { if (k < 256) v = gq[k] * uq[(size_t)k * 384 + n]; }
                else if (n < 896) { if (k >= 256) v = gkv[k - 256] * ukv[(size_t)(k - 256) * 512 + (n - 384)]; }
                return v; }); }
    }
}

__device__ __forceinline__ void row_phase(CArgs& a, int l, bool first, const bf16_t* Y, int sub_y, float gscale, bf16_t* U, int sub_u, int l_u) {
    const int tid_ = ptid(); const int lane = tid_ & 63, wave = tid_ >> 6;
    const int gw = blockIdx.x * 8 + wave, NGW = gridDim.x * 8;
    const float* MOD = (const float*)(a.ws + WS_MOD);
    float* XC = (float*)(a.ws + WS_XC);
#pragma unroll 2
    for (int row = gw; row < R; row += NGW) {
        const int b = row / RPB, t = row % RPB; const bool isctx = t < CTX;
        const float* xs; float* xd;
        if (isctx) { const size_t o = (size_t)(b * CTX + t) * DM; xs = (first ? a.ctx : XC) + o; xd = XC + o; }
        else { const size_t o = (size_t)(b * SEQ + (t - CTX)) * DM; xs = (first ? a.x : a.out) + o; xd = a.out + o; }
        const int mrow = isctx ? 8 : b;
        f32x4 v[4];
#pragma unroll
        for (int j = 0; j < 4; ++j) v[j] = __builtin_nontemporal_load((const f32x4*)(xs + 4 * lane + 256 * j));
        if (Y) {
            const float* md = MOD + ((size_t)l * 9 + mrow) * MODW + (sub_y * 3 + 2) * 1024;
            const float* gp = a.g_post + (l * 3 + sub_y) * 1024;
            f32x4 y[4]; float ss = 0.f;
#pragma unroll
            for (int j = 0; j < 4; ++j) { const u32x2 w = __builtin_nontemporal_load((const u32x2*)(Y + (size_t)row * DM + 4 * lane + 256 * j));
                y[j] = (f32x4){bflo(w.x), bfhi(w.x), bflo(w.y), bfhi(w.y)}; ss += (y[j].x * y[j].x + y[j].y * y[j].y) + (y[j].z * y[j].z + y[j].w * y[j].w); }
            const float rs = __builtin_amdgcn_rsqf(wave_sum(ss) * (1.f / DM) + EPS) * gscale;
#pragma unroll
            for (int j = 0; j < 4; ++j) { const f32x4 g = *(const f32x4*)(md + 4 * lane + 256 * j), p = *(const f32x4*)(gp + 4 * lane + 256 * j);
                v[j] = v[j] + (y[j] * rs) * p * g; __builtin_nontemporal_store(v[j], (f32x4*)(xd + 4 * lane + 256 * j)); }
        }
        if (U) {
            const float* md = MOD + ((size_t)l_u * 9 + mrow) * MODW + (sub_u * 3) * 1024;
            const float* gp = a.g_pre + (l_u * 3 + sub_u) * 1024;
            float ss = 0.f;
#pragma unroll
            for (int j = 0; j < 4; ++j) ss += (v[j].x * v[j].x + v[j].y * v[j].y) + (v[j].z * v[j].z + v[j].w * v[j].w);
            const float rs = __builtin_amdgcn_rsqf(wave_sum(ss) * (1.f / DM) + EPS);
#pragma unroll
            for (int j = 0; j < 4; ++j) { const f32x4 sh = *(const f32x4*)(md + 4 * lane + 256 * j), sc = *(const f32x4*)(md + 1024 + 4 * lane + 256 * j), p = *(const f32x4*)(gp + 4 * lane + 256 * j);
                const f32x4 u = (v[j] * rs) * p * (sc + 1.f) + sh;
                u32x2 w; w.x = pk2(u.x, u.y); w.y = pk2(u.z, u.w);
                *(u32x2*)(U + (size_t)row * DM + 4 * lane + 256 * j) = w; }
        }
    }
}

constexpr int VSTR = 136;
constexpr int TAB_OFF = 768 * VSTR;
__device__ __forceinline__ void rope64p(float& v0, float& v1, int l, bool lat, const LAS float* tab, int prow, int pcol) {
    const float p0 = __shfl_xor(v0, 8), p1 = __shfl_xor(v1, 8);
    const int lh = l & 31, pos = (lh & 16) ? pcol : prow, i0 = (2 * lh) & 15;
    const f32x4 cs = *(const LAS f32x4*)(tab + (pos * 16 + i0) * 2);
    const bool sec = (lh >> 3) & 1;
    const float c0 = lat ? cs[0] : 1.f, s0 = lat ? (sec ? cs[1] : -cs[1]) : 0.f, c1 = lat ? cs[2] : 1.f, s1 = lat ? (sec ? cs[3] : -cs[3]) : 0.f;
    v0 = v0 * c0 + p0 * s0; v1 = v1 * c1 + p1 * s1;
}
__device__ __forceinline__ void rope32p(float& v0, float& v1, int d0, bool lat, const LAS float* tab, int prow, int pcol) {
    const float p0 = __shfl_xor(v0, 4), p1 = __shfl_xor(v1, 4);
    const int pos = (d0 & 16) ? pcol : prow, i0 = d0 & 7;
    const LAS float* t = tab + (pos * 16 + 2 * i0) * 2;
    const bool sec = (d0 >> 3) & 1;
    const float c0 = lat ? t[0] : 1.f, s0 = lat ? (sec ? t[1] : -t[1]) : 0.f, c1 = lat ? t[4] : 1.f, s1 = lat ? (sec ? t[5] : -t[5]) : 0.f;
    v0 = v0 * c0 + p0 * s0; v1 = v1 * c1 + p1 * s1;
}
__device__ __forceinline__ float half_sum(float v) {
#pragma unroll
    for (int o = 1; o < 32; o <<= 1) v += __shfl_xor(v, o);
    return v;
}
__device__ __forceinline__ void prep_phase(CArgs& a, int l, LAS unsigned char* lds) {
    const int tid = ptid(), lane = tid & 63, wave = __builtin_amdgcn_readfirstlane(tid >> 6);
    bf16_t* HIN = (bf16_t*)(a.ws + WS_BIG); bf16_t* MUP = (bf16_t*)(a.ws + WS_Y); bf16_t* VT = (bf16_t*)(a.ws + WS_VT);
    LAS float* tab = (LAS float*)(lds + TAB_OFF);
    for (int i = tid; i < 128 * 16; i += 512) { const int pos = i >> 4, f = i & 15;
        const float invf = fexp2(-(float)(2 * f) * (1.f / 32.f) * 13.287712379549449f);
        float rev = (float)pos * invf * 0.15915494309189535f; rev -= __builtin_floorf(rev);
        tab[i * 2] = __builtin_amdgcn_cosf(rev); tab[i * 2 + 1] = __builtin_amdgcn_sinf(rev); }
    __syncthreads();
    const int lh = lane & 31;
    const float gq0 = a.gqa_qn[l * 64 + 2 * lh], gq1 = a.gqa_qn[l * 64 + 2 * lh + 1], gk0 = a.gqa_kn[l * 64 + 2 * lh], gk1 = a.gqa_kn[l * 64 + 2 * lh + 1];
#define LD2(p, v0, v1) do { const unsigned w_ = *(const unsigned*)(p); v0 = bflo(w_); v1 = bfhi(w_); } while (0)
#define ST2(p, v0, v1) do { *(unsigned*)(p) = pg8::cvt_pk_bf16(v0, v1); } while (0)
    for (int tile = blockIdx.x; tile < R / 64; tile += gridDim.x) {
        const int row0 = tile * 64, b = row0 / RPB, t0 = row0 % RPB;
#pragma unroll 4
        for (int rr = 0; rr < 8; ++rr) {
            const int tk = wave * 8 + rr, row = row0 + tk, t = t0 + tk; const bool lat = t >= CTX;
            const int tl = lat ? t - CTX : 0, prow = tl >> 6, pcol = tl & 63;
            bf16_t* __restrict__ h = HIN + (size_t)row * NHIN; bf16_t* __restrict__ mu = MUP + (size_t)row * 1024;
            LAS bf16_t* vst = (LAS bf16_t*)lds + tk;
#pragma unroll
            for (int j = 0; j < 3; ++j) { float v0, v1; LD2(h + 128 * j + 2 * lane, v0, v1);
                const float rs = __builtin_amdgcn_rsqf(half_sum(v0 * v0 + v1 * v1) * (1.f / 64.f) + EPS);
                v0 = v0 * rs * (j < 2 ? gq0 : gk0); v1 = v1 * rs * (j < 2 ? gq1 : gk1);
                rope64p(v0, v1, lane, lat, tab, prow, pcol);
                if (j < 2) { v0 *= QS_GQA; v1 *= QS_GQA; }
                ST2(h + 128 * j + 2 * lane, v0, v1); }
            { const unsigned w = *(const unsigned*)(h + 384 + 2 * lane); vst[(0 + 2 * lane) * (VSTR / 2)] = (bf16_t)(w & 0xffffu); vst[(0 + 2 * lane + 1) * (VSTR / 2)] = (bf16_t)(w >> 16); }
            float sq = 0.f, skv = 0.f;
#pragma unroll
            for (int j = 0; j < 2; ++j) { float v0, v1; LD2(h + 512 + 128 * j + 2 * lane, v0, v1); sq += v0 * v0 + v1 * v1; }
            { float v0, v1; LD2(h + 768 + 2 * lane, v0, v1); skv = v0 * v0 + v1 * v1; }
            const float rq = __builtin_amdgcn_rsqf(wave_sum(sq) * (1.f / 256.f) + EPS) * QS_MLA, rkv = __builtin_amdgcn_rsqf(wave_sum(skv) * (1.f / 128.f) + EPS);
#pragma unroll
            for (int j = 0; j < 3; ++j) { const int c = 128 * j + 2 * lane, e = c % 96; float v0, v1; LD2(mu + c, v0, v1); v0 *= rq; v1 *= rq;
                float r0 = v0, r1 = v1; rope32p(r0, r1, (e - 64) & 30, lat, tab, prow, pcol);
                if (e >= 64) { v0 = r0; v1 = r1; }
                ST2(mu + c, v0, v1); }
#pragma unroll
            for (int hh = 0; hh < 4; ++hh) { const int c = 384 + 128 * hh + 2 * lane; float v0, v1; LD2(mu + c, v0, v1); v0 *= rkv; v1 *= rkv;
                const unsigned w = pg8::cvt_pk_bf16(v0, v1);
                if (lane < 32) *(unsigned*)(mu + c) = w;
                else { vst[(128 + 64 * hh + 2 * (lane - 32)) * (VSTR / 2)] = (bf16_t)(w & 0xffffu); vst[(128 + 64 * hh + 2 * (lane - 32) + 1) * (VSTR / 2)] = (bf16_t)(w >> 16); } }
            { float v0, v1; LD2(h + 896 + 2 * (lane & 15), v0, v1); rope32p(v0, v1, 2 * (lane & 15), lat, tab, prow, pcol); if (lane < 16) ST2(mu + 896 + 2 * lane, v0, v1); }
#pragma unroll
            for (int j = 0; j < 4; ++j) { float v0, v1; LD2(h + 928 + 128 * j + 2 * lane, v0, v1); rope32p(v0, v1, (2 * lane) & 31, lat, tab, prow, pcol);
                if (j < 2) { v0 *= QS_DIFF; v1 *= QS_DIFF; }
                ST2(h + 928 + 128 * j + 2 * lane, v0, v1); }
#pragma unroll
            for (int j = 0; j < 2; ++j) { const unsigned w = *(const unsigned*)(h + 1440 + 128 * j + 2 * lane); vst[(384 + 128 * j + 2 * lane) * (VSTR / 2)] = (bf16_t)(w & 0xffffu); vst[(384 + 128 * j + 2 * lane + 1) * (VSTR / 2)] = (bf16_t)(w >> 16); }
#pragma unroll
            for (int j = 0; j < 3; ++j) { float v0, v1; LD2(h + 1696 + 128 * j + 2 * lane, v0, v1); rope64p(v0, v1, lane, lat, tab, prow, pcol);
                if (j < 2) { v0 *= QS_GQA; v1 *= QS_GQA; }
                ST2(h + 1696 + 128 * j + 2 * lane, v0, v1); }
            { const unsigned w = *(const unsigned*)(h + 2080 + 2 * lane); vst[(640 + 2 * lane) * (VSTR / 2)] = (bf16_t)(w & 0xffffu); vst[(640 + 2 * lane + 1) * (VSTR / 2)] = (bf16_t)(w >> 16); }
        }
#undef LD2
#undef ST2
        __syncthreads();
        bf16_t* vt = VT + (size_t)b * 768 * RPB + t0;
        for (int p = tid; p < 768 * 8; p += 512) { const int vr = p >> 3, seg = p & 7;
            const LAS u32x2* s = (const LAS u32x2*)(lds + vr * VSTR + seg * 16); const u32x2 lo = s[0], hi = s[1];
            *(u32x4*)(vt + (size_t)vr * RPB + seg * 8) = (u32x4){lo.x, lo.y, hi.x, hi.y}; }
        __syncthreads();
    }
}

__device__ __forceinline__ int crow(int r, int hi) { return (r & 3) + 8 * (r >> 2) + 4 * hi; }
constexpr int AT_KBUF = 128 * (96 * 2 + 16);
constexpr int AT_VSTR = 264, AT_VBUF = 64 * AT_VSTR;
constexpr int AT_K0 = 0, AT_V0 = 2 * AT_KBUF, AT_WS = AT_V0 + 2 * AT_VBUF;

struct AttnSrc { const bf16_t* Q; int ldq; const bf16_t* K1; int ldk1; const bf16_t* K2; int ldk2; const bf16_t* VT; };

template <int DQK, bool WIN>
__device__ __forceinline__ void attn_pass(const AttnSrc& s, int NT, int lo, int q0lat, float sink_l2, bool has_sink, LAS unsigned char* lds, f32x16 (&o)[2]) {
    constexpr int KSTR = DQK * 2 + 16, NCH = DQK / 8, NKS = DQK / 16, NP = (128 * NCH) / 512;
    const int tid = ptid(), lane = tid & 63, r32 = lane & 31, hi = lane >> 5; const int wid = __builtin_amdgcn_readfirstlane(tid >> 6);
    LAS float* wsf = (LAS float*)(lds + AT_WS) + wid * 32;
    bf16x8 qf[NKS];
    { const bf16_t* qp = s.Q + (size_t)(wid * 32 + r32) * s.ldq + 8 * hi;
#pragma unroll
        for (int ks = 0; ks < NKS; ++ks) qf[ks] = *(const bf16x8*)(qp + 16 * ks); }
    o[0] = (f32x16){}; o[1] = (f32x16){};
    f32x16 negm = (f32x16){}; asm volatile("" : "+v"(negm));
    float mhat = 0.f, lsum = 0.f;
    const int NT2 = NT >> 1, lo2 = lo >> 1;
    u32x4 kr[NP], vr[2];
    auto kaddr = [&](int key, int c) -> const bf16_t* { return (DQK == 96 && c >= 8) ? s.K2 + (size_t)key * s.ldk2 + (c - 8) * 8 : s.K1 + (size_t)key * s.ldk1 + c * 8; };
#define AT_TILE(j) ((j) < 2 ? (j) : lo2 - 2 + (j))
#define AT_GLOAD(j) do { const int key0_ = AT_TILE(j) * 128; \
        _Pragma("unroll") for (int p = 0; p < NP; ++p) { const int idx_ = tid + 512 * p; kr[p] = *(const u32x4*)kaddr(key0_ + idx_ / NCH, idx_ % NCH); } \
        _Pragma("unroll") for (int p = 0; p < 2; ++p) { const int idx_ = tid + 512 * p; vr[p] = *(const u32x4*)(s.VT + (size_t)(idx_ >> 4) * RPB + key0_ + (idx_ & 15) * 8); } } while (0)
#define AT_LSTORE(buf) do { \
        _Pragma("unroll") for (int p = 0; p < NP; ++p) { const int idx_ = tid + 512 * p; *(LAS u32x4*)(lds + AT_K0 + (buf) * AT_KBUF + (idx_ / NCH) * KSTR + (idx_ % NCH) * 16) = kr[p]; } \
        _Pragma("unroll") for (int p = 0; p < 2; ++p) { const int idx_ = tid + 512 * p; LAS u32x2* vd_ = (LAS u32x2*)(lds + AT_V0 + (buf) * AT_VBUF + (idx_ >> 4) * AT_VSTR + (idx_ & 15) * 16); vd_[0] = (u32x2){vr[p].x, vr[p].y}; vd_[1] = (u32x2){vr[p].z, vr[p].w}; } } while (0)
#define MX3(a, b, c) __builtin_fmaxf(__builtin_fmaxf((a), (b)), (c))
    AT_GLOAD(0); AT_LSTORE(0);
    if (NT2 > 1) AT_GLOAD(1);
    __syncthreads();
    for (int j = 0; j < NT2; ++j) {
        const int buf = j & 1;
        f32x16 sA0, sA1, sB0, sB1;
#define AT_QK(S0, S1, sub) do { const LAS unsigned char* kb = lds + AT_K0 + buf * AT_KBUF + ((sub) * 64 + r32) * KSTR + hi * 16; \
        _Pragma("unroll") for (int ks = 0; ks < NKS; ++ks) { \
            const bf16x8 a0 = *(const LAS bf16x8*)(kb + ks * 32), a1 = *(const LAS bf16x8*)(kb + 32 * KSTR + ks * 32); \
            if (ks == 0) { S0 = __builtin_amdgcn_mfma_f32_32x32x16_bf16(a0, qf[0], negm, 0, 0, 0); S1 = __builtin_amdgcn_mfma_f32_32x32x16_bf16(a1, qf[0], negm, 0, 0, 0); } \
            else { S0 = __builtin_amdgcn_mfma_f32_32x32x16_bf16(a0, qf[ks], S0, 0, 0, 0); S1 = __builtin_amdgcn_mfma_f32_32x32x16_bf16(a1, qf[ks], S1, 0, 0, 0); } } } while (0)
#define AT_SOFT(s0, s1, u0, u1, sub, HASNEXT) do { \
        if (WIN && j >= 2) { \
            const int jb = AT_TILE(j) * 128 + (sub) * 64 - CTX + 4 * hi, qi = q0lat + wid * 32 + r32; \
            _Pragma("unroll") for (int r = 0; r < 16; ++r) { const int jj = jb + (r & 3) + 8 * (r >> 2); const int d0 = qi - jj, d1 = qi - (jj + 32); \
                if (d0 > 128 || d0 < -128) s0[r] = -1e30f; if (d1 > 128 || d1 < -128) s1[r] = -1e30f; } } \
        float ra = MX3(s0[0], s0[1], s1[0]), rb = MX3(s0[2], s0[3], s1[1]); ra = MX3(ra, s1[2], s1[3]); \
        _Pragma("unroll") for (int r = 4; r < 16; r += 4) { ra = MX3(ra, s0[r], s0[r + 1]); rb = MX3(rb, s0[r + 2], s0[r + 3]); ra = MX3(ra, s1[r], s1[r + 1]); rb = MX3(rb, s1[r + 2], s1[r + 3]); } \
        float rm = __builtin_fmaxf(ra, rb); rm = __builtin_fmaxf(rm, __shfl_xor(rm, 32)); \
        const bool first = (j == 0) && ((sub) == 0); \
        if (first || __any(rm > 8.f)) { float dl = first ? rm : __builtin_fmaxf(rm, 0.f); asm volatile("" : "+v"(dl));     \
            mhat += dl; \
            _Pragma("unroll") for (int r = 0; r < 16; ++r) { s0[r] -= dl; s1[r] -= dl; } \
            if (HASNEXT) { _Pragma("unroll") for (int r = 0; r < 16; ++r) { u0[r] -= dl; u1[r] -= dl; } }     \
            _Pragma("unroll") for (int r = 0; r < 16; ++r) negm[r] = -mhat; \
            asm volatile("" : "+v"(negm)); \
            if (!first) { const float f = fexp2(-dl); lsum *= f; if (hi == 0) wsf[r32] = f; \
                _Pragma("unroll") for (int r = 0; r < 16; ++r) { const float fr_ = wsf[crow(r, hi)]; o[0][r] *= fr_; o[1][r] *= fr_; } } } \
        _Pragma("unroll") for (int r = 0; r < 16; ++r) { s0[r] = fexp2(s0[r]); s1[r] = fexp2(s1[r]); } \
        { float ps = s0[0];     \
          _Pragma("unroll") for (int r = 1; r < 16; ++r) ps += s0[r]; \
          _Pragma("unroll") for (int r = 0; r < 16; ++r) ps += s1[r]; \
          lsum += ps; } \
        bf16x8 pa[4]; \
        _Pragma("unroll") for (int kk = 0; kk < 2; ++kk) { u32x4 w; \
            w.x = pg8::cvt_pk_bf16(s0[8 * kk + 0], s0[8 * kk + 1]); w.y = pg8::cvt_pk_bf16(s0[8 * kk + 2], s0[8 * kk + 3]); w.z = pg8::cvt_pk_bf16(s0[8 * kk + 4], s0[8 * kk + 5]); w.w = pg8::cvt_pk_bf16(s0[8 * kk + 6], s0[8 * kk + 7]); pa[kk] = __builtin_bit_cast(bf16x8, w); \
            w.x = pg8::cvt_pk_bf16(s1[8 * kk + 0], s1[8 * kk + 1]); w.y = pg8::cvt_pk_bf16(s1[8 * kk + 2], s1[8 * kk + 3]); w.z = pg8::cvt_pk_bf16(s1[8 * kk + 4], s1[8 * kk + 5]); w.w = pg8::cvt_pk_bf16(s1[8 * kk + 6], s1[8 * kk + 7]); pa[2 + kk] = __builtin_bit_cast(bf16x8, w); } \
        const LAS unsigned char* vb = lds + AT_V0 + buf * AT_VBUF + r32 * AT_VSTR + (sub) * 128 + hi * 8; \
        _Pragma("unroll") for (int dvb = 0; dvb < 2; ++dvb) _Pragma("unroll") for (int kk = 0; kk < 4; ++kk) { \
                const u32x2 lo_ = *(const LAS u32x2*)(vb + dvb * 32 * AT_VSTR + kk * 32), hi_ = *(const LAS u32x2*)(vb + dvb * 32 * AT_VSTR + kk * 32 + 16); \
                const bf16x8 bv = __builtin_bit_cast(bf16x8, (u32x4){lo_.x, lo_.y, hi_.x, hi_.y}); \
                o[dvb] = __builtin_amdgcn_mfma_f32_32x32x16_bf16(pa[kk], bv, o[dvb], 0, 0, 0); } } while (0)
        AT_QK(sA0, sA1, 0); AT_QK(sB0, sB1, 1);
        AT_SOFT(sA0, sA1, sB0, sB1, 0, true);
        AT_SOFT(sB0, sB1, sA0, sA1, 1, false);
#undef AT_QK
#undef AT_SOFT
        if (j + 1 < NT2) AT_LSTORE(buf ^ 1);
        __syncthreads();
        if (j + 2 < NT2) AT_GLOAD(j + 2);
    }
    float lt = lsum + __shfl_xor(lsum, 32);
    if (has_sink) lt += fexp2(sink_l2 - mhat);
    if (hi == 0) wsf[r32] = frcp(lt);
#pragma unroll
    for (int r = 0; r < 16; ++r) { const float fr_ = wsf[crow(r, hi)]; o[0][r] *= fr_; o[1][r] *= fr_; }
#undef AT_TILE
#undef AT_GLOAD
#undef AT_LSTORE
#undef MX3
}

__device__ __forceinline__ void attn_store(bf16_t* O, int row0, int col0, const f32x16 (&o)[2]) {
    const int tid_ = ptid(); const int lane = tid_ & 63, r32 = lane & 31, hi = lane >> 5, wid = tid_ >> 6;
#pragma unroll
    for (int dvb = 0; dvb < 2; ++dvb)
#pragma unroll
        for (int r = 0; r < 16; ++r) O[(size_t)(row0 + wid * 32 + crow(r, hi)) * 1024 + col0 + dvb * 32 + r32] = (bf16_t)f2bf(o[dvb][r]);
}

__device__ __forceinline__ void attn_unit(CArgs& a, int l, int branch, int b, int h, int qb, float lam, float lam_init, LAS unsigned char* lds) {
    const bf16_t* HIN = (const bf16_t*)(a.ws + WS_BIG) + (size_t)b * RPB * NHIN; const bf16_t* MUP = (const bf16_t*)(a.ws + WS_Y) + (size_t)b * RPB * 1024;
    const bf16_t* VT = (const bf16_t*)(a.ws + WS_VT) + (size_t)b * 768 * RPB; bf16_t* OUTS = (bf16_t*)(a.ws + WS_OUTS);
    const bool cq = qb < 0; const int qrow = cq ? 0 : CTX + 256 * qb;
    const int NTd = cq ? 4 : 132;
    const int orow0 = b * RPB + qrow;
    f32x16 o[2];
    AttnSrc s;
    if (branch == 0) {
        s.Q = HIN + (size_t)qrow * NHIN + 64 * h; s.ldq = NHIN; s.K1 = HIN + 256 + 64 * (h >> 1); s.ldk1 = NHIN; s.K2 = nullptr; s.ldk2 = 0; s.VT = VT + (size_t)(0 + 64 * (h >> 1)) * RPB;
        attn_pass<64, false>(s, NTd, 4, 0, 0.f, false, lds, o);
        attn_store(OUTS, orow0, 0 + 64 * h, o);
    } else if (branch == 1) {
        s.Q = MUP + (size_t)qrow * 1024 + 96 * h; s.ldq = 1024; s.K1 = MUP + 384 + 128 * h; s.ldk1 = 1024; s.K2 = MUP + 896; s.ldk2 = 1024; s.VT = VT + (size_t)(128 + 64 * h) * RPB;
        attn_pass<96, false>(s, NTd, 4, 0, 0.f, false, lds, o);
        attn_store(OUTS, orow0, 256 + 64 * h, o);
    } else if (branch == 2) {
        f32x16 o2[2];
        s.Q = HIN + (size_t)qrow * NHIN + 928 + 64 * h; s.ldq = NHIN; s.K1 = HIN + 1184 + 64 * h; s.ldk1 = NHIN; s.K2 = nullptr; s.ldk2 = 0; s.VT = VT + (size_t)(384 + 64 * h) * RPB;
        attn_pass<32, false>(s, NTd, 4, 0, 0.f, false, lds, o);
        s.Q += 32; s.K1 += 32;
        attn_pass<32, false>(s, NTd, 4, 0, 0.f, false, lds, o2);
        const int lane = ptid() & 63, r32 = lane & 31;
        const float g0 = a.dsub[l * 64 + r32] * (1.f - lam_init), g1 = a.dsub[l * 64 + 32 + r32] * (1.f - lam_init);
#pragma unroll
        for (int r = 0; r < 16; ++r) { const float x0 = o[0][r] - lam * o2[0][r], x1 = o[1][r] - lam * o2[1][r];
            float ss = x0 * x0 + x1 * x1;
#pragma unroll
            for (int m = 1; m < 32; m <<= 1) ss += __shfl_xor(ss, m);
            const float rs = __builtin_amdgcn_rsqf(ss * (1.f / 64.f) + EPS);
            o[0][r] = x0 * rs * g0; o[1][r] = x1 * rs * g1; }
        attn_store(OUTS, orow0, 512 + 64 * h, o);
    } else {
        s.Q = HIN + (size_t)qrow * NHIN + 1696 + 64 * h; s.ldq = NHIN; s.K1 = HIN + 1952 + 64 * (h >> 1); s.ldk1 = NHIN; s.K2 = nullptr; s.ldk2 = 0; s.VT = VT + (size_t)(640 + 64 * (h >> 1)) * RPB;
        const float sk = a.sink[l * 4 + h] * LOG2E;
        if (cq) attn_pass<64, false>(s, 4, 4, 0, sk, true, lds, o);
        else { const int q0 = 256 * qb; const int lo = 4 + (q0 >= 128 ? q0 - 128 : 0) / 64, hiT = 4 + ((q0 + 384) < SEQ ? (q0 + 384) : SEQ) / 64;
            attn_pass<64, true>(s, 4 + hiT - lo, lo, q0, sk, true, lds, o); }
        attn_store(OUTS, orow0, 768 + 64 * h, o);
    }
}

__device__ __forceinline__ void attn_phase(CArgs& a, int l, LAS unsigned char* lds) {
    const float lam_init = 0.8f - 0.6f * __expf(-0.3f * (float)l);
    float lam;
    { const float* dl = a.dlam + l * 128; float s1 = 0.f, s2 = 0.f;
        for (int i = 0; i < 32; ++i) { s1 += dl[i] * dl[32 + i]; s2 += dl[64 + i] * dl[96 + i]; }
        lam = __expf(s1) - __expf(s2) + lam_init; }
    const int G = gridDim.x, bx = blockIdx.x;
    const int vcu = (G % 8 == 0) ? (bx % 8) * (G / 8) + bx / 8 : bx;
    for (int ty = 0; ty < 4; ++ty) {
        const int branch = ty == 0 ? 2 : ty == 1 ? 1 : ty == 2 ? 0 : 3;
        for (int idx = vcu; idx < NB * 4 * 32; idx += G) { const int bh = idx >> 5, qb = idx & 31; attn_unit(a, l, branch, bh >> 2, bh & 3, qb, lam, lam_init, lds); }
    }
    for (int idx = vcu; idx < NB * 16; idx += G) attn_unit(a, l, (idx >> 2) & 3, idx >> 4, idx & 3, -1, lam, lam_init, lds);
}

#define GAS __attribute__((address_space(1)))
#define XB_TMO      128
#define XB_XCNT(j)  (256  + 64 * (j))
#define XB_XSUB(j)  (1280 + 64 * (j))
#define XB_XGEN(j)  (2304 + 64 * (j))
#define XB_TOP      3328
#define XB_TOPGEN   3392
#define XCD_BAR_WORDS 3456
#define XB_SPIN_CAP (1u << 18)

__device__ __forceinline__ unsigned xb_ld(unsigned* p)              { return __hip_atomic_load(p, __ATOMIC_RELAXED, __HIP_MEMORY_SCOPE_AGENT); }
__device__ __forceinline__ unsigned xb_add(unsigned* p, unsigned v) { return __hip_atomic_fetch_add(p, v, __ATOMIC_RELAXED, __HIP_MEMORY_SCOPE_AGENT); }
__device__ __forceinline__ unsigned xb_xcc_id() { return (unsigned)__builtin_amdgcn_s_getreg((3 << 11) | 20) & 0xFu; }
#define XB_SPIN(cond, bar) do { unsigned _sp = 0; while (cond) { __builtin_amdgcn_s_sleep(1); \
    if ((++_sp & 255u) == 0u) { if (xb_ld(&(bar)[XB_TMO])) break; if (_sp > XB_SPIN_CAP) { atomicAdd(&(bar)[XB_TMO], 1u); break; } } } } while (0)

struct XcdBarrier {
    unsigned* bar; unsigned x;
    volatile LAS unsigned* st;
};

__device__ __forceinline__ XcdBarrier xcd_barrier_post(unsigned* bar, volatile LAS unsigned* st) {
    XcdBarrier b; b.bar = bar; b.x = xb_xcc_id(); b.st = st;
    if (threadIdx.x == 0) (void)xb_add(&bar[XB_XCNT(b.x)], 1u);
    return b;
}
__device__ __forceinline__ void xcd_barrier_complete(unsigned* bar, unsigned x, unsigned& nloc, unsigned& nx) {
    const unsigned G = gridDim.x * gridDim.y * gridDim.z;
    unsigned sum, cnt, mine, sp = 0u;
    for (;;) {
        sum = 0u; cnt = 0u; mine = 0u;
#pragma unroll
        for (unsigned j = 0; j < 16; ++j) { const unsigned c = xb_ld(&bar[XB_XCNT(j)]); sum += c; cnt += (c > 0u) ? 1u : 0u; mine = (j == x) ? c : mine; }
        if (sum == G) break;
        __builtin_amdgcn_s_sleep(1);
        if ((++sp & 255u) == 0u) { if (xb_ld(&bar[XB_TMO])) break; if (sp > XB_SPIN_CAP) { atomicAdd(&bar[XB_TMO], 1u); break; } }
    }
    nloc = mine > 0u ? mine : 1u; nx = cnt > 0u ? cnt : 1u;
}

__device__ __forceinline__ void xcd_barrier(const XcdBarrier& b) {
    asm volatile("s_waitcnt vmcnt(0)" ::: "memory");
    __syncthreads();
    if (threadIdx.x == 0) {
        unsigned* bar = b.bar;
        __builtin_amdgcn_s_waitcnt(0);
        unsigned nloc = b.st[0], nx = b.st[1];
        if (nloc == 0u) { xcd_barrier_complete(bar, b.x, nloc, nx); b.st[0] = nloc; b.st[1] = nx; }
        const unsigned old = xb_add(&bar[XB_XSUB(b.x)], 1u);
        const unsigned gen = old / nloc;
        if (old + 1u == (gen + 1u) * nloc) {
            __builtin_amdgcn_fence(__ATOMIC_RELEASE, "agent");
            asm volatile("s_waitcnt vmcnt(0)" ::: "memory");
            const unsigned og = xb_add(&bar[XB_TOP], 1u);
            const unsigned tg = og / nx;
            if (og + 1u == (tg + 1u) * nx) xb_add(&bar[XB_TOPGEN], 1u);
            else XB_SPIN(xb_ld(&bar[XB_TOPGEN]) == tg, bar);
            __builtin_amdgcn_fence(__ATOMIC_ACQUIRE, "agent");
            xb_add(&bar[XB_XGEN(b.x)], 1u);
            asm volatile("s_waitcnt vmcnt(0)" ::: "memory");
        } else {
            XB_SPIN(xb_ld(&bar[XB_XGEN(b.x)]) == gen, bar);
            __builtin_amdgcn_fence(__ATOMIC_ACQUIRE, "agent");
            asm volatile("s_waitcnt vmcnt(0)" ::: "memory");
        }
    }
    __syncthreads();
}


constexpr int NPHASE = 2 + 32;
__global__ void __launch_bounds__(512, 2) fwd_kernel(Args a_) {
    extern __shared__ __attribute__((aligned(16))) unsigned char lds_raw[];
    LAS unsigned char* lds = (LAS unsigned char*)lds_raw;
    cg::grid_group grid = cg::this_grid();
    const int lo = a_.ph_lo, hi = a_.ph_hi < NPHASE ? a_.ph_hi : NPHASE;
    { volatile LAS unsigned* st0 = (volatile LAS unsigned*)(lds + LDS_BARST); if (threadIdx.x < 2) st0[threadIdx.x] = 0u; }
    __syncthreads();
    { XcdBarrier b0 = xcd_barrier_post((unsigned*)(a_.ws + WS_BAR), (volatile LAS unsigned*)(lds + LDS_BARST)); (void)b0; }
    for (int ph = lo; ph < hi; ++ph) {
        CArgs* ap_ = (CArgs*)__builtin_amdgcn_kernarg_segment_ptr(); asm volatile("" : "+s"(ap_) :: "memory"); CArgs& a = *ap_;
        int G = gridDim.x, bx = blockIdx.x; asm volatile("" : "+s"(G), "+s"(bx));
        if (ph == 0) p0_phase(a, lds);
        else if (ph == 1) row_phase(a, 0, true, nullptr, 0, 0.f, (bf16_t*)(a.ws + WS_U), 0, 0);
        else {
            const int l = (ph - 2) / 16, k = (ph - 2) % 16;
            unsigned char* ws = a.ws;
            const unsigned char* wb = ws + WS_W + (size_t)l * W_LAYER;
            bf16_t* U = (bf16_t*)(ws + WS_U); bf16_t* Yb = (bf16_t*)(ws + WS_Y); bf16_t* BIG = (bf16_t*)(ws + WS_BIG);
            if (k == 5) prep_phase(a, l, lds);
#ifndef X_ATTN
            else if (k == 6) attn_phase(a, l, lds);
#endif
            else if (k == 2) row_phase(a, l, l == 0, Yb, 0, 0.5f, U, 1, l);
            else if (k == 12) row_phase(a, l, false, BIG, 1, 1.0f, U, 2, l);
            else if (k == 15) row_phase(a, l, false, Yb, 2, 0.5f, l == 0 ? U : nullptr, 0, l + 1);
            else {
                pg8::Gemm g; pg8::Epi E; int N; int dual = 0; int Mrows = R;
                g.A2 = nullptr; g.Bt2 = nullptr; E.scr = nullptr;
                if (k == 0 || k == 13) { const int s = k == 13; g.A = U; g.Bt = (const bf16_t*)(wb + W_GU + s * W_GU_SZ); g.lda = 1024; g.ldb = 1024; g.K = 1024; N = 5632; E.mode = 1; E.O = BIG; E.ldc = DFF; }
                else if (k == 1 || k == 14) { const int s = k == 14; g.A = BIG; g.Bt = (const bf16_t*)(wb + W_D + s * W_D_SZ); g.lda = DFF; g.ldb = DFF; g.K = DFF; N = 1024; E.mode = 0; E.O = Yb; E.ldc = 1024; }
                else if (k == 3) { g.A = U; g.Bt = (const bf16_t*)(wb + W_IN); g.lda = 1024; g.ldb = 1024; g.K = 1024; N = NHIN; E.mode = 0; E.O = BIG; E.ldc = NHIN; }
                else if (k == 4) { g.A = BIG + 512; g.Bt = (const bf16_t*)(wb + W_MLA); g.lda = NHIN; g.ldb = 384; g.K = 384; N = 1024; E.mode = 0; E.O = Yb; E.ldc = 1024; }
                else if (k == 7 || k == 9) { size_t ro = (size_t)(k == 9) * 32768 * 1024; Mrows = (k == 9) ? R - 32768 : 32768; if (l == 1) { ro = (size_t)(k == 9) * 33792 * 1024; Mrows = 32768; dual = 1; }
                    g.A = U + ro; g.Bt = (const bf16_t*)(wb + W_G); g.lda = 1024; g.ldb = 1024; g.K = 1024; N = 4096; E.mode = 3; E.O = BIG; E.ldc = 4096; }
                else if (k == 8 || k == 10) { size_t ro = (size_t)(k == 10) * 32768 * 1024; Mrows = (k == 10) ? R - 32768 : 32768; if (l == 1) { ro = (size_t)(k == 10) * 33792 * 1024; Mrows = 32768; dual = 1; }
                    g.A = (const bf16_t*)(ws + WS_OUTS) + ro; g.Bt = (const bf16_t*)(wb + W_BR); g.lda = 1024; g.ldb = 1024; g.K = 1024; N = 1024; E.mode = 4; E.O = Yb + ro; E.ldc = 1024; E.scr = (u32x4*)BIG; }
                else { g.A = Yb; g.Bt = (const bf16_t*)(wb + W_OUT); g.lda = 1024; g.ldb = 1024; g.K = 1024; N = 1024; E.mode = 0; E.O = BIG; E.ldc = 1024; }
                if (l == 1 && (k == 11 || k == 13 || k == 14)) { dual = 1; Mrows = 65536; }
                pg8::StaticOrder S; S.init(Mrows, N, G, bx, dual);
                if (k == 8 || k == 10) pg8::gemm_phase<true>(lds, g, S, E); else pg8::gemm_phase<false>(lds, g, S, E);
            }
        }
        if (ph + 1 < hi) {
            if (ph == lo) {
                asm volatile("s_waitcnt vmcnt(0) lgkmcnt(0)" ::: "memory");
                __syncthreads();
                if (ptid() < 64) { __builtin_amdgcn_fence(__ATOMIC_RELEASE, "agent"); asm volatile("s_waitcnt vmcnt(0)" ::: "memory"); }
                grid.sync();
                __builtin_amdgcn_fence(__ATOMIC_ACQUIRE, "agent");
                asm volatile("s_waitcnt vmcnt(0)" ::: "memory");
            } else {
                XcdBarrier bar; bar.bar = (unsigned*)(a.ws + WS_BAR); bar.x = xb_xcc_id(); bar.st = (volatile LAS unsigned*)(lds + LDS_BARST);
                xcd_barrier(bar);
                __builtin_amdgcn_fence(__ATOMIC_ACQUIRE, "agent");
                asm volatile("s_waitcnt vmcnt(0)" ::: "memory");
            }
        }
    }
}

extern "C" void kernel_launch(void* const* d_in, const int* in_sizes, int n_in, void* d_out, int out_size, void* d_ws, size_t ws_size, hipStream_t stream) {
    static int grid = 0;
    if (grid == 0) {
        int dev = 0, cus = 0;
        if (hipGetDevice(&dev) != hipSuccess || hipDeviceGetAttribute(&cus, hipDeviceAttributeMultiprocessorCount, dev) != hipSuccess) { grid = -1; return; }
        if (hipFuncSetAttribute((const void*)fwd_kernel, hipFuncAttributeMaxDynamicSharedMemorySize, LDS_BYTES) != hipSuccess) { fprintf(stderr, "hipFuncSetAttribute failed\n"); grid = -1; return; }
        int per_cu = 0;
        if (hipOccupancyMaxActiveBlocksPerMultiprocessor(&per_cu, (const void*)fwd_kernel, 512, LDS_BYTES) != hipSuccess || per_cu < 1) fprintf(stderr, "occupancy query: %d\n", per_cu);
        (void)hipGetLastError();
        grid = cus;
        if (ws_size < WS_END) { fprintf(stderr, "workspace too small\n"); grid = -1; return; }
    }
    if (grid < 0) return;
    if (hipMemsetAsync((char*)d_ws + WS_BAR, 0, 16384, stream) != hipSuccess) { fprintf(stderr, "memset failed\n"); return; }
    Args a{};
    const float** p = (const float**)&a;
    for (int i = 0; i < 23; ++i) p[i] = (const float*)d_in[i];
    a.out = (float*)d_out; a.ws = (unsigned char*)d_ws; a.ph_lo = 0; a.ph_hi = 1000;
    void* args[] = {&a};
    hipError_t e = hipLaunchCooperativeKernel((const void*)fwd_kernel, dim3(grid), dim3(512), args, LDS_BYTES, stream);
    if (e != hipSuccess) fprintf(stderr, "cooperative launch failed: %s\n", hipGetErrorString(e));
}
```

```cpp
#include <hip/hip_runtime.h>
#include <hip/hip_cooperative_groups.h>
#include <cstdio>
#include <cstdint>
namespace cg = cooperative_groups;

#define LAS __attribute__((address_space(3)))
typedef unsigned short bf16_t;
typedef short bf16x8 __attribute__((ext_vector_type(8)));
typedef short s16x4 __attribute__((ext_vector_type(4)));
typedef float f32x4 __attribute__((ext_vector_type(4)));
typedef float f32x16 __attribute__((ext_vector_type(16)));
typedef unsigned u32x4 __attribute__((ext_vector_type(4)));
typedef unsigned u32x2 __attribute__((ext_vector_type(2)));

constexpr int DM = 1024, NB = 8, SEQ = 8192, CTX = 256, RPB = SEQ + CTX, R = NB * RPB, DFF = 2816;
constexpr int NHIN = 2304, INCOLS = 6304, GATE0 = 2208;
constexpr int MODW = 9216;
constexpr float EPS = 1e-6f;
constexpr float LOG2E = 1.4426950408889634f;
constexpr float QS_GQA = 0.125f * LOG2E, QS_MLA = 0.10206207261596577f * LOG2E, QS_DIFF = 0.17677669529663687f * LOG2E;

constexpr size_t MiB = 1u << 20;
constexpr size_t WS_MOD = 0;
constexpr size_t WS_XC = 2 * MiB;
constexpr size_t WS_W = 10 * MiB;
constexpr size_t W_GU = 0, W_GU_SZ = (size_t)5632 * 1024 * 2;
constexpr size_t W_D = W_GU + 2 * W_GU_SZ, W_D_SZ = (size_t)1024 * 2816 * 2;
constexpr size_t W_IN = W_D + 2 * W_D_SZ, W_IN_SZ = (size_t)NHIN * 1024 * 2;
constexpr size_t W_G = W_IN + W_IN_SZ, W_G_SZ = (size_t)4096 * 1024 * 2;
constexpr size_t W_BR = W_G + W_G_SZ;
constexpr size_t W_OUT = W_BR + W_G_SZ, W_OUT_SZ = (size_t)1024 * 1024 * 2;
constexpr size_t W_MLA = W_OUT + W_OUT_SZ, W_MLA_SZ = (size_t)1024 * 384 * 2;
constexpr size_t W_LAYER = W_MLA + W_MLA_SZ;
static_assert(WS_W + 2 * W_LAYER <= 124 * MiB, "weights");
constexpr size_t ROWBUF = (size_t)R * 1024 * 2;
constexpr size_t WS_U = 124 * MiB;
constexpr size_t WS_Y = WS_U + ROWBUF;
constexpr size_t WS_BIG = WS_Y + ROWBUF;
constexpr size_t WS_OUTS = WS_BIG + (size_t)R * NHIN * 2;
constexpr size_t WS_VT = WS_OUTS + ROWBUF;
constexpr size_t WS_GSCR = WS_VT + (size_t)NB * 768 * RPB * 2;
constexpr size_t WS_END = WS_GSCR + 256 * 131072;
static_assert(WS_END <= 1024 * MiB, "ws");
static_assert(WS_BIG + (size_t)R * DFF * 2 <= WS_END, "H");

constexpr int LDS_BYTES = 147456;
constexpr size_t WS_BAR = 1 * MiB;
constexpr int LDS_BARST = 147456 - 64;

__device__ __forceinline__ unsigned f2bf(float f) { unsigned u = __builtin_bit_cast(unsigned, f); return (u + 0x7fffu + ((u >> 16) & 1u)) >> 16; }
__device__ __forceinline__ unsigned pk2(float lo, float hi) { return f2bf(lo) | (f2bf(hi) << 16); }
__device__ __forceinline__ float bf2f(unsigned short h) { return __builtin_bit_cast(float, (unsigned)h << 16); }
__device__ __forceinline__ float bflo(unsigned w) { return __builtin_bit_cast(float, w << 16); }
__device__ __forceinline__ float bfhi(unsigned w) { return __builtin_bit_cast(float, w & 0xffff0000u); }
__device__ __forceinline__ float wave_sum(float v) {
#pragma unroll
    for (int o = 1; o < 64; o <<= 1) v += __shfl_xor(v, o);
    return v;
}
__device__ __forceinline__ int ptid() { int t = threadIdx.x; asm volatile("" : "+v"(t)); return t; }
__device__ __forceinline__ float fexp2(float x) { return __builtin_amdgcn_exp2f(x); }
__device__ __forceinline__ float frcp(float x) { return __builtin_amdgcn_rcpf(x); }
__device__ __forceinline__ float sigmoidf_(float x) { return frcp(1.f + fexp2(-x * LOG2E)); }

namespace pg8 {
constexpr int BM = 256, BK = 64, HALF = 128, HTB = HALF * BK * 2, STAGE_BYTES = 8 * HTB, NXCD = 8, WGM = 8;
__device__ __forceinline__ int lds_byte(int r, int c) { const int st = (r >> 4) * 2 + (c >> 5), rr = r & 15, cc = c & 31, ob = rr * 64 + cc * 2; return st * 1024 + (ob ^ (((ob >> 9) & 1) << 5)); }
__device__ __forceinline__ void stage_rc(int b, int& Rr, int& C) { const int st = b / 1024, sb = b % 1024, swz = sb ^ (((sb >> 9) & 1) << 5); Rr = (st >> 1) * 16 + swz / 64; C = (st & 1) * 32 + (swz % 64) / 2; }
__device__ __forceinline__ int perm32(int rho) { const int n = rho >> 4, i = rho & 15; return 8 * (i >> 2) + 4 * n + (i & 3); }

struct Unit { int pm, pn, kind; };
struct Gemm { const bf16_t* A; const bf16_t* Bt; const bf16_t* A2; const bf16_t* Bt2; int lda, ldb, K; };

struct StaticOrder {
    int nM, nN, nwg, G, c, dual;
    __device__ void init(int M, int N, int G_, int c_, int dual_) { nM = M / BM; nN = N / BM; nwg = nM * nN; G = G_; c = c_; dual = dual_; }
    __device__ bool next(int i, Unit& u) const {
        const int ii = i;
        const long L = (long)ii * G + c; if (L >= nwg) return false;
        int wgid = (int)L; { const int q = nwg / NXCD, r = nwg % NXCD, xcd = wgid % NXCD, off = wgid / NXCD; wgid = (xcd < r ? xcd * (q + 1) : r * (q + 1) + (xcd - r) * q) + off; }
        const int nig = WGM * nN, gid = wgid / nig, fm = gid * WGM, gsz = (nM - fm) < WGM ? (nM - fm) : WGM;
        u.pm = fm + ((wgid % nig) % gsz); u.pn = (wgid % nig) / gsz;
        if (dual) u.pm = (u.pm >> 5) * 33 + 1 + (u.pm & 31);
        u.kind = 0; return true;
    }
};

typedef float f32x2_t __attribute__((ext_vector_type(2))); typedef __bf16 bf16x2_t __attribute__((ext_vector_type(2)));
__device__ __forceinline__ unsigned cvt_pk_bf16(float lo, float hi) { f32x2_t v = {lo, hi}; bf16x2_t b = __builtin_convertvector(v, bf16x2_t); return __builtin_bit_cast(unsigned, b); }

struct Epi {
    int mode; bf16_t* O; int ldc; u32x4* scr;
    __device__ __forceinline__ void operator()(const f32x4 (&acc)[2][2][4][2], const Unit& u, int wr, int wc, int fr, int fq) const {
        const int row0 = u.pm * BM + wr * 64 + fr;
        if (mode == 0) {
            const int col0 = u.pn * BM + wc * 32 + 8 * fq;
#pragma unroll
            for (int ai = 0; ai < 2; ++ai)
#pragma unroll
                for (int m = 0; m < 4; ++m) { bf16_t* rowp = O + (size_t)(row0 + ai * HALF + m * 16) * ldc + col0;
#pragma unroll
                    for (int bj = 0; bj < 2; ++bj) { const f32x4 v0 = acc[ai][bj][m][0], v1 = acc[ai][bj][m][1];
                        u32x4 w; w.x = cvt_pk_bf16(v0[0], v0[1]); w.y = cvt_pk_bf16(v0[2], v0[3]); w.z = cvt_pk_bf16(v1[0], v1[1]); w.w = cvt_pk_bf16(v1[2], v1[3]);
                        *(u32x4*)(rowp + bj * HALF) = w; } }
        } else if (mode == 1) {
            const int col0 = u.pn * HALF + wc * 32 + 8 * fq;
#pragma unroll
            for (int ai = 0; ai < 2; ++ai)
#pragma unroll
                for (int m = 0; m < 4; ++m) { bf16_t* rowp = O + (size_t)(row0 + ai * HALF + m * 16) * ldc + col0;
                    float h[8];
#pragma unroll
                    for (int n = 0; n < 2; ++n)
#pragma unroll
                        for (int e = 0; e < 4; ++e) { const float g = acc[ai][0][m][n][e], up = acc[ai][1][m][n][e]; h[n * 4 + e] = g * sigmoidf_(g) * up; }
                    u32x4 w; w.x = cvt_pk_bf16(h[0], h[1]); w.y = cvt_pk_bf16(h[2], h[3]); w.z = cvt_pk_bf16(h[4], h[5]); w.w = cvt_pk_bf16(h[6], h[7]);
                    *(u32x4*)rowp = w; }
        } else if (mode == 3) {
            const int col0 = u.pn * BM + wc * 32 + 8 * fq;
#pragma unroll
            for (int ai = 0; ai < 2; ++ai)
#pragma unroll
                for (int m = 0; m < 4; ++m) { bf16_t* rowp = O + (size_t)(row0 + ai * HALF + m * 16) * ldc + col0;
#pragma unroll
                    for (int bj = 0; bj < 2; ++bj) { const f32x4 v0 = acc[ai][bj][m][0], v1 = acc[ai][bj][m][1];
                        u32x4 w; w.x = cvt_pk_bf16(sigmoidf_(v0[0]), sigmoidf_(v0[1])); w.y = cvt_pk_bf16(sigmoidf_(v0[2]), sigmoidf_(v0[3]));
                        w.z = cvt_pk_bf16(sigmoidf_(v1[0]), sigmoidf_(v1[1])); w.w = cvt_pk_bf16(sigmoidf_(v1[2]), sigmoidf_(v1[3]));
                        *(u32x4*)(rowp + bj * HALF) = w; } }
        } else {
            const int col0 = u.pn * BM + wc * 32 + 8 * fq;
#pragma unroll
            for (int ai = 0; ai < 2; ++ai)
#pragma unroll
                for (int m = 0; m < 4; ++m) { const size_t r = (size_t)(row0 + ai * HALF + m * 16);
                    const bf16_t* gp = (const bf16_t*)scr + r * 4096 + 3 * 1024 + col0; bf16_t* rowp = O + r * ldc + col0;
#pragma unroll
                    for (int bj = 0; bj < 2; ++bj) { const u32x4 g = *(const u32x4*)(gp + bj * HALF); const f32x4 v0 = acc[ai][bj][m][0], v1 = acc[ai][bj][m][1];
                        u32x4 w; w.x = cvt_pk_bf16(v0[0] * gclamp(bflo(g.x)), v0[1] * gclamp(bfhi(g.x))); w.y = cvt_pk_bf16(v0[2] * gclamp(bflo(g.y)), v0[3] * gclamp(bfhi(g.y)));
                        w.z = cvt_pk_bf16(v1[0] * gclamp(bflo(g.z)), v1[1] * gclamp(bfhi(g.z))); w.w = cvt_pk_bf16(v1[2] * gclamp(bflo(g.w)), v1[3] * gclamp(bfhi(g.w)));
                        *(u32x4*)(rowp + bj * HALF) = w; } }
        }
    }
    static __device__ __forceinline__ float gclamp(float g) { return __builtin_fmaxf(g, 1e-6f); }
    __device__ __forceinline__ void rescale(f32x4 (&acc)[2][2][4][2], const Unit& u, int i, int wr, int wc, int fr, int fq) const {
        int row0 = u.pm * BM + wr * 64 + fr; const int col0 = u.pn * BM + wc * 32 + 8 * fq;
        asm volatile("" : "+v"(row0));
#pragma unroll
        for (int ai = 0; ai < 2; ++ai)
#pragma unroll
            for (int m = 0; m < 4; ++m) { const bf16_t* gp = (const bf16_t*)scr + (size_t)(row0 + ai * HALF + m * 16) * 4096 + i * 1024 + col0;
#pragma unroll
                for (int bj = 0; bj < 2; ++bj) { const u32x4 ga = *(const u32x4*)(gp + bj * HALF), gb = *(const u32x4*)(gp + 1024 + bj * HALF);
                    f32x4 r0, r1;
                    r0[0] = gclamp(bflo(ga.x)) * frcp(gclamp(bflo(gb.x))); r0[1] = gclamp(bfhi(ga.x)) * frcp(gclamp(bfhi(gb.x)));
                    r0[2] = gclamp(bflo(ga.y)) * frcp(gclamp(bflo(gb.y))); r0[3] = gclamp(bfhi(ga.y)) * frcp(gclamp(bfhi(gb.y)));
                    r1[0] = gclamp(bflo(ga.z)) * frcp(gclamp(bflo(gb.z))); r1[1] = gclamp(bfhi(ga.z)) * frcp(gclamp(bfhi(gb.z)));
                    r1[2] = gclamp(bflo(ga.w)) * frcp(gclamp(bflo(gb.w))); r1[3] = gclamp(bfhi(ga.w)) * frcp(gclamp(bfhi(gb.w)));
                    acc[ai][bj][m][0] = acc[ai][bj][m][0] * r0; acc[ai][bj][m][1] = acc[ai][bj][m][1] * r1; }
                if (m == 3) asm volatile("" ::: "memory"); }
    }
};

template <bool HOOK, class Sched>
__device__ __forceinline__ void gemm_phase(LAS unsigned char* lds, const Gemm g, const Sched& S, const Epi& E) {
    const int tid = ptid(), wid = __builtin_amdgcn_readfirstlane(tid >> 6), lane = tid & 63, wr = wid >> 2, wc = wid & 3, fr = lane & 15, fq = lane >> 4;
    const int K = g.K, nt = K / BK;
    unsigned voffA[2], voffB[2];
#pragma unroll
    for (int i = 0; i < 2; ++i) { int Rr, C; stage_rc(tid * 16 + i * 8192, Rr, C); const int Rb = (Rr & ~31) + perm32(Rr & 31);
        voffA[i] = (unsigned)(Rr * g.lda + C) * 2u; voffB[i] = (unsigned)(Rb * g.ldb + C) * 2u; }
    const size_t kstep = (size_t)(BK * 2);
    const size_t hsA = (size_t)HALF * g.lda * 2, hsB = (size_t)HALF * g.ldb * 2;
    const size_t tsA = 2 * hsA, tsB = 2 * hsB;
    const unsigned ldsw = (unsigned)wid * 1024u;
    const int aoff = lds_byte(wr * 64 + fr, fq * 8), boff = lds_byte(wc * 32 + fr, fq * 8);
#define PG8_SA(b, h) (((b) * 2 + (h)) * HTB)
#define PG8_SB(b, h) ((4 + (b) * 2 + (h)) * HTB)
#define PG8_STAGE(bufoff, gbase, voff) do { _Pragma("unroll") for (int _i = 0; _i < 2; ++_i) \
        __builtin_amdgcn_global_load_lds((const unsigned*)((const char*)(gbase) + (voff)[_i]), (LAS unsigned*)(lds + (bufoff) + ldsw + _i * 8192), 16, 0, 0); } while (0)
#define PG8_LDA(dst, b, h) do { _Pragma("unroll") for (int m = 0; m < 4; ++m) _Pragma("unroll") for (int k = 0; k < 2; ++k) dst[m][k] = *(const LAS bf16x8*)(lds + PG8_SA(b, h) + aoff + m * 2048 + k * 1024); } while (0)
#define PG8_LDB(dst, b, h) do { _Pragma("unroll") for (int n = 0; n < 2; ++n) _Pragma("unroll") for (int k = 0; k < 2; ++k) dst[n][k] = *(const LAS bf16x8*)(lds + PG8_SB(b, h) + boff + n * 2048 + k * 1024); } while (0)
#define PG8_MMA(ai, bj, At, Bt) do { __builtin_amdgcn_s_setprio(1); _Pragma("unroll") for (int m = 0; m < 4; ++m) _Pragma("unroll") for (int n = 0; n < 2; ++n) _Pragma("unroll") for (int k = 0; k < 2; ++k) \
        acc[ai][bj][m][n] = __builtin_amdgcn_mfma_f32_16x16x32_bf16(Bt[n][k], At[m][k], acc[ai][bj][m][n], 0, 0, 0); __builtin_amdgcn_s_setprio(0); } while (0)
#define PG8_MMA1(ai, bj, nn, At, Bt) do { __builtin_amdgcn_s_setprio(1); _Pragma("unroll") for (int m = 0; m < 4; ++m) _Pragma("unroll") for (int k = 0; k < 2; ++k) \
        acc[ai][bj][m][nn] = __builtin_amdgcn_mfma_f32_16x16x32_bf16(Bt[nn][k], At[m][k], acc[ai][bj][m][nn], 0, 0, 0); __builtin_amdgcn_s_setprio(0); } while (0)
#define PG8_MMAZ(ai, At) do { if (zbr == 0) PG8_MMA1(ai, 0, 0, At, B0); else if (zbr == 1) PG8_MMA1(ai, 0, 1, At, B0); else if (zbr == 2) PG8_MMA1(ai, 1, 0, At, B1); else PG8_MMA1(ai, 1, 1, At, B1); } while (0)
#define PG8_MM2(ai, At) do { PG8_MMA(ai, 0, At, B0); PG8_MMA(ai, 1, At, B1); } while (0)
#define PG8_WAIT_V(n) asm volatile("s_waitcnt vmcnt(" #n ")" ::: "memory")
#define PG8_WAIT_L(n) asm volatile("s_waitcnt lgkmcnt(" #n ")" ::: "memory")
#define PG8_BAR __builtin_amdgcn_s_barrier()
#define PG8_SCHED __builtin_amdgcn_sched_barrier(0)
#define PG8_UA(u) ((const char*)((u).kind ? g.A2 : g.A) + (size_t)(u).pm * tsA)
#define PG8_UB(u) ((const char*)((u).kind ? g.Bt2 : g.Bt) + (size_t)(u).pn * tsB)
    Unit cur, nxt; int ui = 0;
    if (!S.next(0, cur)) return;
    f32x4 acc[2][2][4][2];
#pragma unroll
    for (int a = 0; a < 2; ++a)
#pragma unroll
        for (int b = 0; b < 2; ++b)
#pragma unroll
            for (int m = 0; m < 4; ++m)
#pragma unroll
                for (int n = 0; n < 2; ++n) acc[a][b][m][n] = (f32x4){0.f, 0.f, 0.f, 0.f};
    bf16x8 At[4][2], B0[2][2], B1[2][2];
    const char* cA = PG8_UA(cur); const char* cB = PG8_UB(cur);
    {
        PG8_STAGE(PG8_SB(0, 0), cB, voffB); PG8_STAGE(PG8_SB(0, 1), cB + hsB, voffB); PG8_STAGE(PG8_SA(0, 0), cA, voffA); PG8_STAGE(PG8_SA(0, 1), cA + hsA, voffA);
        if (wr == 1) PG8_BAR;
        PG8_WAIT_V(2); PG8_BAR;
        PG8_STAGE(PG8_SB(1, 0), cB + kstep, voffB); PG8_STAGE(PG8_SA(1, 0), cA + kstep, voffA); PG8_STAGE(PG8_SB(1, 1), cB + hsB + kstep, voffB);
        PG8_WAIT_V(6); PG8_BAR;
    }
    for (;;) {
        const bool has_next = S.next(ui + 1, nxt);
        const char* nA = has_next ? PG8_UA(nxt) : cA; const char* nB = has_next ? PG8_UB(nxt) : cB;
        for (int t = 0; t < nt; t += 2) {
            const bool last = (t == nt - 2);
            if constexpr (HOOK) { if (t == 4 || t == 8 || t == 12) { PG8_SCHED; E.rescale(acc, cur, (t >> 2) - 1, wr, wc, fr, fq); PG8_SCHED; } }
            const char* a1 = cA + (size_t)(t + 1) * kstep;
            const char* a2 = last ? nA : cA + (size_t)(t + 2) * kstep; const char* b2 = last ? nB : cB + (size_t)(t + 2) * kstep;
            const char* a3 = a2 + kstep; const char* b3 = b2 + kstep;
            PG8_LDB(B0, 0, 0); PG8_LDB(B1, 0, 1); PG8_SCHED; PG8_LDA(At, 0, 0); PG8_STAGE(PG8_SA(1, 1), a1 + hsA, voffA);
            PG8_WAIT_V(8); PG8_WAIT_L(0); PG8_BAR; PG8_MM2(0, At); PG8_BAR; PG8_SCHED;
            PG8_LDA(At, 0, 1); PG8_STAGE(PG8_SB(0, 0), b2, voffB); PG8_STAGE(PG8_SB(0, 1), b2 + hsB, voffB); PG8_STAGE(PG8_SA(0, 0), a2, voffA);
            PG8_WAIT_V(8); PG8_WAIT_L(0); PG8_BAR; PG8_MM2(1, At); PG8_BAR; PG8_SCHED;
            PG8_LDB(B0, 1, 0); PG8_LDB(B1, 1, 1); PG8_SCHED; PG8_LDA(At, 1, 0); PG8_STAGE(PG8_SA(0, 1), a2 + hsA, voffA);
            PG8_WAIT_V(8); PG8_WAIT_L(0); PG8_BAR; PG8_MM2(0, At); PG8_BAR; PG8_SCHED;
            PG8_LDA(At, 1, 1); PG8_STAGE(PG8_SB(1, 0), b3, voffB); PG8_STAGE(PG8_SB(1, 1), b3 + hsB, voffB); PG8_STAGE(PG8_SA(1, 0), a3, voffA);
            PG8_WAIT_V(8); PG8_WAIT_L(0); PG8_BAR; PG8_MM2(1, At); PG8_BAR; PG8_SCHED;
        }
        if (wr == 0) PG8_BAR;
        E(acc, cur, wr, wc, fr, fq);
        if (!has_next) break;
#pragma unroll
        for (int a = 0; a < 2; ++a)
#pragma unroll
            for (int b = 0; b < 2; ++b)
#pragma unroll
                for (int m = 0; m < 4; ++m)
#pragma unroll
                    for (int n = 0; n < 2; ++n) acc[a][b][m][n] = (f32x4){0.f, 0.f, 0.f, 0.f};
        cur = nxt; cA = nA; cB = nB; ++ui;
        if (wr == 1) PG8_BAR;
    }
    PG8_WAIT_V(0);
    PG8_BAR;
#undef PG8_SA
#undef PG8_SB
#undef PG8_STAGE
#undef PG8_LDA
#undef PG8_LDB
#undef PG8_MMA
#undef PG8_MMA1
#undef PG8_MMAZ
#undef PG8_MM2
#undef PG8_WAIT_V
#undef PG8_WAIT_L
#undef PG8_BAR
#undef PG8_SCHED
#undef PG8_UA
#undef PG8_UB
}
}

struct Args {
    const float* x; const float* c; const float* ctx; const float* c_ctx; const float* w_mod; const float* b_mod; const float* g_pre; const float* g_post;
    const float* w_gate; const float* w_up; const float* w_down; const float* w_in; const float* gqa_qn; const float* gqa_kn; const float* mla_qn; const float* mla_kvn;
    const float* w_uq; const float* w_ukv; const float* dlam; const float* dsub; const float* sink; const float* w_branch; const float* w_out;
    float* out; unsigned char* ws; int ph_lo, ph_hi;
};
typedef const __attribute__((address_space(4))) Args CArgs;

template <class F>
__device__ __forceinline__ void conv_item(bf16_t* WT, int K, int nblk, int item, LAS float* scr, int lane, const F& f) {
    const int kb = item / nblk, nb = item % nblk, k0 = 64 * kb, n0 = 32 * nb;
#pragma unroll 8
    for (int i = 0; i < 32; ++i) { const int kk = 2 * i + (lane >> 5); scr[kk * 33 + (lane & 31)] = f(n0 + (lane & 31), k0 + kk); }
    asm volatile("s_waitcnt lgkmcnt(0)" ::: "memory");
    const int c = lane & 7;
#pragma unroll
    for (int j = 0; j < 4; ++j) { const int n = (lane >> 3) + 8 * j; const LAS float* s = scr + (8 * c) * 33 + n;
        u32x4 o; o.x = pk2(s[0 * 33], s[1 * 33]); o.y = pk2(s[2 * 33], s[3 * 33]); o.z = pk2(s[4 * 33], s[5 * 33]); o.w = pk2(s[6 * 33], s[7 * 33]);
        *(u32x4*)(WT + (size_t)(n0 + n) * K + k0 + 8 * c) = o; }
    asm volatile("s_waitcnt lgkmcnt(0)" ::: "memory");
}

__device__ __forceinline__ void p0_phase(CArgs& a, LAS unsigned char* lds) {
    const int tid = ptid(), lane = tid & 63, wave = tid >> 6;
    float* MOD = (float*)(a.ws + WS_MOD);
    {
        LAS float* sl = (LAS float*)lds;
        LAS float* red = (LAS float*)(lds + 40960);
        for (int i = tid; i < 9 * 1024; i += 512) { const int r = i >> 10, k = i & 1023; const float v = r < 8 ? a.c[r * 1024 + k] : a.c_ctx[k]; sl[i] = v * sigmoidf_(v); }
        __syncthreads();
        for (int it = blockIdx.x; it < 2 * 144; it += gridDim.x) {
            const int l = it / 144, n0 = (it % 144) * 64;
            const float* W = a.w_mod + (size_t)l * 1024 * MODW + n0 + lane;
            float acc[9];
#pragma unroll
            for (int r = 0; r < 9; ++r) acc[r] = 0.f;
#pragma unroll 8
            for (int kk = 0; kk < 128; ++kk) { const int k = wave * 128 + kk; const float wv = W[(size_t)k * MODW];
#pragma unroll
                for (int r = 0; r < 9; ++r) acc[r] += sl[r * 1024 + k] * wv; }
#pragma unroll
            for (int r = 0; r < 9; ++r) red[(wave * 9 + r) * 64 + lane] = acc[r];
            __syncthreads();
            for (int i = tid; i < 9 * 64; i += 512) { const int r = i >> 6, cidx = i & 63; float s = a.b_mod[l * MODW + n0 + cidx];
#pragma unroll
                for (int w = 0; w < 8; ++w) s += red[(w * 9 + r) * 64 + cidx];
                MOD[((size_t)l * 9 + r) * MODW + n0 + cidx] = s; }
            __syncthreads();
        }
        __syncthreads();
    }
    LAS float* scr = (LAS float*)(lds + wave * 8448);
    const int gw = blockIdx.x * 8 + wave, NGW = gridDim.x * 8;
    constexpr int I_GU = 176 * 16, I_D = 32 * 44, I_IN = 72 * 16, I_G = 128 * 16, I_BR = 32 * 16, I_OUT = 32 * 16, I_MLA = 32 * 6;
    constexpr int I_LAYER = 2 * I_GU + 2 * I_D + I_IN + I_G + I_BR + I_OUT + I_MLA;
    for (int it = gw; it < 2 * I_LAYER; it += NGW) {
        const int l = it / I_LAYER; int r = it % I_LAYER;
        unsigned char* wb = a.ws + WS_W + (size_t)l * W_LAYER;
        if (r < 2 * I_GU) { const int s = r / I_GU; r %= I_GU;
            const float* wg = a.w_gate + (size_t)(l * 2 + s) * 1024 * DFF; const float* wu = a.w_up + (size_t)(l * 2 + s) * 1024 * DFF;
            conv_item((bf16_t*)(wb + W_GU + s * W_GU_SZ), 1024, 176, r, scr, lane, [=](int n, int k) { const int j = (n >> 8) * 128 + (n & 127); return ((n >> 7) & 1) ? wu[(size_t)k * DFF + j] : wg[(size_t)k * DFF + j]; });
            continue; }
        r -= 2 * I_GU;
        if (r < 2 * I_D) { const int s = r / I_D; r %= I_D;
            const float* wd = a.w_down + (size_t)(l * 2 + s) * DFF * 1024;
            conv_item((bf16_t*)(wb + W_D + s * W_D_SZ), DFF, 32, r, scr, lane, [=](int n, int k) { return wd[(size_t)k * 1024 + n]; });
            continue; }
        r -= 2 * I_D;
        const float* win = a.w_in + (size_t)l * 1024 * INCOLS;
        if (r < I_IN) { conv_item((bf16_t*)(wb + W_IN), 1024, 72, r, scr, lane, [=](int n, int k) { return n < GATE0 ? win[(size_t)k * INCOLS + n] : 0.f; }); continue; }
        r -= I_IN;
        if (r < I_G) { conv_item((bf16_t*)(wb + W_G), 1024, 128, r, scr, lane, [=](int n, int k) { return win[(size_t)k * INCOLS + GATE0 + n]; }); continue; }
        r -= I_G;
        if (r < I_BR) { const float* wbr = a.w_branch + (size_t)l * 4 * 256 * 1024;
            conv_item((bf16_t*)(wb + W_BR), 1024, 32, r, scr, lane, [=](int n, int k) { return wbr[(size_t)k * 1024 + n]; }); continue; }
        r -= I_BR;
        if (r < I_OUT) { const float* wo = a.w_out + (size_t)l * 1024 * 1024;
            conv_item((bf16_t*)(wb + W_OUT), 1024, 32, r, scr, lane, [=](int n, int k) { return wo[(size_t)k * 1024 + n]; }); continue; }
        r -= I_OUT;
        { const float* uq = a.w_uq + (size_t)l * 256 * 384; const float* ukv = a.w_ukv + (size_t)l * 128 * 512; const float* gq = a.mla_qn + l * 256; const float* gkv = a.mla_kvn + l * 128;
            conv_item((bf16_t*)(wb + W_MLA), 384, 32, r, scr, lane, [=](int n, int k) {
                float v = 0.f;
                if (n < 384) { if (k < 256) v = gq[k] * uq[(size_t)k * 384 + n]; }
                else if (n < 896) { if (k >= 256) v = gkv[k - 256] * ukv[(size_t)(k - 256) * 512 + (n - 384)]; }
                return v; }); }
    }
}

__device__ __forceinline__ void row_phase(CArgs& a, int l, bool first, const bf16_t* Y, int sub_y, float gscale, bf16_t* U, int sub_u, int l_u) {
    const int tid_ = ptid(); const int lane = tid_ & 63, wave = tid_ >> 6;
    const int gw = blockIdx.x * 8 + wave, NGW = gridDim.x * 8;
    const float* MOD = (const float*)(a.ws + WS_MOD);
    float* XC = (float*)(a.ws + WS_XC);
#pragma unroll 2
    for (int row = gw; row < R; row += NGW) {
        const int b = row / RPB, t = row % RPB; const bool isctx = t < CTX;
        const float* xs; float* xd;
        if (isctx) { const size_t o = (size_t)(b * CTX + t) * DM; xs = (first ? a.ctx : XC) + o; xd = XC + o; }
        else { const size_t o = (size_t)(b * SEQ + (t - CTX)) * DM; xs = (first ? a.x : a.out) + o; xd = a.out + o; }
        const int mrow = isctx ? 8 : b;
        f32x4 v[4];
#pragma unroll
        for (int j = 0; j < 4; ++j) v[j] = __builtin_nontemporal_load((const f32x4*)(xs + 4 * lane + 256 * j));
        if (Y) {
            const float* md = MOD + ((size_t)l * 9 + mrow) * MODW + (sub_y * 3 + 2) * 1024;
            const float* gp = a.g_post + (l * 3 + sub_y) * 1024;
            f32x4 y[4]; float ss = 0.f;
#pragma unroll
            for (int j = 0; j < 4; ++j) { const u32x2 w = __builtin_nontemporal_load((const u32x2*)(Y + (size_t)row * DM + 4 * lane + 256 * j));
                y[j] = (f32x4){bflo(w.x), bfhi(w.x), bflo(w.y), bfhi(w.y)}; ss += (y[j].x * y[j].x + y[j].y * y[j].y) + (y[j].z * y[j].z + y[j].w * y[j].w); }
            const float rs = __builtin_amdgcn_rsqf(wave_sum(ss) * (1.f / DM) + EPS) * gscale;
#pragma unroll
            for (int j = 0; j < 4; ++j) { const f32x4 g = *(const f32x4*)(md + 4 * lane + 256 * j), p = *(const f32x4*)(gp + 4 * lane + 256 * j);
                v[j] = v[j] + (y[j] * rs) * p * g; __builtin_nontemporal_store(v[j], (f32x4*)(xd + 4 * lane + 256 * j)); }
        }
        if (U) {
            const float* md = MOD + ((size_t)l_u * 9 + mrow) * MODW + (sub_u * 3) * 1024;
            const float* gp = a.g_pre + (l_u * 3 + sub_u) * 1024;
            float ss = 0.f;
#pragma unroll
            for (int j = 0; j < 4; ++j) ss += (v[j].x * v[j].x + v[j].y * v[j].y) + (v[j].z * v[j].z + v[j].w * v[j].w);
            const float rs = __builtin_amdgcn_rsqf(wave_sum(ss) * (1.f / DM) + EPS);
#pragma unroll
            for (int j = 0; j < 4; ++j) { const f32x4 sh = *(const f32x4*)(md + 4 * lane + 256 * j), sc = *(const f32x4*)(md + 1024 + 4 * lane + 256 * j), p = *(const f32x4*)(gp + 4 * lane + 256 * j);
                const f32x4 u = (v[j] * rs) * p * (sc + 1.f) + sh;
                u32x2 w; w.x = pk2(u.x, u.y); w.y = pk2(u.z, u.w);
                *(u32x2*)(U + (size_t)row * DM + 4 * lane + 256 * j) = w; }
        }
    }
}

constexpr int VSTR = 136;
constexpr int TAB_OFF = 768 * VSTR;
__device__ __forceinline__ void rope64p(float& v0, float& v1, int l, bool lat, const LAS float* tab, int prow, int pcol) {
    const float p0 = __shfl_xor(v0, 8), p1 = __shfl_xor(v1, 8);
    const int lh = l & 31, pos = (lh & 16) ? pcol : prow, i0 = (2 * lh) & 15;
    const f32x4 cs = *(const LAS f32x4*)(tab + (pos * 16 + i0) * 2);
    const bool sec = (lh >> 3) & 1;
    const float c0 = lat ? cs[0] : 1.f, s0 = lat ? (sec ? cs[1] : -cs[1]) : 0.f, c1 = lat ? cs[2] : 1.f, s1 = lat ? (sec ? cs[3] : -cs[3]) : 0.f;
    v0 = v0 * c0 + p0 * s0; v1 = v1 * c1 + p1 * s1;
}
__device__ __forceinline__ void rope32p(float& v0, float& v1, int d0, bool lat, const LAS float* tab, int prow, int pcol) {
    const float p0 = __shfl_xor(v0, 4), p1 = __shfl_xor(v1, 4);
    const int pos = (d0 & 16) ? pcol : prow, i0 = d0 & 7;
    const LAS float* t = tab + (pos * 16 + 2 * i0) * 2;
    const bool sec = (d0 >> 3) & 1;
    const float c0 = lat ? t[0] : 1.f, s0 = lat ? (sec ? t[1] : -t[1]) : 0.f, c1 = lat ? t[4] : 1.f, s1 = lat ? (sec ? t[5] : -t[5]) : 0.f;
    v0 = v0 * c0 + p0 * s0; v1 = v1 * c1 + p1 * s1;
}
__device__ __forceinline__ float half_sum(float v) {
#pragma unroll
    for (int o = 1; o < 32; o <<= 1) v += __shfl_xor(v, o);
    return v;
}
__device__ __forceinline__ void prep_phase(CArgs& a, int l, LAS unsigned char* lds) {
    const int tid = ptid(), lane = tid & 63, wave = __builtin_amdgcn_readfirstlane(tid >> 6);
    bf16_t* HIN = (bf16_t*)(a.ws + WS_BIG); bf16_t* MUP = (bf16_t*)(a.ws + WS_Y); bf16_t* VT = (bf16_t*)(a.ws + WS_VT);
    LAS float* tab = (LAS float*)(lds + TAB_OFF);
    for (int i = tid; i < 128 * 16; i += 512) { const int pos = i >> 4, f = i & 15;
        const float invf = fexp2(-(float)(2 * f) * (1.f / 32.f) * 13.287712379549449f);
        float rev = (float)pos * invf * 0.15915494309189535f; rev -= __builtin_floorf(rev);
        tab[i * 2] = __builtin_amdgcn_cosf(rev); tab[i * 2 + 1] = __builtin_amdgcn_sinf(rev); }
    __syncthreads();
    const int lh = lane & 31;
    const float gq0 = a.gqa_qn[l * 64 + 2 * lh], gq1 = a.gqa_qn[l * 64 + 2 * lh + 1], gk0 = a.gqa_kn[l * 64 + 2 * lh], gk1 = a.gqa_kn[l * 64 + 2 * lh + 1];
#define LD2(p, v0, v1) do { const unsigned w_ = *(const unsigned*)(p); v0 = bflo(w_); v1 = bfhi(w_); } while (0)
#define ST2(p, v0, v1) do { *(unsigned*)(p) = pg8::cvt_pk_bf16(v0, v1); } while (0)
    for (int tile = blockIdx.x; tile < R / 64; tile += gridDim.x) {
        const int row0 = tile * 64, b = row0 / RPB, t0 = row0 % RPB;
#pragma unroll 4
        for (int rr = 0; rr < 8; ++rr) {
            const int tk = wave * 8 + rr, row = row0 + tk, t = t0 + tk; const bool lat = t >= CTX;
            const int tl = lat ? t - CTX : 0, prow = tl >> 6, pcol = tl & 63;
            bf16_t* __restrict__ h = HIN + (size_t)row * NHIN; bf16_t* __restrict__ mu = MUP + (size_t)row * 1024;
            LAS bf16_t* vst = (LAS bf16_t*)lds + tk;
#pragma unroll
            for (int j = 0; j < 3; ++j) { float v0, v1; LD2(h + 128 * j + 2 * lane, v0, v1);
                const float rs = __builtin_amdgcn_rsqf(half_sum(v0 * v0 + v1 * v1) * (1.f / 64.f) + EPS);
                v0 = v0 * rs * (j < 2 ? gq0 : gk0); v1 = v1 * rs * (j < 2 ? gq1 : gk1);
                rope64p(v0, v1, lane, lat, tab, prow, pcol);
                if (j < 2) { v0 *= QS_GQA; v1 *= QS_GQA; }
                ST2(h + 128 * j + 2 * lane, v0, v1); }
            { const unsigned w = *(const unsigned*)(h + 384 + 2 * lane); vst[(0 + 2 * lane) * (VSTR / 2)] = (bf16_t)(w & 0xffffu); vst[(0 + 2 * lane + 1) * (VSTR / 2)] = (bf16_t)(w >> 16); }
            float sq = 0.f, skv = 0.f;
#pragma unroll
            for (int j = 0; j < 2; ++j) { float v0, v1; LD2(h + 512 + 128 * j + 2 * lane, v0, v1); sq += v0 * v0 + v1 * v1; }
            { float v0, v1; LD2(h + 768 + 2 * lane, v0, v1); skv = v0 * v0 + v1 * v1; }
            const float rq = __builtin_amdgcn_rsqf(wave_sum(sq) * (1.f / 256.f) + EPS) * QS_MLA, rkv = __builtin_amdgcn_rsqf(wave_sum(skv) * (1.f / 128.f) + EPS);
#pragma unroll
            for (int j = 0; j < 3; ++j) { const int c = 128 * j + 2 * lane, e = c % 96; float v0, v1; LD2(mu + c, v0, v1); v0 *= rq; v1 *= rq;
                float r0 = v0, r1 = v1; rope32p(r0, r1, (e - 64) & 30, lat, tab, prow, pcol);
                if (e >= 64) { v0 = r0; v1 = r1; }
                ST2(mu + c, v0, v1); }
#pragma unroll
            for (int hh = 0; hh < 4; ++hh) { const int c = 384 + 128 * hh + 2 * lane; float v0, v1; LD2(mu + c, v0, v1); v0 *= rkv; v1 *= rkv;
                const unsigned w = pg8::cvt_pk_bf16(v0, v1);
                if (lane < 32) *(unsigned*)(mu + c) = w;
                else { vst[(128 + 64 * hh + 2 * (lane - 32)) * (VSTR / 2)] = (bf16_t)(w & 0xffffu); vst[(128 + 64 * hh + 2 * (lane - 32) + 1) * (VSTR / 2)] = (bf16_t)(w >> 16); } }
            { float v0, v1; LD2(h + 896 + 2 * (lane & 15), v0, v1); rope32p(v0, v1, 2 * (lane & 15), lat, tab, prow, pcol); if (lane < 16) ST2(mu + 896 + 2 * lane, v0, v1); }
#pragma unroll
            for (int j = 0; j < 4; ++j) { float v0, v1; LD2(h + 928 + 128 * j + 2 * lane, v0, v1); rope32p(v0, v1, (2 * lane) & 31, lat, tab, prow, pcol);
                if (j < 2) { v0 *= QS_DIFF; v1 *= QS_DIFF; }
                ST2(h + 928 + 128 * j + 2 * lane, v0, v1); }
#pragma unroll
            for (int j = 0; j < 2; ++j) { const unsigned w = *(const unsigned*)(h + 1440 + 128 * j + 2 * lane); vst[(384 + 128 * j + 2 * lane) * (VSTR / 2)] = (bf16_t)(w & 0xffffu); vst[(384 + 128 * j + 2 * lane + 1) * (VSTR / 2)] = (bf16_t)(w >> 16); }
#pragma unroll
            for (int j = 0; j < 3; ++j) { float v0, v1; LD2(h + 1696 + 128 * j + 2 * lane, v0, v1); rope64p(v0, v1, lane, lat, tab, prow, pcol);
                if (j < 2) { v0 *= QS_GQA; v1 *= QS_GQA; }
                ST2(h + 1696 + 128 * j + 2 * lane, v0, v1); }
            { const unsigned w = *(const unsigned*)(h + 2080 + 2 * lane); vst[(640 + 2 * lane) * (VSTR / 2)] = (bf16_t)(w & 0xffffu); vst[(640 + 2 * lane + 1) * (VSTR / 2)] = (bf16_t)(w >> 16); }
        }
#undef LD2
#undef ST2
        __syncthreads();
        bf16_t* vt = VT + (size_t)b * 768 * RPB + t0;
        for (int p = tid; p < 768 * 8; p += 512) { const int vr = p >> 3, seg = p & 7;
            const LAS u32x2* s = (const LAS u32x2*)(lds + vr * VSTR + seg * 16); const u32x2 lo = s[0], hi = s[1];
            *(u32x4*)(vt + (size_t)vr * RPB + seg * 8) = (u32x4){lo.x, lo.y, hi.x, hi.y}; }
        __syncthreads();
    }
}

__device__ __forceinline__ int crow(int r, int hi) { return (r & 3) + 8 * (r >> 2) + 4 * hi; }
constexpr int AT_KBUF = 128 * (96 * 2 + 16);
constexpr int AT_VSTR = 264, AT_VBUF = 64 * AT_VSTR;
constexpr int AT_K0 = 0, AT_V0 = 2 * AT_KBUF, AT_WS = AT_V0 + 2 * AT_VBUF;

struct AttnSrc { const bf16_t* Q; int ldq; const bf16_t* K1; int ldk1; const bf16_t* K2; int ldk2; const bf16_t* VT; };

template <int DQK, bool WIN>
__device__ __forceinline__ void attn_pass(const AttnSrc& s, int NT, int lo, int q0lat, float sink_l2, bool has_sink, LAS unsigned char* lds, f32x16 (&o)[2]) {
    constexpr int KSTR = DQK * 2 + 16, NCH = DQK / 8, NKS = DQK / 16, NP = (128 * NCH) / 512;
    const int tid = ptid(), lane = tid & 63, r32 = lane & 31, hi = lane >> 5; const int wid = __builtin_amdgcn_readfirstlane(tid >> 6);
    LAS float* wsf = (LAS float*)(lds + AT_WS) + wid * 32;
    bf16x8 qf[NKS];
    { const bf16_t* qp = s.Q + (size_t)(wid * 32 + r32) * s.ldq + 8 * hi;
#pragma unroll
        for (int ks = 0; ks < NKS; ++ks) qf[ks] = *(const bf16x8*)(qp + 16 * ks); }
    o[0] = (f32x16){}; o[1] = (f32x16){};
    f32x16 negm = (f32x16){}; asm volatile("" : "+v"(negm));
    float mhat = 0.f, lsum = 0.f;
    const int NT2 = NT >> 1, lo2 = lo >> 1;
    u32x4 kr[NP], vr[2];
    auto kaddr = [&](int key, int c) -> const bf16_t* { return (DQK == 96 && c >= 8) ? s.K2 + (size_t)key * s.ldk2 + (c - 8) * 8 : s.K1 + (size_t)key * s.ldk1 + c * 8; };
#define AT_TILE(j) ((j) < 2 ? (j) : lo2 - 2 + (j))
#define AT_GLOAD(j) do { const int key0_ = AT_TILE(j) * 128; \
        _Pragma("unroll") for (int p = 0; p < NP; ++p) { const int idx_ = tid + 512 * p; kr[p] = *(const u32x4*)kaddr(key0_ + idx_ / NCH, idx_ % NCH); } \
        _Pragma("unroll") for (int p = 0; p < 2; ++p) { const int idx_ = tid + 512 * p; vr[p] = *(const u32x4*)(s.VT + (size_t)(idx_ >> 4) * RPB + key0_ + (idx_ & 15) * 8); } } while (0)
#define AT_LSTORE(buf) do { \
        _Pragma("unroll") for (int p = 0; p < NP; ++p) { const int idx_ = tid + 512 * p; *(LAS u32x4*)(lds + AT_K0 + (buf) * AT_KBUF + (idx_ / NCH) * KSTR + (idx_ % NCH) * 16) = kr[p]; } \
        _Pragma("unroll") for (int p = 0; p < 2; ++p) { const int idx_ = tid + 512 * p; LAS u32x2* vd_ = (LAS u32x2*)(lds + AT_V0 + (buf) * AT_VBUF + (idx_ >> 4) * AT_VSTR + (idx_ & 15) * 16); vd_[0] = (u32x2){vr[p].x, vr[p].y}; vd_[1] = (u32x2){vr[p].z, vr[p].w}; } } while (0)
#define MX3(a, b, c) __builtin_fmaxf(__builtin_fmaxf((a), (b)), (c))
    AT_GLOAD(0); AT_LSTORE(0);
    if (NT2 > 1) AT_GLOAD(1);
    __syncthreads();
    for (int j = 0; j < NT2; ++j) {
        const int buf = j & 1;
        f32x16 sA0, sA1, sB0, sB1;
#define AT_QK(S0, S1, sub) do { const LAS unsigned char* kb = lds + AT_K0 + buf * AT_KBUF + ((sub) * 64 + r32) * KSTR + hi * 16; \
        _Pragma("unroll") for (int ks = 0; ks < NKS; ++ks) { \
            const bf16x8 a0 = *(const LAS bf16x8*)(kb + ks * 32), a1 = *(const LAS bf16x8*)(kb + 32 * KSTR + ks * 32); \
            if (ks == 0) { S0 = __builtin_amdgcn_mfma_f32_32x32x16_bf16(a0, qf[0], negm, 0, 0, 0); S1 = __builtin_amdgcn_mfma_f32_32x32x16_bf16(a1, qf[0], negm, 0, 0, 0); } \
            else { S0 = __builtin_amdgcn_mfma_f32_32x32x16_bf16(a0, qf[ks], S0, 0, 0, 0); S1 = __builtin_amdgcn_mfma_f32_32x32x16_bf16(a1, qf[ks], S1, 0, 0, 0); } } } while (0)
#define AT_SOFT(s0, s1, u0, u1, sub, HASNEXT) do { \
        if (WIN && j >= 2) { \
            const int jb = AT_TILE(j) * 128 + (sub) * 64 - CTX + 4 * hi, qi = q0lat + wid * 32 + r32; \
            _Pragma("unroll") for (int r = 0; r < 16; ++r) { const int jj = jb + (r & 3) + 8 * (r >> 2); const int d0 = qi - jj, d1 = qi - (jj + 32); \
                if (d0 > 128 || d0 < -128) s0[r] = -1e30f; if (d1 > 128 || d1 < -128) s1[r] = -1e30f; } } \
        float ra = MX3(s0[0], s0[1], s1[0]), rb = MX3(s0[2], s0[3], s1[1]); ra = MX3(ra, s1[2], s1[3]); \
        _Pragma("unroll") for (int r = 4; r < 16; r += 4) { ra = MX3(ra, s0[r], s0[r + 1]); rb = MX3(rb, s0[r + 2], s0[r + 3]); ra = MX3(ra, s1[r], s1[r + 1]); rb = MX3(rb, s1[r + 2], s1[r + 3]); } \
        float rm = __builtin_fmaxf(ra, rb); rm = __builtin_fmaxf(rm, __shfl_xor(rm, 32)); \
        const bool first = (j == 0) && ((sub) == 0); \
        if (first || __any(rm > 8.f)) { float dl = first ? rm : __builtin_fmaxf(rm, 0.f); asm volatile("" : "+v"(dl));     \
            mhat += dl; \
            _Pragma("unroll") for (int r = 0; r < 16; ++r) { s0[r] -= dl; s1[r] -= dl; } \
            if (HASNEXT) { _Pragma("unroll") for (int r = 0; r < 16; ++r) { u0[r] -= dl; u1[r] -= dl; } }     \
            _Pragma("unroll") for (int r = 0; r < 16; ++r) negm[r] = -mhat; \
            asm volatile("" : "+v"(negm)); \
            if (!first) { const float f = fexp2(-dl); lsum *= f; if (hi == 0) wsf[r32] = f; \
                _Pragma("unroll") for (int r = 0; r < 16; ++r) { const float fr_ = wsf[crow(r, hi)]; o[0][r] *= fr_; o[1][r] *= fr_; } } } \
        _Pragma("unroll") for (int r = 0; r < 16; ++r) { s0[r] = fexp2(s0[r]); s1[r] = fexp2(s1[r]); } \
        { float ps = s0[0];     \
          _Pragma("unroll") for (int r = 1; r < 16; ++r) ps += s0[r]; \
          _Pragma("unroll") for (int r = 0; r < 16; ++r) ps += s1[r]; \
          lsum += ps; } \
        bf16x8 pa[4]; \
        _Pragma("unroll") for (int kk = 0; kk < 2; ++kk) { u32x4 w; \
            w.x = pg8::cvt_pk_bf16(s0[8 * kk + 0], s0[8 * kk + 1]); w.y = pg8::cvt_pk_bf16(s0[8 * kk + 2], s0[8 * kk + 3]); w.z = pg8::cvt_pk_bf16(s0[8 * kk + 4], s0[8 * kk + 5]); w.w = pg8::cvt_pk_bf16(s0[8 * kk + 6], s0[8 * kk + 7]); pa[kk] = __builtin_bit_cast(bf16x8, w); \
            w.x = pg8::cvt_pk_bf16(s1[8 * kk + 0], s1[8 * kk + 1]); w.y = pg8::cvt_pk_bf16(s1[8 * kk + 2], s1[8 * kk + 3]); w.z = pg8::cvt_pk_bf16(s1[8 * kk + 4], s1[8 * kk + 5]); w.w = pg8::cvt_pk_bf16(s1[8 * kk + 6], s1[8 * kk + 7]); pa[2 + kk] = __builtin_bit_cast(bf16x8, w); } \
        const LAS unsigned char* vb = lds + AT_V0 + buf * AT_VBUF + r32 * AT_VSTR + (sub) * 128 + hi * 8; \
        _Pragma("unroll") for (int dvb = 0; dvb < 2; ++dvb) _Pragma("unroll") for (int kk = 0; kk < 4; ++kk) { \
                const u32x2 lo_ = *(const LAS u32x2*)(vb + dvb * 32 * AT_VSTR + kk * 32), hi_ = *(const LAS u32x2*)(vb + dvb * 32 * AT_VSTR + kk * 32 + 16); \
                const bf16x8 bv = __builtin_bit_cast(bf16x8, (u32x4){lo_.x, lo_.y, hi_.x, hi_.y}); \
                o[dvb] = __builtin_amdgcn_mfma_f32_32x32x16_bf16(pa[kk], bv, o[dvb], 0, 0, 0); } } while (0)
        AT_QK(sA0, sA1, 0); AT_QK(sB0, sB1, 1);
        AT_SOFT(sA0, sA1, sB0, sB1, 0, true);
        AT_SOFT(sB0, sB1, sA0, sA1, 1, false);
#undef AT_QK
#undef AT_SOFT
        if (j + 1 < NT2) AT_LSTORE(buf ^ 1);
        __syncthreads();
        if (j + 2 < NT2) AT_GLOAD(j + 2);
    }
    float lt = lsum + __shfl_xor(lsum, 32);
    if (has_sink) lt += fexp2(sink_l2 - mhat);
    if (hi == 0) wsf[r32] = frcp(lt);
#pragma unroll
    for (int r = 0; r < 16; ++r) { const float fr_ = wsf[crow(r, hi)]; o[0][r] *= fr_; o[1][r] *= fr_; }
#undef AT_TILE
#undef AT_GLOAD
#undef AT_LSTORE
#undef MX3
}

__device__ __forceinline__ void attn_store(bf16_t* O, int row0, int col0, const f32x16 (&o)[2]) {
    const int tid_ = ptid(); const int lane = tid_ & 63, r32 = lane & 31, hi = lane >> 5, wid = tid_ >> 6;
#pragma unroll
    for (int dvb = 0; dvb < 2; ++dvb)
#pragma unroll
        for (int r = 0; r < 16; ++r) O[(size_t)(row0 + wid * 32 + crow(r, hi)) * 1024 + col0 + dvb * 32 + r32] = (bf16_t)f2bf(o[dvb][r]);
}

__device__ __forceinline__ void attn_unit(CArgs& a, int l, int branch, int b, int h, int qb, float lam, float lam_init, LAS unsigned char* lds) {
    const bf16_t* HIN = (const bf16_t*)(a.ws + WS_BIG) + (size_t)b * RPB * NHIN; const bf16_t* MUP = (const bf16_t*)(a.ws + WS_Y) + (size_t)b * RPB * 1024;
    const bf16_t* VT = (const bf16_t*)(a.ws + WS_VT) + (size_t)b * 768 * RPB; bf16_t* OUTS = (bf16_t*)(a.ws + WS_OUTS);
    const bool cq = qb < 0; const int qrow = cq ? 0 : CTX + 256 * qb;
    const int NTd = cq ? 4 : 132;
    const int orow0 = b * RPB + qrow;
    f32x16 o[2];
    AttnSrc s;
    if (branch == 0) {
        s.Q = HIN + (size_t)qrow * NHIN + 64 * h; s.ldq = NHIN; s.K1 = HIN + 256 + 64 * (h >> 1); s.ldk1 = NHIN; s.K2 = nullptr; s.ldk2 = 0; s.VT = VT + (size_t)(0 + 64 * (h >> 1)) * RPB;
        attn_pass<64, false>(s, NTd, 4, 0, 0.f, false, lds, o);
        attn_store(OUTS, orow0, 0 + 64 * h, o);
    } else if (branch == 1) {
        s.Q = MUP + (size_t)qrow * 1024 + 96 * h; s.ldq = 1024; s.K1 = MUP + 384 + 128 * h; s.ldk1 = 1024; s.K2 = MUP + 896; s.ldk2 = 1024; s.VT = VT + (size_t)(128 + 64 * h) * RPB;
        attn_pass<96, false>(s, NTd, 4, 0, 0.f, false, lds, o);
        attn_store(OUTS, orow0, 256 + 64 * h, o);
    } else if (branch == 2) {
        f32x16 o2[2];
        s.Q = HIN + (size_t)qrow * NHIN + 928 + 64 * h; s.ldq = NHIN; s.K1 = HIN + 1184 + 64 * h; s.ldk1 = NHIN; s.K2 = nullptr; s.ldk2 = 0; s.VT = VT + (size_t)(384 + 64 * h) * RPB;
        attn_pass<32, false>(s, NTd, 4, 0, 0.f, false, lds, o);
        s.Q += 32; s.K1 += 32;
        attn_pass<32, false>(s, NTd, 4, 0, 0.f, false, lds, o2);
        const int lane = ptid() & 63, r32 = lane & 31;
        const float g0 = a.dsub[l * 64 + r32] * (1.f - lam_init), g1 = a.dsub[l * 64 + 32 + r32] * (1.f - lam_init);
#pragma unroll
        for (int r = 0; r < 16; ++r) { const float x0 = o[0][r] - lam * o2[0][r], x1 = o[1][r] - lam * o2[1][r];
            float ss = x0 * x0 + x1 * x1;
#pragma unroll
            for (int m = 1; m < 32; m <<= 1) ss += __shfl_xor(ss, m);
            const float rs = __builtin_amdgcn_rsqf(ss * (1.f / 64.f) + EPS);
            o[0][r] = x0 * rs * g0; o[1][r] = x1 * rs * g1; }
        attn_store(OUTS, orow0, 512 + 64 * h, o);
    } else {
        s.Q = HIN + (size_t)qrow * NHIN + 1696 + 64 * h; s.ldq = NHIN; s.K1 = HIN + 1952 + 64 * (h >> 1); s.ldk1 = NHIN; s.K2 = nullptr; s.ldk2 = 0; s.VT = VT + (size_t)(640 + 64 * (h >> 1)) * RPB;
        const float sk = a.sink[l * 4 + h] * LOG2E;
        if (cq) attn_pass<64, false>(s, 4, 4, 0, sk, true, lds, o);
        else { const int q0 = 256 * qb; const int lo = 4 + (q0 >= 128 ? q0 - 128 : 0) / 64, hiT = 4 + ((q0 + 384) < SEQ ? (q0 + 384) : SEQ) / 64;
            attn_pass<64, true>(s, 4 + hiT - lo, lo, q0, sk, true, lds, o); }
        attn_store(OUTS, orow0, 768 + 64 * h, o);
    }
}

__device__ __forceinline__ void attn_phase(CArgs& a, int l, LAS unsigned char* lds) {
    const float lam_init = 0.8f - 0.6f * __expf(-0.3f * (float)l);
    float lam;
    { const float* dl = a.dlam + l * 128; float s1 = 0.f, s2 = 0.f;
        for (int i = 0; i < 32; ++i) { s1 += dl[i] * dl[32 + i]; s2 += dl[64 + i] * dl[96 + i]; }
        lam = __expf(s1) - __expf(s2) + lam_init; }
    const int G = gridDim.x, bx = blockIdx.x;
    const int vcu = (G % 8 == 0) ? (bx % 8) * (G / 8) + bx / 8 : bx;
    for (int ty = 0; ty < 4; ++ty) {
        const int branch = ty == 0 ? 2 : ty == 1 ? 1 : ty == 2 ? 0 : 3;
        for (int idx = vcu; idx < NB * 4 * 32; idx += G) { const int bh = idx >> 5, qb = idx & 31; attn_unit(a, l, branch, bh >> 2, bh & 3, qb, lam, lam_init, lds); }
    }
    for (int idx = vcu; idx < NB * 16; idx += G) attn_unit(a, l, (idx >> 2) & 3, idx >> 4, idx & 3, -1, lam, lam_init, lds);
}

#define GAS __attribute__((address_space(1)))
#define XB_TMO      128
#define XB_XCNT(j)  (256  + 64 * (j))
#define XB_XSUB(j)  (1280 + 64 * (j))
#define XB_XGEN(j)  (2304 + 64 * (j))
#define XB_TOP      3328
#define XB_TOPGEN   3392
#define XCD_BAR_WORDS 3456
#define XB_SPIN_CAP (1u << 18)

__device__ __forceinline__ unsigned xb_ld(unsigned* p)              { return __hip_atomic_load(p, __ATOMIC_RELAXED, __HIP_MEMORY_SCOPE_AGENT); }
__device__ __forceinline__ unsigned xb_add(unsigned* p, unsigned v) { return __hip_atomic_fetch_add(p, v, __ATOMIC_RELAXED, __HIP_MEMORY_SCOPE_AGENT); }
__device__ __forceinline__ unsigned xb_xcc_id() { return (unsigned)__builtin_amdgcn_s_getreg((3 << 11) | 20) & 0xFu; }
#define XB_SPIN(cond, bar) do { unsigned _sp = 0; while (cond) { __builtin_amdgcn_s_sleep(1); \
    if ((++_sp & 255u) == 0u) { if (xb_ld(&(bar)[XB_TMO])) break; if (_sp > XB_SPIN_CAP) { atomicAdd(&(bar)[XB_TMO], 1u); break; } } } } while (0)

struct XcdBarrier {
    unsigned* bar; unsigned x;
    volatile LAS unsigned* st;
};

__device__ __forceinline__ XcdBarrier xcd_barrier_post(unsigned* bar, volatile LAS unsigned* st) {
    XcdBarrier b; b.bar = bar; b.x = xb_xcc_id(); b.st = st;
    if (threadIdx.x == 0) (void)xb_add(&bar[XB_XCNT(b.x)], 1u);
    return b;
}
__device__ __forceinline__ void xcd_barrier_complete(unsigned* bar, unsigned x, unsigned& nloc, unsigned& nx) {
    const unsigned G = gridDim.x * gridDim.y * gridDim.z;
    unsigned sum, cnt, mine, sp = 0u;
    for (;;) {
        sum = 0u; cnt = 0u; mine = 0u;
#pragma unroll
        for (unsigned j = 0; j < 16; ++j) { const unsigned c = xb_ld(&bar[XB_XCNT(j)]); sum += c; cnt += (c > 0u) ? 1u : 0u; mine = (j == x) ? c : mine; }
        if (sum == G) break;
        __builtin_amdgcn_s_sleep(1);
        if ((++sp & 255u) == 0u) { if (xb_ld(&bar[XB_TMO])) break; if (sp > XB_SPIN_CAP) { atomicAdd(&bar[XB_TMO], 1u); break; } }
    }
    nloc = mine > 0u ? mine : 1u; nx = cnt > 0u ? cnt : 1u;
}

__device__ __forceinline__ void xcd_barrier(const XcdBarrier& b) {
    asm volatile("s_waitcnt vmcnt(0)" ::: "memory");
    __syncthreads();
    if (threadIdx.x == 0) {
        unsigned* bar = b.bar;
        __builtin_amdgcn_s_waitcnt(0);
        unsigned nloc = b.st[0], nx = b.st[1];
        if (nloc == 0u) { xcd_barrier_complete(bar, b.x, nloc, nx); b.st[0] = nloc; b.st[1] = nx; }
        const unsigned old = xb_add(&bar[XB_XSUB(b.x)], 1u);
        const unsigned gen = old / nloc;
        if (old + 1u == (gen + 1u) * nloc) {
            __builtin_amdgcn_fence(__ATOMIC_RELEASE, "agent");
            asm volatile("s_waitcnt vmcnt(0)" ::: "memory");
            const unsigned og = xb_add(&bar[XB_TOP], 1u);
            const unsigned tg = og / nx;
            if (og + 1u == (tg + 1u) * nx) xb_add(&bar[XB_TOPGEN], 1u);
            else XB_SPIN(xb_ld(&bar[XB_TOPGEN]) == tg, bar);
            __builtin_amdgcn_fence(__ATOMIC_ACQUIRE, "agent");
            xb_add(&bar[XB_XGEN(b.x)], 1u);
            asm volatile("s_waitcnt vmcnt(0)" ::: "memory");
        } else {
            XB_SPIN(xb_ld(&bar[XB_XGEN(b.x)]) == gen, bar);
            __builtin_amdgcn_fence(__ATOMIC_ACQUIRE, "agent");
            asm volatile("s_waitcnt vmcnt(0)" ::: "memory");
        }
    }
    __syncthreads();
}


constexpr int NPHASE = 2 + 32;
__global__ void __launch_bounds__(512, 2) fwd_kernel(Args a_) {
    extern __shared__ __attribute__((aligned(16))) unsigned char lds_raw[];
    LAS unsigned char* lds = (LAS unsigned char*)lds_raw;
    cg::grid_group grid = cg::this_grid();
    const int lo = a_.ph_lo, hi = a_.ph_hi < NPHASE ? a_.ph_hi : NPHASE;
    { volatile LAS unsigned* st0 = (volatile LAS unsigned*)(lds + LDS_BARST); if (threadIdx.x < 2) st0[threadIdx.x] = 0u; }
    __syncthreads();
    { XcdBarrier b0 = xcd_barrier_post((unsigned*)(a_.ws + WS_BAR), (volatile LAS unsigned*)(lds + LDS_BARST)); (void)b0; }
    for (int ph = lo; ph < hi; ++ph) {
        CArgs* ap_ = (CArgs*)__builtin_amdgcn_kernarg_segment_ptr(); asm volatile("" : "+s"(ap_) :: "memory"); CArgs& a = *ap_;
        int G = gridDim.x, bx = blockIdx.x; asm volatile("" : "+s"(G), "+s"(bx));
        if (ph == 0) p0_phase(a, lds);
        else if (ph == 1) row_phase(a, 0, true, nullptr, 0, 0.f, (bf16_t*)(a.ws + WS_U), 0, 0);
        else {
            const int l = (ph - 2) / 16, k = (ph - 2) % 16;
            unsigned char* ws = a.ws;
            const unsigned char* wb = ws + WS_W + (size_t)l * W_LAYER;
            bf16_t* U = (bf16_t*)(ws + WS_U); bf16_t* Yb = (bf16_t*)(ws + WS_Y); bf16_t* BIG = (bf16_t*)(ws + WS_BIG);
            if (k == 5) prep_phase(a, l, lds);
#ifndef X_ATTN
            else if (k == 6) attn_phase(a, l, lds);
#endif
            else if (k == 2) row_phase(a, l, l == 0, Yb, 0, 0.5f, U, 1, l);
            else if (k == 12) row_phase(a, l, false, BIG, 1, 1.0f, U, 2, l);
            else if (k == 15) row_phase(a, l, false, Yb, 2, 0.5f, l == 0 ? U : nullptr, 0, l + 1);
            else {
                pg8::Gemm g; pg8::Epi E; int N; int dual = 0; int Mrows = R;
                g.A2 = nullptr; g.Bt2 = nullptr; E.scr = nullptr;
                if (k == 0 || k == 13) { const int s = k == 13; g.A = U; g.Bt = (const bf16_t*)(wb + W_GU + s * W_GU_SZ); g.lda = 1024; g.ldb = 1024; g.K = 1024; N = 5632; E.mode = 1; E.O = BIG; E.ldc = DFF; }
                else if (k == 1 || k == 14) { const int s = k == 14; g.A = BIG; g.Bt = (const bf16_t*)(wb + W_D + s * W_D_SZ); g.lda = DFF; g.ldb = DFF; g.K = DFF; N = 1024; E.mode = 0; E.O = Yb; E.ldc = 1024; }
                else if (k == 3) { g.A = U; g.Bt = (const bf16_t*)(wb + W_IN); g.lda = 1024; g.ldb = 1024; g.K = 1024; N = NHIN; E.mode = 0; E.O = BIG; E.ldc = NHIN; }
                else if (k == 4) { g.A = BIG + 512; g.Bt = (const bf16_t*)(wb + W_MLA); g.lda = NHIN; g.ldb = 384; g.K = 384; N = 1024; E.mode = 0; E.O = Yb; E.ldc = 1024; }
                else if (k == 7 || k == 9) { size_t ro = (size_t)(k == 9) * 32768 * 1024; Mrows = (k == 9) ? R - 32768 : 32768; if (l == 1) { ro = (size_t)(k == 9) * 33792 * 1024; Mrows = 32768; dual = 1; }
                    g.A = U + ro; g.Bt = (const bf16_t*)(wb + W_G); g.lda = 1024; g.ldb = 1024; g.K = 1024; N = 4096; E.mode = 3; E.O = BIG; E.ldc = 4096; }
                else if (k == 8 || k == 10) { size_t ro = (size_t)(k == 10) * 32768 * 1024; Mrows = (k == 10) ? R - 32768 : 32768; if (l == 1) { ro = (size_t)(k == 10) * 33792 * 1024; Mrows = 32768; dual = 1; }
                    g.A = (const bf16_t*)(ws + WS_OUTS) + ro; g.Bt = (const bf16_t*)(wb + W_BR); g.lda = 1024; g.ldb = 1024; g.K = 1024; N = 1024; E.mode = 4; E.O = Yb + ro; E.ldc = 1024; E.scr = (u32x4*)BIG; }
                else { g.A = Yb; g.Bt = (const bf16_t*)(wb + W_OUT); g.lda = 1024; g.ldb = 1024; g.K = 1024; N = 1024; E.mode = 0; E.O = BIG; E.ldc = 1024; }
                if (l == 1 && (k == 11 || k == 13 || k == 14)) { dual = 1; Mrows = 65536; }
                pg8::StaticOrder S; S.init(Mrows, N, G, bx, dual);
                if (k == 8 || k == 10) pg8::gemm_phase<true>(lds, g, S, E); else pg8::gemm_phase<false>(lds, g, S, E);
            }
        }
        if (ph + 1 < hi) {
            if (ph == lo) {
                asm volatile("s_waitcnt vmcnt(0) lgkmcnt(0)" ::: "memory");
                __syncthreads();
                if (ptid() < 64) { __builtin_amdgcn_fence(__ATOMIC_RELEASE, "agent"); asm volatile("s_waitcnt vmcnt(0)" ::: "memory"); }
                grid.sync();
                __builtin_amdgcn_fence(__ATOMIC_ACQUIRE, "agent");
                asm volatile("s_waitcnt vmcnt(0)" ::: "memory");
            } else {
                XcdBarrier bar; bar.bar = (unsigned*)(a.ws + WS_BAR); bar.x = xb_xcc_id(); bar.st = (volatile LAS unsigned*)(lds + LDS_BARST);
                xcd_barrier(bar);
            }
        }
    }
}

extern "C" void kernel_launch(void* const* d_in, const int* in_sizes, int n_in, void* d_out, int out_size, void* d_ws, size_t ws_size, hipStream_t stream) {
    static int grid = 0;
    if (grid == 0) {
        int dev = 0, cus = 0;
        if (hipGetDevice(&dev) != hipSuccess || hipDeviceGetAttribute(&cus, hipDeviceAttributeMultiprocessorCount, dev) != hipSuccess) { grid = -1; return; }
        if (hipFuncSetAttribute((const void*)fwd_kernel, hipFuncAttributeMaxDynamicSharedMemorySize, LDS_BYTES) != hipSuccess) { fprintf(stderr, "hipFuncSetAttribute failed\n"); grid = -1; return; }
        int per_cu = 0;
        if (hipOccupancyMaxActiveBlocksPerMultiprocessor(&per_cu, (const void*)fwd_kernel, 512, LDS_BYTES) != hipSuccess || per_cu < 1) fprintf(stderr, "occupancy query: %d\n", per_cu);
        (void)hipGetLastError();
        grid = cus;
        if (ws_size < WS_END) { fprintf(stderr, "workspace too small\n"); grid = -1; return; }
    }
    if (grid < 0) return;
    if (hipMemsetAsync((char*)d_ws + WS_BAR, 0, 16384, stream) != hipSuccess) { fprintf(stderr, "memset failed\n"); return; }
    Args a{};
    const float** p = (const float**)&a;
    for (int i = 0; i < 23; ++i) p[i] = (const float*)d_in[i];
    a.out = (float*)d_out; a.ws = (unsigned char*)d_ws; a.ph_lo = 0; a.ph_hi = 1000;
    void* args[] = {&a};
    hipError_t e = hipLaunchCooperativeKernel((const void*)fwd_kernel, dim3(grid), dim3(512), args, LDS_BYTES, stream);
    if (e != hipSuccess) fprintf(stderr, "cooperative launch failed: %s\n", hipGetErrorString(e));
}
```
